# Optimizing an MI355X kernel written in HIP

```python
import math
import jax, jax.numpy as jnp
from jax import lax
import numpy as np

D_MODEL = 2048
BATCH = 1
SEQ = 8192
DEPTH = 4

DIFF_HEADS = 4
DIFF_QK_DIM = 64
DIFF_V_DIM = 2 * DIFF_QK_DIM
DIFF_WIDTH = DIFF_HEADS * DIFF_V_DIM
DIFF_QK_COLS = DIFF_HEADS * 2 * DIFF_QK_DIM
SWA_Q_HEADS = 8
SWA_KV_HEADS = 2
SWA_GROUP = SWA_Q_HEADS // SWA_KV_HEADS
SWA_HEAD_DIM = 64
SWA_WINDOW = 128
SWA_WIDTH = SWA_Q_HEADS * SWA_HEAD_DIM
SWA_KV_COLS = SWA_KV_HEADS * SWA_HEAD_DIM
RWKV_HEADS = 16
RWKV_HEAD_DIM = 64
RWKV_WIDTH = RWKV_HEADS * RWKV_HEAD_DIM
DECAY_LORA = 96
ICLR_LORA = 96
GATE_LORA = 256
RWKV_COLS = 3 * RWKV_WIDTH + DECAY_LORA + ICLR_LORA + GATE_LORA

MIX_WIDTH = DIFF_WIDTH + SWA_WIDTH + RWKV_WIDTH
IN_COLS = 2 * DIFF_QK_COLS + DIFF_WIDTH + SWA_WIDTH + 2 * SWA_KV_COLS + RWKV_COLS
FFN_HIDDEN = (8 * D_MODEL + 3 * 256 - 1) // (3 * 256) * 256

ALIBI_HEADS = DIFF_HEADS + SWA_Q_HEADS
Q_BLOCK = 128
NORM_EPS = 1e-5
RWKV_GN_EPS = 64e-5
NEG_INF = -1e30

kernel_name = 'hybrid_diffattn_swa_sink_rwkv7_swiglu'


def _split(z, sizes):
    out, start = [], 0
    for s in sizes:
        out.append(z[..., start:start + s])
        start += s
    return out


def rms_norm(x, g):
    xf = x.astype(jnp.float32)
    y = xf * lax.rsqrt(jnp.mean(xf * xf, axis=-1, keepdims=True) + NORM_EPS)
    return (y * g.astype(jnp.float32)).astype(x.dtype)


def alibi_slopes():
    idx = jnp.arange(1, ALIBI_HEADS + 1, dtype=jnp.float32)
    m = jnp.exp2(-8.0 * idx / ALIBI_HEADS)
    diff_idx = np.arange(2, ALIBI_HEADS, 3)
    swa_idx = np.setdiff1d(np.arange(ALIBI_HEADS), diff_idx)
    return m[diff_idx], m[swa_idx]


def token_shift(h, mu):
    prev = jnp.pad(h, ((0, 0), (1, 0), (0, 0)))[:, :-1]
    return h + (prev - h) * mu


def diff_attention(q, k, v, lam, lambda_init, subln_g, slopes):
    b, t = q.shape[:2]
    nblk = t // Q_BLOCK
    qf = q.astype(jnp.float32) * (DIFF_QK_DIM ** -0.5)
    kf = k.astype(jnp.float32)
    vf = v.astype(jnp.float32)
    q_blocks = jnp.moveaxis(qf.reshape(b, nblk, Q_BLOCK, DIFF_HEADS, 2, DIFF_QK_DIM), 1, 0)
    kpos = jnp.arange(t)

    def one_block(args):
        q_blk, blk = args
        s = jnp.einsum('bqhcd,bkhcd->bhcqk', q_blk, kf)
        qpos = blk * Q_BLOCK + jnp.arange(Q_BLOCK)
        dist = qpos[:, None] - kpos[None, :]
        s = s - slopes[None, :, None, None, None] * dist.astype(jnp.float32)
        s = jnp.where(dist >= 0, s, NEG_INF)
        p = jax.nn.softmax(s, axis=-1)
        w = p[:, :, 0] - lam * p[:, :, 1]
        return jnp.einsum('bhqk,bkhe->bqhe', w, vf)

    o = lax.map(one_block, (q_blocks, jnp.arange(nblk)))
    o = jnp.moveaxis(o, 0, 1).reshape(b, t, DIFF_HEADS, DIFF_V_DIM)
    o = o * lax.rsqrt(jnp.mean(o * o, axis=-1, keepdims=True) + NORM_EPS)
    o = o * subln_g.astype(jnp.float32) * (1.0 - lambda_init)
    return o.reshape(b, t, DIFF_WIDTH)


def sliding_window_attention(q, k, v, sinks, slopes):
    b, t = q.shape[:2]
    W = SWA_WINDOW
    nb = t // W
    qb = (q.astype(jnp.float32) * (SWA_HEAD_DIM ** -0.5)).reshape(
        b, nb, W, SWA_KV_HEADS, SWA_GROUP, SWA_HEAD_DIM)

    def band(z):
        zb = z.astype(jnp.float32).reshape(b, nb, W, SWA_KV_HEADS, SWA_HEAD_DIM)
        prev = jnp.pad(zb, ((0, 0), (1, 0), (0, 0), (0, 0), (0, 0)))[:, :-1]
        return jnp.concatenate([prev, zb], axis=2)

    kw, vw = band(k), band(v)
    s = jnp.einsum('bnqhgd,bnkhd->bnhgqk', qb, kw)
    i = jnp.arange(W)
    j = jnp.arange(2 * W)
    dist = i[:, None] + W - j[None, :]
    key_abs = jnp.arange(nb)[:, None, None] * W - W + j[None, None, :]
    valid = (dist >= 0) & (dist < W) & (key_abs >= 0)
    bias = -slopes.reshape(SWA_KV_HEADS, SWA_GROUP)[:, :, None, None] * dist.astype(jnp.float32)
    s = jnp.where(valid[None, :, None, None], s + bias, NEG_INF)
    sink = jnp.broadcast_to(
        sinks.astype(jnp.float32).reshape(SWA_KV_HEADS, SWA_GROUP)[None, None, :, :, None, None],
        s.shape[:-1] + (1,))
    p = jax.nn.softmax(jnp.concatenate([s, sink], axis=-1), axis=-1)[..., :-1]
    o = jnp.einsum('bnhgqk,bnkhd->bnqhgd', p, vw)
    return o.reshape(b, t, SWA_WIDTH)


def wkv7_scan(r, w, k, v, a, bvec):
    b, t, H, N = r.shape

    def step(S, inp):
        r_t, w_t, k_t, v_t, a_t, b_t = inp
        sa = jnp.einsum('bhvk,bhk->bhv', S, a_t)
        S = S * w_t[:, :, None, :] + sa[..., None] * b_t[:, :, None, :] + v_t[..., None] * k_t[:, :, None, :]
        return S, jnp.einsum('bhvk,bhk->bhv', S, r_t)

    xs = tuple(jnp.moveaxis(z, 1, 0) for z in (r, w, k, v, a, bvec))
    S0 = jnp.zeros((b, H, N, N), jnp.float32)
    _, y = lax.scan(step, S0, xs)
    return jnp.moveaxis(y, 0, 1)


def rwkv7_time_mix(feats, w0, w2, a0, a2, g2, k_k, k_a, r_k, ln_w, ln_b):
    b, t = feats.shape[:2]
    H, N = RWKV_HEADS, RWKV_HEAD_DIM
    f32 = jnp.float32
    r, k, v, wl, al, gl = _split(feats.astype(f32),
                                 [RWKV_WIDTH] * 3 + [DECAY_LORA, ICLR_LORA, GATE_LORA])
    logw = -jax.nn.softplus(-(w0.astype(f32) + jnp.tanh(wl) @ w2.astype(f32))) - 0.5
    decay = jnp.exp(-jnp.exp(logw))
    a = jax.nn.sigmoid(a0.astype(f32) + al @ a2.astype(f32))
    g = jax.nn.sigmoid(gl) @ g2.astype(f32)

    def hs(z):
        return z.reshape(b, t, H, N)

    kk = hs(k * k_k.astype(f32))
    kk = kk / jnp.maximum(jnp.sqrt(jnp.sum(kk * kk, axis=-1, keepdims=True)), 1e-12)
    k = k * (1.0 + (a - 1.0) * k_a.astype(f32))
    r4, k4, v4, a4 = hs(r), hs(k), hs(v), hs(a)
    y = wkv7_scan(r4, hs(decay), k4, v4, -kk, kk * a4)
    mu = jnp.mean(y, axis=-1, keepdims=True)
    var = jnp.mean(jnp.square(y - mu), axis=-1, keepdims=True)
    y = ((y - mu) * lax.rsqrt(var + RWKV_GN_EPS)).reshape(b, t, RWKV_WIDTH)
    y = y * ln_w.astype(f32) + ln_b.astype(f32)
    bonus = jnp.sum(r4 * k4 * r_k.astype(f32), axis=-1, keepdims=True) * v4
    y = y + bonus.reshape(b, t, RWKV_WIDTH)
    return y * g


def setup_inputs(seed: int = 0) -> dict:
    key = jax.random.key(seed)
    ks = jax.random.split(key, 22)
    f32 = jnp.float32
    L = DEPTH

    def nrm(k, shape, scale):
        return jax.random.normal(k, shape, f32) * scale

    return {
        'x': nrm(ks[0], (BATCH, SEQ, D_MODEL), 1.0),
        'attn_norm_g': 1.0 + nrm(ks[1], (L, D_MODEL), 0.02),
        'w_in': nrm(ks[2], (L, D_MODEL, IN_COLS), D_MODEL ** -0.5),
        'diff_lambda': nrm(ks[3], (L, 4, DIFF_QK_DIM), 0.1),
        'diff_subln_g': 1.0 + nrm(ks[4], (L, DIFF_V_DIM), 0.02),
        'swa_sinks': nrm(ks[5], (L, SWA_Q_HEADS), 0.5),
        'rwkv_mu': jax.random.uniform(ks[6], (L, RWKV_COLS), f32),
        'rwkv_w0': jax.random.uniform(ks[7], (L, RWKV_WIDTH), f32, minval=-5.0, maxval=0.0),
        'rwkv_w2': nrm(ks[8], (L, DECAY_LORA, RWKV_WIDTH), 0.3 * DECAY_LORA ** -0.5),
        'rwkv_a0': nrm(ks[9], (L, RWKV_WIDTH), 0.2),
        'rwkv_a2': nrm(ks[10], (L, ICLR_LORA, RWKV_WIDTH), 0.3 * ICLR_LORA ** -0.5),
        'rwkv_g2': nrm(ks[11], (L, GATE_LORA, RWKV_WIDTH), GATE_LORA ** -0.5),
        'rwkv_k_k': 0.85 + nrm(ks[12], (L, RWKV_WIDTH), 0.02),
        'rwkv_k_a': 1.0 + nrm(ks[13], (L, RWKV_WIDTH), 0.02),
        'rwkv_r_k': nrm(ks[14], (L, RWKV_HEADS, RWKV_HEAD_DIM), 0.1),
        'rwkv_ln_w': 1.0 + nrm(ks[15], (L, RWKV_WIDTH), 0.02),
        'rwkv_ln_b': nrm(ks[16], (L, RWKV_WIDTH), 0.02),
        'w_out': nrm(ks[17], (L, MIX_WIDTH, D_MODEL), MIX_WIDTH ** -0.5),
        'ffn_norm_g': 1.0 + nrm(ks[18], (L, D_MODEL), 0.02),
        'w_gate_up': nrm(ks[19], (L, D_MODEL, 2 * FFN_HIDDEN), D_MODEL ** -0.5),
        'w_down': nrm(ks[20], (L, FFN_HIDDEN, D_MODEL), FFN_HIDDEN ** -0.5),
        'final_norm_g': 1.0 + nrm(ks[21], (D_MODEL,), 0.02),
    }


def reference(x, attn_norm_g, w_in, diff_lambda, diff_subln_g, swa_sinks, rwkv_mu,
              rwkv_w0, rwkv_w2, rwkv_a0, rwkv_a2, rwkv_g2, rwkv_k_k, rwkv_k_a, rwkv_r_k,
              rwkv_ln_w, rwkv_ln_b, w_out, ffn_norm_g, w_gate_up, w_down, final_norm_g):
    b, t, _ = x.shape
    diff_slopes, swa_slopes = alibi_slopes()
    for l in range(DEPTH):
        h = rms_norm(x, attn_norm_g[l])
        proj = h @ w_in[l]
        qa, ka, va, qb, kb, vb, rw = _split(
            proj, [DIFF_QK_COLS, DIFF_QK_COLS, DIFF_WIDTH, SWA_WIDTH, SWA_KV_COLS, SWA_KV_COLS, RWKV_COLS])

        lambda_init = 0.8 - 0.6 * math.exp(-0.3 * l)
        lamv = diff_lambda[l].astype(jnp.float32)
        lam = jnp.exp(jnp.sum(lamv[0] * lamv[1])) - jnp.exp(jnp.sum(lamv[2] * lamv[3])) + lambda_init
        ya = diff_attention(qa.reshape(b, t, DIFF_HEADS, 2, DIFF_QK_DIM),
                            ka.reshape(b, t, DIFF_HEADS, 2, DIFF_QK_DIM),
                            va.reshape(b, t, DIFF_HEADS, DIFF_V_DIM),
                            lam, lambda_init, diff_subln_g[l], diff_slopes)

        yb = sliding_window_attention(qb.reshape(b, t, SWA_Q_HEADS, SWA_HEAD_DIM),
                                      kb.reshape(b, t, SWA_KV_HEADS, SWA_HEAD_DIM),
                                      vb.reshape(b, t, SWA_KV_HEADS, SWA_HEAD_DIM),
                                      swa_sinks[l], swa_slopes)

        feats = token_shift(rw, rwkv_mu[l])
        yc = rwkv7_time_mix(feats, rwkv_w0[l], rwkv_w2[l], rwkv_a0[l], rwkv_a2[l], rwkv_g2[l],
                            rwkv_k_k[l], rwkv_k_a[l], rwkv_r_k[l], rwkv_ln_w[l], rwkv_ln_b[l])

        mix = jnp.concatenate([ya.astype(x.dtype), yb.astype(x.dtype), yc.astype(x.dtype)], axis=-1)
        x = x + mix @ w_out[l]

        h = rms_norm(x, ffn_norm_g[l])
        gate, up = _split(h @ w_gate_up[l], [FFN_HIDDEN, FFN_HIDDEN])
        x = x + (jax.nn.silu(gate) * up) @ w_down[l]
    return rms_norm(x, final_norm_g)
```

```cpp
#include <hip/hip_runtime.h>
#include <hip/hip_cooperative_groups.h>
#include <cstdio>
#include <cstdint>
namespace cg = cooperative_groups;

#define LAS __attribute__((address_space(3)))
typedef unsigned short bf16_t;
typedef short bf16x8 __attribute__((ext_vector_type(8)));
typedef float f32x4 __attribute__((ext_vector_type(4)));
typedef float f32x2 __attribute__((ext_vector_type(2)));
typedef float f32x16 __attribute__((ext_vector_type(16)));
typedef unsigned u32x4 __attribute__((ext_vector_type(4)));
typedef unsigned u32x2 __attribute__((ext_vector_type(2)));
typedef __bf16 bf16x2_t __attribute__((ext_vector_type(2)));

constexpr int M = 8192, DM = 2048, INC = 5824, INCP = 5888, FF = 5632, GU = 11264, RW0 = 2304, RWC = 3520;
constexpr int NL = 4, NCH = 128, CL = 64;
constexpr float EPS = 1e-5f, LOG2E = 1.4426950408889634f;
constexpr float QSC = 0.125f * LOG2E;

constexpr size_t MiB = 1u << 20;
constexpr size_t SZ_WIN = (size_t)INCP * DM * 2, SZ_WOUT = (size_t)DM * DM * 2, SZ_WGU = (size_t)GU * DM * 2, SZ_WDN = (size_t)DM * FF * 2;
constexpr size_t SZ_W2T = 1024 * 128 * 2, SZ_G2T = 1024 * 256 * 2;
constexpr size_t LW_WIN = 0, LW_WOUT = LW_WIN + SZ_WIN, LW_WGU = LW_WOUT + SZ_WOUT, LW_WDN = LW_WGU + SZ_WGU, LW_W2T = LW_WDN + SZ_WDN,
                 LW_A2T = LW_W2T + SZ_W2T, LW_G2T = LW_A2T + SZ_W2T, LW_STRIDE = LW_G2T + SZ_G2T;
constexpr size_t SZ_F = (size_t)M * 1024 * 4;
constexpr size_t WS_CTL = 0, WS_W = 1 * MiB, WS_XB = WS_W + NL * LW_STRIDE, WS_PROJ = WS_XB + (size_t)M * DM * 2,
                 WS_VAT = WS_PROJ + (size_t)M * INCP * 2, WS_VBT = WS_VAT + (size_t)512 * M * 2, WS_AW = WS_VBT + (size_t)128 * M * 2,
                 WS_AA = WS_AW + (size_t)M * 128 * 2, WS_AG = WS_AA + (size_t)M * 128 * 2, WS_R = WS_AG + (size_t)M * 256 * 2,
                 WS_KR = WS_R + SZ_F, WS_V = WS_KR + SZ_F, WS_DEC = WS_V + SZ_F, WS_A = WS_DEC + SZ_F, WS_G = WS_A + SZ_F,
                 WS_KF = WS_G + SZ_F, WS_AN = WS_KF + SZ_F, WS_BB = WS_AN + SZ_F, WS_PB = WS_BB + SZ_F, WS_UB = WS_PB + SZ_F,
                 WS_SI = WS_UB + SZ_F, WS_OD = WS_SI + SZ_F, WS_MIX = WS_OD + SZ_F, WS_SSQA = WS_MIX + (size_t)M * DM * 2,
                 WS_SSQB = WS_SSQA + (size_t)M * 32 * 4, WS_END = WS_SSQB + (size_t)M * 32 * 4;
constexpr size_t WS_H = WS_PROJ;
static_assert((size_t)M * FF * 2 <= (size_t)M * INCP * 2, "H overlay");

constexpr int LDS_BYTES = 147456;

struct Params { const float* in[22]; float* out; unsigned char* ws; };
typedef const __attribute__((address_space(4))) Params* KP;
__device__ __forceinline__ KP fresh_params() { KP k = (KP)__builtin_amdgcn_kernarg_segment_ptr(); asm volatile("" : "+s"(k)); return k; }

__device__ __forceinline__ unsigned cvtpk(float lo, float hi) { f32x2 v = {lo, hi}; bf16x2_t b = __builtin_convertvector(v, bf16x2_t); return __builtin_bit_cast(unsigned, b); }
__device__ __forceinline__ float bf2f(unsigned short b) { return __builtin_bit_cast(float, (unsigned)b << 16); }
__device__ __forceinline__ float bflo(unsigned w) { return __builtin_bit_cast(float, w << 16); }
__device__ __forceinline__ float bfhi(unsigned w) { return __builtin_bit_cast(float, w & 0xffff0000u); }
template <int CTRL> __device__ __forceinline__ float dppm(float v) { return __builtin_bit_cast(float, __builtin_amdgcn_mov_dpp(__builtin_bit_cast(int, v), CTRL, 0xF, 0xF, true)); }
__device__ __forceinline__ float xor16_sum(float v) { const unsigned b = __builtin_bit_cast(unsigned, v); auto rr = __builtin_amdgcn_permlane16_swap(b, b, false, false); return __builtin_bit_cast(float, (unsigned)rr[0]) + __builtin_bit_cast(float, (unsigned)rr[1]); }
__device__ __forceinline__ float xor32_sum(float v) { const unsigned b = __builtin_bit_cast(unsigned, v); auto rr = __builtin_amdgcn_permlane32_swap(b, b, false, false); return __builtin_bit_cast(float, (unsigned)rr[0]) + __builtin_bit_cast(float, (unsigned)rr[1]); }
__device__ __forceinline__ float xor32_max(float v) { const unsigned b = __builtin_bit_cast(unsigned, v); auto rr = __builtin_amdgcn_permlane32_swap(b, b, false, false); return fmaxf(__builtin_bit_cast(float, (unsigned)rr[0]), __builtin_bit_cast(float, (unsigned)rr[1])); }
__device__ __forceinline__ float row16_sum(float v) { v += dppm<0xB1>(v); v += dppm<0x4E>(v); v += dppm<0x141>(v); v += dppm<0x140>(v); return v; }
__device__ __forceinline__ float wave_sum(float v) { return xor32_sum(xor16_sum(row16_sum(v))); }
__device__ __forceinline__ float dpp_xor1(float v) { return __builtin_bit_cast(float, __builtin_amdgcn_mov_dpp(__builtin_bit_cast(int, v), 0xB1, 0xF, 0xF, true)); }
__device__ __forceinline__ float dpp_xor2(float v) { return __builtin_bit_cast(float, __builtin_amdgcn_mov_dpp(__builtin_bit_cast(int, v), 0x4E, 0xF, 0xF, true)); }
__device__ __forceinline__ float quad_sum(float v) { v += dpp_xor1(v); v += dpp_xor2(v); return v; }
__device__ __forceinline__ float sigmoidf_(float x) { return 1.0f / (1.0f + __expf(-x)); }

__device__ __forceinline__ int fresh_tid(int wave0) { unsigned z = 0u; asm volatile("" : "+v"(z)); int t = wave0 * 64 + (int)__builtin_amdgcn_mbcnt_hi(~0u, __builtin_amdgcn_mbcnt_lo(~0u, z)); asm volatile("" : "+v"(t)); return t; }

__device__ __forceinline__ float row_rstd(const float* ssq, int row, int fq) {
    const float* pp = ssq + (size_t)row * 32 + 8 * fq; const f32x4 a = *(const f32x4*)pp, b = *(const f32x4*)(pp + 4);
    float s = ((a[0] + a[1]) + (a[2] + a[3])) + ((b[0] + b[1]) + (b[2] + b[3]));
    s = xor32_sum(xor16_sum(s));
    return rsqrtf(s * (1.0f / DM) + EPS);
}

namespace pg8 {
constexpr int BM = 256, BK = 64, HALF = 128, HTB = HALF * BK * 2, STAGE_BYTES = 8 * HTB, NXCD = 8, WGM = 8;
__host__ __device__ __forceinline__ int lds_byte(int r, int c) { const int st = (r >> 4) * 2 + (c >> 5), rr = r & 15, cc = c & 31, ob = rr * 64 + cc * 2; return st * 1024 + (ob ^ (((ob >> 9) & 1) << 5)); }
__host__ __device__ __forceinline__ void stage_rc(int b, int& R, int& C) { const int st = b / 1024, sb = b % 1024, swz = sb ^ (((sb >> 9) & 1) << 5); R = (st >> 1) * 16 + swz / 64; C = (st & 1) * 32 + (swz % 64) / 2; }
__host__ __device__ __forceinline__ int perm32(int rho) { const int n = rho >> 4, i = rho & 15; return 8 * (i >> 2) + 4 * n + (i & 3); }
struct Unit { int pm, pn; };
struct Gemm { const bf16_t* A; const bf16_t* Bt; int M, N, K; };
struct StaticOrder {
    int nM, nN, nwg, G, c;
    __host__ __device__ void init(int M_, int N_, int G_, int c_) { nM = M_ / BM; nN = N_ / BM; nwg = nM * nN; G = G_; c = c_; }
    __host__ __device__ bool next(int i, Unit& u) const {
        const long L = (long)i * G + c; if (L >= nwg) return false;
        int wgid = (int)L; { const int q = nwg / NXCD, r = nwg % NXCD, xcd = wgid % NXCD, off = wgid / NXCD; wgid = (xcd < r ? xcd * (q + 1) : r * (q + 1) + (xcd - r) * q) + off; }
        const int nig = WGM * nN, gid = wgid / nig, fm = gid * WGM, gsz = (nM - fm) < WGM ? (nM - fm) : WGM;
        u.pm = fm + ((wgid % nig) % gsz); u.pn = (wgid % nig) / gsz; return true;
    }
};

template <class Epi, class Sched, bool ALIGN_EPI, bool SP2>
__device__ __forceinline__ void gemm_phase(LAS unsigned char* lds, const Gemm g, const Sched& S, const Epi& E, const int tid) {
    const int wid = __builtin_amdgcn_readfirstlane(tid >> 6), lane = tid & 63, wr = wid >> 2, wc = wid & 3, fr = lane & 15, fq = lane >> 4;
    const int K = g.K, nt = K / BK;
    unsigned voffA[2], voffB[2];
#pragma unroll
    for (int i = 0; i < 2; ++i) { int R, C; stage_rc(tid * 16 + i * 8192, R, C); const int Rb = Epi::PERM ? ((R & ~31) + perm32(R & 31)) : R;
        voffA[i] = (unsigned)(R * K + C) * 2u; voffB[i] = (unsigned)(Rb * K + C) * 2u; }
    const size_t kstep = (size_t)(BK * 2);
    const size_t hstep = (size_t)HALF * K * 2;
    const size_t tstep = 2 * hstep;
    const unsigned ldsw = (unsigned)wid * 1024u;
    const int aoff = lds_byte(wr * 64 + fr, fq * 8), boff = lds_byte(wc * 32 + fr, fq * 8);
#define PG8_SA(b, h) (((b) * 2 + (h)) * HTB)
#define PG8_SB(b, h) ((4 + (b) * 2 + (h)) * HTB)
#define PG8_STAGE(bufoff, gbase, voff) do { _Pragma("unroll") for (int _i = 0; _i < 2; ++_i) \
        __builtin_amdgcn_global_load_lds((const unsigned*)((const char*)(gbase) + (voff)[_i]), (LAS unsigned*)(lds + (bufoff) + ldsw + _i * 8192), 16, 0, 0); } while (0)
#define PG8_LDA(dst, b, h) do { _Pragma("unroll") for (int m = 0; m < 4; ++m) _Pragma("unroll") for (int k = 0; k < 2; ++k) dst[m][k] = *(const LAS bf16x8*)(lds + PG8_SA(b, h) + aoff + m * 2048 + k * 1024); } while (0)
#define PG8_LDB(dst, b, h) do { _Pragma("unroll") for (int n = 0; n < 2; ++n) _Pragma("unroll") for (int k = 0; k < 2; ++k) dst[n][k] = *(const LAS bf16x8*)(lds + PG8_SB(b, h) + boff + n * 2048 + k * 1024); } while (0)
#define PG8_MMA(ai, bj, At, Bt) do { __builtin_amdgcn_s_setprio(1); _Pragma("unroll") for (int m = 0; m < 4; ++m) _Pragma("unroll") for (int n = 0; n < 2; ++n) _Pragma("unroll") for (int k = 0; k < 2; ++k) \
        acc[ai][bj][m][n] = __builtin_amdgcn_mfma_f32_16x16x32_bf16(Bt[n][k], At[m][k], acc[ai][bj][m][n], 0, 0, 0); __builtin_amdgcn_s_setprio(0); } while (0)
#define PG8_WAIT_V(n) asm volatile("s_waitcnt vmcnt(" #n ")" ::: "memory")
#define PG8_WAIT_L(n) asm volatile("s_waitcnt lgkmcnt(" #n ")" ::: "memory")
#define PG8_BAR __builtin_amdgcn_s_barrier()
#define PG8_SCHED __builtin_amdgcn_sched_barrier(0)
    Unit cur, nxt; int ui = 0;
    if (!S.next(0, cur)) return;
    f32x4 acc[2][2][4][2];
#pragma unroll
    for (int a = 0; a < 2; ++a)
#pragma unroll
        for (int b = 0; b < 2; ++b)
#pragma unroll
            for (int m = 0; m < 4; ++m)
#pragma unroll
                for (int n = 0; n < 2; ++n) acc[a][b][m][n] = (f32x4){0.f, 0.f, 0.f, 0.f};
    bf16x8 At[4][2], B0[2][2], B1[2][2];
    const char* cA = (const char*)g.A + (size_t)cur.pm * tstep; const char* cB = (const char*)g.Bt + (size_t)cur.pn * tstep;
    if constexpr (SP2) {
        PG8_STAGE(PG8_SB(0, 0), cB, voffB); PG8_STAGE(PG8_SB(0, 1), cB + hstep, voffB); PG8_STAGE(PG8_SA(0, 0), cA, voffA); PG8_STAGE(PG8_SA(0, 1), cA + hstep, voffA);
        if (wr == 1) PG8_BAR;
        PG8_WAIT_V(2); PG8_BAR;
        PG8_STAGE(PG8_SB(1, 0), cB + kstep, voffB); PG8_STAGE(PG8_SA(1, 0), cA + kstep, voffA); PG8_STAGE(PG8_SB(1, 1), cB + hstep + kstep, voffB);
        PG8_WAIT_V(6); PG8_BAR;
    } else {
        PG8_STAGE(PG8_SB(0, 0), cB, voffB); PG8_STAGE(PG8_SA(0, 0), cA, voffA); PG8_STAGE(PG8_SB(0, 1), cB + hstep, voffB); PG8_STAGE(PG8_SA(0, 1), cA + hstep, voffA);
        if (wr == 1) PG8_BAR;
        PG8_WAIT_V(4); PG8_BAR;
        PG8_STAGE(PG8_SB(1, 0), cB + kstep, voffB); PG8_STAGE(PG8_SA(1, 0), cA + kstep, voffA); PG8_STAGE(PG8_SB(1, 1), cB + hstep + kstep, voffB);
        PG8_WAIT_V(6); PG8_BAR;
    }
    for (;;) {
        const bool has_next = S.next(ui + 1, nxt);
        const char* nA = has_next ? (const char*)g.A + (size_t)nxt.pm * tstep : cA; const char* nB = has_next ? (const char*)g.Bt + (size_t)nxt.pn * tstep : cB;
        for (int t = 0; t < nt; t += 2) {
            const bool last = (t == nt - 2);
            const char* a1 = cA + (size_t)(t + 1) * kstep;
            const char* a2 = last ? nA : cA + (size_t)(t + 2) * kstep; const char* b2 = last ? nB : cB + (size_t)(t + 2) * kstep;
            const char* a3 = a2 + kstep; const char* b3 = b2 + kstep;
            if constexpr (SP2) {
            PG8_LDB(B0, 0, 0); PG8_LDB(B1, 0, 1); PG8_SCHED; PG8_LDA(At, 0, 0); PG8_STAGE(PG8_SA(1, 1), a1 + hstep, voffA);
            PG8_WAIT_V(8); PG8_WAIT_L(0); PG8_BAR; PG8_MMA(0, 0, At, B0); PG8_MMA(0, 1, At, B1); PG8_BAR; PG8_SCHED;
            PG8_LDA(At, 0, 1); PG8_STAGE(PG8_SB(0, 0), b2, voffB); PG8_STAGE(PG8_SB(0, 1), b2 + hstep, voffB); PG8_STAGE(PG8_SA(0, 0), a2, voffA);
            PG8_WAIT_V(8); PG8_WAIT_L(0); PG8_BAR; PG8_MMA(1, 0, At, B0); PG8_MMA(1, 1, At, B1); PG8_BAR; PG8_SCHED;
            PG8_LDB(B0, 1, 0); PG8_LDB(B1, 1, 1); PG8_SCHED; PG8_LDA(At, 1, 0); PG8_STAGE(PG8_SA(0, 1), a2 + hstep, voffA);
            PG8_WAIT_V(8); PG8_WAIT_L(0); PG8_BAR; PG8_MMA(0, 0, At, B0); PG8_MMA(0, 1, At, B1); PG8_BAR; PG8_SCHED;
            PG8_LDA(At, 1, 1); PG8_STAGE(PG8_SB(1, 0), b3, voffB); PG8_STAGE(PG8_SB(1, 1), b3 + hstep, voffB); PG8_STAGE(PG8_SA(1, 0), a3, voffA);
            PG8_WAIT_V(8); PG8_WAIT_L(0); PG8_BAR; PG8_MMA(1, 0, At, B0); PG8_MMA(1, 1, At, B1); PG8_BAR; PG8_SCHED;
            } else {
            PG8_LDB(B0, 0, 0); PG8_SCHED; PG8_LDA(At, 0, 0); PG8_STAGE(PG8_SA(1, 1), a1 + hstep, voffA);
            PG8_WAIT_L(8); PG8_BAR; PG8_WAIT_L(0); PG8_MMA(0, 0, At, B0); PG8_BAR; PG8_SCHED;
            PG8_LDB(B1, 0, 1); PG8_STAGE(PG8_SB(0, 0), b2, voffB);
            PG8_BAR; PG8_WAIT_L(0); PG8_MMA(0, 1, At, B1); PG8_BAR;
            PG8_LDA(At, 0, 1); PG8_STAGE(PG8_SA(0, 0), a2, voffA);
            PG8_BAR; PG8_WAIT_L(0); PG8_MMA(1, 0, At, B0); PG8_BAR; PG8_SCHED;
            PG8_STAGE(PG8_SB(0, 1), b2 + hstep, voffB);
            PG8_WAIT_V(6); PG8_BAR; PG8_MMA(1, 1, At, B1); PG8_BAR;
            PG8_LDB(B0, 1, 0); PG8_SCHED; PG8_LDA(At, 1, 0); PG8_STAGE(PG8_SA(0, 1), a2 + hstep, voffA);
            PG8_WAIT_L(8); PG8_BAR; PG8_WAIT_L(0); PG8_MMA(0, 0, At, B0); PG8_BAR; PG8_SCHED;
            PG8_LDB(B1, 1, 1); PG8_STAGE(PG8_SB(1, 0), b3, voffB);
            PG8_BAR; PG8_WAIT_L(0); PG8_MMA(0, 1, At, B1); PG8_BAR;
            PG8_LDA(At, 1, 1); PG8_STAGE(PG8_SA(1, 0), a3, voffA);
            PG8_BAR; PG8_WAIT_L(0); PG8_MMA(1, 0, At, B0); PG8_BAR; PG8_SCHED;
            PG8_STAGE(PG8_SB(1, 1), b3 + hstep, voffB);
            PG8_WAIT_V(6); PG8_BAR; PG8_MMA(1, 1, At, B1); PG8_BAR;
            }
        }
        if constexpr (ALIGN_EPI) { if (wr == 0) PG8_BAR; }
        E(acc, cur, wr, wc, fr, fq);
        if (!has_next) break;
#pragma unroll
        for (int a = 0; a < 2; ++a)
#pragma unroll
            for (int b = 0; b < 2; ++b)
#pragma unroll
                for (int m = 0; m < 4; ++m)
#pragma unroll
                    for (int n = 0; n < 2; ++n) acc[a][b][m][n] = (f32x4){0.f, 0.f, 0.f, 0.f};
        cur = nxt; cA = nA; cB = nB; ++ui;
        if constexpr (ALIGN_EPI) { if (wr == 1) PG8_BAR; }
    }
    PG8_WAIT_V(0);
    if constexpr (!ALIGN_EPI) { if (wr == 0) PG8_BAR; }
    PG8_BAR;
#undef PG8_SA
#undef PG8_SB
#undef PG8_STAGE
#undef PG8_LDA
#undef PG8_LDB
#undef PG8_MMA
#undef PG8_WAIT_V
#undef PG8_WAIT_L
#undef PG8_BAR
#undef PG8_SCHED
}

struct EpiProj {
    static constexpr bool PERM = true;
    bf16_t* O; int ldc; const float* ssq;
    __device__ __forceinline__ void operator()(const f32x4 (&acc)[2][2][4][2], const Unit& u, int wr, int wc, int fr, int fq) const {
        const int row0 = u.pm * BM + wr * 64 + fr, col0 = u.pn * BM + wc * 32 + 8 * fq;
#pragma unroll
        for (int ai = 0; ai < 2; ++ai)
#pragma unroll
            for (int m = 0; m < 4; ++m) { const int row = row0 + ai * HALF + m * 16; const float rs = row_rstd(ssq, row, fq);
                bf16_t* rowp = O + (size_t)row * ldc + col0;
#pragma unroll
                for (int bj = 0; bj < 2; ++bj) { const f32x4 v0 = acc[ai][bj][m][0] * rs, v1 = acc[ai][bj][m][1] * rs;
                    u32x4 w; w.x = cvtpk(v0[0], v0[1]); w.y = cvtpk(v0[2], v0[3]); w.z = cvtpk(v1[0], v1[1]); w.w = cvtpk(v1[2], v1[3]);
                    *(u32x4*)(rowp + bj * HALF) = w; } }
    }
};
struct EpiSwiGLU {
    static constexpr bool PERM = true;
    bf16_t* O; const float* ssq;
    __device__ __forceinline__ void operator()(const f32x4 (&acc)[2][2][4][2], const Unit& u, int wr, int wc, int fr, int fq) const {
        const int row0 = u.pm * BM + wr * 64 + fr, col0 = u.pn * HALF + wc * 32 + 8 * fq;
#pragma unroll
        for (int ai = 0; ai < 2; ++ai)
#pragma unroll
            for (int m = 0; m < 4; ++m) { const int row = row0 + ai * HALF + m * 16; const float rs = row_rstd(ssq, row, fq);
                float h[8];
#pragma unroll
                for (int n = 0; n < 2; ++n)
#pragma unroll
                    for (int j = 0; j < 4; ++j) { const float gt = acc[ai][0][m][n][j] * rs, up = acc[ai][1][m][n][j] * rs; h[n * 4 + j] = gt * up / (1.0f + __expf(-gt)); }
                u32x4 w; w.x = cvtpk(h[0], h[1]); w.y = cvtpk(h[2], h[3]); w.z = cvtpk(h[4], h[5]); w.w = cvtpk(h[6], h[7]);
                *(u32x4*)(O + (size_t)row * FF + col0) = w; }
    }
};
struct EpiResid {
    static constexpr bool PERM = false;
    float* X; bf16_t* XB; float* ssq;
    __device__ __forceinline__ void operator()(const f32x4 (&acc)[2][2][4][2], const Unit& u, int wr, int wc, int fr, int fq) const {
        const int row0 = u.pm * BM + wr * 64 + fr, col0 = u.pn * BM + wc * 32 + 4 * fq;
#pragma unroll
        for (int ai = 0; ai < 2; ++ai)
#pragma unroll
            for (int m = 0; m < 4; ++m) { const int row = row0 + ai * HALF + m * 16; const size_t off = (size_t)row * DM + col0; float ss = 0.f;
#pragma unroll
                for (int bj = 0; bj < 2; ++bj)
#pragma unroll
                    for (int n = 0; n < 2; ++n) { const size_t o = off + bj * HALF + n * 16; const f32x4 xv = *(const f32x4*)(X + o) + acc[ai][bj][m][n];
                        *(f32x4*)(X + o) = xv; u32x2 w; w.x = cvtpk(xv[0], xv[1]); w.y = cvtpk(xv[2], xv[3]); *(u32x2*)(XB + o) = w;
                        ss += (xv[0] * xv[0] + xv[1] * xv[1]) + (xv[2] * xv[2] + xv[3] * xv[3]); }
                ss = xor32_sum(xor16_sum(ss));
                if (fq == 0) ssq[(size_t)row * 32 + u.pn * 4 + wc] = ss; }
    }
};
template <int MODE> struct EpiLora {
    static constexpr bool PERM = false;
    float* O; const float* bias;
    __device__ __forceinline__ void operator()(const f32x4 (&acc)[2][2][4][2], const Unit& u, int wr, int wc, int fr, int fq) const {
        const int row0 = u.pm * BM + wr * 64 + fr, col0 = u.pn * BM + wc * 32 + 4 * fq;
#pragma unroll
        for (int bj = 0; bj < 2; ++bj)
#pragma unroll
            for (int n = 0; n < 2; ++n) { const int col = col0 + bj * HALF + n * 16;
                f32x4 bv = (f32x4){0.f, 0.f, 0.f, 0.f}; if (MODE != 2) bv = *(const f32x4*)(bias + col);
#pragma unroll
                for (int ai = 0; ai < 2; ++ai)
#pragma unroll
                    for (int m = 0; m < 4; ++m) { const int row = row0 + ai * HALF + m * 16; f32x4 v = acc[ai][bj][m][n] + bv;
                        if (MODE == 0) {
#pragma unroll
                            for (int j = 0; j < 4; ++j) { const float z = -v[j]; const float sp = fmaxf(z, 0.f) + log1pf(__expf(-fabsf(z))); v[j] = __expf(-__expf(-sp - 0.5f)); }
                        } else if (MODE == 1) {
#pragma unroll
                            for (int j = 0; j < 4; ++j) v[j] = sigmoidf_(v[j]);
                        }
                        *(f32x4*)(O + (size_t)row * 1024 + col) = v; } }
    }
};
}

template <int MAP>
__device__ __forceinline__ void transpose_item(const float* W, int K, int N, bf16_t* WT, const float* gk, LAS float* scr, int item, int lane) {
    const int nblk = N / 32, kb = item / nblk, nb = item % nblk, k0 = 64 * kb, n0 = 32 * nb;
#pragma unroll 8
    for (int i = 0; i < 32; ++i) { const int kk = 2 * i + (lane >> 5); float v = W[(size_t)(k0 + kk) * N + n0 + (lane & 31)]; if (gk) v *= gk[k0 + kk]; scr[kk * 33 + (lane & 31)] = v; }
    asm volatile("s_waitcnt lgkmcnt(0)" ::: "memory");
    const int c = lane & 7;
#pragma unroll
    for (int j = 0; j < 4; ++j) { const int n = n0 + (lane >> 3) + 8 * j; const LAS float* s = scr + (8 * c) * 33 + (n - n0);
        float sc = 1.f; int drow = n;
        if (MAP == 0) { if (n < 512 || (n >= 1536 && n < 2048)) sc = QSC; }
        if (MAP == 1) { const int hn = n < FF ? n : n - FF; drow = (hn >> 7) * 256 + (n < FF ? 0 : 128) + (hn & 127); }
        u32x4 o; o.x = cvtpk(s[0 * 33] * sc, s[1 * 33] * sc); o.y = cvtpk(s[2 * 33] * sc, s[3 * 33] * sc); o.z = cvtpk(s[4 * 33] * sc, s[5 * 33] * sc); o.w = cvtpk(s[6 * 33] * sc, s[7 * 33] * sc);
        *(u32x4*)(WT + (size_t)drow * K + k0 + 8 * c) = o; }
    asm volatile("s_waitcnt lgkmcnt(0)" ::: "memory");
}

__device__ __forceinline__ void phase0(KP p, LAS unsigned char* lds, int gw, int NGW, int wave, int lane) {
    LAS float* scr = (LAS float*)(lds + wave * 16384);
    constexpr int I_IN = (DM / 64) * (INC / 32), I_OUT = (DM / 64) * (DM / 32), I_GU = (DM / 64) * (GU / 32), I_DN = (FF / 64) * (DM / 32);
    constexpr int I_L = I_IN + I_OUT + I_GU + I_DN;
    for (int it = gw; it < NL * I_L; it += NGW) {
        const int l = it / I_L; int r = it % I_L; unsigned char* wb = p->ws + WS_W + (size_t)l * LW_STRIDE;
        if (r < I_IN) { transpose_item<0>(p->in[2] + (size_t)l * DM * INC, DM, INC, (bf16_t*)(wb + LW_WIN), p->in[1] + l * DM, scr, r, lane); continue; } r -= I_IN;
        if (r < I_OUT) { transpose_item<2>(p->in[17] + (size_t)l * DM * DM, DM, DM, (bf16_t*)(wb + LW_WOUT), nullptr, scr, r, lane); continue; } r -= I_OUT;
        if (r < I_GU) { transpose_item<1>(p->in[19] + (size_t)l * DM * GU, DM, GU, (bf16_t*)(wb + LW_WGU), p->in[18] + l * DM, scr, r, lane); continue; } r -= I_GU;
        transpose_item<2>(p->in[20] + (size_t)l * FF * DM, FF, DM, (bf16_t*)(wb + LW_WDN), nullptr, scr, r, lane);
    }
    const int gt = gw * 64 + lane, NGT = NGW * 64;
    for (int l = 0; l < NL; ++l) {
        unsigned char* wb = p->ws + WS_W + (size_t)l * LW_STRIDE;
        bf16_t* w2t = (bf16_t*)(wb + LW_W2T); bf16_t* a2t = (bf16_t*)(wb + LW_A2T); bf16_t* g2t = (bf16_t*)(wb + LW_G2T);
        const float* w2 = p->in[8] + (size_t)l * 96 * 1024; const float* a2 = p->in[10] + (size_t)l * 96 * 1024; const float* g2 = p->in[11] + (size_t)l * 256 * 1024;
        for (int i = gt; i < 1024 * 128; i += NGT) { const int n = i >> 7, k = i & 127;
            w2t[i] = (bf16_t)(cvtpk(k < 96 ? w2[k * 1024 + n] : 0.f, 0.f) & 0xffff); a2t[i] = (bf16_t)(cvtpk(k < 96 ? a2[k * 1024 + n] : 0.f, 0.f) & 0xffff); }
        for (int i = gt; i < 1024 * 256; i += NGT) { const int n = i >> 8, k = i & 255; g2t[i] = (bf16_t)(cvtpk(g2[k * 1024 + n], 0.f) & 0xffff); }
        unsigned* padz = (unsigned*)(wb + LW_WIN + (size_t)INC * DM * 2);
        for (int i = gt; i < (INCP - INC) * DM / 2; i += NGT) padz[i] = 0u;
    }
    const float* x = p->in[0]; float* X = p->out; bf16_t* XB = (bf16_t*)(p->ws + WS_XB); float* ssqA = (float*)(p->ws + WS_SSQA);
    for (int m = gw; m < M; m += NGW) { float ss = 0.f;
#pragma unroll
        for (int j = 0; j < 8; ++j) { const size_t o = (size_t)m * DM + j * 256 + lane * 4; const f32x4 v = *(const f32x4*)(x + o); *(f32x4*)(X + o) = v;
            u32x2 w; w.x = cvtpk(v[0], v[1]); w.y = cvtpk(v[2], v[3]); *(u32x2*)(XB + o) = w; ss += (v[0] * v[0] + v[1] * v[1]) + (v[2] * v[2] + v[3] * v[3]); }
        ss = wave_sum(ss); if (lane < 32) ssqA[(size_t)m * 32 + lane] = lane == 0 ? ss : 0.f; }
}

__device__ __forceinline__ void phase_prep1(KP p, int l, LAS unsigned char* lds, int gw, int NGW, int wave, int lane) {
    const bf16_t* PROJ = (const bf16_t*)(p->ws + WS_PROJ);
    LAS unsigned short* tile = (LAS unsigned short*)(lds + wave * 8448);
    bf16_t* VAT = (bf16_t*)(p->ws + WS_VAT); bf16_t* VBT = (bf16_t*)(p->ws + WS_VBT);
    for (int it = gw; it < 128 * 10; it += NGW) {
        const int tb = it / 10, g = it % 10, t0 = tb * 64; const int cbase = g < 8 ? 1024 + 64 * g : 2176 + 64 * (g - 8);
        bf16_t* dst = g < 8 ? VAT + (size_t)(64 * g) * M : VBT + (size_t)(64 * (g - 8)) * M;
#pragma unroll
        for (int i = 0; i < 8; ++i) { const int row = i * 8 + (lane >> 3), ch = lane & 7; const u32x4 v = *(const u32x4*)(PROJ + (size_t)(t0 + row) * INCP + cbase + 8 * ch);
            LAS unsigned* d = (LAS unsigned*)(tile + row * 66 + 8 * ch); d[0] = v.x; d[1] = v.y; d[2] = v.z; d[3] = v.w; }
        asm volatile("s_waitcnt lgkmcnt(0)" ::: "memory");
#pragma unroll
        for (int i = 0; i < 8; ++i) { const int c = i * 8 + (lane >> 3), tch = lane & 7, j = tch >> 1, hi = tch & 1; unsigned short v[8];
#pragma unroll
            for (int s = 0; s < 8; ++s) v[s] = tile[(16 * j + (s & 3) + 8 * (s >> 2) + 4 * hi) * 66 + c];
            u32x4 o; o.x = v[0] | ((unsigned)v[1] << 16); o.y = v[2] | ((unsigned)v[3] << 16); o.z = v[4] | ((unsigned)v[5] << 16); o.w = v[6] | ((unsigned)v[7] << 16);
            *(u32x4*)(dst + (size_t)c * M + t0 + 16 * j + 8 * hi) = o; }
        asm volatile("s_waitcnt lgkmcnt(0)" ::: "memory");
    }
    const float* mu = p->in[6] + (size_t)l * RWC;
    float* R = (float*)(p->ws + WS_R); float* KR = (float*)(p->ws + WS_KR); float* V = (float*)(p->ws + WS_V);
    bf16_t* AW = (bf16_t*)(p->ws + WS_AW); bf16_t* AA = (bf16_t*)(p->ws + WS_AA); bf16_t* AG = (bf16_t*)(p->ws + WS_AG);
    for (int t = gw; t < M; t += NGW) {
        const bf16_t* cur = PROJ + (size_t)t * INCP + RW0;
        for (int it = 0; it < 7; ++it) { const int ch = it * 64 + lane; if (ch >= 440) break; const int j0 = ch * 8;
            const u32x4 c4 = *(const u32x4*)(cur + j0); u32x4 p4 = (u32x4){0u, 0u, 0u, 0u}; if (t > 0) p4 = *(const u32x4*)(cur - INCP + j0);
            const f32x4 m0 = *(const f32x4*)(mu + j0), m1 = *(const f32x4*)(mu + j0 + 4);
            float f[8]; const unsigned cw[4] = {c4.x, c4.y, c4.z, c4.w}, pw[4] = {p4.x, p4.y, p4.z, p4.w};
#pragma unroll
            for (int q = 0; q < 4; ++q) { const float c0 = bflo(cw[q]), c1 = bfhi(cw[q]), p0 = bflo(pw[q]), p1 = bfhi(pw[q]);
                const float mu0 = q < 2 ? m0[2 * q] : m1[2 * q - 4], mu1 = q < 2 ? m0[2 * q + 1] : m1[2 * q - 3];
                f[2 * q] = c0 + (p0 - c0) * mu0; f[2 * q + 1] = c1 + (p1 - c1) * mu1; }
            if (j0 < 3072) { float* dstp = (j0 < 1024 ? R + j0 : j0 < 2048 ? KR + (j0 - 1024) : V + (j0 - 2048)) + (size_t)t * 1024;
                *(f32x4*)dstp = (f32x4){f[0], f[1], f[2], f[3]}; *(f32x4*)(dstp + 4) = (f32x4){f[4], f[5], f[6], f[7]}; }
            else { bf16_t* dstp;
                if (j0 < 3168) { dstp = AW + (size_t)t * 128 + (j0 - 3072);
#pragma unroll
                    for (int q = 0; q < 8; ++q) f[q] = tanhf(f[q]); }
                else if (j0 < 3264) { dstp = AA + (size_t)t * 128 + (j0 - 3168); }
                else { dstp = AG + (size_t)t * 256 + (j0 - 3264);
#pragma unroll
                    for (int q = 0; q < 8; ++q) f[q] = sigmoidf_(f[q]); }
                u32x4 o; o.x = cvtpk(f[0], f[1]); o.y = cvtpk(f[2], f[3]); o.z = cvtpk(f[4], f[5]); o.w = cvtpk(f[6], f[7]); *(u32x4*)dstp = o; }
        }
        if (lane < 4) *(u32x4*)(AW + (size_t)t * 128 + 96 + 8 * lane) = (u32x4){0u, 0u, 0u, 0u};
        else if (lane < 8) *(u32x4*)(AA + (size_t)t * 128 + 96 + 8 * (lane - 4)) = (u32x4){0u, 0u, 0u, 0u};
    }
}

__device__ __forceinline__ void phase_prep2(KP p, int l, int gw, int NGW, int lane) {
    const float* KR = (const float*)(p->ws + WS_KR); const float* A = (const float*)(p->ws + WS_A);
    float* KF = (float*)(p->ws + WS_KF); float* AN = (float*)(p->ws + WS_AN); float* BB = (float*)(p->ws + WS_BB);
    const float* k_k = p->in[12] + l * 1024; const float* k_a = p->in[13] + l * 1024;
    const int c0 = 16 * lane;
    for (int t = gw; t < M; t += NGW) { const size_t o = (size_t)t * 1024 + c0; float n2 = 0.f; f32x4 kkv[4], kr[4], av[4];
#pragma unroll
        for (int q = 0; q < 4; ++q) { kr[q] = *(const f32x4*)(KR + o + 4 * q); av[q] = *(const f32x4*)(A + o + 4 * q); kkv[q] = kr[q] * *(const f32x4*)(k_k + c0 + 4 * q);
            n2 += (kkv[q][0] * kkv[q][0] + kkv[q][1] * kkv[q][1]) + (kkv[q][2] * kkv[q][2] + kkv[q][3] * kkv[q][3]); }
        n2 = quad_sum(n2); const float inv = 1.0f / fmaxf(sqrtf(n2), 1e-12f);
#pragma unroll
        for (int q = 0; q < 4; ++q) { const f32x4 kk = kkv[q] * inv; const f32x4 ka = *(const f32x4*)(k_a + c0 + 4 * q);
            *(f32x4*)(KF + o + 4 * q) = kr[q] * (1.0f + (av[q] - 1.0f) * ka); *(f32x4*)(AN + o + 4 * q) = -kk; *(f32x4*)(BB + o + 4 * q) = kk * av[q]; }
    }
}

template <int MODE>
__device__ __forceinline__ void scan_task(KP p, int l, LAS unsigned char* wl, int c, int h, int lane) {
    constexpr int NV = MODE == 0 ? 3 : (MODE == 1 ? 5 : 6);
    constexpr int SB = 4;
    LAS float* vec = (LAS float*)wl;
    LAS float* ybuf = (LAS float*)(wl + 6 * SB * 256);
    const float* src[6] = {(const float*)(p->ws + WS_DEC), (const float*)(p->ws + WS_AN), (const float*)(p->ws + WS_BB), (const float*)(p->ws + WS_KF), (const float*)(p->ws + WS_V), (const float*)(p->ws + WS_R)};
    const int rb = lane >> 2, cb = lane & 3, t0 = c * CL;
    f32x2 s[4][8];
    if (MODE == 0) {
#pragma unroll
        for (int r = 0; r < 4; ++r)
#pragma unroll
            for (int q = 0; q < 8; ++q) { s[r][q].x = (4 * rb + r == 16 * cb + 2 * q) ? 1.f : 0.f; s[r][q].y = (4 * rb + r == 16 * cb + 2 * q + 1) ? 1.f : 0.f; }
    } else if (MODE == 1) {
#pragma unroll
        for (int r = 0; r < 4; ++r)
#pragma unroll
            for (int q = 0; q < 8; ++q) s[r][q] = (f32x2){0.f, 0.f};
    } else {
        const float* SI = (const float*)(p->ws + WS_SI) + ((size_t)(h * NCH + c)) * 4096;
#pragma unroll
        for (int r = 0; r < 4; ++r)
#pragma unroll
            for (int q = 0; q < 4; ++q) { const f32x4 v = *(const f32x4*)(SI + (4 * rb + r) * 64 + 16 * cb + 4 * q); s[r][2 * q] = (f32x2){v[0], v[1]}; s[r][2 * q + 1] = (f32x2){v[2], v[3]}; }
    }
    float lnw = 0.f, lnb = 0.f, rk = 0.f;
    if (MODE == 2) { lnw = p->in[15][l * 1024 + 64 * h + lane]; lnb = p->in[16][l * 1024 + 64 * h + lane]; rk = p->in[14][l * 1024 + 64 * h + lane]; }
    const int lst = lane >> 4, lq = lane & 15;
    const size_t goff = (size_t)(t0 + lst) * 1024 + 64 * h + 4 * lq;
    f32x4 pre[NV];
#pragma unroll
    for (int v = 0; v < NV; ++v) pre[v] = *(const f32x4*)(src[v] + goff);
    for (int sb = 0; sb < CL / SB; ++sb) {
#pragma unroll
        for (int v = 0; v < NV; ++v) *(LAS f32x4*)(vec + (v * SB + lst) * 64 + 4 * lq) = pre[v];
        if (sb + 1 < CL / SB) {
#pragma unroll
            for (int v = 0; v < NV; ++v) pre[v] = *(const f32x4*)(src[v] + goff + (size_t)(SB * (sb + 1)) * 1024);
        }
#pragma unroll 1
        for (int st = 0; st < SB; ++st) {
            const LAS float* vb = vec + st * 64 + 16 * cb;
            float sa[4];
            {   f32x2 a2[8];
#pragma unroll
                for (int q = 0; q < 4; ++q) { const f32x4 y = *(const LAS f32x4*)(vb + 1 * SB * 64 + 4 * q); a2[2 * q] = (f32x2){y[0], y[1]}; a2[2 * q + 1] = (f32x2){y[2], y[3]}; }
#pragma unroll
                for (int r = 0; r < 4; ++r) { f32x2 a = s[r][0] * a2[0];
#pragma unroll
                    for (int q = 1; q < 8; ++q) a = s[r][q] * a2[q] + a;
                    sa[r] = quad_sum(a.x + a.y); } }
            f32x4 vv = (f32x4){0.f, 0.f, 0.f, 0.f};
            if (MODE != 0) vv = *(const LAS f32x4*)(vec + (4 * SB + st) * 64 + 4 * rb);
#pragma unroll
            for (int q = 0; q < 4; ++q) { const f32x4 w4 = *(const LAS f32x4*)(vb + 0 * SB * 64 + 4 * q), b4 = *(const LAS f32x4*)(vb + 2 * SB * 64 + 4 * q);
                const f32x2 w0 = (f32x2){w4[0], w4[1]}, w1 = (f32x2){w4[2], w4[3]}, b0 = (f32x2){b4[0], b4[1]}, b1 = (f32x2){b4[2], b4[3]};
                if (MODE == 0) {
#pragma unroll
                    for (int r = 0; r < 4; ++r) { s[r][2 * q] = s[r][2 * q] * w0 + b0 * sa[r]; s[r][2 * q + 1] = s[r][2 * q + 1] * w1 + b1 * sa[r]; }
                } else { const f32x4 k4 = *(const LAS f32x4*)(vb + 3 * SB * 64 + 4 * q); const f32x2 k0 = (f32x2){k4[0], k4[1]}, k1 = (f32x2){k4[2], k4[3]};
#pragma unroll
                    for (int r = 0; r < 4; ++r) { s[r][2 * q] = s[r][2 * q] * w0 + (b0 * sa[r] + k0 * vv[r]); s[r][2 * q + 1] = s[r][2 * q + 1] * w1 + (b1 * sa[r] + k1 * vv[r]); }
                } }
            if (MODE == 2) {
                f32x2 r2[8];
#pragma unroll
                for (int q = 0; q < 4; ++q) { const f32x4 x = *(const LAS f32x4*)(vb + 5 * SB * 64 + 4 * q); r2[2 * q] = (f32x2){x[0], x[1]}; r2[2 * q + 1] = (f32x2){x[2], x[3]}; }
                f32x4 yv;
#pragma unroll
                for (int r = 0; r < 4; ++r) { f32x2 a = s[r][0] * r2[0];
#pragma unroll
                    for (int q = 1; q < 8; ++q) a = s[r][q] * r2[q] + a;
                    yv[r] = quad_sum(a.x + a.y); }
                if (cb == 0) *(LAS f32x4*)(ybuf + st * 64 + 4 * rb) = yv;
            }
        }
        if (MODE == 2) {
            const float* G = (const float*)(p->ws + WS_G); bf16_t* MIX = (bf16_t*)(p->ws + WS_MIX);
#pragma unroll 1
            for (int st = 0; st < SB; ++st) { const int t = t0 + SB * sb + st;
                const float y = ybuf[st * 64 + lane]; const float rr = vec[(5 * SB + st) * 64 + lane], kk = vec[(3 * SB + st) * 64 + lane], vv = vec[(4 * SB + st) * 64 + lane];
                const float mean = wave_sum(y) * (1.0f / 64.0f); const float d = y - mean; const float var = wave_sum(d * d) * (1.0f / 64.0f);
                const float bon = wave_sum(rr * kk * rk);
                const float g = G[(size_t)t * 1024 + 64 * h + lane];
                const float o = (d * rsqrtf(var + 64e-5f) * lnw + lnb + bon * vv) * g;
                MIX[(size_t)t * DM + 1024 + 64 * h + lane] = (bf16_t)(cvtpk(o, 0.f) & 0xffff); }
        }
    }
    if (MODE != 2) { float* dst = (float*)(p->ws + (MODE == 0 ? WS_PB : WS_UB)) + ((size_t)(h * NCH + c)) * 4096;
#pragma unroll
        for (int r = 0; r < 4; ++r)
#pragma unroll
            for (int q = 0; q < 4; ++q) *(f32x4*)(dst + (4 * rb + r) * 64 + 16 * cb + 4 * q) = (f32x4){s[r][2 * q].x, s[r][2 * q].y, s[r][2 * q + 1].x, s[r][2 * q + 1].y}; }
}

__device__ __forceinline__ void s2_head(KP p, LAS unsigned char* lds, int h, const int tid) {
    LAS float* sS = (LAS float*)lds;
    LAS float* sP = (LAS float*)(lds + 17408);
    const float* PB = (const float*)(p->ws + WS_PB) + (size_t)h * NCH * 4096; const float* UB = (const float*)(p->ws + WS_UB) + (size_t)h * NCH * 4096;
    float* SI = (float*)(p->ws + WS_SI) + (size_t)h * NCH * 4096;
    const int i = tid >> 3, kq = tid & 7;
    f32x4 s0 = (f32x4){0.f, 0.f, 0.f, 0.f}, s1 = s0;
    f32x4 pr0 = *(const f32x4*)(PB + tid * 8), pr1 = *(const f32x4*)(PB + tid * 8 + 4);
    f32x4 u0 = *(const f32x4*)(UB + i * 64 + 8 * kq), u1 = *(const f32x4*)(UB + i * 64 + 8 * kq + 4);
    for (int c = 0; c < NCH; ++c) {
        float* si = SI + (size_t)c * 4096 + i * 64 + 8 * kq;
        *(f32x4*)si = s0; *(f32x4*)(si + 4) = s1;
        if (c == NCH - 1) break;
        *(LAS f32x4*)(sS + i * 68 + 8 * kq) = s0; *(LAS f32x4*)(sS + i * 68 + 8 * kq + 4) = s1;
        *(LAS f32x4*)(sP + tid * 8) = pr0; *(LAS f32x4*)(sP + tid * 8 + 4) = pr1;
        f32x4 a0 = u0, a1 = u1;
        __syncthreads();
        if (c + 2 < NCH) { const size_t nb = (size_t)(c + 1) * 4096; pr0 = *(const f32x4*)(PB + nb + tid * 8); pr1 = *(const f32x4*)(PB + nb + tid * 8 + 4);
            u0 = *(const f32x4*)(UB + nb + i * 64 + 8 * kq); u1 = *(const f32x4*)(UB + nb + i * 64 + 8 * kq + 4); }
#pragma unroll 4
        for (int j = 0; j < 64; j += 4) { const f32x4 sv = *(const LAS f32x4*)(sS + i * 68 + j);
#pragma unroll
            for (int jj = 0; jj < 4; ++jj) { const f32x4 p0 = *(const LAS f32x4*)(sP + (j + jj) * 64 + 8 * kq), p1 = *(const LAS f32x4*)(sP + (j + jj) * 64 + 8 * kq + 4);
                a0 += p0 * sv[jj]; a1 += p1 * sv[jj]; } }
        __syncthreads();
        s0 = a0; s1 = a1;
    }
    __syncthreads();
}

template <int DV, bool SWA>
__device__ __forceinline__ void attn_unit(LAS unsigned char* lds, const bf16_t* Q, const bf16_t* Kp, const bf16_t* VT, float slope2, int q0, float sink2,
                                          float* Of32, bf16_t* Obf, const int tid) {
    constexpr int KROW = 144, KTILE = 64 * KROW, VTILE = DV * KROW, BUF = KTILE + VTILE, NVL = DV / 64;
    const int lane = tid & 63, w = __builtin_amdgcn_readfirstlane(tid >> 6), r32 = lane & 31, hi = lane >> 5;
    const int qpos = q0 + 32 * w + r32;
    bf16x8 qf[4];
#pragma unroll
    for (int j = 0; j < 4; ++j) qf[j] = *(const bf16x8*)(Q + (size_t)qpos * INCP + 16 * j + 8 * hi);
    const int kt0 = SWA ? (q0 >= 128 ? (q0 - 128) / 64 : 0) : 0, kt1 = (q0 + 255) / 64;
    const int qlo = q0 + 32 * w, qhi = qlo + 31;
    f32x16 o[DV / 32];
#pragma unroll
    for (int d = 0; d < DV / 32; ++d)
#pragma unroll
        for (int r = 0; r < 16; ++r) o[d][r] = 0.f;
    float mrun = -1e30f, lsum = 0.f;
    const int krow = tid >> 3, kch = tid & 7;
    u32x4 kreg, vreg[NVL];
    {   const int k0 = 64 * kt0; kreg = *(const u32x4*)(Kp + (size_t)(k0 + krow) * INCP + 8 * kch);
#pragma unroll
        for (int i = 0; i < NVL; ++i) { const int idx = tid + 512 * i; vreg[i] = *(const u32x4*)(VT + (size_t)(idx >> 3) * M + k0 + 8 * (idx & 7)); } }
    for (int kt = kt0; kt <= kt1; ++kt) {
        LAS unsigned char* buf = lds + ((kt - kt0) & 1) * BUF;
        *(LAS u32x4*)(buf + krow * KROW + 16 * kch) = kreg;
#pragma unroll
        for (int i = 0; i < NVL; ++i) { const int idx = tid + 512 * i; *(LAS u32x4*)(buf + KTILE + (idx >> 3) * KROW + 16 * (idx & 7)) = vreg[i]; }
        __syncthreads();
        if (kt < kt1) { const int k0 = 64 * (kt + 1); kreg = *(const u32x4*)(Kp + (size_t)(k0 + krow) * INCP + 8 * kch);
#pragma unroll
            for (int i = 0; i < NVL; ++i) { const int idx = tid + 512 * i; vreg[i] = *(const u32x4*)(VT + (size_t)(idx >> 3) * M + k0 + 8 * (idx & 7)); } }
        const int k0 = 64 * kt;
        bool act = k0 <= qhi; if (SWA) act = act && (k0 + 63 >= qlo - 127);
        if (act) {
            f32x16 p0, p1;
#pragma unroll
            for (int r = 0; r < 16; ++r) { p0[r] = 0.f; p1[r] = 0.f; }
#pragma unroll
            for (int j = 0; j < 4; ++j) { const bf16x8 a0 = *(const LAS bf16x8*)(buf + r32 * KROW + 32 * j + 16 * hi), a1 = *(const LAS bf16x8*)(buf + (r32 + 32) * KROW + 32 * j + 16 * hi);
                p0 = __builtin_amdgcn_mfma_f32_32x32x16_bf16(a0, qf[j], p0, 0, 0, 0); p1 = __builtin_amdgcn_mfma_f32_32x32x16_bf16(a1, qf[j], p1, 0, 0, 0); }
            float mx = -1e30f;
#pragma unroll
            for (int r = 0; r < 16; ++r) { const int kv = k0 + (r & 3) + 8 * (r >> 2) + 4 * hi; const int d0 = qpos - kv, d1 = d0 - 32;
                float s0 = p0[r] - slope2 * (float)d0, s1 = p1[r] - slope2 * (float)d1;
                bool ok0 = d0 >= 0, ok1 = d1 >= 0; if (SWA) { ok0 = ok0 && d0 < 128; ok1 = ok1 && d1 < 128; }
                s0 = ok0 ? s0 : -1e30f; s1 = ok1 ? s1 : -1e30f; p0[r] = s0; p1[r] = s1; mx = fmaxf(mx, fmaxf(s0, s1)); }
            mx = xor32_max(mx);
            const float mnew = fmaxf(mrun, mx), f = exp2f(mrun - mnew); mrun = mnew;
            float rs = 0.f;
#pragma unroll
            for (int r = 0; r < 16; ++r) { p0[r] = exp2f(p0[r] - mnew); p1[r] = exp2f(p1[r] - mnew); rs += p0[r] + p1[r]; }
            lsum = lsum * f + rs;
#pragma unroll
            for (int d = 0; d < DV / 32; ++d)
#pragma unroll
                for (int r = 0; r < 16; ++r) o[d][r] *= f;
            u32x4 pw[4];
            pw[0] = (u32x4){cvtpk(p0[0], p0[1]), cvtpk(p0[2], p0[3]), cvtpk(p0[4], p0[5]), cvtpk(p0[6], p0[7])};
            pw[1] = (u32x4){cvtpk(p0[8], p0[9]), cvtpk(p0[10], p0[11]), cvtpk(p0[12], p0[13]), cvtpk(p0[14], p0[15])};
            pw[2] = (u32x4){cvtpk(p1[0], p1[1]), cvtpk(p1[2], p1[3]), cvtpk(p1[4], p1[5]), cvtpk(p1[6], p1[7])};
            pw[3] = (u32x4){cvtpk(p1[8], p1[9]), cvtpk(p1[10], p1[11]), cvtpk(p1[12], p1[13]), cvtpk(p1[14], p1[15])};
#pragma unroll
            for (int d = 0; d < DV / 32; ++d)
#pragma unroll
                for (int j = 0; j < 4; ++j) { const bf16x8 vf = *(const LAS bf16x8*)(buf + KTILE + (32 * d + r32) * KROW + 32 * j + 16 * hi);
                    o[d] = __builtin_amdgcn_mfma_f32_32x32x16_bf16(vf, __builtin_bit_cast(bf16x8, pw[j]), o[d], 0, 0, 0); }
        }
    }
    lsum = xor32_sum(lsum);
    if (SWA) lsum += exp2f(sink2 - mrun);
    const float inv = 1.0f / lsum;
    if (SWA) { bf16_t* op = Obf + (size_t)qpos * DM;
#pragma unroll
        for (int d = 0; d < DV / 32; ++d)
#pragma unroll
            for (int g = 0; g < 4; ++g) { u32x2 wv; wv.x = cvtpk(o[d][4 * g] * inv, o[d][4 * g + 1] * inv); wv.y = cvtpk(o[d][4 * g + 2] * inv, o[d][4 * g + 3] * inv);
                *(u32x2*)(op + 32 * d + 8 * g + 4 * hi) = wv; }
    } else { float* op = Of32 + (size_t)qpos * 1024;
#pragma unroll
        for (int d = 0; d < DV / 32; ++d)
#pragma unroll
            for (int g = 0; g < 4; ++g) *(f32x4*)(op + 32 * d + 8 * g + 4 * hi) = (f32x4){o[d][4 * g] * inv, o[d][4 * g + 1] * inv, o[d][4 * g + 2] * inv, o[d][4 * g + 3] * inv};
    }
    __syncthreads();
}

__device__ __forceinline__ void phase_diffcombine(KP p, int l, int gw, int NGW, int lane) {
    const float* lamv = p->in[3] + l * 256;
    const float lambda_init = 0.8f - 0.6f * expf(-0.3f * (float)l);
    const float s1 = wave_sum(lamv[lane] * lamv[64 + lane]), s2 = wave_sum(lamv[128 + lane] * lamv[192 + lane]);
    const float lam = expf(s1) - expf(s2) + lambda_init;
    const float* OD = (const float*)(p->ws + WS_OD); bf16_t* MIX = (bf16_t*)(p->ws + WS_MIX);
    const int h = lane >> 4, d0 = (lane & 15) * 8;
    const f32x4 g0 = *(const f32x4*)(p->in[4] + l * 128 + d0), g1 = *(const f32x4*)(p->in[4] + l * 128 + d0 + 4);
    for (int t = gw; t < M; t += NGW) { const float* b = OD + (size_t)t * 1024 + h * 256 + d0;
        const f32x4 a0 = *(const f32x4*)b, a1 = *(const f32x4*)(b + 4), c0 = *(const f32x4*)(b + 128), c1 = *(const f32x4*)(b + 132);
        const f32x4 o0 = a0 - c0 * lam, o1 = a1 - c1 * lam;
        float ss = (o0[0] * o0[0] + o0[1] * o0[1]) + (o0[2] * o0[2] + o0[3] * o0[3]) + (o1[0] * o1[0] + o1[1] * o1[1]) + (o1[2] * o1[2] + o1[3] * o1[3]);
        ss = row16_sum(ss);
        const float r = rsqrtf(ss * (1.0f / 128.0f) + EPS) * (1.0f - lambda_init);
        const f32x4 y0 = o0 * g0 * r, y1 = o1 * g1 * r;
        u32x4 wv; wv.x = cvtpk(y0[0], y0[1]); wv.y = cvtpk(y0[2], y0[3]); wv.z = cvtpk(y1[0], y1[1]); wv.w = cvtpk(y1[2], y1[3]);
        *(u32x4*)(MIX + (size_t)t * DM + h * 128 + d0) = wv; }
}


#define XB_TMO      128
#define XB_XCNT(j)  (256  + 64 * (j))
#define XB_XSUB(j)  (1280 + 64 * (j))
#define XB_XGEN(j)  (2304 + 64 * (j))
#define XB_TOP      3328
#define XB_TOPGEN   3392
#define XCD_BAR_WORDS 3456
#define XB_SPIN_CAP (1u << 22)
__device__ __forceinline__ unsigned xb_ld(unsigned* p)              { return __hip_atomic_load(p, __ATOMIC_RELAXED, __HIP_MEMORY_SCOPE_AGENT); }
__device__ __forceinline__ unsigned xb_add(unsigned* p, unsigned v) { return __hip_atomic_fetch_add(p, v, __ATOMIC_RELAXED, __HIP_MEMORY_SCOPE_AGENT); }
__device__ __forceinline__ unsigned xb_xcc_id() { return (unsigned)__builtin_amdgcn_s_getreg((3 << 11) | 20) & 0xFu; }
#define XB_SPIN(cond, bar) do { unsigned _sp = 0; while (cond) { __builtin_amdgcn_s_sleep(1); \
    if ((++_sp & 255u) == 0u) { if (xb_ld(&(bar)[XB_TMO])) break; if (_sp > XB_SPIN_CAP) { atomicAdd(&(bar)[XB_TMO], 1u); break; } } } } while (0)
__device__ __forceinline__ void xcd_barrier_complete(unsigned* bar, unsigned x, unsigned& nloc, unsigned& nx) {
    const unsigned G = gridDim.x;
    unsigned sum, cnt, mine, sp = 0u;
    for (;;) {
        sum = 0u; cnt = 0u; mine = 0u;
#pragma unroll
        for (unsigned j = 0; j < 16; ++j) { const unsigned c = xb_ld(&bar[XB_XCNT(j)]); sum += c; cnt += (c > 0u) ? 1u : 0u; mine = (j == x) ? c : mine; }
        if (sum == G) break;
        __builtin_amdgcn_s_sleep(1);
        if ((++sp & 255u) == 0u) { if (xb_ld(&bar[XB_TMO])) break; if (sp > XB_SPIN_CAP) { atomicAdd(&bar[XB_TMO], 1u); break; } }
    }
    nloc = mine > 0u ? mine : 1u; nx = cnt > 0u ? cnt : 1u;
}
__device__ __forceinline__ void xcd_barrier(unsigned* bar, volatile LAS unsigned* st, const int tid) {
    asm volatile("s_waitcnt vmcnt(0)" ::: "memory");
    __syncthreads();
    if (tid == 0) {
        const unsigned x = xb_xcc_id();
        __builtin_amdgcn_s_waitcnt(0);
        unsigned nloc = st[0], nx = st[1];
        if (nloc == 0u) { xcd_barrier_complete(bar, x, nloc, nx); st[0] = nloc; st[1] = nx; }
        const unsigned old = xb_add(&bar[XB_XSUB(x)], 1u);
        const unsigned gen = old / nloc;
        if (old + 1u == (gen + 1u) * nloc) {
            __builtin_amdgcn_fence(__ATOMIC_RELEASE, "agent");
            asm volatile("s_waitcnt vmcnt(0)" ::: "memory");
            const unsigned og = xb_add(&bar[XB_TOP], 1u);
            const unsigned tg = og / nx;
            if (og + 1u == (tg + 1u) * nx) xb_add(&bar[XB_TOPGEN], 1u);
            else XB_SPIN(xb_ld(&bar[XB_TOPGEN]) == tg, bar);
            __builtin_amdgcn_fence(__ATOMIC_ACQUIRE, "agent");
            xb_add(&bar[XB_XGEN(x)], 1u);
            asm volatile("s_waitcnt vmcnt(0)" ::: "memory");
        } else {
            XB_SPIN(xb_ld(&bar[XB_XGEN(x)]) == gen, bar);
            __builtin_amdgcn_fence(__ATOMIC_ACQUIRE, "agent");
            asm volatile("s_waitcnt vmcnt(0)" ::: "memory");
        }
    }
    __syncthreads();
}

#define GSYNC() do { FRESH(); xcd_barrier((unsigned*)(p->ws + WS_CTL) + 4096, (volatile LAS unsigned*)(lds + LDS_BYTES - 32), tid); } while (0)
#define PTRS() unsigned* ctl = (unsigned*)(p->ws + WS_CTL); bf16_t* XB = (bf16_t*)(p->ws + WS_XB); bf16_t* PROJ = (bf16_t*)(p->ws + WS_PROJ); bf16_t* MIX = (bf16_t*)(p->ws + WS_MIX); bf16_t* H = (bf16_t*)(p->ws + WS_H); \
    float* ssqA = (float*)(p->ws + WS_SSQA); float* ssqB = (float*)(p->ws + WS_SSQB); unsigned char* wb = p->ws + WS_W + (size_t)l * LW_STRIDE; (void)ctl; (void)XB; (void)PROJ; (void)MIX; (void)H; (void)ssqA; (void)ssqB; (void)wb
#define FRESH() KP p = fresh_params(); int G = gridDim.x, bx = blockIdx.x; asm volatile("" : "+s"(G), "+s"(bx)); const int NGW = G * 8; (void)NGW; const int tid = fresh_tid(wave0), lane = tid & 63, wave = __builtin_amdgcn_readfirstlane(tid >> 6), gw = bx * 8 + wave; (void)lane; (void)gw
template <int L> __device__ __forceinline__ void layer_body(LAS unsigned char* lds, const int wave0) {
    constexpr int l = L;

        {   FRESH(); PTRS(); pg8::Gemm g{XB, (const bf16_t*)(wb + LW_WIN), M, INCP, DM}; pg8::StaticOrder S; S.init(M, INCP, G, bx);
            pg8::EpiProj E{PROJ, INCP, ssqA};
            pg8::gemm_phase<pg8::EpiProj, pg8::StaticOrder, true, true>(lds, g, S, E, tid); }
        GSYNC();
        { FRESH(); phase_prep1(p, l, lds, gw, NGW, wave, lane); }
        GSYNC();
        {   FRESH(); PTRS(); pg8::Gemm g{(const bf16_t*)(p->ws + WS_AW), (const bf16_t*)(wb + LW_W2T), M, 1024, 128}; pg8::StaticOrder S; S.init(M, 1024, G, bx);
            pg8::EpiLora<0> E{(float*)(p->ws + WS_DEC), p->in[7] + l * 1024};
            pg8::gemm_phase<pg8::EpiLora<0>, pg8::StaticOrder, true, true>(lds, g, S, E, tid); }
        {   FRESH(); PTRS(); pg8::Gemm g{(const bf16_t*)(p->ws + WS_AA), (const bf16_t*)(wb + LW_A2T), M, 1024, 128}; pg8::StaticOrder S; S.init(M, 1024, G, (bx + 128) % G);
            pg8::EpiLora<1> E{(float*)(p->ws + WS_A), p->in[9] + l * 1024};
            pg8::gemm_phase<pg8::EpiLora<1>, pg8::StaticOrder, true, true>(lds, g, S, E, tid); }
        {   FRESH(); PTRS(); pg8::Gemm g{(const bf16_t*)(p->ws + WS_AG), (const bf16_t*)(wb + LW_G2T), M, 1024, 256}; pg8::StaticOrder S; S.init(M, 1024, G, bx);
            pg8::EpiLora<2> E{(float*)(p->ws + WS_G), nullptr};
            pg8::gemm_phase<pg8::EpiLora<2>, pg8::StaticOrder, true, true>(lds, g, S, E, tid); }
        GSYNC();
        { FRESH(); phase_prep2(p, l, gw, NGW, lane); }
        GSYNC();
        {   FRESH(); LAS unsigned char* wl = lds + wave * 14336;
            for (int it = gw; it < 2 * NCH * 16; it += NGW) { const int mode = it & 1, ch = it >> 1, c = ch % NCH, h = ch / NCH;
                if (mode == 0) scan_task<0>(p, l, wl, c, h, lane); else scan_task<1>(p, l, wl, c, h, lane); } }
        GSYNC();
        {   FRESH(); PTRS(); LAS int* slot = (LAS int*)(lds + LDS_BYTES - 64);
            const float* sinks = p->in[5] + l * 8;
            for (;;) {
                if (tid == 0) *slot = (int)atomicAdd(ctl + 64 * (l + 1), 1u);
                __syncthreads();
                const int it = *slot;
                __syncthreads();
                if (it >= 16 + 256 + 256) break;
                if (it < 16) { s2_head(p, lds, it, tid); }
                else if (it < 272) { const int d = it - 16, qb = 31 - (d >> 3), h = (d & 7) >> 1, c = d & 1;
                    const float slope2 = exp2f(-2.0f * (float)(h + 1)) * LOG2E;
                    attn_unit<128, false>(lds, PROJ + h * 128 + c * 64, PROJ + 512 + h * 128 + c * 64, (const bf16_t*)(p->ws + WS_VAT) + (size_t)(h * 128) * M, slope2, qb * 256, 0.f,
                                          (float*)(p->ws + WS_OD) + h * 256 + c * 128, nullptr, tid); }
                else { const int s = it - 272, hq = s & 7, qb = s >> 3;
                    const int aidx = (hq >> 1) * 3 + (hq & 1);
                    const float slope2 = exp2f(-8.0f * (float)(aidx + 1) / 12.0f) * LOG2E;
                    attn_unit<64, true>(lds, PROJ + 1536 + hq * 64, PROJ + 2048 + (hq >> 2) * 64, (const bf16_t*)(p->ws + WS_VBT) + (size_t)((hq >> 2) * 64) * M, slope2, qb * 256, sinks[hq] * LOG2E,
                                        nullptr, MIX + 512 + hq * 64, tid); }
            } }
        GSYNC();
        {   FRESH(); LAS unsigned char* wl = lds + wave * 14336;
            for (int it = gw; it < NCH * 16; it += NGW) { const int c = it % NCH, h = it / NCH; scan_task<2>(p, l, wl, c, h, lane); }
            phase_diffcombine(p, l, gw, NGW, lane); }
        GSYNC();
        {   FRESH(); PTRS(); pg8::Gemm g{MIX, (const bf16_t*)(wb + LW_WOUT), M, DM, DM}; pg8::StaticOrder S; S.init(M, DM, G, bx);
            pg8::EpiResid E{p->out, XB, ssqB};
            pg8::gemm_phase<pg8::EpiResid, pg8::StaticOrder, true, true>(lds, g, S, E, tid); }
        GSYNC();
        {   FRESH(); PTRS(); pg8::Gemm g{XB, (const bf16_t*)(wb + LW_WGU), M, GU, DM}; pg8::StaticOrder S; S.init(M, GU, G, bx);
            pg8::EpiSwiGLU E{H, ssqB};
            pg8::gemm_phase<pg8::EpiSwiGLU, pg8::StaticOrder, true, true>(lds, g, S, E, tid); }
        GSYNC();
        {   FRESH(); PTRS(); pg8::Gemm g{H, (const bf16_t*)(wb + LW_WDN), M, DM, FF}; pg8::StaticOrder S; S.init(M, DM, G, bx);
            pg8::EpiResid E{p->out, XB, ssqA};
            pg8::gemm_phase<pg8::EpiResid, pg8::StaticOrder, true, true>(lds, g, S, E, tid); }
        GSYNC();
    }

__global__ void __launch_bounds__(512, 2) fwd_megakernel(Params p_unused) {
    extern __shared__ __attribute__((aligned(16))) unsigned char lds_raw[];
    LAS unsigned char* lds = (LAS unsigned char*)lds_raw;
    cg::grid_group grid = cg::this_grid();
    const int wave0 = __builtin_amdgcn_readfirstlane((int)threadIdx.x >> 6);
    if (threadIdx.x < 16) ((LAS unsigned*)(lds + LDS_BYTES - 64))[threadIdx.x] = 0u;
    if (threadIdx.x == 0) xb_add((unsigned*)(p_unused.ws + WS_CTL) + 4096 + XB_XCNT(xb_xcc_id()), 1u);
    __syncthreads();

    { FRESH(); phase0(p, lds, gw, NGW, wave, lane); }
    grid.sync();

    layer_body<0>(lds, wave0); layer_body<1>(lds, wave0); layer_body<2>(lds, wave0); layer_body<3>(lds, wave0);
    {   FRESH(); const int l = 0; PTRS(); const float* gf = p->in[21];
        for (int m = gw; m < M; m += NGW) { const float rs = rsqrtf(wave_sum(lane < 32 ? ssqA[(size_t)m * 32 + lane] : 0.f) * (1.0f / DM) + EPS);
#pragma unroll
            for (int j = 0; j < 8; ++j) { const size_t o = (size_t)m * DM + j * 256 + lane * 4; const f32x4 v = *(const f32x4*)(p->out + o); const f32x4 gv = *(const f32x4*)(gf + j * 256 + lane * 4);
                *(f32x4*)(p->out + o) = v * rs * gv; } } }
}

extern "C" void kernel_launch(void* const* d_in, const int* in_sizes, int n_in, void* d_out, int out_size, void* d_ws, size_t ws_size, hipStream_t stream) {
    static int grid = 0;
    if (grid == 0) {
        if (n_in != 22 || out_size != M * DM || ws_size < WS_END) { fprintf(stderr, "kernel_launch: unexpected shapes (n_in %d out %d ws %zu need %zu)\n", n_in, out_size, ws_size, (size_t)WS_END); grid = -1; return; }
        int dev = 0, cus = 0, per_cu = 0;
        hipGetDevice(&dev); hipDeviceGetAttribute(&cus, hipDeviceAttributeMultiprocessorCount, dev);
        hipFuncSetAttribute((const void*)fwd_megakernel, hipFuncAttributeMaxDynamicSharedMemorySize, LDS_BYTES);
        hipOccupancyMaxActiveBlocksPerMultiprocessor(&per_cu, (const void*)fwd_megakernel, 512, LDS_BYTES);
        if (per_cu < 1) { fprintf(stderr, "kernel_launch: occupancy query says %d blocks per CU\n", per_cu); per_cu = 1; }
        (void)hipGetLastError();
        grid = cus;
    }
    if (grid < 0) return;
    hipMemsetAsync((char*)d_ws + WS_CTL, 0, 65536, stream);
    Params p{};
    for (int i = 0; i < 22; ++i) p.in[i] = (const float*)d_in[i];
    p.out = (float*)d_out; p.ws = (unsigned char*)d_ws;
    void* args[] = {&p};
    hipError_t e = hipLaunchCooperativeKernel((const void*)fwd_megakernel, dim3(grid), dim3(512), args, LDS_BYTES, stream);
    if (e != hipSuccess) fprintf(stderr, "cooperative launch failed: %s (grid %d)\n", hipGetErrorString(e), grid);
}
```

```cpp
#include <hip/hip_runtime.h>
#include <hip/hip_cooperative_groups.h>
#include <cstdio>
#include <cstdint>
namespace cg = cooperative_groups;

#define LAS __attribute__((address_space(3)))
typedef unsigned short bf16_t;
typedef short bf16x8 __attribute__((ext_vector_type(8)));
typedef float f32x4 __attribute__((ext_vector_type(4)));
typedef float f32x2 __attribute__((ext_vector_type(2)));
typedef float f32x16 __attribute__((ext_vector_type(16)));
typedef unsigned u32x4 __attribute__((ext_vector_type(4)));
typedef unsigned u32x2 __attribute__((ext_vector_type(2)));
typedef __bf16 bf16x2_t __attribute__((ext_vector_type(2)));

constexpr int M = 8192, DM = 2048, INC = 5824, INCP = 5888, FF = 5632, GU = 11264, RW0 = 2304, RWC = 3520;
constexpr int NL = 4, NCH = 64, CL = 128;
constexpr float EPS = 1e-5f, LOG2E = 1.4426950408889634f;
constexpr float QSC = 0.125f * LOG2E;

constexpr size_t MiB = 1u << 20;
constexpr size_t SZ_WIN = (size_t)INCP * DM * 2, SZ_WOUT = (size_t)DM * DM * 2, SZ_WGU = (size_t)GU * DM * 2, SZ_WDN = (size_t)DM * FF * 2;
constexpr size_t SZ_W2T = 1024 * 128 * 2, SZ_G2T = 1024 * 256 * 2;
constexpr size_t LW_WIN = 0, LW_WOUT = LW_WIN + SZ_WIN, LW_WGU = LW_WOUT + SZ_WOUT, LW_WDN = LW_WGU + SZ_WGU, LW_W2T = LW_WDN + SZ_WDN,
                 LW_A2T = LW_W2T + SZ_W2T, LW_G2T = LW_A2T + SZ_W2T, LW_STRIDE = LW_G2T + SZ_G2T;
constexpr size_t SZ_F = (size_t)M * 1024 * 4;
constexpr size_t WS_CTL = 0, WS_W = 1 * MiB, WS_XB = WS_W + NL * LW_STRIDE, WS_PROJ = WS_XB + (size_t)M * DM * 2,
                 WS_VAT = WS_PROJ + (size_t)M * INCP * 2, WS_VBT = WS_VAT + (size_t)512 * M * 2, WS_AW = WS_VBT + (size_t)128 * M * 2,
                 WS_AA = WS_AW + (size_t)M * 128 * 2, WS_AG = WS_AA + (size_t)M * 128 * 2, WS_R = WS_AG + (size_t)M * 256 * 2,
                 WS_KR = WS_R + SZ_F, WS_V = WS_KR + SZ_F, WS_DEC = WS_V + SZ_F, WS_A = WS_DEC + SZ_F, WS_G = WS_A + SZ_F,
                 WS_KF = WS_G + SZ_F, WS_AN = WS_KF + SZ_F, WS_BB = WS_AN + SZ_F, WS_PB = WS_BB + SZ_F, WS_UB = WS_PB + SZ_F,
                 WS_SI = WS_UB + SZ_F, WS_OD = WS_SI + SZ_F, WS_ML = WS_OD + 4 * SZ_F, WS_KNP = WS_ML + (size_t)4 * M * 16 * 4, WS_MIX = WS_KNP + 65536, WS_SSQA = WS_MIX + (size_t)M * DM * 2,
                 WS_SSQB = WS_SSQA + (size_t)M * 32 * 4, WS_END = WS_SSQB + (size_t)M * 32 * 4;
constexpr size_t WS_H = WS_PROJ;
static_assert((size_t)M * FF * 2 <= (size_t)M * INCP * 2, "H overlay");

constexpr int LDS_BYTES = 147456;

struct Params { const float* in[22]; float* out; unsigned char* ws; };
typedef const __attribute__((address_space(4))) Params* KP;
__device__ __forceinline__ KP fresh_params() { KP k = (KP)__builtin_amdgcn_kernarg_segment_ptr(); asm volatile("" : "+s"(k)); return k; }

__device__ __forceinline__ unsigned cvtpk(float lo, float hi) { f32x2 v = {lo, hi}; bf16x2_t b = __builtin_convertvector(v, bf16x2_t); return __builtin_bit_cast(unsigned, b); }
__device__ __forceinline__ float bf2f(unsigned short b) { return __builtin_bit_cast(float, (unsigned)b << 16); }
__device__ __forceinline__ float bflo(unsigned w) { return __builtin_bit_cast(float, w << 16); }
__device__ __forceinline__ float bfhi(unsigned w) { return __builtin_bit_cast(float, w & 0xffff0000u); }
template <int CTRL> __device__ __forceinline__ float dppm(float v) { return __builtin_bit_cast(float, __builtin_amdgcn_mov_dpp(__builtin_bit_cast(int, v), CTRL, 0xF, 0xF, true)); }
__device__ __forceinline__ float xor16_sum(float v) { const unsigned b = __builtin_bit_cast(unsigned, v); auto rr = __builtin_amdgcn_permlane16_swap(b, b, false, false); return __builtin_bit_cast(float, (unsigned)rr[0]) + __builtin_bit_cast(float, (unsigned)rr[1]); }
__device__ __forceinline__ float xor32_sum(float v) { const unsigned b = __builtin_bit_cast(unsigned, v); auto rr = __builtin_amdgcn_permlane32_swap(b, b, false, false); return __builtin_bit_cast(float, (unsigned)rr[0]) + __builtin_bit_cast(float, (unsigned)rr[1]); }
__device__ __forceinline__ float xor32_max(float v) { const unsigned b = __builtin_bit_cast(unsigned, v); auto rr = __builtin_amdgcn_permlane32_swap(b, b, false, false); return fmaxf(__builtin_bit_cast(float, (unsigned)rr[0]), __builtin_bit_cast(float, (unsigned)rr[1])); }
__device__ __forceinline__ float row16_sum(float v) { v += dppm<0xB1>(v); v += dppm<0x4E>(v); v += dppm<0x141>(v); v += dppm<0x140>(v); return v; }
__device__ __forceinline__ float wave_sum(float v) { return xor32_sum(xor16_sum(row16_sum(v))); }
__device__ __forceinline__ float dpp_xor1(float v) { return __builtin_bit_cast(float, __builtin_amdgcn_mov_dpp(__builtin_bit_cast(int, v), 0xB1, 0xF, 0xF, true)); }
__device__ __forceinline__ float dpp_xor2(float v) { return __builtin_bit_cast(float, __builtin_amdgcn_mov_dpp(__builtin_bit_cast(int, v), 0x4E, 0xF, 0xF, true)); }
__device__ __forceinline__ float quad_sum(float v) { v += dpp_xor1(v); v += dpp_xor2(v); return v; }
__device__ __forceinline__ float sigmoidf_(float x) { return 1.0f / (1.0f + __expf(-x)); }

__device__ __forceinline__ int fresh_tid(int wave0) { unsigned z = 0u; asm volatile("" : "+v"(z)); int t = wave0 * 64 + (int)__builtin_amdgcn_mbcnt_hi(~0u, __builtin_amdgcn_mbcnt_lo(~0u, z)); asm volatile("" : "+v"(t)); return t; }

__device__ __forceinline__ float row_rstd(const float* ssq, int row, int fq) {
    const float* pp = ssq + (size_t)row * 32 + 8 * fq; const f32x4 a = *(const f32x4*)pp, b = *(const f32x4*)(pp + 4);
    float s = ((a[0] + a[1]) + (a[2] + a[3])) + ((b[0] + b[1]) + (b[2] + b[3]));
    s = xor32_sum(xor16_sum(s));
    return rsqrtf(s * (1.0f / DM) + EPS);
}

namespace pg8 {
constexpr int BM = 256, BK = 64, HALF = 128, HTB = HALF * BK * 2, STAGE_BYTES = 8 * HTB, NXCD = 8, WGM = 8;
__host__ __device__ __forceinline__ int lds_byte(int r, int c) { const int st = (r >> 4) * 2 + (c >> 5), rr = r & 15, cc = c & 31, ob = rr * 64 + cc * 2; return st * 1024 + (ob ^ (((ob >> 9) & 1) << 5)); }
__host__ __device__ __forceinline__ void stage_rc(int b, int& R, int& C) { const int st = b / 1024, sb = b % 1024, swz = sb ^ (((sb >> 9) & 1) << 5); R = (st >> 1) * 16 + swz / 64; C = (st & 1) * 32 + (swz % 64) / 2; }
__host__ __device__ __forceinline__ int perm32(int rho) { const int n = rho >> 4, i = rho & 15; return 8 * (i >> 2) + 4 * n + (i & 3); }
struct Unit { int pm, pn; };
struct Gemm { const bf16_t* A; const bf16_t* Bt; int M, N, K; };
struct StaticOrder {
    int nM, nN, nwg, G, c;
    __host__ __device__ void init(int M_, int N_, int G_, int c_) { nM = M_ / BM; nN = N_ / BM; nwg = nM * nN; G = G_; c = c_; }
    __host__ __device__ bool next(int i, Unit& u) const {
        const long L = (long)i * G + c; if (L >= nwg) return false;
        int wgid = (int)L; { const int q = nwg / NXCD, r = nwg % NXCD, xcd = wgid % NXCD, off = wgid / NXCD; wgid = (xcd < r ? xcd * (q + 1) : r * (q + 1) + (xcd - r) * q) + off; }
        const int nig = WGM * nN, gid = wgid / nig, fm = gid * WGM, gsz = (nM - fm) < WGM ? (nM - fm) : WGM;
        u.pm = fm + ((wgid % nig) % gsz); u.pn = (wgid % nig) / gsz; return true;
    }
};

template <class Epi, class Sched, bool ALIGN_EPI, bool SP2>
__device__ __forceinline__ void gemm_phase(LAS unsigned char* lds, const Gemm g, const Sched& S, const Epi& E, const int tid) {
    const int wid = __builtin_amdgcn_readfirstlane(tid >> 6), lane = tid & 63, wr = wid >> 2, wc = wid & 3, fr = lane & 15, fq = lane >> 4;
    const int K = g.K, nt = K / BK;
    unsigned voffA[2], voffB[2];
#pragma unroll
    for (int i = 0; i < 2; ++i) { int R, C; stage_rc(tid * 16 + i * 8192, R, C); const int Rb = Epi::PERM ? ((R & ~31) + perm32(R & 31)) : R;
        voffA[i] = (unsigned)(R * K + C) * 2u; voffB[i] = (unsigned)(Rb * K + C) * 2u; }
    const size_t kstep = (size_t)(BK * 2);
    const size_t hstep = (size_t)HALF * K * 2;
    const size_t tstep = 2 * hstep;
    const unsigned ldsw = (unsigned)wid * 1024u;
    const int aoff = lds_byte(wr * 64 + fr, fq * 8), boff = lds_byte(wc * 32 + fr, fq * 8);
#define PG8_SA(b, h) (((b) * 2 + (h)) * HTB)
#define PG8_SB(b, h) ((4 + (b) * 2 + (h)) * HTB)
#define PG8_STAGE(bufoff, gbase, voff) do { _Pragma("unroll") for (int _i = 0; _i < 2; ++_i) \
        __builtin_amdgcn_global_load_lds((const unsigned*)((const char*)(gbase) + (voff)[_i]), (LAS unsigned*)(lds + (bufoff) + ldsw + _i * 8192), 16, 0, 0); } while (0)
#define PG8_LDA(dst, b, h) do { _Pragma("unroll") for (int m = 0; m < 4; ++m) _Pragma("unroll") for (int k = 0; k < 2; ++k) dst[m][k] = *(const LAS bf16x8*)(lds + PG8_SA(b, h) + aoff + m * 2048 + k * 1024); } while (0)
#define PG8_LDB(dst, b, h) do { _Pragma("unroll") for (int n = 0; n < 2; ++n) _Pragma("unroll") for (int k = 0; k < 2; ++k) dst[n][k] = *(const LAS bf16x8*)(lds + PG8_SB(b, h) + boff + n * 2048 + k * 1024); } while (0)
#define PG8_MMA(ai, bj, At, Bt) do { __builtin_amdgcn_s_setprio(1); _Pragma("unroll") for (int m = 0; m < 4; ++m) _Pragma("unroll") for (int n = 0; n < 2; ++n) _Pragma("unroll") for (int k = 0; k < 2; ++k) \
        acc[ai][bj][m][n] = __builtin_amdgcn_mfma_f32_16x16x32_bf16(Bt[n][k], At[m][k], acc[ai][bj][m][n], 0, 0, 0); __builtin_amdgcn_s_setprio(0); } while (0)
#define PG8_WAIT_V(n) asm volatile("s_waitcnt vmcnt(" #n ")" ::: "memory")
#define PG8_WAIT_L(n) asm volatile("s_waitcnt lgkmcnt(" #n ")" ::: "memory")
#define PG8_BAR __builtin_amdgcn_s_barrier()
#define PG8_SCHED __builtin_amdgcn_sched_barrier(0)
    Unit cur, nxt; int ui = 0;
    if (!S.next(0, cur)) return;
    f32x4 acc[2][2][4][2];
#pragma unroll
    for (int a = 0; a < 2; ++a)
#pragma unroll
        for (int b = 0; b < 2; ++b)
#pragma unroll
            for (int m = 0; m < 4; ++m)
#pragma unroll
                for (int n = 0; n < 2; ++n) acc[a][b][m][n] = (f32x4){0.f, 0.f, 0.f, 0.f};
    bf16x8 At[4][2], B0[2][2], B1[2][2];
    const char* cA = (const char*)g.A + (size_t)cur.pm * tstep; const char* cB = (const char*)g.Bt + (size_t)cur.pn * tstep;
    if constexpr (SP2) {
        PG8_STAGE(PG8_SB(0, 0), cB, voffB); PG8_STAGE(PG8_SB(0, 1), cB + hstep, voffB); PG8_STAGE(PG8_SA(0, 0), cA, voffA); PG8_STAGE(PG8_SA(0, 1), cA + hstep, voffA);
        if (wr == 1) PG8_BAR;
        PG8_WAIT_V(2); PG8_BAR;
        PG8_STAGE(PG8_SB(1, 0), cB + kstep, voffB); PG8_STAGE(PG8_SA(1, 0), cA + kstep, voffA); PG8_STAGE(PG8_SB(1, 1), cB + hstep + kstep, voffB);
        PG8_WAIT_V(6); PG8_BAR;
    } else {
        PG8_STAGE(PG8_SB(0, 0), cB, voffB); PG8_STAGE(PG8_SA(0, 0), cA, voffA); PG8_STAGE(PG8_SB(0, 1), cB + hstep, voffB); PG8_STAGE(PG8_SA(0, 1), cA + hstep, voffA);
        if (wr == 1) PG8_BAR;
        PG8_WAIT_V(4); PG8_BAR;
        PG8_STAGE(PG8_SB(1, 0), cB + kstep, voffB); PG8_STAGE(PG8_SA(1, 0), cA + kstep, voffA); PG8_STAGE(PG8_SB(1, 1), cB + hstep + kstep, voffB);
        PG8_WAIT_V(6); PG8_BAR;
    }
    for (;;) {
        const bool has_next = S.next(ui + 1, nxt);
        const char* nA = has_next ? (const char*)g.A + (size_t)nxt.pm * tstep : cA; const char* nB = has_next ? (const char*)g.Bt + (size_t)nxt.pn * tstep : cB;
        for (int t = 0; t < nt; t += 2) {
            const bool last = (t == nt - 2);
            const char* a1 = cA + (size_t)(t + 1) * kstep;
            const char* a2 = last ? nA : cA + (size_t)(t + 2) * kstep; const char* b2 = last ? nB : cB + (size_t)(t + 2) * kstep;
            const char* a3 = a2 + kstep; const char* b3 = b2 + kstep;
            if constexpr (SP2) {
            PG8_LDB(B0, 0, 0); PG8_LDB(B1, 0, 1); PG8_SCHED; PG8_LDA(At, 0, 0); PG8_STAGE(PG8_SA(1, 1), a1 + hstep, voffA);
            PG8_WAIT_V(8); PG8_WAIT_L(0); PG8_BAR; PG8_MMA(0, 0, At, B0); PG8_MMA(0, 1, At, B1); PG8_BAR; PG8_SCHED;
            PG8_LDA(At, 0, 1); PG8_STAGE(PG8_SB(0, 0), b2, voffB); PG8_STAGE(PG8_SB(0, 1), b2 + hstep, voffB); PG8_STAGE(PG8_SA(0, 0), a2, voffA);
            PG8_WAIT_V(8); PG8_WAIT_L(0); PG8_BAR; PG8_MMA(1, 0, At, B0); PG8_MMA(1, 1, At, B1); PG8_BAR; PG8_SCHED;
            PG8_LDB(B0, 1, 0); PG8_LDB(B1, 1, 1); PG8_SCHED; PG8_LDA(At, 1, 0); PG8_STAGE(PG8_SA(0, 1), a2 + hstep, voffA);
            PG8_WAIT_V(8); PG8_WAIT_L(0); PG8_BAR; PG8_MMA(0, 0, At, B0); PG8_MMA(0, 1, At, B1); PG8_BAR; PG8_SCHED;
            PG8_LDA(At, 1, 1); PG8_STAGE(PG8_SB(1, 0), b3, voffB); PG8_STAGE(PG8_SB(1, 1), b3 + hstep, voffB); PG8_STAGE(PG8_SA(1, 0), a3, voffA);
            PG8_WAIT_V(8); PG8_WAIT_L(0); PG8_BAR; PG8_MMA(1, 0, At, B0); PG8_MMA(1, 1, At, B1); PG8_BAR; PG8_SCHED;
            } else {
            PG8_LDB(B0, 0, 0); PG8_SCHED; PG8_LDA(At, 0, 0); PG8_STAGE(PG8_SA(1, 1), a1 + hstep, voffA);
            PG8_WAIT_L(8); PG8_BAR; PG8_WAIT_L(0); PG8_MMA(0, 0, At, B0); PG8_BAR; PG8_SCHED;
            PG8_LDB(B1, 0, 1); PG8_STAGE(PG8_SB(0, 0), b2, voffB);
            PG8_BAR; PG8_WAIT_L(0); PG8_MMA(0, 1, At, B1); PG8_BAR;
            PG8_LDA(At, 0, 1); PG8_STAGE(PG8_SA(0, 0), a2, voffA);
            PG8_BAR; PG8_WAIT_L(0); PG8_MMA(1, 0, At, B0); PG8_BAR; PG8_SCHED;
            PG8_STAGE(PG8_SB(0, 1), b2 + hstep, voffB);
            PG8_WAIT_V(6); PG8_BAR; PG8_MMA(1, 1, At, B1); PG8_BAR;
            PG8_LDB(B0, 1, 0); PG8_SCHED; PG8_LDA(At, 1, 0); PG8_STAGE(PG8_SA(0, 1), a2 + hstep, voffA);
            PG8_WAIT_L(8); PG8_BAR; PG8_WAIT_L(0); PG8_MMA(0, 0, At, B0); PG8_BAR; PG8_SCHED;
            PG8_LDB(B1, 1, 1); PG8_STAGE(PG8_SB(1, 0), b3, voffB);
            PG8_BAR; PG8_WAIT_L(0); PG8_MMA(0, 1, At, B1); PG8_BAR;
            PG8_LDA(At, 1, 1); PG8_STAGE(PG8_SA(1, 0), a3, voffA);
            PG8_BAR; PG8_WAIT_L(0); PG8_MMA(1, 0, At, B0); PG8_BAR; PG8_SCHED;
            PG8_STAGE(PG8_SB(1, 1), b3 + hstep, voffB);
            PG8_WAIT_V(6); PG8_BAR; PG8_MMA(1, 1, At, B1); PG8_BAR;
            }
        }
        if constexpr (ALIGN_EPI) { if (wr == 0) PG8_BAR; }
        E(acc, cur, wr, wc, fr, fq);
        if (!has_next) break;
#pragma unroll
        for (int a = 0; a < 2; ++a)
#pragma unroll
            for (int b = 0; b < 2; ++b)
#pragma unroll
                for (int m = 0; m < 4; ++m)
#pragma unroll
                    for (int n = 0; n < 2; ++n) acc[a][b][m][n] = (f32x4){0.f, 0.f, 0.f, 0.f};
        cur = nxt; cA = nA; cB = nB; ++ui;
        if constexpr (ALIGN_EPI) { if (wr == 1) PG8_BAR; }
    }
    PG8_WAIT_V(0);
    if constexpr (!ALIGN_EPI) { if (wr == 0) PG8_BAR; }
    PG8_BAR;
#undef PG8_SA
#undef PG8_SB
#undef PG8_STAGE
#undef PG8_LDA
#undef PG8_LDB
#undef PG8_MMA
#undef PG8_WAIT_V
#undef PG8_WAIT_L
#undef PG8_BAR
#undef PG8_SCHED
}

struct EpiProj {
    static constexpr bool PERM = true;
    bf16_t* O; int ldc; const float* ssq;
    __device__ __forceinline__ void operator()(const f32x4 (&acc)[2][2][4][2], const Unit& u, int wr, int wc, int fr, int fq) const {
        const int row0 = u.pm * BM + wr * 64 + fr, col0 = u.pn * BM + wc * 32 + 8 * fq;
#pragma unroll
        for (int ai = 0; ai < 2; ++ai)
#pragma unroll
            for (int m = 0; m < 4; ++m) { const int row = row0 + ai * HALF + m * 16; const float rs = row_rstd(ssq, row, fq);
                bf16_t* rowp = O + (size_t)row * ldc + col0;
#pragma unroll
                for (int bj = 0; bj < 2; ++bj) { const f32x4 v0 = acc[ai][bj][m][0] * rs, v1 = acc[ai][bj][m][1] * rs;
                    u32x4 w; w.x = cvtpk(v0[0], v0[1]); w.y = cvtpk(v0[2], v0[3]); w.z = cvtpk(v1[0], v1[1]); w.w = cvtpk(v1[2], v1[3]);
                    *(u32x4*)(rowp + bj * HALF) = w; } }
    }
};
struct EpiSwiGLU {
    static constexpr bool PERM = true;
    bf16_t* O; const float* ssq;
    __device__ __forceinline__ void operator()(const f32x4 (&acc)[2][2][4][2], const Unit& u, int wr, int wc, int fr, int fq) const {
        const int row0 = u.pm * BM + wr * 64 + fr, col0 = u.pn * HALF + wc * 32 + 8 * fq;
#pragma unroll
        for (int ai = 0; ai < 2; ++ai)
#pragma unroll
            for (int m = 0; m < 4; ++m) { const int row = row0 + ai * HALF + m * 16; const float rs = row_rstd(ssq, row, fq);
                float h[8];
#pragma unroll
                for (int n = 0; n < 2; ++n)
#pragma unroll
                    for (int j = 0; j < 4; ++j) { const float gt = acc[ai][0][m][n][j] * rs, up = acc[ai][1][m][n][j] * rs; h[n * 4 + j] = gt * up / (1.0f + __expf(-gt)); }
                u32x4 w; w.x = cvtpk(h[0], h[1]); w.y = cvtpk(h[2], h[3]); w.z = cvtpk(h[4], h[5]); w.w = cvtpk(h[6], h[7]);
                *(u32x4*)(O + (size_t)row * FF + col0) = w; }
    }
};
struct EpiResid {
    static constexpr bool PERM = false;
    float* X; bf16_t* XB; float* ssq;
    __device__ __forceinline__ void operator()(const f32x4 (&acc)[2][2][4][2], const Unit& u, int wr, int wc, int fr, int fq) const {
        const int row0 = u.pm * BM + wr * 64 + fr, col0 = u.pn * BM + wc * 32 + 4 * fq;
#pragma unroll
        for (int ai = 0; ai < 2; ++ai)
#pragma unroll
            for (int m = 0; m < 4; ++m) { const int row = row0 + ai * HALF + m * 16; const size_t off = (size_t)row * DM + col0; float ss = 0.f;
#pragma unroll
                for (int bj = 0; bj < 2; ++bj)
#pragma unroll
                    for (int n = 0; n < 2; ++n) { const size_t o = off + bj * HALF + n * 16; const f32x4 xv = *(const f32x4*)(X + o) + acc[ai][bj][m][n];
                        *(f32x4*)(X + o) = xv; u32x2 w; w.x = cvtpk(xv[0], xv[1]); w.y = cvtpk(xv[2], xv[3]); *(u32x2*)(XB + o) = w;
                        ss += (xv[0] * xv[0] + xv[1] * xv[1]) + (xv[2] * xv[2] + xv[3] * xv[3]); }
                ss = xor32_sum(xor16_sum(ss));
                if (fq == 0) ssq[(size_t)row * 32 + u.pn * 4 + wc] = ss; }
    }
};
template <int MODE> struct EpiLora {
    static constexpr bool PERM = false;
    float* O; const float* bias;
    __device__ __forceinline__ void operator()(const f32x4 (&acc)[2][2][4][2], const Unit& u, int wr, int wc, int fr, int fq) const {
        const int row0 = u.pm * BM + wr * 64 + fr, col0 = u.pn * BM + wc * 32 + 4 * fq;
#pragma unroll
        for (int bj = 0; bj < 2; ++bj)
#pragma unroll
            for (int n = 0; n < 2; ++n) { const int col = col0 + bj * HALF + n * 16;
                f32x4 bv = (f32x4){0.f, 0.f, 0.f, 0.f}; if (MODE != 2) bv = *(const f32x4*)(bias + col);
#pragma unroll
                for (int ai = 0; ai < 2; ++ai)
#pragma unroll
                    for (int m = 0; m < 4; ++m) { const int row = row0 + ai * HALF + m * 16; f32x4 v = acc[ai][bj][m][n] + bv;
                        if (MODE == 0) {
#pragma unroll
                            for (int j = 0; j < 4; ++j) { const float z = -v[j]; const float sp = fmaxf(z, 0.f) + log1pf(__expf(-fabsf(z))); v[j] = __expf(-__expf(-sp - 0.5f)); }
                        } else if (MODE == 1) {
#pragma unroll
                            for (int j = 0; j < 4; ++j) v[j] = sigmoidf_(v[j]);
                        }
                        *(f32x4*)(O + (size_t)row * 1024 + col) = v; } }
    }
};
}

template <int MAP>
__device__ __forceinline__ void transpose_item(const float* W, int K, int N, bf16_t* WT, const float* gk, LAS float* scr, int item, int lane) {
    const int nblk = N / 32, kb = item / nblk, nb = item % nblk, k0 = 64 * kb, n0 = 32 * nb;
#pragma unroll 8
    for (int i = 0; i < 32; ++i) { const int kk = 2 * i + (lane >> 5); float v = W[(size_t)(k0 + kk) * N + n0 + (lane & 31)]; if (gk) v *= gk[k0 + kk]; scr[kk * 33 + (lane & 31)] = v; }
    asm volatile("s_waitcnt lgkmcnt(0)" ::: "memory");
    const int c = lane & 7;
#pragma unroll
    for (int j = 0; j < 4; ++j) { const int n = n0 + (lane >> 3) + 8 * j; const LAS float* s = scr + (8 * c) * 33 + (n - n0);
        float sc = 1.f; int drow = n;
        if (MAP == 0) { if (n < 512 || (n >= 1536 && n < 2048)) sc = QSC; }
        if (MAP == 1) { const int hn = n < FF ? n : n - FF; drow = (hn >> 7) * 256 + (n < FF ? 0 : 128) + (hn & 127); }
        u32x4 o; o.x = cvtpk(s[0 * 33] * sc, s[1 * 33] * sc); o.y = cvtpk(s[2 * 33] * sc, s[3 * 33] * sc); o.z = cvtpk(s[4 * 33] * sc, s[5 * 33] * sc); o.w = cvtpk(s[6 * 33] * sc, s[7 * 33] * sc);
        *(u32x4*)(WT + (size_t)drow * K + k0 + 8 * c) = o; }
    asm volatile("s_waitcnt lgkmcnt(0)" ::: "memory");
}

__device__ __forceinline__ void phase0(KP p, LAS unsigned char* lds, int gw, int NGW, int wave, int lane) {
    LAS float* scr = (LAS float*)(lds + wave * 16384);
    constexpr int I_IN = (DM / 64) * (INC / 32), I_OUT = (DM / 64) * (DM / 32), I_GU = (DM / 64) * (GU / 32), I_DN = (FF / 64) * (DM / 32);
    constexpr int I_L = I_IN + I_OUT + I_GU + I_DN;
    for (int it = gw; it < NL * I_L; it += NGW) {
        const int l = it / I_L; int r = it % I_L; unsigned char* wb = p->ws + WS_W + (size_t)l * LW_STRIDE;
        if (r < I_IN) { transpose_item<0>(p->in[2] + (size_t)l * DM * INC, DM, INC, (bf16_t*)(wb + LW_WIN), p->in[1] + l * DM, scr, r, lane); continue; } r -= I_IN;
        if (r < I_OUT) { transpose_item<2>(p->in[17] + (size_t)l * DM * DM, DM, DM, (bf16_t*)(wb + LW_WOUT), nullptr, scr, r, lane); continue; } r -= I_OUT;
        if (r < I_GU) { transpose_item<1>(p->in[19] + (size_t)l * DM * GU, DM, GU, (bf16_t*)(wb + LW_WGU), p->in[18] + l * DM, scr, r, lane); continue; } r -= I_GU;
        transpose_item<2>(p->in[20] + (size_t)l * FF * DM, FF, DM, (bf16_t*)(wb + LW_WDN), nullptr, scr, r, lane);
    }
    const int gt = gw * 64 + lane, NGT = NGW * 64;
    for (int l = 0; l < NL; ++l) {
        unsigned char* wb = p->ws + WS_W + (size_t)l * LW_STRIDE;
        bf16_t* w2t = (bf16_t*)(wb + LW_W2T); bf16_t* a2t = (bf16_t*)(wb + LW_A2T); bf16_t* g2t = (bf16_t*)(wb + LW_G2T);
        const float* w2 = p->in[8] + (size_t)l * 96 * 1024; const float* a2 = p->in[10] + (size_t)l * 96 * 1024; const float* g2 = p->in[11] + (size_t)l * 256 * 1024;
        for (int i = gt; i < 1024 * 128; i += NGT) { const int n = i >> 7, k = i & 127;
            w2t[i] = (bf16_t)(cvtpk(k < 96 ? w2[k * 1024 + n] : 0.f, 0.f) & 0xffff); a2t[i] = (bf16_t)(cvtpk(k < 96 ? a2[k * 1024 + n] : 0.f, 0.f) & 0xffff); }
        for (int i = gt; i < 1024 * 256; i += NGT) { const int n = i >> 8, k = i & 255; g2t[i] = (bf16_t)(cvtpk(g2[k * 1024 + n], 0.f) & 0xffff); }
        unsigned* padz = (unsigned*)(wb + LW_WIN + (size_t)INC * DM * 2);
        for (int i = gt; i < (INCP - INC) * DM / 2; i += NGT) padz[i] = 0u;
    }
    const float* x = p->in[0]; float* X = p->out; bf16_t* XB = (bf16_t*)(p->ws + WS_XB); float* ssqA = (float*)(p->ws + WS_SSQA);
    for (int m = gw; m < M; m += NGW) { float ss = 0.f;
#pragma unroll
        for (int j = 0; j < 8; ++j) { const size_t o = (size_t)m * DM + j * 256 + lane * 4; const f32x4 v = *(const f32x4*)(x + o); *(f32x4*)(X + o) = v;
            u32x2 w; w.x = cvtpk(v[0], v[1]); w.y = cvtpk(v[2], v[3]); *(u32x2*)(XB + o) = w; ss += (v[0] * v[0] + v[1] * v[1]) + (v[2] * v[2] + v[3] * v[3]); }
        ss = wave_sum(ss); if (lane < 32) ssqA[(size_t)m * 32 + lane] = lane == 0 ? ss : 0.f; }
}

__device__ __forceinline__ void phase_prep1(KP p, int l, LAS unsigned char* lds, int gw, int NGW, int wave, int lane) {
    const bf16_t* PROJ = (const bf16_t*)(p->ws + WS_PROJ);
    LAS unsigned short* tile = (LAS unsigned short*)(lds + wave * 8448);
    bf16_t* VAT = (bf16_t*)(p->ws + WS_VAT); bf16_t* VBT = (bf16_t*)(p->ws + WS_VBT);
    for (int it = gw; it < 128 * 10; it += NGW) {
        const int tb = it / 10, g = it % 10, t0 = tb * 64; const int cbase = g < 8 ? 1024 + 64 * g : 2176 + 64 * (g - 8);
        bf16_t* dst = g < 8 ? VAT + (size_t)(64 * g) * M : VBT + (size_t)(64 * (g - 8)) * M;
#pragma unroll
        for (int i = 0; i < 8; ++i) { const int row = i * 8 + (lane >> 3), ch = lane & 7; const u32x4 v = *(const u32x4*)(PROJ + (size_t)(t0 + row) * INCP + cbase + 8 * ch);
            LAS unsigned* d = (LAS unsigned*)(tile + row * 66 + 8 * ch); d[0] = v.x; d[1] = v.y; d[2] = v.z; d[3] = v.w; }
        asm volatile("s_waitcnt lgkmcnt(0)" ::: "memory");
#pragma unroll
        for (int i = 0; i < 8; ++i) { const int c = i * 8 + (lane >> 3), tch = lane & 7, j = tch >> 1, hi = tch & 1; unsigned short v[8];
#pragma unroll
            for (int s = 0; s < 8; ++s) v[s] = tile[(16 * j + (s & 3) + 8 * (s >> 2) + 4 * hi) * 66 + c];
            u32x4 o; o.x = v[0] | ((unsigned)v[1] << 16); o.y = v[2] | ((unsigned)v[3] << 16); o.z = v[4] | ((unsigned)v[5] << 16); o.w = v[6] | ((unsigned)v[7] << 16);
            *(u32x4*)(dst + (size_t)c * M + t0 + 16 * j + 8 * hi) = o; }
        asm volatile("s_waitcnt lgkmcnt(0)" ::: "memory");
    }
    const float* mu = p->in[6] + (size_t)l * RWC;
    float* R = (float*)(p->ws + WS_R); float* KR = (float*)(p->ws + WS_KR); float* V = (float*)(p->ws + WS_V);
    bf16_t* AW = (bf16_t*)(p->ws + WS_AW); bf16_t* AA = (bf16_t*)(p->ws + WS_AA); bf16_t* AG = (bf16_t*)(p->ws + WS_AG);
    float knmax = 0.f;
    for (int t = gw; t < M; t += NGW) {
        const bf16_t* cur = PROJ + (size_t)t * INCP + RW0;
        {   const u32x4 kv = *(const u32x4*)(PROJ + (size_t)t * INCP + 512 + 8 * lane);
            float a0 = bflo(kv.x), a1 = bfhi(kv.x), a2 = bflo(kv.y), a3 = bfhi(kv.y), a4 = bflo(kv.z), a5 = bfhi(kv.z), a6 = bflo(kv.w), a7 = bfhi(kv.w);
            float ss = (a0 * a0 + a1 * a1) + (a2 * a2 + a3 * a3) + (a4 * a4 + a5 * a5) + (a6 * a6 + a7 * a7);
            ss += dppm<0xB1>(ss); ss += dppm<0x4E>(ss); ss += dppm<0x141>(ss); knmax = fmaxf(knmax, ss); }
        for (int it = 0; it < 7; ++it) { const int ch = it * 64 + lane; if (ch >= 440) break; const int j0 = ch * 8;
            const u32x4 c4 = *(const u32x4*)(cur + j0); u32x4 p4 = (u32x4){0u, 0u, 0u, 0u}; if (t > 0) p4 = *(const u32x4*)(cur - INCP + j0);
            const f32x4 m0 = *(const f32x4*)(mu + j0), m1 = *(const f32x4*)(mu + j0 + 4);
            float f[8]; const unsigned cw[4] = {c4.x, c4.y, c4.z, c4.w}, pw[4] = {p4.x, p4.y, p4.z, p4.w};
#pragma unroll
            for (int q = 0; q < 4; ++q) { const float c0 = bflo(cw[q]), c1 = bfhi(cw[q]), p0 = bflo(pw[q]), p1 = bfhi(pw[q]);
                const float mu0 = q < 2 ? m0[2 * q] : m1[2 * q - 4], mu1 = q < 2 ? m0[2 * q + 1] : m1[2 * q - 3];
                f[2 * q] = c0 + (p0 - c0) * mu0; f[2 * q + 1] = c1 + (p1 - c1) * mu1; }
            if (j0 < 3072) { float* dstp = (j0 < 1024 ? R + j0 : j0 < 2048 ? KR + (j0 - 1024) : V + (j0 - 2048)) + (size_t)t * 1024;
                *(f32x4*)dstp = (f32x4){f[0], f[1], f[2], f[3]}; *(f32x4*)(dstp + 4) = (f32x4){f[4], f[5], f[6], f[7]}; }
            else { bf16_t* dstp;
                if (j0 < 3168) { dstp = AW + (size_t)t * 128 + (j0 - 3072);
#pragma unroll
                    for (int q = 0; q < 8; ++q) f[q] = tanhf(f[q]); }
                else if (j0 < 3264) { dstp = AA + (size_t)t * 128 + (j0 - 3168); }
                else { dstp = AG + (size_t)t * 256 + (j0 - 3264);
#pragma unroll
                    for (int q = 0; q < 8; ++q) f[q] = sigmoidf_(f[q]); }
                u32x4 o; o.x = cvtpk(f[0], f[1]); o.y = cvtpk(f[2], f[3]); o.z = cvtpk(f[4], f[5]); o.w = cvtpk(f[6], f[7]); *(u32x4*)dstp = o; }
        }
        if (lane < 4) *(u32x4*)(AW + (size_t)t * 128 + 96 + 8 * lane) = (u32x4){0u, 0u, 0u, 0u};
        else if (lane < 8) *(u32x4*)(AA + (size_t)t * 128 + 96 + 8 * (lane - 4)) = (u32x4){0u, 0u, 0u, 0u};
    }
    {   LAS float* kr = (LAS float*)(lds + 8 * 8448);
        if ((lane & 7) == 0) kr[wave * 8 + (lane >> 3)] = knmax;
        __syncthreads();
        if (wave == 0 && lane < 8) { float m = kr[lane];
#pragma unroll
            for (int w2 = 1; w2 < 8; ++w2) m = fmaxf(m, kr[w2 * 8 + lane]);
            ((float*)(p->ws + WS_KNP))[(size_t)(gw >> 3) * 8 + lane] = m; }
        __syncthreads(); }
}

__device__ __forceinline__ void phase_prep2(KP p, int l, int gw, int NGW, int lane) {
    const float* KR = (const float*)(p->ws + WS_KR); const float* A = (const float*)(p->ws + WS_A);
    float* KF = (float*)(p->ws + WS_KF); float* AN = (float*)(p->ws + WS_AN); float* BB = (float*)(p->ws + WS_BB);
    const float* k_k = p->in[12] + l * 1024; const float* k_a = p->in[13] + l * 1024;
    const int c0 = 16 * lane;
    for (int t = gw; t < M; t += NGW) { const size_t o = (size_t)t * 1024 + c0; float n2 = 0.f; f32x4 kkv[4], kr[4], av[4];
#pragma unroll
        for (int q = 0; q < 4; ++q) { kr[q] = *(const f32x4*)(KR + o + 4 * q); av[q] = *(const f32x4*)(A + o + 4 * q); kkv[q] = kr[q] * *(const f32x4*)(k_k + c0 + 4 * q);
            n2 += (kkv[q][0] * kkv[q][0] + kkv[q][1] * kkv[q][1]) + (kkv[q][2] * kkv[q][2] + kkv[q][3] * kkv[q][3]); }
        n2 = quad_sum(n2); const float inv = 1.0f / fmaxf(sqrtf(n2), 1e-12f);
#pragma unroll
        for (int q = 0; q < 4; ++q) { const f32x4 kk = kkv[q] * inv; const f32x4 ka = *(const f32x4*)(k_a + c0 + 4 * q);
            *(f32x4*)(KF + o + 4 * q) = kr[q] * (1.0f + (av[q] - 1.0f) * ka); *(f32x4*)(AN + o + 4 * q) = -kk; *(f32x4*)(BB + o + 4 * q) = kk * av[q]; }
    }
}

template <int MODE>
__device__ __forceinline__ void scan_task(KP p, int l, LAS unsigned char* wl, int c, int h, int lane) {
    constexpr int NV = MODE == 0 ? 3 : (MODE == 1 ? 5 : 6);
    constexpr int SB = 4;
    LAS float* vec = (LAS float*)wl;
    LAS float* ybuf = (LAS float*)(wl + 6 * SB * 256);
    const float* src[6] = {(const float*)(p->ws + WS_DEC), (const float*)(p->ws + WS_AN), (const float*)(p->ws + WS_BB), (const float*)(p->ws + WS_KF), (const float*)(p->ws + WS_V), (const float*)(p->ws + WS_R)};
    const int rb = lane >> 2, cb = lane & 3, t0 = c * CL;
    f32x2 s[4][8];
    if (MODE == 0) {
#pragma unroll
        for (int r = 0; r < 4; ++r)
#pragma unroll
            for (int q = 0; q < 8; ++q) { s[r][q].x = (4 * rb + r == 16 * cb + 2 * q) ? 1.f : 0.f; s[r][q].y = (4 * rb + r == 16 * cb + 2 * q + 1) ? 1.f : 0.f; }
    } else if (MODE == 1) {
#pragma unroll
        for (int r = 0; r < 4; ++r)
#pragma unroll
            for (int q = 0; q < 8; ++q) s[r][q] = (f32x2){0.f, 0.f};
    } else {
        const float* SI = (const float*)(p->ws + WS_SI) + ((size_t)(h * NCH + c)) * 4096;
#pragma unroll
        for (int x = 0; x < 16; ++x) { const f32x4 v = *(const f32x4*)(SI + (16 * cb + x) * 64 + 4 * rb);
#pragma unroll
            for (int r = 0; r < 4; ++r) { if (x & 1) s[r][x >> 1].y = v[r]; else s[r][x >> 1].x = v[r]; } }
    }
    float lnw = 0.f, lnb = 0.f, rk = 0.f;
    if (MODE == 2) { lnw = p->in[15][l * 1024 + 64 * h + lane]; lnb = p->in[16][l * 1024 + 64 * h + lane]; rk = p->in[14][l * 1024 + 64 * h + lane]; }
    const int lst = lane >> 4, lq = lane & 15;
    const size_t goff = (size_t)(t0 + lst) * 1024 + 64 * h + 4 * lq;
    f32x4 pre[NV];
#pragma unroll
    for (int v = 0; v < NV; ++v) pre[v] = *(const f32x4*)(src[v] + goff);
    for (int sb = 0; sb < CL / SB; ++sb) {
#pragma unroll
        for (int v = 0; v < NV; ++v) *(LAS f32x4*)(vec + (v * SB + lst) * 64 + 4 * lq) = pre[v];
        if (sb + 1 < CL / SB) {
#pragma unroll
            for (int v = 0; v < NV; ++v) pre[v] = *(const f32x4*)(src[v] + goff + (size_t)(SB * (sb + 1)) * 1024);
        }
#pragma unroll 1
        for (int st = 0; st < SB; ++st) {
            const LAS float* vb = vec + st * 64 + 16 * cb;
            float sa[4];
            {   f32x2 a2[8];
#pragma unroll
                for (int q = 0; q < 4; ++q) { const f32x4 y = *(const LAS f32x4*)(vb + 1 * SB * 64 + 4 * q); a2[2 * q] = (f32x2){y[0], y[1]}; a2[2 * q + 1] = (f32x2){y[2], y[3]}; }
#pragma unroll
                for (int r = 0; r < 4; ++r) { f32x2 a = s[r][0] * a2[0];
#pragma unroll
                    for (int q = 1; q < 8; ++q) a = s[r][q] * a2[q] + a;
                    sa[r] = quad_sum(a.x + a.y); } }
            f32x4 vv = (f32x4){0.f, 0.f, 0.f, 0.f};
            if (MODE != 0) vv = *(const LAS f32x4*)(vec + (4 * SB + st) * 64 + 4 * rb);
#pragma unroll
            for (int q = 0; q < 4; ++q) { const f32x4 w4 = *(const LAS f32x4*)(vb + 0 * SB * 64 + 4 * q), b4 = *(const LAS f32x4*)(vb + 2 * SB * 64 + 4 * q);
                const f32x2 w0 = (f32x2){w4[0], w4[1]}, w1 = (f32x2){w4[2], w4[3]}, b0 = (f32x2){b4[0], b4[1]}, b1 = (f32x2){b4[2], b4[3]};
                if (MODE == 0) {
#pragma unroll
                    for (int r = 0; r < 4; ++r) { s[r][2 * q] = s[r][2 * q] * w0 + b0 * sa[r]; s[r][2 * q + 1] = s[r][2 * q + 1] * w1 + b1 * sa[r]; }
                } else { const f32x4 k4 = *(const LAS f32x4*)(vb + 3 * SB * 64 + 4 * q); const f32x2 k0 = (f32x2){k4[0], k4[1]}, k1 = (f32x2){k4[2], k4[3]};
#pragma unroll
                    for (int r = 0; r < 4; ++r) { s[r][2 * q] = s[r][2 * q] * w0 + (b0 * sa[r] + k0 * vv[r]); s[r][2 * q + 1] = s[r][2 * q + 1] * w1 + (b1 * sa[r] + k1 * vv[r]); }
                } }
            if (MODE == 2) {
                f32x2 r2[8];
#pragma unroll
                for (int q = 0; q < 4; ++q) { const f32x4 x = *(const LAS f32x4*)(vb + 5 * SB * 64 + 4 * q); r2[2 * q] = (f32x2){x[0], x[1]}; r2[2 * q + 1] = (f32x2){x[2], x[3]}; }
                f32x4 yv;
#pragma unroll
                for (int r = 0; r < 4; ++r) { f32x2 a = s[r][0] * r2[0];
#pragma unroll
                    for (int q = 1; q < 8; ++q) a = s[r][q] * r2[q] + a;
                    yv[r] = quad_sum(a.x + a.y); }
                if (cb == 0) *(LAS f32x4*)(ybuf + st * 64 + 4 * rb) = yv;
            }
        }
        if (MODE == 2) {
            const float* G = (const float*)(p->ws + WS_G); bf16_t* MIX = (bf16_t*)(p->ws + WS_MIX);
#pragma unroll 1
            for (int st = 0; st < SB; ++st) { const int t = t0 + SB * sb + st;
                const float y = ybuf[st * 64 + lane]; const float rr = vec[(5 * SB + st) * 64 + lane], kk = vec[(3 * SB + st) * 64 + lane], vv = vec[(4 * SB + st) * 64 + lane];
                const float mean = wave_sum(y) * (1.0f / 64.0f); const float d = y - mean; const float var = wave_sum(d * d) * (1.0f / 64.0f);
                const float bon = wave_sum(rr * kk * rk);
                const float g = G[(size_t)t * 1024 + 64 * h + lane];
                const float o = (d * rsqrtf(var + 64e-5f) * lnw + lnb + bon * vv) * g;
                MIX[(size_t)t * DM + 1024 + 64 * h + lane] = (bf16_t)(cvtpk(o, 0.f) & 0xffff); }
        }
    }
    if (MODE == 0) { float* dst = (float*)(p->ws + WS_PB) + ((size_t)(h * NCH + c)) * 4096;
#pragma unroll
        for (int r = 0; r < 4; ++r)
#pragma unroll
            for (int q = 0; q < 4; ++q) *(f32x4*)(dst + (4 * rb + r) * 64 + 16 * cb + 4 * q) = (f32x4){s[r][2 * q].x, s[r][2 * q].y, s[r][2 * q + 1].x, s[r][2 * q + 1].y}; }
    if (MODE == 1) { float* dst = (float*)(p->ws + WS_UB) + ((size_t)(h * NCH + c)) * 4096;
#pragma unroll
        for (int x = 0; x < 16; ++x) { f32x4 v;
#pragma unroll
            for (int r = 0; r < 4; ++r) v[r] = (x & 1) ? s[r][x >> 1].y : s[r][x >> 1].x;
            *(f32x4*)(dst + (16 * cb + x) * 64 + 4 * rb) = v; } }
}

__device__ __forceinline__ void s2_head(KP p, LAS unsigned char* lds, int h, const int tid) {
    const float* PB = (const float*)(p->ws + WS_PB) + (size_t)h * NCH * 4096; const float* UT = (const float*)(p->ws + WS_UB) + (size_t)h * NCH * 4096;
    float* SI = (float*)(p->ws + WS_SI) + (size_t)h * NCH * 4096;
    const int lane = tid & 63, w = __builtin_amdgcn_readfirstlane(tid >> 6), n = lane & 31, lh = lane >> 5, to = (w >> 1) & 1, ti = w & 1;
    const bool worker = w < 4;
    f32x16 sreg, uc; float pc[32];
#pragma unroll
    for (int r = 0; r < 16; ++r) sreg[r] = 0.f;
    if (worker) {
#pragma unroll
        for (int r = 0; r < 16; ++r) { const int cr = (r & 3) + 8 * (r >> 2) + 4 * lh; uc[r] = UT[(32 * to + cr) * 64 + 32 * ti + n];
            pc[r] = PB[cr * 64 + 32 * to + n]; pc[16 + r] = PB[(32 + cr) * 64 + 32 * to + n]; }
    }
    for (int c = 0; c < NCH; ++c) {
        if (worker) { float* si = SI + (size_t)c * 4096;
#pragma unroll
            for (int r = 0; r < 16; ++r) si[(32 * to + (r & 3) + 8 * (r >> 2) + 4 * lh) * 64 + 32 * ti + n] = sreg[r]; }
        if (c == NCH - 1) break;
        LAS f32x4* ex = (LAS f32x4*)(lds + (c & 1) * 16384);
        if (worker) {
#pragma unroll
            for (int q = 0; q < 4; ++q) ex[(w * 4 + q) * 64 + lane] = (f32x4){sreg[4 * q], sreg[4 * q + 1], sreg[4 * q + 2], sreg[4 * q + 3]}; }
        __syncthreads();
        if (worker) {
            f32x16 un; float pn[32];
            if (c + 2 < NCH) { const float* pb = PB + (size_t)(c + 1) * 4096; const float* ub = UT + (size_t)(c + 1) * 4096;
#pragma unroll
                for (int r = 0; r < 16; ++r) { const int cr = (r & 3) + 8 * (r >> 2) + 4 * lh; un[r] = ub[(32 * to + cr) * 64 + 32 * ti + n];
                    pn[r] = pb[cr * 64 + 32 * to + n]; pn[16 + r] = pb[(32 + cr) * 64 + 32 * to + n]; }
            } else {
#pragma unroll
                for (int r = 0; r < 16; ++r) { un[r] = 0.f; pn[r] = 0.f; pn[16 + r] = 0.f; } }
            f32x16 preg;
#pragma unroll
            for (int q = 0; q < 4; ++q) { const f32x4 v = ex[((w ^ 2) * 4 + q) * 64 + lane]; preg[4 * q] = v[0]; preg[4 * q + 1] = v[1]; preg[4 * q + 2] = v[2]; preg[4 * q + 3] = v[3]; }
            f32x16 acc = uc;
            const f32x16 b0 = to == 0 ? sreg : preg, b1 = to == 0 ? preg : sreg;
#pragma unroll
            for (int r = 0; r < 16; ++r) acc = __builtin_amdgcn_mfma_f32_32x32x2f32(pc[r], b0[r], acc, 0, 0, 0);
#pragma unroll
            for (int r = 0; r < 16; ++r) acc = __builtin_amdgcn_mfma_f32_32x32x2f32(pc[16 + r], b1[r], acc, 0, 0, 0);
            sreg = acc; uc = un;
#pragma unroll
            for (int r = 0; r < 32; ++r) pc[r] = pn[r];
        }
    }
    __syncthreads();
}

template <int DV, bool SWA>
__device__ __forceinline__ void attn_unit(LAS unsigned char* lds, const bf16_t* Q, const bf16_t* Kp, const bf16_t* VT, float slope2, int q0, float sink2,
                                          float* Of32, float* MLp, bf16_t* Obf, const int tid, int kt_lo, int kt_hi, float kn) {
    constexpr int KROW = 144, KTILE = 64 * KROW, VTILE = DV * KROW, BUF = KTILE + VTILE, NVL = DV / 64;
    const int lane = tid & 63, w = __builtin_amdgcn_readfirstlane(tid >> 6), r32 = lane & 31, hi = lane >> 5;
    const int qpos = q0 + 32 * w + r32;
    bf16x8 qf[4];
#pragma unroll
    for (int j = 0; j < 4; ++j) qf[j] = *(const bf16x8*)(Q + (size_t)qpos * INCP + 16 * j + 8 * hi);
    int kt0 = kt_lo, kt1 = kt_hi;
    if (!SWA) {
        float qq = 0.f, qk = 0.f;
#pragma unroll
        for (int j = 0; j < 4; ++j) { const bf16x8 kf = *(const bf16x8*)(Kp + (size_t)qpos * INCP + 16 * j + 8 * hi);
#pragma unroll
            for (int e = 0; e < 8; ++e) { const float qv = bf2f((unsigned short)qf[j][e]), kv = bf2f((unsigned short)kf[e]); qq += qv * qv; qk += qv * kv; } }
        qq = xor32_sum(qq); qk = xor32_sum(qk);
        const float dneed = (sqrtf(qq) * kn - qk + 45.0f) / slope2;
        float kneed = (float)qpos - dneed;
        kneed = fminf(kneed, dppm<0xB1>(kneed)); kneed = fminf(kneed, dppm<0x4E>(kneed)); kneed = fminf(kneed, dppm<0x141>(kneed)); kneed = fminf(kneed, dppm<0x140>(kneed));
        LAS float* red = (LAS float*)(lds + 2 * BUF);
        if ((lane & 15) == 0) red[w * 4 + (lane >> 4)] = kneed;
        __syncthreads();
        float km = red[0];
#pragma unroll
        for (int i = 1; i < 32; ++i) km = fminf(km, red[i]);
        const int ktw = km <= 0.f ? 0 : ((int)km >> 6);
        kt0 = ktw > kt_lo ? ktw : kt_lo;
    }
    const int qlo = q0 + 32 * w, qhi = qlo + 31;
    f32x16 o[DV / 32];
#pragma unroll
    for (int d = 0; d < DV / 32; ++d)
#pragma unroll
        for (int r = 0; r < 16; ++r) o[d][r] = 0.f;
    float mrun = -1e30f, lsum = 0.f;
    const int krow = tid >> 3, kch = tid & 7;
    u32x4 kreg, vreg[NVL];
    if (kt0 <= kt1) {   const int k0 = 64 * kt0; kreg = *(const u32x4*)(Kp + (size_t)(k0 + krow) * INCP + 8 * kch);
#pragma unroll
        for (int i = 0; i < NVL; ++i) { const int idx = tid + 512 * i; vreg[i] = *(const u32x4*)(VT + (size_t)(idx >> 3) * M + k0 + 8 * (idx & 7)); } }
    for (int kt = kt0; kt <= kt1; ++kt) {
        LAS unsigned char* buf = lds + ((kt - kt0) & 1) * BUF;
        *(LAS u32x4*)(buf + krow * KROW + 16 * kch) = kreg;
#pragma unroll
        for (int i = 0; i < NVL; ++i) { const int idx = tid + 512 * i; *(LAS u32x4*)(buf + KTILE + (idx >> 3) * KROW + 16 * (idx & 7)) = vreg[i]; }
        __syncthreads();
        if (kt < kt1) { const int k0 = 64 * (kt + 1); kreg = *(const u32x4*)(Kp + (size_t)(k0 + krow) * INCP + 8 * kch);
#pragma unroll
            for (int i = 0; i < NVL; ++i) { const int idx = tid + 512 * i; vreg[i] = *(const u32x4*)(VT + (size_t)(idx >> 3) * M + k0 + 8 * (idx & 7)); } }
        const int k0 = 64 * kt;
        bool act = k0 <= qhi; if (SWA) act = act && (k0 + 63 >= qlo - 127);
        if (act) {
            f32x16 p0, p1;
#pragma unroll
            for (int r = 0; r < 16; ++r) { p0[r] = 0.f; p1[r] = 0.f; }
#pragma unroll
            for (int j = 0; j < 4; ++j) { const bf16x8 a0 = *(const LAS bf16x8*)(buf + r32 * KROW + 32 * j + 16 * hi), a1 = *(const LAS bf16x8*)(buf + (r32 + 32) * KROW + 32 * j + 16 * hi);
                p0 = __builtin_amdgcn_mfma_f32_32x32x16_bf16(a0, qf[j], p0, 0, 0, 0); p1 = __builtin_amdgcn_mfma_f32_32x32x16_bf16(a1, qf[j], p1, 0, 0, 0); }
            float mx = -1e30f;
#pragma unroll
            for (int r = 0; r < 16; ++r) { const int kv = k0 + (r & 3) + 8 * (r >> 2) + 4 * hi; const int d0 = qpos - kv, d1 = d0 - 32;
                float s0 = p0[r] - slope2 * (float)d0, s1 = p1[r] - slope2 * (float)d1;
                bool ok0 = d0 >= 0, ok1 = d1 >= 0; if (SWA) { ok0 = ok0 && d0 < 128; ok1 = ok1 && d1 < 128; }
                s0 = ok0 ? s0 : -1e30f; s1 = ok1 ? s1 : -1e30f; p0[r] = s0; p1[r] = s1; mx = fmaxf(mx, fmaxf(s0, s1)); }
            mx = xor32_max(mx);
            const float mnew = fmaxf(mrun, mx), f = exp2f(mrun - mnew); mrun = mnew;
            float rs = 0.f;
#pragma unroll
            for (int r = 0; r < 16; ++r) { p0[r] = exp2f(p0[r] - mnew); p1[r] = exp2f(p1[r] - mnew); rs += p0[r] + p1[r]; }
            lsum = lsum * f + rs;
#pragma unroll
            for (int d = 0; d < DV / 32; ++d)
#pragma unroll
                for (int r = 0; r < 16; ++r) o[d][r] *= f;
            u32x4 pw[4];
            pw[0] = (u32x4){cvtpk(p0[0], p0[1]), cvtpk(p0[2], p0[3]), cvtpk(p0[4], p0[5]), cvtpk(p0[6], p0[7])};
            pw[1] = (u32x4){cvtpk(p0[8], p0[9]), cvtpk(p0[10], p0[11]), cvtpk(p0[12], p0[13]), cvtpk(p0[14], p0[15])};
            pw[2] = (u32x4){cvtpk(p1[0], p1[1]), cvtpk(p1[2], p1[3]), cvtpk(p1[4], p1[5]), cvtpk(p1[6], p1[7])};
            pw[3] = (u32x4){cvtpk(p1[8], p1[9]), cvtpk(p1[10], p1[11]), cvtpk(p1[12], p1[13]), cvtpk(p1[14], p1[15])};
#pragma unroll
            for (int d = 0; d < DV / 32; ++d)
#pragma unroll
                for (int j = 0; j < 4; ++j) { const bf16x8 vf = *(const LAS bf16x8*)(buf + KTILE + (32 * d + r32) * KROW + 32 * j + 16 * hi);
                    o[d] = __builtin_amdgcn_mfma_f32_32x32x16_bf16(vf, __builtin_bit_cast(bf16x8, pw[j]), o[d], 0, 0, 0); }
        }
    }
    lsum = xor32_sum(lsum);
    if (SWA) { lsum += exp2f(sink2 - mrun);
        const float inv = 1.0f / lsum; bf16_t* op = Obf + (size_t)qpos * DM;
#pragma unroll
        for (int d = 0; d < DV / 32; ++d)
#pragma unroll
            for (int g = 0; g < 4; ++g) { u32x2 wv; wv.x = cvtpk(o[d][4 * g] * inv, o[d][4 * g + 1] * inv); wv.y = cvtpk(o[d][4 * g + 2] * inv, o[d][4 * g + 3] * inv);
                *(u32x2*)(op + 32 * d + 8 * g + 4 * hi) = wv; }
    } else { float* op = Of32 + (size_t)qpos * 1024;
#pragma unroll
        for (int d = 0; d < DV / 32; ++d)
#pragma unroll
            for (int g = 0; g < 4; ++g) *(f32x4*)(op + 32 * d + 8 * g + 4 * hi) = (f32x4){o[d][4 * g], o[d][4 * g + 1], o[d][4 * g + 2], o[d][4 * g + 3]};
        if (hi == 0) *(f32x2*)(MLp + (size_t)qpos * 16) = (f32x2){mrun, lsum};
    }
    __syncthreads();
}

__device__ __forceinline__ void phase_diffcombine(KP p, int l, int gw, int NGW, int lane) {
    const float* lamv = p->in[3] + l * 256;
    const float lambda_init = 0.8f - 0.6f * expf(-0.3f * (float)l);
    const float s1 = wave_sum(lamv[lane] * lamv[64 + lane]), s2 = wave_sum(lamv[128 + lane] * lamv[192 + lane]);
    const float lam = expf(s1) - expf(s2) + lambda_init;
    const float* OD = (const float*)(p->ws + WS_OD); const float* ML = (const float*)(p->ws + WS_ML); bf16_t* MIX = (bf16_t*)(p->ws + WS_MIX);
    const int h = lane >> 4, d0 = (lane & 15) * 8;
    const f32x4 g0 = *(const f32x4*)(p->in[4] + l * 128 + d0), g1 = *(const f32x4*)(p->in[4] + l * 128 + d0 + 4);
    for (int t = gw; t < M; t += NGW) { const int nseg = ((t >> 8) + 8) >> 3;
        f32x4 oc[2][2];
#pragma unroll
        for (int c = 0; c < 2; ++c) {
            f32x2 ml[4]; float mm = -1e30f;
#pragma unroll
            for (int s = 0; s < 4; ++s) if (s < nseg) { ml[s] = *(const f32x2*)(ML + ((size_t)s * M + t) * 16 + h * 4 + c * 2); mm = fmaxf(mm, ml[s].x); }
            f32x4 a0 = (f32x4){0.f, 0.f, 0.f, 0.f}, a1 = a0; float L = 0.f;
#pragma unroll
            for (int s = 0; s < 4; ++s) if (s < nseg) { const float f = exp2f(ml[s].x - mm); L += ml[s].y * f;
                const float* b = OD + ((size_t)s * M + t) * 1024 + h * 256 + c * 128 + d0; a0 += *(const f32x4*)b * f; a1 += *(const f32x4*)(b + 4) * f; }
            const float inv = 1.0f / L; oc[c][0] = a0 * inv; oc[c][1] = a1 * inv; }
        const f32x4 o0 = oc[0][0] - oc[1][0] * lam, o1 = oc[0][1] - oc[1][1] * lam;
        float ss = (o0[0] * o0[0] + o0[1] * o0[1]) + (o0[2] * o0[2] + o0[3] * o0[3]) + (o1[0] * o1[0] + o1[1] * o1[1]) + (o1[2] * o1[2] + o1[3] * o1[3]);
        ss = row16_sum(ss);
        const float r = rsqrtf(ss * (1.0f / 128.0f) + EPS) * (1.0f - lambda_init);
        const f32x4 y0 = o0 * g0 * r, y1 = o1 * g1 * r;
        u32x4 wv; wv.x = cvtpk(y0[0], y0[1]); wv.y = cvtpk(y0[2], y0[3]); wv.z = cvtpk(y1[0], y1[1]); wv.w = cvtpk(y1[2], y1[3]);
        *(u32x4*)(MIX + (size_t)t * DM + h * 128 + d0) = wv; }
}

#define XB_TMO      128
#define XB_XCNT(j)  (256  + 64 * (j))
#define XB_XSUB(j)  (1280 + 64 * (j))
#define XB_XGEN(j)  (2304 + 64 * (j))
#define XB_TOP      3328
#define XB_TOPGEN   3392
#define XCD_BAR_WORDS 3456
#define XB_SPIN_CAP (1u << 22)
__device__ __forceinline__ unsigned xb_ld(unsigned* p)              { return __hip_atomic_load(p, __ATOMIC_RELAXED, __HIP_MEMORY_SCOPE_AGENT); }
__device__ __forceinline__ unsigned xb_add(unsigned* p, unsigned v) { return __hip_atomic_fetch_add(p, v, __ATOMIC_RELAXED, __HIP_MEMORY_SCOPE_AGENT); }
__device__ __forceinline__ unsigned xb_xcc_id() { return (unsigned)__builtin_amdgcn_s_getreg((3 << 11) | 20) & 0xFu; }
#define XB_SPIN(cond, bar) do { unsigned _sp = 0; while (cond) { __builtin_amdgcn_s_sleep(1); \
    if ((++_sp & 255u) == 0u) { if (xb_ld(&(bar)[XB_TMO])) break; if (_sp > XB_SPIN_CAP) { atomicAdd(&(bar)[XB_TMO], 1u); break; } } } } while (0)
__device__ __forceinline__ void xcd_barrier_complete(unsigned* bar, unsigned x, unsigned& nloc, unsigned& nx) {
    const unsigned G = gridDim.x;
    unsigned sum, cnt, mine, sp = 0u;
    for (;;) {
        sum = 0u; cnt = 0u; mine = 0u;
#pragma unroll
        for (unsigned j = 0; j < 16; ++j) { const unsigned c = xb_ld(&bar[XB_XCNT(j)]); sum += c; cnt += (c > 0u) ? 1u : 0u; mine = (j == x) ? c : mine; }
        if (sum == G) break;
        __builtin_amdgcn_s_sleep(1);
        if ((++sp & 255u) == 0u) { if (xb_ld(&bar[XB_TMO])) break; if (sp > XB_SPIN_CAP) { atomicAdd(&bar[XB_TMO], 1u); break; } }
    }
    nloc = mine > 0u ? mine : 1u; nx = cnt > 0u ? cnt : 1u;
}
__device__ __forceinline__ void xcd_barrier(unsigned* bar, volatile LAS unsigned* st, const int tid) {
    asm volatile("s_waitcnt vmcnt(0)" ::: "memory");
    __syncthreads();
    if (tid == 0) {
        const unsigned x = xb_xcc_id();
        __builtin_amdgcn_s_waitcnt(0);
        unsigned nloc = st[0], nx = st[1];
        if (nloc == 0u) { xcd_barrier_complete(bar, x, nloc, nx); st[0] = nloc; st[1] = nx; }
        const unsigned old = xb_add(&bar[XB_XSUB(x)], 1u);
        const unsigned gen = old / nloc;
        if (old + 1u == (gen + 1u) * nloc) {
            __builtin_amdgcn_fence(__ATOMIC_RELEASE, "agent");
            asm volatile("s_waitcnt vmcnt(0)" ::: "memory");
            const unsigned og = xb_add(&bar[XB_TOP], 1u);
            const unsigned tg = og / nx;
            if (og + 1u == (tg + 1u) * nx) xb_add(&bar[XB_TOPGEN], 1u);
            else XB_SPIN(xb_ld(&bar[XB_TOPGEN]) == tg, bar);
            __builtin_amdgcn_fence(__ATOMIC_ACQUIRE, "agent");
            xb_add(&bar[XB_XGEN(x)], 1u);
            asm volatile("s_waitcnt vmcnt(0)" ::: "memory");
        } else {
            XB_SPIN(xb_ld(&bar[XB_XGEN(x)]) == gen, bar);
            __builtin_amdgcn_fence(__ATOMIC_ACQUIRE, "agent");
            asm volatile("s_waitcnt vmcnt(0)" ::: "memory");
        }
    }
    __syncthreads();
}

#define GSYNC() do { FRESH(); xcd_barrier((unsigned*)(p->ws + WS_CTL) + 4096, (volatile LAS unsigned*)(lds + LDS_BYTES - 32), tid); } while (0)
#define PTRS() unsigned* ctl = (unsigned*)(p->ws + WS_CTL); bf16_t* XB = (bf16_t*)(p->ws + WS_XB); bf16_t* PROJ = (bf16_t*)(p->ws + WS_PROJ); bf16_t* MIX = (bf16_t*)(p->ws + WS_MIX); bf16_t* H = (bf16_t*)(p->ws + WS_H); \
    float* ssqA = (float*)(p->ws + WS_SSQA); float* ssqB = (float*)(p->ws + WS_SSQB); unsigned char* wb = p->ws + WS_W + (size_t)l * LW_STRIDE; (void)ctl; (void)XB; (void)PROJ; (void)MIX; (void)H; (void)ssqA; (void)ssqB; (void)wb
#define FRESH() KP p = fresh_params(); int G = gridDim.x, bx = blockIdx.x; asm volatile("" : "+s"(G), "+s"(bx)); const int NGW = G * 8; (void)NGW; const int tid = fresh_tid(wave0), lane = tid & 63, wave = __builtin_amdgcn_readfirstlane(tid >> 6), gw = bx * 8 + wave; (void)lane; (void)gw
template <int L> __device__ __forceinline__ void layer_body(LAS unsigned char* lds, const int wave0) {
    constexpr int l = L;

        {   FRESH(); PTRS(); pg8::Gemm g{XB, (const bf16_t*)(wb + LW_WIN), M, INCP, DM}; pg8::StaticOrder S; S.init(M, INCP, G, bx);
            pg8::EpiProj E{PROJ, INCP, ssqA};
            pg8::gemm_phase<pg8::EpiProj, pg8::StaticOrder, true, true>(lds, g, S, E, tid); }
        GSYNC();
        { FRESH(); phase_prep1(p, l, lds, gw, NGW, wave, lane); }
        GSYNC();
        {   FRESH(); PTRS(); pg8::Gemm g{(const bf16_t*)(p->ws + WS_AW), (const bf16_t*)(wb + LW_W2T), M, 1024, 128}; pg8::StaticOrder S; S.init(M, 1024, G, bx);
            pg8::EpiLora<0> E{(float*)(p->ws + WS_DEC), p->in[7] + l * 1024};
            pg8::gemm_phase<pg8::EpiLora<0>, pg8::StaticOrder, true, true>(lds, g, S, E, tid); }
        {   FRESH(); PTRS(); pg8::Gemm g{(const bf16_t*)(p->ws + WS_AA), (const bf16_t*)(wb + LW_A2T), M, 1024, 128}; pg8::StaticOrder S; S.init(M, 1024, G, (bx + 128) % G);
            pg8::EpiLora<1> E{(float*)(p->ws + WS_A), p->in[9] + l * 1024};
            pg8::gemm_phase<pg8::EpiLora<1>, pg8::StaticOrder, true, true>(lds, g, S, E, tid); }
        {   FRESH(); PTRS(); pg8::Gemm g{(const bf16_t*)(p->ws + WS_AG), (const bf16_t*)(wb + LW_G2T), M, 1024, 256}; pg8::StaticOrder S; S.init(M, 1024, G, bx);
            pg8::EpiLora<2> E{(float*)(p->ws + WS_G), nullptr};
            pg8::gemm_phase<pg8::EpiLora<2>, pg8::StaticOrder, true, true>(lds, g, S, E, tid); }
        GSYNC();
        { FRESH(); phase_prep2(p, l, gw, NGW, lane); }
        GSYNC();
        {   FRESH(); LAS unsigned char* wl = lds + wave * 14336;
#ifndef DUP57
#define DUP57 1
#endif
            for (int rep = 0; rep < DUP57; ++rep) for (int it = gw; it < 2 * NCH * 16; it += NGW) { const int mode = it & 1, ch = it >> 1, c = ch % NCH, h = ch / NCH;
                if (mode == 0) scan_task<0>(p, l, wl, c, h, lane); else scan_task<1>(p, l, wl, c, h, lane); } }
        GSYNC();
#ifndef DUP6
#define DUP6 1
#endif
        for (int rep = 0; rep < DUP6; ++rep) {   if (rep) GSYNC(); FRESH(); PTRS(); LAS int* slot = (LAS int*)(lds + LDS_BYTES - 64);
            LAS float* knl = (LAS float*)(lds + LDS_BYTES - 128);
            {   LAS float* kr = (LAS float*)lds; const float* knp = (const float*)(p->ws + WS_KNP); const int g = tid & 7, part = tid >> 3; float m = 0.f;
                for (int b2 = part; b2 < G; b2 += 64) m = fmaxf(m, knp[(size_t)b2 * 8 + g]);
                kr[part * 8 + g] = m; __syncthreads();
                if (tid < 8) { float mm = kr[tid]; for (int q2 = 1; q2 < 64; ++q2) mm = fmaxf(mm, kr[q2 * 8 + tid]); knl[tid] = mm; }
                __syncthreads(); }
            const float* sinks = p->in[5] + l * 8;
            for (;;) {
                if (tid == 0) *slot = (int)atomicAdd(ctl + 64 * (l + 1) + 16 * rep, 1u);
                __syncthreads();
                const int it = *slot;
                __syncthreads();
                if (it >= 16 + 640 + 256) break;
                if (it < 16) {
#ifndef NO_S2
                    s2_head(p, lds, it, tid);
#endif
                }
                else if (it < 656) { const int d = it - 16, h = 3 - d / 160, u = d % 160, c = u & 1, v = u >> 1; int qb, seg;
                    if (v < 32) { qb = 31 - (v >> 2); seg = v & 3; } else if (v < 56) { const int w2 = v - 32; qb = 23 - w2 / 3; seg = w2 % 3; }
                    else if (v < 72) { const int w2 = v - 56; qb = 15 - (w2 >> 1); seg = w2 & 1; } else { qb = 79 - v; seg = 0; }
                    const float slope2 = exp2f(-2.0f * (float)(h + 1)) * LOG2E;
                    const float kn = sqrtf(knl[h * 2 + c]);
                    const int kt1 = 4 * qb + 3, klo = 32 * seg, khi = (klo + 31 < kt1) ? klo + 31 : kt1;
                    attn_unit<128, false>(lds, PROJ + h * 128 + c * 64, PROJ + 512 + h * 128 + c * 64, (const bf16_t*)(p->ws + WS_VAT) + (size_t)(h * 128) * M, slope2, qb * 256, 0.f,
                                          (float*)(p->ws + WS_OD) + (size_t)seg * M * 1024 + h * 256 + c * 128, (float*)(p->ws + WS_ML) + (size_t)seg * M * 16 + h * 4 + c * 2, nullptr, tid, klo, khi, kn); }
                else { const int s = it - 656, hq = s & 7, qb = s >> 3;
                    const int aidx = (hq >> 1) * 3 + (hq & 1);
                    const float slope2 = exp2f(-8.0f * (float)(aidx + 1) / 12.0f) * LOG2E;
                    const int q0 = qb * 256;
                    attn_unit<64, true>(lds, PROJ + 1536 + hq * 64, PROJ + 2048 + (hq >> 2) * 64, (const bf16_t*)(p->ws + WS_VBT) + (size_t)((hq >> 2) * 64) * M, slope2, q0, sinks[hq] * LOG2E,
                                        nullptr, nullptr, MIX + 512 + hq * 64, tid, q0 >= 128 ? (q0 - 128) / 64 : 0, (q0 + 255) / 64, 0.f); }
            } }
        GSYNC();
        {   FRESH(); LAS unsigned char* wl = lds + wave * 14336;
            for (int rep = 0; rep < DUP57; ++rep) for (int it = gw; it < NCH * 16; it += NGW) { const int c = it % NCH, h = it / NCH; scan_task<2>(p, l, wl, c, h, lane); }
            phase_diffcombine(p, l, gw, NGW, lane); }
        GSYNC();
        {   FRESH(); PTRS(); pg8::Gemm g{MIX, (const bf16_t*)(wb + LW_WOUT), M, DM, DM}; pg8::StaticOrder S; S.init(M, DM, G, bx);
            pg8::EpiResid E{p->out, XB, ssqB};
            pg8::gemm_phase<pg8::EpiResid, pg8::StaticOrder, true, true>(lds, g, S, E, tid); }
        GSYNC();
        {   FRESH(); PTRS(); pg8::Gemm g{XB, (const bf16_t*)(wb + LW_WGU), M, GU, DM}; pg8::StaticOrder S; S.init(M, GU, G, bx);
            pg8::EpiSwiGLU E{H, ssqB};
            pg8::gemm_phase<pg8::EpiSwiGLU, pg8::StaticOrder, true, true>(lds, g, S, E, tid); }
        GSYNC();
        {   FRESH(); PTRS(); pg8::Gemm g{H, (const bf16_t*)(wb + LW_WDN), M, DM, FF}; pg8::StaticOrder S; S.init(M, DM, G, bx);
            pg8::EpiResid E{p->out, XB, ssqA};
            pg8::gemm_phase<pg8::EpiResid, pg8::StaticOrder, true, true>(lds, g, S, E, tid); }
        GSYNC();
    }

__global__ void __launch_bounds__(512, 2) fwd_megakernel(Params p_unused) {
    extern __shared__ __attribute__((aligned(16))) unsigned char lds_raw[];
    LAS unsigned char* lds = (LAS unsigned char*)lds_raw;
    cg::grid_group grid = cg::this_grid();
    const int wave0 = __builtin_amdgcn_readfirstlane((int)threadIdx.x >> 6);
    if (threadIdx.x < 16) ((LAS unsigned*)(lds + LDS_BYTES - 64))[threadIdx.x] = 0u;
    if (threadIdx.x == 0) xb_add((unsigned*)(p_unused.ws + WS_CTL) + 4096 + XB_XCNT(xb_xcc_id()), 1u);
    __syncthreads();

    { FRESH(); phase0(p, lds, gw, NGW, wave, lane); }
    grid.sync();

    layer_body<0>(lds, wave0); layer_body<1>(lds, wave0); layer_body<2>(lds, wave0); layer_body<3>(lds, wave0);
    {   FRESH(); const int l = 0; PTRS(); const float* gf = p->in[21];
        for (int m = gw; m < M; m += NGW) { const float rs = rsqrtf(wave_sum(lane < 32 ? ssqA[(size_t)m * 32 + lane] : 0.f) * (1.0f / DM) + EPS);
#pragma unroll
            for (int j = 0; j < 8; ++j) { const size_t o = (size_t)m * DM + j * 256 + lane * 4; const f32x4 v = *(const f32x4*)(p->out + o); const f32x4 gv = *(const f32x4*)(gf + j * 256 + lane * 4);
                *(f32x4*)(p->out + o) = v * rs * gv; } } }
}

extern "C" void kernel_launch(void* const* d_in, const int* in_sizes, int n_in, void* d_out, int out_size, void* d_ws, size_t ws_size, hipStream_t stream) {
    static int grid = 0;
    if (grid == 0) {
        if (n_in != 22 || out_size != M * DM || ws_size < WS_END) { fprintf(stderr, "kernel_launch: unexpected shapes (n_in %d out %d ws %zu need %zu)\n", n_in, out_size, ws_size, (size_t)WS_END); grid = -1; return; }
        int dev = 0, cus = 0, per_cu = 0;
        hipGetDevice(&dev); hipDeviceGetAttribute(&cus, hipDeviceAttributeMultiprocessorCount, dev);
        hipFuncSetAttribute((const void*)fwd_megakernel, hipFuncAttributeMaxDynamicSharedMemorySize, LDS_BYTES);
        hipOccupancyMaxActiveBlocksPerMultiprocessor(&per_cu, (const void*)fwd_megakernel, 512, LDS_BYTES);
        if (per_cu < 1) { fprintf(stderr, "kernel_launch: occupancy query says %d blocks per CU\n", per_cu); per_cu = 1; }
        (void)hipGetLastError();
        grid = cus;
    }
    if (grid < 0) return;
    hipMemsetAsync((char*)d_ws + WS_CTL, 0, 65536, stream);
    Params p{};
    for (int i = 0; i < 22; ++i) p.in[i] = (const float*)d_in[i];
    p.out = (float*)d_out; p.ws = (unsigned char*)d_ws;
    void* args[] = {&p};
    hipError_t e = hipLaunchCooperativeKernel((const void*)fwd_megakernel, dim3(grid), dim3(512), args, LDS_BYTES, stream);
    if (e != hipSuccess) fprintf(stderr, "cooperative launch failed: %s (grid %d)\n", hipGetErrorString(e), grid);
}
```

```cpp
#include <hip/hip_runtime.h>
#include <hip/hip_cooperative_groups.h>
#include <cstdio>
#include <cstdint>
namespace cg = cooperative_groups;

#define LAS __attribute__((address_space(3)))
typedef unsigned short bf16_t;
typedef short bf16x8 __attribute__((ext_vector_type(8)));
typedef float f32x4 __attribute__((ext_vector_type(4)));
typedef float f32x2 __attribute__((ext_vector_type(2)));
typedef float f32x16 __attribute__((ext_vector_type(16)));
typedef unsigned u32x4 __attribute__((ext_vector_type(4)));
typedef unsigned u32x2 __attribute__((ext_vector_type(2)));
typedef __bf16 bf16x2_t __attribute__((ext_vector_type(2)));

constexpr int M = 8192, DM = 2048, INC = 5824, INCP = 5888, FF = 5632, GU = 11264, RW0 = 2304, RWC = 3520;
constexpr int NL = 4, NCH = 64, CL = 128;
constexpr float EPS = 1e-5f, LOG2E = 1.4426950408889634f;
constexpr float QSC = 0.125f * LOG2E;

constexpr size_t MiB = 1u << 20;
constexpr size_t SZ_WIN = (size_t)INCP * DM * 2, SZ_WOUT = (size_t)DM * DM * 2, SZ_WGU = (size_t)GU * DM * 2, SZ_WDN = (size_t)DM * FF * 2;
constexpr size_t SZ_W2T = 1024 * 128 * 2, SZ_G2T = 1024 * 256 * 2;
constexpr size_t LW_WIN = 0, LW_WOUT = LW_WIN + SZ_WIN, LW_WGU = LW_WOUT + SZ_WOUT, LW_WDN = LW_WGU + SZ_WGU, LW_W2T = LW_WDN + SZ_WDN,
                 LW_A2T = LW_W2T + SZ_W2T, LW_G2T = LW_A2T + SZ_W2T, LW_STRIDE = LW_G2T + SZ_G2T;
constexpr size_t SZ_F = (size_t)M * 1024 * 4;
constexpr size_t WS_CTL = 0, WS_W = 1 * MiB, WS_XB = WS_W + NL * LW_STRIDE, WS_PROJ = WS_XB + (size_t)M * DM * 2,
                 WS_VAT = WS_PROJ + (size_t)M * INCP * 2, WS_VBT = WS_VAT + (size_t)512 * M * 2, WS_AW = WS_VBT + (size_t)128 * M * 2,
                 WS_AA = WS_AW + (size_t)M * 128 * 2, WS_AG = WS_AA + (size_t)M * 128 * 2, WS_R = WS_AG + (size_t)M * 256 * 2,
                 WS_KR = WS_R + SZ_F, WS_V = WS_KR + SZ_F, WS_DEC = WS_V + SZ_F, WS_A = WS_DEC + SZ_F, WS_G = WS_A + SZ_F,
                 WS_KF = WS_G + SZ_F, WS_AN = WS_KF + SZ_F, WS_BB = WS_AN + SZ_F, WS_PB = WS_BB + SZ_F, WS_UB = WS_PB + SZ_F,
                 WS_SI = WS_UB + SZ_F, WS_OD = WS_SI + SZ_F, WS_ML = WS_OD + 4 * SZ_F, WS_KNP = WS_ML + (size_t)4 * M * 16 * 4, WS_MIX = WS_KNP + 65536, WS_SSQA = WS_MIX + (size_t)M * DM * 2,
                 WS_SSQB = WS_SSQA + (size_t)M * 32 * 4, WS_END = WS_SSQB + (size_t)M * 32 * 4;
constexpr size_t WS_H = WS_PROJ;
static_assert((size_t)M * FF * 2 <= (size_t)M * INCP * 2, "H overlay");

constexpr int LDS_BYTES = 147456;

struct Params { const float* in[22]; float* out; unsigned char* ws; };
typedef const __attribute__((address_space(4))) Params* KP;
__device__ __forceinline__ KP fresh_params() { KP k = (KP)__builtin_amdgcn_kernarg_segment_ptr(); asm volatile("" : "+s"(k)); return k; }

__device__ __forceinline__ unsigned cvtpk(float lo, float hi) { f32x2 v = {lo, hi}; bf16x2_t b = __builtin_convertvector(v, bf16x2_t); return __builtin_bit_cast(unsigned, b); }
__device__ __forceinline__ float bf2f(unsigned short b) { return __builtin_bit_cast(float, (unsigned)b << 16); }
__device__ __forceinline__ float bflo(unsigned w) { return __builtin_bit_cast(float, w << 16); }
__device__ __forceinline__ float bfhi(unsigned w) { return __builtin_bit_cast(float, w & 0xffff0000u); }
template <int CTRL> __device__ __forceinline__ float dppm(float v) { return __builtin_bit_cast(float, __builtin_amdgcn_mov_dpp(__builtin_bit_cast(int, v), CTRL, 0xF, 0xF, true)); }
__device__ __forceinline__ float xor16_sum(float v) { const unsigned b = __builtin_bit_cast(unsigned, v); auto rr = __builtin_amdgcn_permlane16_swap(b, b, false, false); return __builtin_bit_cast(float, (unsigned)rr[0]) + __builtin_bit_cast(float, (unsigned)rr[1]); }
__device__ __forceinline__ float xor32_sum(float v) { const unsigned b = __builtin_bit_cast(unsigned, v); auto rr = __builtin_amdgcn_permlane32_swap(b, b, false, false); return __builtin_bit_cast(float, (unsigned)rr[0]) + __builtin_bit_cast(float, (unsigned)rr[1]); }
__device__ __forceinline__ float xor32_max(float v) { const unsigned b = __builtin_bit_cast(unsigned, v); auto rr = __builtin_amdgcn_permlane32_swap(b, b, false, false); return fmaxf(__builtin_bit_cast(float, (unsigned)rr[0]), __builtin_bit_cast(float, (unsigned)rr[1])); }
__device__ __forceinline__ float row16_sum(float v) { v += dppm<0xB1>(v); v += dppm<0x4E>(v); v += dppm<0x141>(v); v += dppm<0x140>(v); return v; }
__device__ __forceinline__ float wave_sum(float v) { return xor32_sum(xor16_sum(row16_sum(v))); }
__device__ __forceinline__ float dpp_xor1(float v) { return __builtin_bit_cast(float, __builtin_amdgcn_mov_dpp(__builtin_bit_cast(int, v), 0xB1, 0xF, 0xF, true)); }
__device__ __forceinline__ float dpp_xor2(float v) { return __builtin_bit_cast(float, __builtin_amdgcn_mov_dpp(__builtin_bit_cast(int, v), 0x4E, 0xF, 0xF, true)); }
__device__ __forceinline__ float quad_sum(float v) { v += dpp_xor1(v); v += dpp_xor2(v); return v; }
__device__ __forceinline__ float sigmoidf_(float x) { return 1.0f / (1.0f + __expf(-x)); }

__device__ __forceinline__ int fresh_tid(int wave0) { unsigned z = 0u; asm volatile("" : "+v"(z)); int t = wave0 * 64 + (int)__builtin_amdgcn_mbcnt_hi(~0u, __builtin_amdgcn_mbcnt_lo(~0u, z)); asm volatile("" : "+v"(t)); return t; }

__device__ __forceinline__ float row_rstd(const float* ssq, int row, int fq) {
    const float* pp = ssq + (size_t)row * 32 + 8 * fq; const f32x4 a = *(const f32x4*)pp, b = *(const f32x4*)(pp + 4);
    float s = ((a[0] + a[1]) + (a[2] + a[3])) + ((b[0] + b[1]) + (b[2] + b[3]));
    s = xor32_sum(xor16_sum(s));
    return rsqrtf(s * (1.0f / DM) + EPS);
}

namespace pg8 {
constexpr int BM = 256, BK = 64, HALF = 128, HTB = HALF * BK * 2, STAGE_BYTES = 8 * HTB, NXCD = 8, WGM = 8;
__host__ __device__ __forceinline__ int lds_byte(int r, int c) { const int st = (r >> 4) * 2 + (c >> 5), rr = r & 15, cc = c & 31, ob = rr * 64 + cc * 2; return st * 1024 + (ob ^ (((ob >> 9) & 1) << 5)); }
__host__ __device__ __forceinline__ void stage_rc(int b, int& R, int& C) { const int st = b / 1024, sb = b % 1024, swz = sb ^ (((sb >> 9) & 1) << 5); R = (st >> 1) * 16 + swz / 64; C = (st & 1) * 32 + (swz % 64) / 2; }
__host__ __device__ __forceinline__ int perm32(int rho) { const int n = rho >> 4, i = rho & 15; return 8 * (i >> 2) + 4 * n + (i & 3); }
struct Unit { int pm, pn; };
struct Gemm { const bf16_t* A; const bf16_t* Bt; int M, N, K; };
struct StaticOrder {
    int nM, nN, nwg, G, c;
    __host__ __device__ void init(int M_, int N_, int G_, int c_) { nM = M_ / BM; nN = N_ / BM; nwg = nM * nN; G = G_; c = c_; }
    __host__ __device__ bool next(int i, Unit& u) const {
        const long L = (long)i * G + c; if (L >= nwg) return false;
        int wgid = (int)L; { const int q = nwg / NXCD, r = nwg % NXCD, xcd = wgid % NXCD, off = wgid / NXCD; wgid = (xcd < r ? xcd * (q + 1) : r * (q + 1) + (xcd - r) * q) + off; }
        const int nig = WGM * nN, gid = wgid / nig, fm = gid * WGM, gsz = (nM - fm) < WGM ? (nM - fm) : WGM;
        u.pm = fm + ((wgid % nig) % gsz); u.pn = (wgid % nig) / gsz; return true;
    }
};

template <class Epi, class Sched, bool ALIGN_EPI, bool SP2>
__device__ __forceinline__ void gemm_phase(LAS unsigned char* lds, const Gemm g, const Sched& S, const Epi& E, const int tid) {
    const int wid = __builtin_amdgcn_readfirstlane(tid >> 6), lane = tid & 63, wr = wid >> 2, wc = wid & 3, fr = lane & 15, fq = lane >> 4;
    const int K = g.K, nt = K / BK;
    unsigned voffA[2], voffB[2];
#pragma unroll
    for (int i = 0; i < 2; ++i) { int R, C; stage_rc(tid * 16 + i * 8192, R, C); const int Rb = Epi::PERM ? ((R & ~31) + perm32(R & 31)) : R;
        voffA[i] = (unsigned)(R * K + C) * 2u; voffB[i] = (unsigned)(Rb * K + C) * 2u; }
    const size_t kstep = (size_t)(BK * 2);
    const size_t hstep = (size_t)HALF * K * 2;
    const size_t tstep = 2 * hstep;
    const unsigned ldsw = (unsigned)wid * 1024u;
    const int aoff = lds_byte(wr * 64 + fr, fq * 8), boff = lds_byte(wc * 32 + fr, fq * 8);
#define PG8_SA(b, h) (((b) * 2 + (h)) * HTB)
#define PG8_SB(b, h) ((4 + (b) * 2 + (h)) * HTB)
#define PG8_STAGE(bufoff, gbase, voff) do { _Pragma("unroll") for (int _i = 0; _i < 2; ++_i) \
        __builtin_amdgcn_global_load_lds((const unsigned*)((const char*)(gbase) + (voff)[_i]), (LAS unsigned*)(lds + (bufoff) + ldsw + _i * 8192), 16, 0, 0); } while (0)
#define PG8_LDA(dst, b, h) do { _Pragma("unroll") for (int m = 0; m < 4; ++m) _Pragma("unroll") for (int k = 0; k < 2; ++k) dst[m][k] = *(const LAS bf16x8*)(lds + PG8_SA(b, h) + aoff + m * 2048 + k * 1024); } while (0)
#define PG8_LDB(dst, b, h) do { _Pragma("unroll") for (int n = 0; n < 2; ++n) _Pragma("unroll") for (int k = 0; k < 2; ++k) dst[n][k] = *(const LAS bf16x8*)(lds + PG8_SB(b, h) + boff + n * 2048 + k * 1024); } while (0)
#define PG8_MMA(ai, bj, At, Bt) do { __builtin_amdgcn_s_setprio(1); _Pragma("unroll") for (int m = 0; m < 4; ++m) _Pragma("unroll") for (int n = 0; n < 2; ++n) _Pragma("unroll") for (int k = 0; k < 2; ++k) \
        acc[ai][bj][m][n] = __builtin_amdgcn_mfma_f32_16x16x32_bf16(Bt[n][k], At[m][k], acc[ai][bj][m][n], 0, 0, 0); __builtin_amdgcn_s_setprio(0); } while (0)
#define PG8_WAIT_V(n) asm volatile("s_waitcnt vmcnt(" #n ")" ::: "memory")
#define PG8_WAIT_L(n) asm volatile("s_waitcnt lgkmcnt(" #n ")" ::: "memory")
#define PG8_BAR __builtin_amdgcn_s_barrier()
#define PG8_SCHED __builtin_amdgcn_sched_barrier(0)
    Unit cur, nxt; int ui = 0;
    if (!S.next(0, cur)) return;
    f32x4 acc[2][2][4][2];
#pragma unroll
    for (int a = 0; a < 2; ++a)
#pragma unroll
        for (int b = 0; b < 2; ++b)
#pragma unroll
            for (int m = 0; m < 4; ++m)
#pragma unroll
                for (int n = 0; n < 2; ++n) acc[a][b][m][n] = (f32x4){0.f, 0.f, 0.f, 0.f};
    bf16x8 At[4][2], B0[2][2], B1[2][2];
    const char* cA = (const char*)g.A + (size_t)cur.pm * tstep; const char* cB = (const char*)g.Bt + (size_t)cur.pn * tstep;
    if constexpr (SP2) {
        PG8_STAGE(PG8_SB(0, 0), cB, voffB); PG8_STAGE(PG8_SB(0, 1), cB + hstep, voffB); PG8_STAGE(PG8_SA(0, 0), cA, voffA); PG8_STAGE(PG8_SA(0, 1), cA + hstep, voffA);
        if (wr == 1) PG8_BAR;
        PG8_WAIT_V(2); PG8_BAR;
        PG8_STAGE(PG8_SB(1, 0), cB + kstep, voffB); PG8_STAGE(PG8_SA(1, 0), cA + kstep, voffA); PG8_STAGE(PG8_SB(1, 1), cB + hstep + kstep, voffB);
        PG8_WAIT_V(6); PG8_BAR;
    } else {
        PG8_STAGE(PG8_SB(0, 0), cB, voffB); PG8_STAGE(PG8_SA(0, 0), cA, voffA); PG8_STAGE(PG8_SB(0, 1), cB + hstep, voffB); PG8_STAGE(PG8_SA(0, 1), cA + hstep, voffA);
        if (wr == 1) PG8_BAR;
        PG8_WAIT_V(4); PG8_BAR;
        PG8_STAGE(PG8_SB(1, 0), cB + kstep, voffB); PG8_STAGE(PG8_SA(1, 0), cA + kstep, voffA); PG8_STAGE(PG8_SB(1, 1), cB + hstep + kstep, voffB);
        PG8_WAIT_V(6); PG8_BAR;
    }
    for (;;) {
        const bool has_next = S.next(ui + 1, nxt);
        const char* nA = has_next ? (const char*)g.A + (size_t)nxt.pm * tstep : cA; const char* nB = has_next ? (const char*)g.Bt + (size_t)nxt.pn * tstep : cB;
        for (int t = 0; t < nt; t += 2) {
            const bool last = (t == nt - 2);
            const char* a1 = cA + (size_t)(t + 1) * kstep;
            const char* a2 = last ? nA : cA + (size_t)(t + 2) * kstep; const char* b2 = last ? nB : cB + (size_t)(t + 2) * kstep;
            const char* a3 = a2 + kstep; const char* b3 = b2 + kstep;
            if constexpr (SP2) {
            PG8_LDB(B0, 0, 0); PG8_LDB(B1, 0, 1); PG8_SCHED; PG8_LDA(At, 0, 0); PG8_STAGE(PG8_SA(1, 1), a1 + hstep, voffA);
            PG8_WAIT_V(8); PG8_WAIT_L(0); PG8_BAR; PG8_MMA(0, 0, At, B0); PG8_MMA(0, 1, At, B1); PG8_BAR; PG8_SCHED;
            PG8_LDA(At, 0, 1); PG8_STAGE(PG8_SB(0, 0), b2, voffB); PG8_STAGE(PG8_SB(0, 1), b2 + hstep, voffB); PG8_STAGE(PG8_SA(0, 0), a2, voffA);
            PG8_WAIT_V(8); PG8_WAIT_L(0); PG8_BAR; PG8_MMA(1, 0, At, B0); PG8_MMA(1, 1, At, B1); PG8_BAR; PG8_SCHED;
            PG8_LDB(B0, 1, 0); PG8_LDB(B1, 1, 1); PG8_SCHED; PG8_LDA(At, 1, 0); PG8_STAGE(PG8_SA(0, 1), a2 + hstep, voffA);
            PG8_WAIT_V(8); PG8_WAIT_L(0); PG8_BAR; PG8_MMA(0, 0, At, B0); PG8_MMA(0, 1, At, B1); PG8_BAR; PG8_SCHED;
            PG8_LDA(At, 1, 1); PG8_STAGE(PG8_SB(1, 0), b3, voffB); PG8_STAGE(PG8_SB(1, 1), b3 + hstep, voffB); PG8_STAGE(PG8_SA(1, 0), a3, voffA);
            PG8_WAIT_V(8); PG8_WAIT_L(0); PG8_BAR; PG8_MMA(1, 0, At, B0); PG8_MMA(1, 1, At, B1); PG8_BAR; PG8_SCHED;
            } else {
            PG8_LDB(B0, 0, 0); PG8_SCHED; PG8_LDA(At, 0, 0); PG8_STAGE(PG8_SA(1, 1), a1 + hstep, voffA);
            PG8_WAIT_L(8); PG8_BAR; PG8_WAIT_L(0); PG8_MMA(0, 0, At, B0); PG8_BAR; PG8_SCHED;
            PG8_LDB(B1, 0, 1); PG8_STAGE(PG8_SB(0, 0), b2, voffB);
            PG8_BAR; PG8_WAIT_L(0); PG8_MMA(0, 1, At, B1); PG8_BAR;
            PG8_LDA(At, 0, 1); PG8_STAGE(PG8_SA(0, 0), a2, voffA);
            PG8_BAR; PG8_WAIT_L(0); PG8_MMA(1, 0, At, B0); PG8_BAR; PG8_SCHED;
            PG8_STAGE(PG8_SB(0, 1), b2 + hstep, voffB);
            PG8_WAIT_V(6); PG8_BAR; PG8_MMA(1, 1, At, B1); PG8_BAR;
            PG8_LDB(B0, 1, 0); PG8_SCHED; PG8_LDA(At, 1, 0); PG8_STAGE(PG8_SA(0, 1), a2 + hstep, voffA);
            PG8_WAIT_L(8); PG8_BAR; PG8_WAIT_L(0); PG8_MMA(0, 0, At, B0); PG8_BAR; PG8_SCHED;
            PG8_LDB(B1, 1, 1); PG8_STAGE(PG8_SB(1, 0), b3, voffB);
            PG8_BAR; PG8_WAIT_L(0); PG8_MMA(0, 1, At, B1); PG8_BAR;
            PG8_LDA(At, 1, 1); PG8_STAGE(PG8_SA(1, 0), a3, voffA);
            PG8_BAR; PG8_WAIT_L(0); PG8_MMA(1, 0, At, B0); PG8_BAR; PG8_SCHED;
            PG8_STAGE(PG8_SB(1, 1), b3 + hstep, voffB);
            PG8_WAIT_V(6); PG8_BAR; PG8_MMA(1, 1, At, B1); PG8_BAR;
            }
        }
        if constexpr (ALIGN_EPI) { if (wr == 0) PG8_BAR; }
        E(acc, cur, wr, wc, fr, fq);
        if (!has_next) break;
#pragma unroll
        for (int a = 0; a < 2; ++a)
#pragma unroll
            for (int b = 0; b < 2; ++b)
#pragma unroll
                for (int m = 0; m < 4; ++m)
#pragma unroll
                    for (int n = 0; n < 2; ++n) acc[a][b][m][n] = (f32x4){0.f, 0.f, 0.f, 0.f};
        cur = nxt; cA = nA; cB = nB; ++ui;
        if constexpr (ALIGN_EPI) { if (wr == 1) PG8_BAR; }
    }
    PG8_WAIT_V(0);
    if constexpr (!ALIGN_EPI) { if (wr == 0) PG8_BAR; }
    PG8_BAR;
#undef PG8_SA
#undef PG8_SB
#undef PG8_STAGE
#undef PG8_LDA
#undef PG8_LDB
#undef PG8_MMA
#undef PG8_WAIT_V
#undef PG8_WAIT_L
#undef PG8_BAR
#undef PG8_SCHED
}

struct EpiProj {
    static constexpr bool PERM = true;
    bf16_t* O; int ldc; const float* ssq;
    __device__ __forceinline__ void operator()(const f32x4 (&acc)[2][2][4][2], const Unit& u, int wr, int wc, int fr, int fq) const {
        const int row0 = u.pm * BM + wr * 64 + fr, col0 = u.pn * BM + wc * 32 + 8 * fq;
#pragma unroll
        for (int ai = 0; ai < 2; ++ai)
#pragma unroll
            for (int m = 0; m < 4; ++m) { const int row = row0 + ai * HALF + m * 16; const float rs = row_rstd(ssq, row, fq);
                bf16_t* rowp = O + (size_t)row * ldc + col0;
#pragma unroll
                for (int bj = 0; bj < 2; ++bj) { const f32x4 v0 = acc[ai][bj][m][0] * rs, v1 = acc[ai][bj][m][1] * rs;
                    u32x4 w; w.x = cvtpk(v0[0], v0[1]); w.y = cvtpk(v0[2], v0[3]); w.z = cvtpk(v1[0], v1[1]); w.w = cvtpk(v1[2], v1[3]);
                    *(u32x4*)(rowp + bj * HALF) = w; } }
    }
};
struct EpiSwiGLU {
    static constexpr bool PERM = true;
    bf16_t* O; const float* ssq;
    __device__ __forceinline__ void operator()(const f32x4 (&acc)[2][2][4][2], const Unit& u, int wr, int wc, int fr, int fq) const {
        const int row0 = u.pm * BM + wr * 64 + fr, col0 = u.pn * HALF + wc * 32 + 8 * fq;
#pragma unroll
        for (int ai = 0; ai < 2; ++ai)
#pragma unroll
            for (int m = 0; m < 4; ++m) { const int row = row0 + ai * HALF + m * 16; const float rs = row_rstd(ssq, row, fq);
                float h[8];
#pragma unroll
                for (int n = 0; n < 2; ++n)
#pragma unroll
                    for (int j = 0; j < 4; ++j) { const float gt = acc[ai][0][m][n][j] * rs, up = acc[ai][1][m][n][j] * rs; h[n * 4 + j] = gt * up / (1.0f + __expf(-gt)); }
                u32x4 w; w.x = cvtpk(h[0], h[1]); w.y = cvtpk(h[2], h[3]); w.z = cvtpk(h[4], h[5]); w.w = cvtpk(h[6], h[7]);
                *(u32x4*)(O + (size_t)row * FF + col0) = w; }
    }
};
struct EpiResid {
    static constexpr bool PERM = false;
    float* X; bf16_t* XB; float* ssq;
    __device__ __forceinline__ void operator()(const f32x4 (&acc)[2][2][4][2], const Unit& u, int wr, int wc, int fr, int fq) const {
        const int row0 = u.pm * BM + wr * 64 + fr, col0 = u.pn * BM + wc * 32 + 4 * fq;
#pragma unroll
        for (int ai = 0; ai < 2; ++ai)
#pragma unroll
            for (int m = 0; m < 4; ++m) { const int row = row0 + ai * HALF + m * 16; const size_t off = (size_t)row * DM + col0; float ss = 0.f;
#pragma unroll
                for (int bj = 0; bj < 2; ++bj)
#pragma unroll
                    for (int n = 0; n < 2; ++n) { const size_t o = off + bj * HALF + n * 16; const f32x4 xv = *(const f32x4*)(X + o) + acc[ai][bj][m][n];
                        *(f32x4*)(X + o) = xv; u32x2 w; w.x = cvtpk(xv[0], xv[1]); w.y = cvtpk(xv[2], xv[3]); *(u32x2*)(XB + o) = w;
                        ss += (xv[0] * xv[0] + xv[1] * xv[1]) + (xv[2] * xv[2] + xv[3] * xv[3]); }
                ss = xor32_sum(xor16_sum(ss));
                if (fq == 0) ssq[(size_t)row * 32 + u.pn * 4 + wc] = ss; }
    }
};
template <int MODE> struct EpiLora {
    static constexpr bool PERM = false;
    float* O; const float* bias;
    __device__ __forceinline__ void operator()(const f32x4 (&acc)[2][2][4][2], const Unit& u, int wr, int wc, int fr, int fq) const {
        const int row0 = u.pm * BM + wr * 64 + fr, col0 = u.pn * BM + wc * 32 + 4 * fq;
#pragma unroll
        for (int bj = 0; bj < 2; ++bj)
#pragma unroll
            for (int n = 0; n < 2; ++n) { const int col = col0 + bj * HALF + n * 16;
                f32x4 bv = (f32x4){0.f, 0.f, 0.f, 0.f}; if (MODE != 2) bv = *(const f32x4*)(bias + col);
#pragma unroll
                for (int ai = 0; ai < 2; ++ai)
#pragma unroll
                    for (int m = 0; m < 4; ++m) { const int row = row0 + ai * HALF + m * 16; f32x4 v = acc[ai][bj][m][n] + bv;
                        if (MODE == 0) {
#pragma unroll
                            for (int j = 0; j < 4; ++j) { const float z = -v[j]; const float sp = fmaxf(z, 0.f) + log1pf(__expf(-fabsf(z))); v[j] = __expf(-__expf(-sp - 0.5f)); }
                        } else if (MODE == 1) {
#pragma unroll
                            for (int j = 0; j < 4; ++j) v[j] = sigmoidf_(v[j]);
                        }
                        *(f32x4*)(O + (size_t)row * 1024 + col) = v; } }
    }
};
}

template <int MAP>
__device__ __forceinline__ void transpose_item(const float* W, int K, int N, bf16_t* WT, const float* gk, LAS float* scr, int item, int lane) {
    const int nblk = N / 32, kb = item / nblk, nb = item % nblk, k0 = 64 * kb, n0 = 32 * nb;
    float v[32];
    const float* wp = W + (size_t)(k0 + (lane >> 5)) * N + n0 + (lane & 31);
#pragma unroll
    for (int i = 0; i < 32; ++i) v[i] = __builtin_nontemporal_load(wp + (size_t)(2 * i) * N);
    const int c = lane & 7;
    f32x4 g0 = (f32x4){1.f, 1.f, 1.f, 1.f}, g1 = g0;
    if (gk) { g0 = *(const f32x4*)(gk + k0 + 8 * c); g1 = *(const f32x4*)(gk + k0 + 8 * c + 4); }
#pragma unroll
    for (int i = 0; i < 32; ++i) scr[(2 * i + (lane >> 5)) * 33 + (lane & 31)] = v[i];
    asm volatile("s_waitcnt lgkmcnt(0)" ::: "memory");
#pragma unroll
    for (int j = 0; j < 4; ++j) { const int n = n0 + (lane >> 3) + 8 * j; const LAS float* s = scr + (8 * c) * 33 + (n - n0);
        float sc = 1.f; int drow = n;
        if (MAP == 0) { if (n < 512 || (n >= 1536 && n < 2048)) sc = QSC; }
        if (MAP == 1) { const int hn = n < FF ? n : n - FF; drow = (hn >> 7) * 256 + (n < FF ? 0 : 128) + (hn & 127); }
        const f32x4 h0 = g0 * sc, h1 = g1 * sc;
        u32x4 o; o.x = cvtpk(s[0 * 33] * h0[0], s[1 * 33] * h0[1]); o.y = cvtpk(s[2 * 33] * h0[2], s[3 * 33] * h0[3]); o.z = cvtpk(s[4 * 33] * h1[0], s[5 * 33] * h1[1]); o.w = cvtpk(s[6 * 33] * h1[2], s[7 * 33] * h1[3]);
        *(u32x4*)(WT + (size_t)drow * K + k0 + 8 * c) = o; }
    asm volatile("s_waitcnt lgkmcnt(0)" ::: "memory");
}

constexpr int I_IN = (DM / 64) * (INC / 32), I_OUT = (DM / 64) * (DM / 32), I_GU = (DM / 64) * (GU / 32), I_DN = (FF / 64) * (DM / 32);
constexpr int CONV_ITEMS = I_IN + I_OUT + I_GU + I_DN;
__device__ __forceinline__ void convert_item(KP p, int l, int r, LAS float* scr, int lane) {
    unsigned char* wb = p->ws + WS_W + (size_t)l * LW_STRIDE;
    if (r < I_IN) { transpose_item<0>(p->in[2] + (size_t)l * DM * INC, DM, INC, (bf16_t*)(wb + LW_WIN), p->in[1] + l * DM, scr, r, lane); return; } r -= I_IN;
    if (r < I_OUT) { transpose_item<2>(p->in[17] + (size_t)l * DM * DM, DM, DM, (bf16_t*)(wb + LW_WOUT), nullptr, scr, r, lane); return; } r -= I_OUT;
    if (r < I_GU) { transpose_item<1>(p->in[19] + (size_t)l * DM * GU, DM, GU, (bf16_t*)(wb + LW_WGU), p->in[18] + l * DM, scr, r, lane); return; } r -= I_GU;
    transpose_item<2>(p->in[20] + (size_t)l * FF * DM, FF, DM, (bf16_t*)(wb + LW_WDN), nullptr, scr, r, lane);
}

__device__ __forceinline__ void phase0(KP p, LAS unsigned char* lds, int gw, int NGW, int wave, int lane) {
    LAS float* scr = (LAS float*)(lds + wave * 16384);
    for (int it = gw; it < CONV_ITEMS; it += NGW) convert_item(p, 0, it, scr, lane);
    const int gt = gw * 64 + lane, NGT = NGW * 64;
    for (int l = 0; l < NL; ++l) {
        unsigned char* wb = p->ws + WS_W + (size_t)l * LW_STRIDE;
        bf16_t* w2t = (bf16_t*)(wb + LW_W2T); bf16_t* a2t = (bf16_t*)(wb + LW_A2T); bf16_t* g2t = (bf16_t*)(wb + LW_G2T);
        const float* w2 = p->in[8] + (size_t)l * 96 * 1024; const float* a2 = p->in[10] + (size_t)l * 96 * 1024; const float* g2 = p->in[11] + (size_t)l * 256 * 1024;
        for (int i = gt; i < 1024 * 128; i += NGT) { const int n = i >> 7, k = i & 127;
            w2t[i] = (bf16_t)(cvtpk(k < 96 ? w2[k * 1024 + n] : 0.f, 0.f) & 0xffff); a2t[i] = (bf16_t)(cvtpk(k < 96 ? a2[k * 1024 + n] : 0.f, 0.f) & 0xffff); }
        for (int i = gt; i < 1024 * 256; i += NGT) { const int n = i >> 8, k = i & 255; g2t[i] = (bf16_t)(cvtpk(g2[k * 1024 + n], 0.f) & 0xffff); }
        unsigned* padz = (unsigned*)(wb + LW_WIN + (size_t)INC * DM * 2);
        for (int i = gt; i < (INCP - INC) * DM / 2; i += NGT) padz[i] = 0u;
    }
    const float* x = p->in[0]; float* X = p->out; bf16_t* XB = (bf16_t*)(p->ws + WS_XB); float* ssqA = (float*)(p->ws + WS_SSQA);
    for (int m = gw; m < M; m += NGW) { float ss = 0.f;
#pragma unroll
        for (int j = 0; j < 8; ++j) { const size_t o = (size_t)m * DM + j * 256 + lane * 4; const f32x4 v = *(const f32x4*)(x + o); *(f32x4*)(X + o) = v;
            u32x2 w; w.x = cvtpk(v[0], v[1]); w.y = cvtpk(v[2], v[3]); *(u32x2*)(XB + o) = w; ss += (v[0] * v[0] + v[1] * v[1]) + (v[2] * v[2] + v[3] * v[3]); }
        ss = wave_sum(ss); if (lane < 32) ssqA[(size_t)m * 32 + lane] = lane == 0 ? ss : 0.f; }
}

__device__ __forceinline__ void phase_prep1(KP p, int l, LAS unsigned char* lds, int gw, int NGW, int wave, int lane) {
    const bf16_t* PROJ = (const bf16_t*)(p->ws + WS_PROJ);
    LAS unsigned short* tile = (LAS unsigned short*)(lds + wave * 8448);
    bf16_t* VAT = (bf16_t*)(p->ws + WS_VAT); bf16_t* VBT = (bf16_t*)(p->ws + WS_VBT);
    for (int it = gw; it < 128 * 10; it += NGW) {
        const int tb = it / 10, g = it % 10, t0 = tb * 64; const int cbase = g < 8 ? 1024 + 64 * g : 2176 + 64 * (g - 8);
        bf16_t* dst = g < 8 ? VAT + (size_t)(64 * g) * M : VBT + (size_t)(64 * (g - 8)) * M;
#pragma unroll
        for (int i = 0; i < 8; ++i) { const int row = i * 8 + (lane >> 3), ch = lane & 7; const u32x4 v = *(const u32x4*)(PROJ + (size_t)(t0 + row) * INCP + cbase + 8 * ch);
            LAS unsigned* d = (LAS unsigned*)(tile + row * 66 + 8 * ch); d[0] = v.x; d[1] = v.y; d[2] = v.z; d[3] = v.w; }
        asm volatile("s_waitcnt lgkmcnt(0)" ::: "memory");
#pragma unroll
        for (int i = 0; i < 8; ++i) { const int c = i * 8 + (lane >> 3), tch = lane & 7, j = tch >> 1, hi = tch & 1; unsigned short v[8];
#pragma unroll
            for (int s = 0; s < 8; ++s) v[s] = tile[(16 * j + (s & 3) + 8 * (s >> 2) + 4 * hi) * 66 + c];
            u32x4 o; o.x = v[0] | ((unsigned)v[1] << 16); o.y = v[2] | ((unsigned)v[3] << 16); o.z = v[4] | ((unsigned)v[5] << 16); o.w = v[6] | ((unsigned)v[7] << 16);
            *(u32x4*)(dst + (size_t)c * M + t0 + 16 * j + 8 * hi) = o; }
        asm volatile("s_waitcnt lgkmcnt(0)" ::: "memory");
    }
    const float* mu = p->in[6] + (size_t)l * RWC;
    float* R = (float*)(p->ws + WS_R); float* KR = (float*)(p->ws + WS_KR); float* V = (float*)(p->ws + WS_V);
    bf16_t* AW = (bf16_t*)(p->ws + WS_AW); bf16_t* AA = (bf16_t*)(p->ws + WS_AA); bf16_t* AG = (bf16_t*)(p->ws + WS_AG);
    float knmax = 0.f;
    for (int t = gw; t < M; t += NGW) {
        const bf16_t* cur = PROJ + (size_t)t * INCP + RW0;
        {   const u32x4 kv = *(const u32x4*)(PROJ + (size_t)t * INCP + 512 + 8 * lane);
            float a0 = bflo(kv.x), a1 = bfhi(kv.x), a2 = bflo(kv.y), a3 = bfhi(kv.y), a4 = bflo(kv.z), a5 = bfhi(kv.z), a6 = bflo(kv.w), a7 = bfhi(kv.w);
            float ss = (a0 * a0 + a1 * a1) + (a2 * a2 + a3 * a3) + (a4 * a4 + a5 * a5) + (a6 * a6 + a7 * a7);
            ss += dppm<0xB1>(ss); ss += dppm<0x4E>(ss); ss += dppm<0x141>(ss); knmax = fmaxf(knmax, ss); }
        for (int it = 0; it < 7; ++it) { const int ch = it * 64 + lane; if (ch >= 440) break; const int j0 = ch * 8;
            const u32x4 c4 = *(const u32x4*)(cur + j0); u32x4 p4 = (u32x4){0u, 0u, 0u, 0u}; if (t > 0) p4 = *(const u32x4*)(cur - INCP + j0);
            const f32x4 m0 = *(const f32x4*)(mu + j0), m1 = *(const f32x4*)(mu + j0 + 4);
            float f[8]; const unsigned cw[4] = {c4.x, c4.y, c4.z, c4.w}, pw[4] = {p4.x, p4.y, p4.z, p4.w};
#pragma unroll
            for (int q = 0; q < 4; ++q) { const float c0 = bflo(cw[q]), c1 = bfhi(cw[q]), p0 = bflo(pw[q]), p1 = bfhi(pw[q]);
                const float mu0 = q < 2 ? m0[2 * q] : m1[2 * q - 4], mu1 = q < 2 ? m0[2 * q + 1] : m1[2 * q - 3];
                f[2 * q] = c0 + (p0 - c0) * mu0; f[2 * q + 1] = c1 + (p1 - c1) * mu1; }
            if (j0 < 3072) { float* dstp = (j0 < 1024 ? R + j0 : j0 < 2048 ? KR + (j0 - 1024) : V + (j0 - 2048)) + (size_t)t * 1024;
                *(f32x4*)dstp = (f32x4){f[0], f[1], f[2], f[3]}; *(f32x4*)(dstp + 4) = (f32x4){f[4], f[5], f[6], f[7]}; }
            else { bf16_t* dstp;
                if (j0 < 3168) { dstp = AW + (size_t)t * 128 + (j0 - 3072);
#pragma unroll
                    for (int q = 0; q < 8; ++q) f[q] = tanhf(f[q]); }
                else if (j0 < 3264) { dstp = AA + (size_t)t * 128 + (j0 - 3168); }
                else { dstp = AG + (size_t)t * 256 + (j0 - 3264);
#pragma unroll
                    for (int q = 0; q < 8; ++q) f[q] = sigmoidf_(f[q]); }
                u32x4 o; o.x = cvtpk(f[0], f[1]); o.y = cvtpk(f[2], f[3]); o.z = cvtpk(f[4], f[5]); o.w = cvtpk(f[6], f[7]); *(u32x4*)dstp = o; }
        }
        if (lane < 4) *(u32x4*)(AW + (size_t)t * 128 + 96 + 8 * lane) = (u32x4){0u, 0u, 0u, 0u};
        else if (lane < 8) *(u32x4*)(AA + (size_t)t * 128 + 96 + 8 * (lane - 4)) = (u32x4){0u, 0u, 0u, 0u};
    }
    {   LAS float* kr = (LAS float*)(lds + 8 * 8448);
        if ((lane & 7) == 0) kr[wave * 8 + (lane >> 3)] = knmax;
        __syncthreads();
        if (wave == 0 && lane < 8) { float m = kr[lane];
#pragma unroll
            for (int w2 = 1; w2 < 8; ++w2) m = fmaxf(m, kr[w2 * 8 + lane]);
            ((float*)(p->ws + WS_KNP))[(size_t)(gw >> 3) * 8 + lane] = m; }
        __syncthreads(); }
}

__device__ __forceinline__ void phase_prep2(KP p, int l, int gw, int NGW, int lane) {
    const float* KR = (const float*)(p->ws + WS_KR); const float* A = (const float*)(p->ws + WS_A);
    float* KF = (float*)(p->ws + WS_KF); float* AN = (float*)(p->ws + WS_AN); float* BB = (float*)(p->ws + WS_BB);
    const float* k_k = p->in[12] + l * 1024; const float* k_a = p->in[13] + l * 1024;
    const int c0 = 16 * lane;
    for (int t = gw; t < M; t += NGW) { const size_t o = (size_t)t * 1024 + c0; float n2 = 0.f; f32x4 kkv[4], kr[4], av[4];
#pragma unroll
        for (int q = 0; q < 4; ++q) { kr[q] = *(const f32x4*)(KR + o + 4 * q); av[q] = *(const f32x4*)(A + o + 4 * q); kkv[q] = kr[q] * *(const f32x4*)(k_k + c0 + 4 * q);
            n2 += (kkv[q][0] * kkv[q][0] + kkv[q][1] * kkv[q][1]) + (kkv[q][2] * kkv[q][2] + kkv[q][3] * kkv[q][3]); }
        n2 = quad_sum(n2); const float inv = 1.0f / fmaxf(sqrtf(n2), 1e-12f);
#pragma unroll
        for (int q = 0; q < 4; ++q) { const f32x4 kk = kkv[q] * inv; const f32x4 ka = *(const f32x4*)(k_a + c0 + 4 * q);
            *(f32x4*)(KF + o + 4 * q) = kr[q] * (1.0f + (av[q] - 1.0f) * ka); *(f32x4*)(AN + o + 4 * q) = -kk; *(f32x4*)(BB + o + 4 * q) = kk * av[q]; }
    }
}

template <int MODE>
__device__ __forceinline__ void scan_task(KP p, int l, LAS unsigned char* wl, int c, int h, int lane) {
    constexpr int NR = MODE == 0 ? 3 : (MODE == 1 ? 4 : 5);
    constexpr int SB = 4;
    LAS float* vec = (LAS float*)wl;
    LAS float* ybuf = (LAS float*)(wl + 6 * SB * 256);
    const float* src[5] = {(const float*)(p->ws + WS_DEC), (const float*)(p->ws + WS_KR), (const float*)(p->ws + WS_A), (const float*)(p->ws + WS_V), (const float*)(p->ws + WS_R)};
    const int rb = lane >> 2, cb = lane & 3, t0 = c * CL;
    f32x2 s[4][8];
    if (MODE == 0) {
#pragma unroll
        for (int r = 0; r < 4; ++r)
#pragma unroll
            for (int q = 0; q < 8; ++q) { s[r][q].x = (4 * rb + r == 16 * cb + 2 * q) ? 1.f : 0.f; s[r][q].y = (4 * rb + r == 16 * cb + 2 * q + 1) ? 1.f : 0.f; }
    } else if (MODE == 1) {
#pragma unroll
        for (int r = 0; r < 4; ++r)
#pragma unroll
            for (int q = 0; q < 8; ++q) s[r][q] = (f32x2){0.f, 0.f};
    } else {
        const float* SI = (const float*)(p->ws + WS_SI) + ((size_t)(h * NCH + c)) * 4096;
#pragma unroll
        for (int x = 0; x < 16; ++x) { const f32x4 v = *(const f32x4*)(SI + (16 * cb + x) * 64 + 4 * rb);
#pragma unroll
            for (int r = 0; r < 4; ++r) { if (x & 1) s[r][x >> 1].y = v[r]; else s[r][x >> 1].x = v[r]; } }
    }
    float lnw = 0.f, lnb = 0.f, rk = 0.f;
    if (MODE == 2) { lnw = p->in[15][l * 1024 + 64 * h + lane]; lnb = p->in[16][l * 1024 + 64 * h + lane]; rk = p->in[14][l * 1024 + 64 * h + lane]; }
    const int lst = lane >> 4, lq = lane & 15;
    const f32x4 kk4 = *(const f32x4*)(p->in[12] + l * 1024 + 64 * h + 4 * lq), ka4 = *(const f32x4*)(p->in[13] + l * 1024 + 64 * h + 4 * lq);
    const size_t goff = (size_t)(t0 + lst) * 1024 + 64 * h + 4 * lq;
    f32x4 pre[NR];
#pragma unroll
    for (int v = 0; v < NR; ++v) pre[v] = *(const f32x4*)(src[v] + goff);
    for (int sb = 0; sb < CL / SB; ++sb) {
        {
            const f32x4 kr = pre[1], av = pre[2]; const f32x4 kkv = kr * kk4;
            float n2 = (kkv[0] * kkv[0] + kkv[1] * kkv[1]) + (kkv[2] * kkv[2] + kkv[3] * kkv[3]); n2 = row16_sum(n2);
            const float inv = 1.0f / fmaxf(sqrtf(n2), 1e-12f); const f32x4 kkn = kkv * inv;
            LAS float* vw = vec + lst * 64 + 4 * lq;
            *(LAS f32x4*)(vw + 0 * SB * 64) = pre[0]; *(LAS f32x4*)(vw + 1 * SB * 64) = -kkn; *(LAS f32x4*)(vw + 2 * SB * 64) = kkn * av;
            if (MODE != 0) { *(LAS f32x4*)(vw + 3 * SB * 64) = kr * (1.0f + (av - 1.0f) * ka4); *(LAS f32x4*)(vw + 4 * SB * 64) = pre[3]; }
            if (MODE == 2) *(LAS f32x4*)(vw + 5 * SB * 64) = pre[NR - 1]; }
        if (sb + 1 < CL / SB) {
#pragma unroll
            for (int v = 0; v < NR; ++v) pre[v] = *(const f32x4*)(src[v] + goff + (size_t)(SB * (sb + 1)) * 1024);
        }
#pragma unroll 1
        for (int st = 0; st < SB; ++st) {
            const LAS float* vb = vec + st * 64 + 16 * cb;
            float sa[4];
            {   f32x2 a2[8];
#pragma unroll
                for (int q = 0; q < 4; ++q) { const f32x4 y = *(const LAS f32x4*)(vb + 1 * SB * 64 + 4 * q); a2[2 * q] = (f32x2){y[0], y[1]}; a2[2 * q + 1] = (f32x2){y[2], y[3]}; }
#pragma unroll
                for (int r = 0; r < 4; ++r) { f32x2 a = s[r][0] * a2[0];
#pragma unroll
                    for (int q = 1; q < 8; ++q) a = s[r][q] * a2[q] + a;
                    sa[r] = quad_sum(a.x + a.y); } }
            f32x4 vv = (f32x4){0.f, 0.f, 0.f, 0.f};
            if (MODE != 0) vv = *(const LAS f32x4*)(vec + (4 * SB + st) * 64 + 4 * rb);
#pragma unroll
            for (int q = 0; q < 4; ++q) { const f32x4 w4 = *(const LAS f32x4*)(vb + 0 * SB * 64 + 4 * q), b4 = *(const LAS f32x4*)(vb + 2 * SB * 64 + 4 * q);
                const f32x2 w0 = (f32x2){w4[0], w4[1]}, w1 = (f32x2){w4[2], w4[3]}, b0 = (f32x2){b4[0], b4[1]}, b1 = (f32x2){b4[2], b4[3]};
                if (MODE == 0) {
#pragma unroll
                    for (int r = 0; r < 4; ++r) { s[r][2 * q] = s[r][2 * q] * w0 + b0 * sa[r]; s[r][2 * q + 1] = s[r][2 * q + 1] * w1 + b1 * sa[r]; }
                } else { const f32x4 k4 = *(const LAS f32x4*)(vb + 3 * SB * 64 + 4 * q); const f32x2 k0 = (f32x2){k4[0], k4[1]}, k1 = (f32x2){k4[2], k4[3]};
#pragma unroll
                    for (int r = 0; r < 4; ++r) { s[r][2 * q] = s[r][2 * q] * w0 + (b0 * sa[r] + k0 * vv[r]); s[r][2 * q + 1] = s[r][2 * q + 1] * w1 + (b1 * sa[r] + k1 * vv[r]); }
                } }
            if (MODE == 2) {
                f32x2 r2[8];
#pragma unroll
                for (int q = 0; q < 4; ++q) { const f32x4 x = *(const LAS f32x4*)(vb + 5 * SB * 64 + 4 * q); r2[2 * q] = (f32x2){x[0], x[1]}; r2[2 * q + 1] = (f32x2){x[2], x[3]}; }
                f32x4 yv;
#pragma unroll
                for (int r = 0; r < 4; ++r) { f32x2 a = s[r][0] * r2[0];
#pragma unroll
                    for (int q = 1; q < 8; ++q) a = s[r][q] * r2[q] + a;
                    yv[r] = quad_sum(a.x + a.y); }
                if (cb == 0) *(LAS f32x4*)(ybuf + st * 64 + 4 * rb) = yv;
            }
        }
        if (MODE == 2) {
            const float* G = (const float*)(p->ws + WS_G); bf16_t* MIX = (bf16_t*)(p->ws + WS_MIX);
#pragma unroll 1
            for (int st = 0; st < SB; ++st) { const int t = t0 + SB * sb + st;
                const float y = ybuf[st * 64 + lane]; const float rr = vec[(5 * SB + st) * 64 + lane], kk = vec[(3 * SB + st) * 64 + lane], vv = vec[(4 * SB + st) * 64 + lane];
                const float mean = wave_sum(y) * (1.0f / 64.0f); const float d = y - mean; const float var = wave_sum(d * d) * (1.0f / 64.0f);
                const float bon = wave_sum(rr * kk * rk);
                const float g = G[(size_t)t * 1024 + 64 * h + lane];
                const float o = (d * rsqrtf(var + 64e-5f) * lnw + lnb + bon * vv) * g;
                MIX[(size_t)t * DM + 1024 + 64 * h + lane] = (bf16_t)(cvtpk(o, 0.f) & 0xffff); }
        }
    }
    if (MODE == 0) { float* dst = (float*)(p->ws + WS_PB) + ((size_t)(h * NCH + c)) * 4096;
#pragma unroll
        for (int r = 0; r < 4; ++r)
#pragma unroll
            for (int q = 0; q < 4; ++q) *(f32x4*)(dst + (4 * rb + r) * 64 + 16 * cb + 4 * q) = (f32x4){s[r][2 * q].x, s[r][2 * q].y, s[r][2 * q + 1].x, s[r][2 * q + 1].y}; }
    if (MODE == 1) { float* dst = (float*)(p->ws + WS_UB) + ((size_t)(h * NCH + c)) * 4096;
#pragma unroll
        for (int x = 0; x < 16; ++x) { f32x4 v;
#pragma unroll
            for (int r = 0; r < 4; ++r) v[r] = (x & 1) ? s[r][x >> 1].y : s[r][x >> 1].x;
            *(f32x4*)(dst + (16 * cb + x) * 64 + 4 * rb) = v; } }
}

__device__ __forceinline__ void s2_head(KP p, LAS unsigned char* lds, int h, const int tid) {
    const float* PB = (const float*)(p->ws + WS_PB) + (size_t)h * NCH * 4096; const float* UT = (const float*)(p->ws + WS_UB) + (size_t)h * NCH * 4096;
    float* SI = (float*)(p->ws + WS_SI) + (size_t)h * NCH * 4096;
    const int lane = tid & 63, w = __builtin_amdgcn_readfirstlane(tid >> 6), n = lane & 31, lh = lane >> 5, to = (w >> 1) & 1, ti = w & 1;
    static_assert((NCH - 1) % 3 == 0, "three rotating prefetch buffers");
    if (w >= 4) {
        for (int c = 0; c < NCH - 1; ++c) __syncthreads();
    } else {
        f32x16 sreg, ua, ub, uc2; float pa[32], pb[32], pc2[32];
#pragma unroll
        for (int r = 0; r < 16; ++r) sreg[r] = 0.f;
        const int offu = (32 * to + 4 * lh) * 64 + 32 * ti + n, offp = (4 * lh) * 64 + 32 * to + n;
#define S2_LOAD(CH, U_, P_) do { const int ch_ = (CH) < NCH - 1 ? (CH) : NCH - 2; const float* pb_ = PB + (size_t)ch_ * 4096 + offp; const float* ub_ = UT + (size_t)ch_ * 4096 + offu; \
        _Pragma("unroll") for (int r = 0; r < 16; ++r) { const int cr = ((r & 3) + 8 * (r >> 2)) * 64; U_[r] = ub_[cr]; P_[r] = pb_[cr]; P_[16 + r] = pb_[2048 + cr]; } } while (0)
#define S2_STEP(C, UC_, PC_, UN_, PN_) do { \
        {   float* si = SI + (size_t)(C) * 4096 + offu; \
            _Pragma("unroll") for (int r = 0; r < 16; ++r) si[((r & 3) + 8 * (r >> 2)) * 64] = sreg[r]; } \
        LAS f32x4* ex = (LAS f32x4*)(lds + ((C) & 1) * 16384); \
        _Pragma("unroll") for (int q = 0; q < 4; ++q) ex[(w * 4 + q) * 64 + lane] = (f32x4){sreg[4 * q], sreg[4 * q + 1], sreg[4 * q + 2], sreg[4 * q + 3]}; \
        __syncthreads(); \
        S2_LOAD((C) + 2, UN_, PN_); \
        f32x16 preg; \
        _Pragma("unroll") for (int q = 0; q < 4; ++q) { const f32x4 v = ex[((w ^ 2) * 4 + q) * 64 + lane]; preg[4 * q] = v[0]; preg[4 * q + 1] = v[1]; preg[4 * q + 2] = v[2]; preg[4 * q + 3] = v[3]; } \
        f32x16 acc = UC_; \
        if (to == 0) { \
            _Pragma("unroll") for (int r = 0; r < 16; ++r) acc = __builtin_amdgcn_mfma_f32_32x32x2f32(PC_[r], sreg[r], acc, 0, 0, 0); \
            _Pragma("unroll") for (int r = 0; r < 16; ++r) acc = __builtin_amdgcn_mfma_f32_32x32x2f32(PC_[16 + r], preg[r], acc, 0, 0, 0); \
        } else { \
            _Pragma("unroll") for (int r = 0; r < 16; ++r) acc = __builtin_amdgcn_mfma_f32_32x32x2f32(PC_[r], preg[r], acc, 0, 0, 0); \
            _Pragma("unroll") for (int r = 0; r < 16; ++r) acc = __builtin_amdgcn_mfma_f32_32x32x2f32(PC_[16 + r], sreg[r], acc, 0, 0, 0); } \
        sreg = acc; } while (0)
        S2_LOAD(0, ua, pa); S2_LOAD(1, ub, pb);
#pragma unroll 1
        for (int c = 0; c < NCH - 1; c += 3) {
            S2_STEP(c, ua, pa, uc2, pc2);
            S2_STEP(c + 1, ub, pb, ua, pa);
            S2_STEP(c + 2, uc2, pc2, ub, pb);
        }
        {   float* si = SI + (size_t)(NCH - 1) * 4096 + offu;
#pragma unroll
            for (int r = 0; r < 16; ++r) si[((r & 3) + 8 * (r >> 2)) * 64] = sreg[r]; }
#undef S2_LOAD
#undef S2_STEP
    }
    __syncthreads();
}

template <int DV, bool SWA>
__device__ __forceinline__ void attn_unit(LAS unsigned char* lds, const bf16_t* Q, const bf16_t* Kp, const bf16_t* VT, float slope2, int q0, float sink2,
                                          float* Of32, float* MLp, bf16_t* Obf, const int tid, int kt_lo, int kt_hi, float kn) {
    constexpr int KROW = 144, KTILE = 64 * KROW, VTILE = DV * KROW, BUF = KTILE + VTILE, NVL = DV / 64;
    const int lane = tid & 63, w = __builtin_amdgcn_readfirstlane(tid >> 6), r32 = lane & 31, hi = lane >> 5;
    const int qpos = q0 + 32 * w + r32;
    bf16x8 qf[4];
#pragma unroll
    for (int j = 0; j < 4; ++j) qf[j] = *(const bf16x8*)(Q + (size_t)qpos * INCP + 16 * j + 8 * hi);
    int kt0 = kt_lo, kt1 = kt_hi;
    if (!SWA) {
        float qq = 0.f, qk = 0.f;
#pragma unroll
        for (int j = 0; j < 4; ++j) { const bf16x8 kf = *(const bf16x8*)(Kp + (size_t)qpos * INCP + 16 * j + 8 * hi);
#pragma unroll
            for (int e = 0; e < 8; ++e) { const float qv = bf2f((unsigned short)qf[j][e]), kv = bf2f((unsigned short)kf[e]); qq += qv * qv; qk += qv * kv; } }
        qq = xor32_sum(qq); qk = xor32_sum(qk);
        const float dneed = (sqrtf(qq) * kn - qk + 45.0f) / slope2;
        float kneed = (float)qpos - dneed;
        kneed = fminf(kneed, dppm<0xB1>(kneed)); kneed = fminf(kneed, dppm<0x4E>(kneed)); kneed = fminf(kneed, dppm<0x141>(kneed)); kneed = fminf(kneed, dppm<0x140>(kneed));
        LAS float* red = (LAS float*)(lds + 2 * BUF);
        if ((lane & 15) == 0) red[w * 4 + (lane >> 4)] = kneed;
        __syncthreads();
        float km = red[0];
#pragma unroll
        for (int i = 1; i < 32; ++i) km = fminf(km, red[i]);
        const int ktw = km <= 0.f ? 0 : ((int)km >> 6);
        kt0 = ktw > kt_lo ? ktw : kt_lo;
    }
    const int qlo = q0 + 32 * w, qhi = qlo + 31;
    f32x16 o[DV / 32];
#pragma unroll
    for (int d = 0; d < DV / 32; ++d)
#pragma unroll
        for (int r = 0; r < 16; ++r) o[d][r] = 0.f;
    float mrun = -1e30f, lsum = 0.f;
    const int krow = tid >> 3, kch = tid & 7;
    u32x4 kreg, vreg[NVL];
    if (kt0 <= kt1) {   const int k0 = 64 * kt0; kreg = *(const u32x4*)(Kp + (size_t)(k0 + krow) * INCP + 8 * kch);
#pragma unroll
        for (int i = 0; i < NVL; ++i) { const int idx = tid + 512 * i; vreg[i] = *(const u32x4*)(VT + (size_t)(idx >> 3) * M + k0 + 8 * (idx & 7)); } }
    for (int kt = kt0; kt <= kt1; ++kt) {
        LAS unsigned char* buf = lds + ((kt - kt0) & 1) * BUF;
        *(LAS u32x4*)(buf + krow * KROW + 16 * kch) = kreg;
#pragma unroll
        for (int i = 0; i < NVL; ++i) { const int idx = tid + 512 * i; *(LAS u32x4*)(buf + KTILE + (idx >> 3) * KROW + 16 * (idx & 7)) = vreg[i]; }
        __syncthreads();
        if (kt < kt1) { const int k0 = 64 * (kt + 1); kreg = *(const u32x4*)(Kp + (size_t)(k0 + krow) * INCP + 8 * kch);
#pragma unroll
            for (int i = 0; i < NVL; ++i) { const int idx = tid + 512 * i; vreg[i] = *(const u32x4*)(VT + (size_t)(idx >> 3) * M + k0 + 8 * (idx & 7)); } }
        const int k0 = 64 * kt;
        bool act = k0 <= qhi; if (SWA) act = act && (k0 + 63 >= qlo - 127);
        if (act) {
            f32x16 p0, p1;
            {   const float c0 = slope2 * (float)(k0 + 4 * hi - qpos), c1 = c0 + 32.0f * slope2;
#pragma unroll
                for (int r = 0; r < 16; ++r) { const float cr = (float)((r & 3) + 8 * (r >> 2)); p0[r] = __builtin_fmaf(slope2, cr, c0); p1[r] = __builtin_fmaf(slope2, cr, c1); } }
#pragma unroll
            for (int j = 0; j < 4; ++j) { const bf16x8 a0 = *(const LAS bf16x8*)(buf + r32 * KROW + 32 * j + 16 * hi), a1 = *(const LAS bf16x8*)(buf + (r32 + 32) * KROW + 32 * j + 16 * hi);
                p0 = __builtin_amdgcn_mfma_f32_32x32x16_bf16(a0, qf[j], p0, 0, 0, 0); p1 = __builtin_amdgcn_mfma_f32_32x32x16_bf16(a1, qf[j], p1, 0, 0, 0); }
            bool need_mask = k0 + 63 > qlo; if (SWA) need_mask = need_mask || (qhi - k0 >= 128);
            if (need_mask) {
#pragma unroll
                for (int r = 0; r < 16; ++r) { const int kv = k0 + (r & 3) + 8 * (r >> 2) + 4 * hi; const int d0 = qpos - kv, d1 = d0 - 32;
                    bool ok0 = d0 >= 0, ok1 = d1 >= 0; if (SWA) { ok0 = ok0 && d0 < 128; ok1 = ok1 && d1 < 128; }
                    p0[r] = ok0 ? p0[r] : -1e30f; p1[r] = ok1 ? p1[r] : -1e30f; } }
            float mx = fmaxf(p0[0], p1[0]);
#pragma unroll
            for (int r = 1; r < 16; ++r) mx = fmaxf(mx, fmaxf(p0[r], p1[r]));
            mx = xor32_max(mx);
            if (__builtin_amdgcn_ballot_w64(mx > mrun + 8.0f) != 0ull) {
                const float mnew = fmaxf(mrun, mx), f = exp2f(mrun - mnew); mrun = mnew; lsum *= f;
#pragma unroll
                for (int d = 0; d < DV / 32; ++d)
#pragma unroll
                    for (int r = 0; r < 16; ++r) o[d][r] *= f; }
            float rs = 0.f;
#pragma unroll
            for (int r = 0; r < 16; ++r) { p0[r] = exp2f(p0[r] - mrun); p1[r] = exp2f(p1[r] - mrun); rs += p0[r] + p1[r]; }
            lsum += rs;
            u32x4 pw[4];
            pw[0] = (u32x4){cvtpk(p0[0], p0[1]), cvtpk(p0[2], p0[3]), cvtpk(p0[4], p0[5]), cvtpk(p0[6], p0[7])};
            pw[1] = (u32x4){cvtpk(p0[8], p0[9]), cvtpk(p0[10], p0[11]), cvtpk(p0[12], p0[13]), cvtpk(p0[14], p0[15])};
            pw[2] = (u32x4){cvtpk(p1[0], p1[1]), cvtpk(p1[2], p1[3]), cvtpk(p1[4], p1[5]), cvtpk(p1[6], p1[7])};
            pw[3] = (u32x4){cvtpk(p1[8], p1[9]), cvtpk(p1[10], p1[11]), cvtpk(p1[12], p1[13]), cvtpk(p1[14], p1[15])};
#pragma unroll
            for (int d = 0; d < DV / 32; ++d)
#pragma unroll
                for (int j = 0; j < 4; ++j) { const bf16x8 vf = *(const LAS bf16x8*)(buf + KTILE + (32 * d + r32) * KROW + 32 * j + 16 * hi);
                    o[d] = __builtin_amdgcn_mfma_f32_32x32x16_bf16(vf, __builtin_bit_cast(bf16x8, pw[j]), o[d], 0, 0, 0); }
        }
    }
    lsum = xor32_sum(lsum);
    if (SWA) { lsum += exp2f(sink2 - mrun);
        const float inv = 1.0f / lsum; bf16_t* op = Obf + (size_t)qpos * DM;
#pragma unroll
        for (int d = 0; d < DV / 32; ++d)
#pragma unroll
            for (int g = 0; g < 4; ++g) { u32x2 wv; wv.x = cvtpk(o[d][4 * g] * inv, o[d][4 * g + 1] * inv); wv.y = cvtpk(o[d][4 * g + 2] * inv, o[d][4 * g + 3] * inv);
                *(u32x2*)(op + 32 * d + 8 * g + 4 * hi) = wv; }
    } else { float* op = Of32 + (size_t)qpos * 1024;
#pragma unroll
        for (int d = 0; d < DV / 32; ++d)
#pragma unroll
            for (int g = 0; g < 4; ++g) *(f32x4*)(op + 32 * d + 8 * g + 4 * hi) = (f32x4){o[d][4 * g], o[d][4 * g + 1], o[d][4 * g + 2], o[d][4 * g + 3]};
        if (hi == 0) *(f32x2*)(MLp + (size_t)qpos * 16) = (f32x2){mrun, lsum};
    }
    __syncthreads();
}

__device__ __forceinline__ void phase_diffcombine(KP p, int l, int gw, int NGW, int lane) {
    const float* lamv = p->in[3] + l * 256;
    const float lambda_init = 0.8f - 0.6f * expf(-0.3f * (float)l);
    const float s1 = wave_sum(lamv[lane] * lamv[64 + lane]), s2 = wave_sum(lamv[128 + lane] * lamv[192 + lane]);
    const float lam = expf(s1) - expf(s2) + lambda_init;
    const float* OD = (const float*)(p->ws + WS_OD); const float* ML = (const float*)(p->ws + WS_ML); bf16_t* MIX = (bf16_t*)(p->ws + WS_MIX);
    const int h = lane >> 4, d0 = (lane & 15) * 8;
    const f32x4 g0 = *(const f32x4*)(p->in[4] + l * 128 + d0), g1 = *(const f32x4*)(p->in[4] + l * 128 + d0 + 4);
    for (int t = gw; t < M; t += NGW) { const int nseg = ((t >> 8) + 8) >> 3;
        f32x4 oc[2][2];
#pragma unroll
        for (int c = 0; c < 2; ++c) {
            f32x2 ml[4]; float mm = -1e30f;
#pragma unroll
            for (int s = 0; s < 4; ++s) if (s < nseg) { ml[s] = *(const f32x2*)(ML + ((size_t)s * M + t) * 16 + h * 4 + c * 2); mm = fmaxf(mm, ml[s].x); }
            f32x4 a0 = (f32x4){0.f, 0.f, 0.f, 0.f}, a1 = a0; float L = 0.f;
#pragma unroll
            for (int s = 0; s < 4; ++s) if (s < nseg) { const float f = exp2f(ml[s].x - mm); L += ml[s].y * f;
                const float* b = OD + ((size_t)s * M + t) * 1024 + h * 256 + c * 128 + d0; a0 += *(const f32x4*)b * f; a1 += *(const f32x4*)(b + 4) * f; }
            const float inv = 1.0f / L; oc[c][0] = a0 * inv; oc[c][1] = a1 * inv; }
        const f32x4 o0 = oc[0][0] - oc[1][0] * lam, o1 = oc[0][1] - oc[1][1] * lam;
        float ss = (o0[0] * o0[0] + o0[1] * o0[1]) + (o0[2] * o0[2] + o0[3] * o0[3]) + (o1[0] * o1[0] + o1[1] * o1[1]) + (o1[2] * o1[2] + o1[3] * o1[3]);
        ss = row16_sum(ss);
        const float r = rsqrtf(ss * (1.0f / 128.0f) + EPS) * (1.0f - lambda_init);
        const f32x4 y0 = o0 * g0 * r, y1 = o1 * g1 * r;
        u32x4 wv; wv.x = cvtpk(y0[0], y0[1]); wv.y = cvtpk(y0[2], y0[3]); wv.z = cvtpk(y1[0], y1[1]); wv.w = cvtpk(y1[2], y1[3]);
        *(u32x4*)(MIX + (size_t)t * DM + h * 128 + d0) = wv; }
}

#define XB_TMO      128
#define XB_XCNT(j)  (256  + 64 * (j))
#define XB_XSUB(j)  (1280 + 64 * (j))
#define XB_XGEN(j)  (2304 + 64 * (j))
#define XB_TOP      3328
#define XB_TOPGEN   3392
#define XCD_BAR_WORDS 3456
#define XB_SPIN_CAP (1u << 22)
__device__ __forceinline__ unsigned xb_ld(unsigned* p)              { return __hip_atomic_load(p, __ATOMIC_RELAXED, __HIP_MEMORY_SCOPE_AGENT); }
__device__ __forceinline__ unsigned xb_add(unsigned* p, unsigned v) { return __hip_atomic_fetch_add(p, v, __ATOMIC_RELAXED, __HIP_MEMORY_SCOPE_AGENT); }
__device__ __forceinline__ unsigned xb_xcc_id() { return (unsigned)__builtin_amdgcn_s_getreg((3 << 11) | 20) & 0xFu; }
#define XB_SPIN(cond, bar) do { unsigned _sp = 0; while (cond) { __builtin_amdgcn_s_sleep(1); \
    if ((++_sp & 255u) == 0u) { if (xb_ld(&(bar)[XB_TMO])) break; if (_sp > XB_SPIN_CAP) { atomicAdd(&(bar)[XB_TMO], 1u); break; } } } } while (0)
__device__ __forceinline__ void xcd_barrier_complete(unsigned* bar, unsigned x, unsigned& nloc, unsigned& nx) {
    const unsigned G = gridDim.x;
    unsigned sum, cnt, mine, sp = 0u;
    for (;;) {
        sum = 0u; cnt = 0u; mine = 0u;
#pragma unroll
        for (unsigned j = 0; j < 16; ++j) { const unsigned c = xb_ld(&bar[XB_XCNT(j)]); sum += c; cnt += (c > 0u) ? 1u : 0u; mine = (j == x) ? c : mine; }
        if (sum == G) break;
        __builtin_amdgcn_s_sleep(1);
        if ((++sp & 255u) == 0u) { if (xb_ld(&bar[XB_TMO])) break; if (sp > XB_SPIN_CAP) { atomicAdd(&bar[XB_TMO], 1u); break; } }
    }
    nloc = mine > 0u ? mine : 1u; nx = cnt > 0u ? cnt : 1u;
}
__device__ __forceinline__ void xcd_barrier(unsigned* bar, volatile LAS unsigned* st, const int tid) {
    asm volatile("s_waitcnt vmcnt(0)" ::: "memory");
    __syncthreads();
    if (tid == 0) {
        const unsigned x = xb_xcc_id();
        __builtin_amdgcn_s_waitcnt(0);
        unsigned nloc = st[0], nx = st[1];
        if (nloc == 0u) { xcd_barrier_complete(bar, x, nloc, nx); st[0] = nloc; st[1] = nx; }
        const unsigned old = xb_add(&bar[XB_XSUB(x)], 1u);
        const unsigned gen = old / nloc;
        if (old + 1u == (gen + 1u) * nloc) {
            __builtin_amdgcn_fence(__ATOMIC_RELEASE, "agent");
            asm volatile("s_waitcnt vmcnt(0)" ::: "memory");
            const unsigned og = xb_add(&bar[XB_TOP], 1u);
            const unsigned tg = og / nx;
            if (og + 1u == (tg + 1u) * nx) xb_add(&bar[XB_TOPGEN], 1u);
            else XB_SPIN(xb_ld(&bar[XB_TOPGEN]) == tg, bar);
            __builtin_amdgcn_fence(__ATOMIC_ACQUIRE, "agent");
            xb_add(&bar[XB_XGEN(x)], 1u);
            asm volatile("s_waitcnt vmcnt(0)" ::: "memory");
        } else {
            XB_SPIN(xb_ld(&bar[XB_XGEN(x)]) == gen, bar);
            __builtin_amdgcn_fence(__ATOMIC_ACQUIRE, "agent");
            asm volatile("s_waitcnt vmcnt(0)" ::: "memory");
        }
    }
    __syncthreads();
}

#ifndef DUPBAR
#define DUPBAR 1
#endif
#define GSYNC() do { FRESH(); for (int rb_ = 0; rb_ < DUPBAR; ++rb_) xcd_barrier((unsigned*)(p->ws + WS_CTL) + 4096, (volatile LAS unsigned*)(lds + LDS_BYTES - 32), tid); } while (0)
#define PTRS() unsigned* ctl = (unsigned*)(p->ws + WS_CTL); bf16_t* XB = (bf16_t*)(p->ws + WS_XB); bf16_t* PROJ = (bf16_t*)(p->ws + WS_PROJ); bf16_t* MIX = (bf16_t*)(p->ws + WS_MIX); bf16_t* H = (bf16_t*)(p->ws + WS_H); \
    float* ssqA = (float*)(p->ws + WS_SSQA); float* ssqB = (float*)(p->ws + WS_SSQB); unsigned char* wb = p->ws + WS_W + (size_t)l * LW_STRIDE; (void)ctl; (void)XB; (void)PROJ; (void)MIX; (void)H; (void)ssqA; (void)ssqB; (void)wb
#define FRESH() KP p = fresh_params(); int G = gridDim.x, bx = blockIdx.x; asm volatile("" : "+s"(G), "+s"(bx)); const int NGW = G * 8; (void)NGW; const int tid = fresh_tid(wave0), lane = tid & 63, wave = __builtin_amdgcn_readfirstlane(tid >> 6), gw = bx * 8 + wave; (void)lane; (void)gw
template <int L> __device__ __forceinline__ void layer_body(LAS unsigned char* lds, const int wave0) {
    constexpr int l = L;

#ifndef DUP1
#define DUP1 1
#endif
        for (int rep = 0; rep < DUP1; ++rep) {   if (rep) GSYNC(); FRESH(); PTRS(); pg8::Gemm g{XB, (const bf16_t*)(wb + LW_WIN), M, INCP, DM}; pg8::StaticOrder S; S.init(M, INCP, G, bx);
            pg8::EpiProj E{PROJ, INCP, ssqA};
            pg8::gemm_phase<pg8::EpiProj, pg8::StaticOrder, true, true>(lds, g, S, E, tid); }
        GSYNC();
#ifndef DUP234
#define DUP234 1
#endif
        for (int rep = 0; rep < DUP234; ++rep) { if (rep) GSYNC(); FRESH(); phase_prep1(p, l, lds, gw, NGW, wave, lane); }
        GSYNC();
        {   FRESH(); PTRS(); pg8::Gemm g{(const bf16_t*)(p->ws + WS_AW), (const bf16_t*)(wb + LW_W2T), M, 1024, 128}; pg8::StaticOrder S; S.init(M, 1024, G, bx);
            pg8::EpiLora<0> E{(float*)(p->ws + WS_DEC), p->in[7] + l * 1024};
            pg8::gemm_phase<pg8::EpiLora<0>, pg8::StaticOrder, true, true>(lds, g, S, E, tid); }
        {   FRESH(); PTRS(); pg8::Gemm g{(const bf16_t*)(p->ws + WS_AA), (const bf16_t*)(wb + LW_A2T), M, 1024, 128}; pg8::StaticOrder S; S.init(M, 1024, G, (bx + 128) % G);
            pg8::EpiLora<1> E{(float*)(p->ws + WS_A), p->in[9] + l * 1024};
            pg8::gemm_phase<pg8::EpiLora<1>, pg8::StaticOrder, true, true>(lds, g, S, E, tid); }
        {   FRESH(); PTRS(); pg8::Gemm g{(const bf16_t*)(p->ws + WS_AG), (const bf16_t*)(wb + LW_G2T), M, 1024, 256}; pg8::StaticOrder S; S.init(M, 1024, G, bx);
            pg8::EpiLora<2> E{(float*)(p->ws + WS_G), nullptr};
            pg8::gemm_phase<pg8::EpiLora<2>, pg8::StaticOrder, true, true>(lds, g, S, E, tid); }
        GSYNC();
        {   FRESH(); LAS unsigned char* wl = lds + wave * 14336;
#ifndef DUP57
#define DUP57 1
#endif
            for (int rep = 0; rep < DUP57; ++rep) for (int it = gw; it < 2 * NCH * 16; it += NGW) { const int mode = it & 1, ch = it >> 1, c = ch % NCH, h = ch / NCH;
                if (mode == 0) scan_task<0>(p, l, wl, c, h, lane); else scan_task<1>(p, l, wl, c, h, lane); } }
        GSYNC();
#ifndef DUP6
#define DUP6 1
#endif
        for (int rep = 0; rep < DUP6; ++rep) {   if (rep) GSYNC(); FRESH(); PTRS(); LAS int* slot = (LAS int*)(lds + LDS_BYTES - 64);
            LAS float* knl = (LAS float*)(lds + LDS_BYTES - 128);
            {   LAS float* kr = (LAS float*)lds; const float* knp = (const float*)(p->ws + WS_KNP); const int g = tid & 7, part = tid >> 3; float m = 0.f;
                for (int b2 = part; b2 < G; b2 += 64) m = fmaxf(m, knp[(size_t)b2 * 8 + g]);
                kr[part * 8 + g] = m; __syncthreads();
                if (tid < 8) { float mm = kr[tid]; for (int q2 = 1; q2 < 64; ++q2) mm = fmaxf(mm, kr[q2 * 8 + tid]); knl[tid] = mm; }
                __syncthreads(); }
            const float* sinks = p->in[5] + l * 8;
            for (;;) {
                if (tid == 0) *slot = (int)atomicAdd(ctl + 64 * (l + 1) + 16 * rep, 1u);
                __syncthreads();
                const int it = *slot;
                __syncthreads();
                constexpr int NCONV = (l + 1 < NL) ? (CONV_ITEMS + 7) / 8 : 0;
                if (it >= 912 + NCONV) break;
                if (it >= 912) { const int r = 8 * (it - 912) + wave; if (r < CONV_ITEMS) convert_item(p, l + 1, r, (LAS float*)(lds + wave * 16384), lane); continue; }
                if (it < 16) {
#ifndef NO_S2
                    s2_head(p, lds, it, tid);
#endif
                }
                else if (it < 656) { const int d = it - 16, h = 3 - d / 160, u = d % 160, c = u & 1, v = u >> 1; int qb, seg;
                    if (v < 32) { qb = 31 - (v >> 2); seg = v & 3; } else if (v < 56) { const int w2 = v - 32; qb = 23 - w2 / 3; seg = w2 % 3; }
                    else if (v < 72) { const int w2 = v - 56; qb = 15 - (w2 >> 1); seg = w2 & 1; } else { qb = 79 - v; seg = 0; }
                    const float slope2 = exp2f(-2.0f * (float)(h + 1)) * LOG2E;
                    const float kn = sqrtf(knl[h * 2 + c]);
                    const int kt1 = 4 * qb + 3, klo = 32 * seg, khi = (klo + 31 < kt1) ? klo + 31 : kt1;
                    attn_unit<128, false>(lds, PROJ + h * 128 + c * 64, PROJ + 512 + h * 128 + c * 64, (const bf16_t*)(p->ws + WS_VAT) + (size_t)(h * 128) * M, slope2, qb * 256, 0.f,
                                          (float*)(p->ws + WS_OD) + (size_t)seg * M * 1024 + h * 256 + c * 128, (float*)(p->ws + WS_ML) + (size_t)seg * M * 16 + h * 4 + c * 2, nullptr, tid, klo, khi, kn); }
                else { const int s = it - 656, hq = s & 7, qb = s >> 3;
                    const int aidx = (hq >> 1) * 3 + (hq & 1);
                    const float slope2 = exp2f(-8.0f * (float)(aidx + 1) / 12.0f) * LOG2E;
                    const int q0 = qb * 256;
                    attn_unit<64, true>(lds, PROJ + 1536 + hq * 64, PROJ + 2048 + (hq >> 2) * 64, (const bf16_t*)(p->ws + WS_VBT) + (size_t)((hq >> 2) * 64) * M, slope2, q0, sinks[hq] * LOG2E,
                                        nullptr, nullptr, MIX + 512 + hq * 64, tid, q0 >= 128 ? (q0 - 128) / 64 : 0, (q0 + 255) / 64, 0.f); }
            } }
        GSYNC();
        {   FRESH(); LAS unsigned char* wl = lds + wave * 14336;
            for (int rep = 0; rep < DUP57; ++rep) for (int it = gw; it < NCH * 16; it += NGW) { const int c = it % NCH, h = it / NCH; scan_task<2>(p, l, wl, c, h, lane); }
            phase_diffcombine(p, l, gw, NGW, lane); }
        GSYNC();
        {   FRESH(); PTRS(); pg8::Gemm g{MIX, (const bf16_t*)(wb + LW_WOUT), M, DM, DM}; pg8::StaticOrder S; S.init(M, DM, G, bx);
            pg8::EpiResid E{p->out, XB, ssqB};
            pg8::gemm_phase<pg8::EpiResid, pg8::StaticOrder, true, true>(lds, g, S, E, tid); }
        GSYNC();
        for (int rep = 0; rep < DUP1; ++rep) {   if (rep) GSYNC(); FRESH(); PTRS(); pg8::Gemm g{XB, (const bf16_t*)(wb + LW_WGU), M, GU, DM}; pg8::StaticOrder S; S.init(M, GU, G, bx);
            pg8::EpiSwiGLU E{H, ssqB};
            pg8::gemm_phase<pg8::EpiSwiGLU, pg8::StaticOrder, true, true>(lds, g, S, E, tid); }
        GSYNC();
        {   FRESH(); PTRS(); pg8::Gemm g{H, (const bf16_t*)(wb + LW_WDN), M, DM, FF}; pg8::StaticOrder S; S.init(M, DM, G, bx);
            pg8::EpiResid E{p->out, XB, ssqA};
            pg8::gemm_phase<pg8::EpiResid, pg8::StaticOrder, true, true>(lds, g, S, E, tid); }
        GSYNC();
    }

__global__ void __launch_bounds__(512, 2) fwd_megakernel(Params p_unused) {
    extern __shared__ __attribute__((aligned(16))) unsigned char lds_raw[];
    LAS unsigned char* lds = (LAS unsigned char*)lds_raw;
    cg::grid_group grid = cg::this_grid();
    const int wave0 = __builtin_amdgcn_readfirstlane((int)threadIdx.x >> 6);
    if (threadIdx.x < 16) ((LAS unsigned*)(lds + LDS_BYTES - 64))[threadIdx.x] = 0u;
    if (threadIdx.x == 0) xb_add((unsigned*)(p_unused.ws + WS_CTL) + 4096 + XB_XCNT(xb_xcc_id()), 1u);
    __syncthreads();

#ifndef DUP0
#define DUP0 1
#endif
    for (int rep = 0; rep < DUP0; ++rep) { FRESH(); phase0(p, lds, gw, NGW, wave, lane); __syncthreads(); }
    grid.sync();

    layer_body<0>(lds, wave0); layer_body<1>(lds, wave0); layer_body<2>(lds, wave0); layer_body<3>(lds, wave0);
    {   FRESH(); const int l = 0; PTRS(); const float* gf = p->in[21];
        for (int m = gw; m < M; m += NGW) { const float rs = rsqrtf(wave_sum(lane < 32 ? ssqA[(size_t)m * 32 + lane] : 0.f) * (1.0f / DM) + EPS);
#pragma unroll
            for (int j = 0; j < 8; ++j) { const size_t o = (size_t)m * DM + j * 256 + lane * 4; const f32x4 v = *(const f32x4*)(p->out + o); const f32x4 gv = *(const f32x4*)(gf + j * 256 + lane * 4);
                *(f32x4*)(p->out + o) = v * rs * gv; } } }
}

extern "C" void kernel_launch(void* const* d_in, const int* in_sizes, int n_in, void* d_out, int out_size, void* d_ws, size_t ws_size, hipStream_t stream) {
    static int grid = 0;
    if (grid == 0) {
        if (n_in != 22 || out_size != M * DM || ws_size < WS_END) { fprintf(stderr, "kernel_launch: unexpected shapes (n_in %d out %d ws %zu need %zu)\n", n_in, out_size, ws_size, (size_t)WS_END); grid = -1; return; }
        int dev = 0, cus = 0, per_cu = 0;
        hipGetDevice(&dev); hipDeviceGetAttribute(&cus, hipDeviceAttributeMultiprocessorCount, dev);
        hipFuncSetAttribute((const void*)fwd_megakernel, hipFuncAttributeMaxDynamicSharedMemorySize, LDS_BYTES);
        hipOccupancyMaxActiveBlocksPerMultiprocessor(&per_cu, (const void*)fwd_megakernel, 512, LDS_BYTES);
        if (per_cu < 1) { fprintf(stderr, "kernel_launch: occupancy query says %d blocks per CU\n", per_cu); per_cu = 1; }
        (void)hipGetLastError();
        grid = cus;
    }
    if (grid < 0) return;
    hipMemsetAsync((char*)d_ws + WS_CTL, 0, 65536, stream);
    Params p{};
    for (int i = 0; i < 22; ++i) p.in[i] = (const float*)d_in[i];
    p.out = (float*)d_out; p.ws = (unsigned char*)d_ws;
    void* args[] = {&p};
    hipError_t e = hipLaunchCooperativeKernel((const void*)fwd_megakernel, dim3(grid), dim3(512), args, LDS_BYTES, stream);
    if (e != hipSuccess) fprintf(stderr, "cooperative launch failed: %s (grid %d)\n", hipGetErrorString(e), grid);
}
```

```cpp
#include <hip/hip_runtime.h>
#include <hip/hip_cooperative_groups.h>
#include <cstdio>
#include <cstdint>
namespace cg = cooperative_groups;

#define LAS __attribute__((address_space(3)))
typedef unsigned short bf16_t;
typedef short bf16x8 __attribute__((ext_vector_type(8)));
typedef float f32x4 __attribute__((ext_vector_type(4)));
typedef float f32x2 __attribute__((ext_vector_type(2)));
typedef float f32x16 __attribute__((ext_vector_type(16)));
typedef unsigned u32x4 __attribute__((ext_vector_type(4)));
typedef unsigned u32x2 __attribute__((ext_vector_type(2)));
typedef __bf16 bf16x2_t __attribute__((ext_vector_type(2)));

constexpr int M = 8192, DM = 2048, INC = 5824, INCP = 5888, FF = 5632, GU = 11264, RW0 = 2304, RWC = 3520;
constexpr int NL = 4, NCH = 64, CL = 128;
constexpr float EPS = 1e-5f, LOG2E = 1.4426950408889634f;
constexpr float QSC = 0.125f * LOG2E;

constexpr size_t MiB = 1u << 20;
constexpr size_t SZ_WIN = (size_t)INCP * DM * 2, SZ_WOUT = (size_t)DM * DM * 2, SZ_WGU = (size_t)GU * DM * 2, SZ_WDN = (size_t)DM * FF * 2;
constexpr size_t SZ_W2T = 1024 * 128 * 2, SZ_G2T = 1024 * 256 * 2;
constexpr size_t LW_WIN = 0, LW_WOUT = LW_WIN + SZ_WIN, LW_WGU = LW_WOUT + SZ_WOUT, LW_WDN = LW_WGU + SZ_WGU, LW_W2T = LW_WDN + SZ_WDN,
                 LW_A2T = LW_W2T + SZ_W2T, LW_G2T = LW_A2T + SZ_W2T, LW_STRIDE = LW_G2T + SZ_G2T;
constexpr size_t SZ_F = (size_t)M * 1024 * 4;
constexpr size_t WS_CTL = 0, WS_W = 1 * MiB, WS_XB = WS_W + NL * LW_STRIDE, WS_PROJ = WS_XB + (size_t)M * DM * 2,
                 WS_VAT = WS_PROJ + (size_t)M * INCP * 2, WS_VBT = WS_VAT + (size_t)512 * M * 2, WS_AW = WS_VBT + (size_t)128 * M * 2,
                 WS_AA = WS_AW + (size_t)M * 128 * 2, WS_AG = WS_AA + (size_t)M * 128 * 2, WS_R = WS_AG + (size_t)M * 256 * 2,
                 WS_KR = WS_R + SZ_F, WS_V = WS_KR + SZ_F, WS_DEC = WS_V + SZ_F, WS_A = WS_DEC + SZ_F, WS_G = WS_A + SZ_F,
                 WS_KF = WS_G + SZ_F, WS_AN = WS_KF + SZ_F, WS_BB = WS_AN + SZ_F, WS_PB = WS_BB + SZ_F, WS_UB = WS_PB + SZ_F,
                 WS_SI = WS_UB + SZ_F, WS_OD = WS_SI + SZ_F, WS_ML = WS_OD + 4 * SZ_F, WS_KNP = WS_ML + (size_t)4 * M * 16 * 4, WS_MIX = WS_KNP + 65536, WS_SSQA = WS_MIX + (size_t)M * DM * 2,
                 WS_SSQB = WS_SSQA + (size_t)M * 32 * 4, WS_END = WS_SSQB + (size_t)M * 32 * 4;
constexpr size_t WS_H = WS_PROJ;
static_assert((size_t)M * FF * 2 <= (size_t)M * INCP * 2, "H overlay");

constexpr int LDS_BYTES = 147456;

struct Params { const float* in[22]; float* out; unsigned char* ws; };
typedef const __attribute__((address_space(4))) Params* KP;
__device__ __forceinline__ KP fresh_params() { KP k = (KP)__builtin_amdgcn_kernarg_segment_ptr(); asm volatile("" : "+s"(k)); return k; }

__device__ __forceinline__ unsigned cvtpk(float lo, float hi) { f32x2 v = {lo, hi}; bf16x2_t b = __builtin_convertvector(v, bf16x2_t); return __builtin_bit_cast(unsigned, b); }
__device__ __forceinline__ float bf2f(unsigned short b) { return __builtin_bit_cast(float, (unsigned)b << 16); }
__device__ __forceinline__ float bflo(unsigned w) { return __builtin_bit_cast(float, w << 16); }
__device__ __forceinline__ float bfhi(unsigned w) { return __builtin_bit_cast(float, w & 0xffff0000u); }
template <int CTRL> __device__ __forceinline__ float dppm(float v) { return __builtin_bit_cast(float, __builtin_amdgcn_mov_dpp(__builtin_bit_cast(int, v), CTRL, 0xF, 0xF, true)); }
__device__ __forceinline__ float xor16_sum(float v) { const unsigned b = __builtin_bit_cast(unsigned, v); auto rr = __builtin_amdgcn_permlane16_swap(b, b, false, false); return __builtin_bit_cast(float, (unsigned)rr[0]) + __builtin_bit_cast(float, (unsigned)rr[1]); }
__device__ __forceinline__ float xor32_sum(float v) { const unsigned b = __builtin_bit_cast(unsigned, v); auto rr = __builtin_amdgcn_permlane32_swap(b, b, false, false); return __builtin_bit_cast(float, (unsigned)rr[0]) + __builtin_bit_cast(float, (unsigned)rr[1]); }
__device__ __forceinline__ float xor32_max(float v) { const unsigned b = __builtin_bit_cast(unsigned, v); auto rr = __builtin_amdgcn_permlane32_swap(b, b, false, false); return fmaxf(__builtin_bit_cast(float, (unsigned)rr[0]), __builtin_bit_cast(float, (unsigned)rr[1])); }
__device__ __forceinline__ float row16_sum(float v) { v += dppm<0xB1>(v); v += dppm<0x4E>(v); v += dppm<0x141>(v); v += dppm<0x140>(v); return v; }
__device__ __forceinline__ float wave_sum(float v) { return xor32_sum(xor16_sum(row16_sum(v))); }
__device__ __forceinline__ float dpp_xor1(float v) { return __builtin_bit_cast(float, __builtin_amdgcn_mov_dpp(__builtin_bit_cast(int, v), 0xB1, 0xF, 0xF, true)); }
__device__ __forceinline__ float dpp_xor2(float v) { return __builtin_bit_cast(float, __builtin_amdgcn_mov_dpp(__builtin_bit_cast(int, v), 0x4E, 0xF, 0xF, true)); }
__device__ __forceinline__ float quad_sum(float v) { v += dpp_xor1(v); v += dpp_xor2(v); return v; }
__device__ __forceinline__ float sigmoidf_(float x) { return 1.0f / (1.0f + __expf(-x)); }

__device__ __forceinline__ int fresh_tid(int wave0) { unsigned z = 0u; asm volatile("" : "+v"(z)); int t = wave0 * 64 + (int)__builtin_amdgcn_mbcnt_hi(~0u, __builtin_amdgcn_mbcnt_lo(~0u, z)); asm volatile("" : "+v"(t)); return t; }

__device__ __forceinline__ float row_rstd(const float* ssq, int row, int fq) {
    const float* pp = ssq + (size_t)row * 32 + 8 * fq; const f32x4 a = *(const f32x4*)pp, b = *(const f32x4*)(pp + 4);
    float s = ((a[0] + a[1]) + (a[2] + a[3])) + ((b[0] + b[1]) + (b[2] + b[3]));
    s = xor32_sum(xor16_sum(s));
    return rsqrtf(s * (1.0f / DM) + EPS);
}

namespace pg8 {
constexpr int BM = 256, BK = 64, HALF = 128, HTB = HALF * BK * 2, STAGE_BYTES = 8 * HTB, NXCD = 8, WGM = 8;
__host__ __device__ __forceinline__ int lds_byte(int r, int c) { const int st = (r >> 4) * 2 + (c >> 5), rr = r & 15, cc = c & 31, ob = rr * 64 + cc * 2; return st * 1024 + (ob ^ (((ob >> 9) & 1) << 5)); }
__host__ __device__ __forceinline__ void stage_rc(int b, int& R, int& C) { const int st = b / 1024, sb = b % 1024, swz = sb ^ (((sb >> 9) & 1) << 5); R = (st >> 1) * 16 + swz / 64; C = (st & 1) * 32 + (swz % 64) / 2; }
__host__ __device__ __forceinline__ int perm32(int rho) { const int n = rho >> 4, i = rho & 15; return 8 * (i >> 2) + 4 * n + (i & 3); }
struct Unit { int pm, pn; };
struct Gemm { const bf16_t* A; const bf16_t* Bt; int M, N, K; };
struct StaticOrder {
    int nM, nN, nwg, G, c;
    __host__ __device__ void init(int M_, int N_, int G_, int c_) { nM = M_ / BM; nN = N_ / BM; nwg = nM * nN; G = G_; c = c_; }
    __host__ __device__ bool next(int i, Unit& u) const {
        const long L = (long)i * G + c; if (L >= nwg) return false;
        int wgid = (int)L; { const int q = nwg / NXCD, r = nwg % NXCD, xcd = wgid % NXCD, off = wgid / NXCD; wgid = (xcd < r ? xcd * (q + 1) : r * (q + 1) + (xcd - r) * q) + off; }
        const int nig = WGM * nN, gid = wgid / nig, fm = gid * WGM, gsz = (nM - fm) < WGM ? (nM - fm) : WGM;
        u.pm = fm + ((wgid % nig) % gsz); u.pn = (wgid % nig) / gsz; return true;
    }
};

template <class Epi, class Sched, bool ALIGN_EPI, bool SP2>
__device__ __forceinline__ void gemm_phase(LAS unsigned char* lds, const Gemm g, const Sched& S, const Epi& E, const int tid) {
    const int wid = __builtin_amdgcn_readfirstlane(tid >> 6), lane = tid & 63, wr = wid >> 2, wc = wid & 3, fr = lane & 15, fq = lane >> 4;
    const int K = g.K, nt = K / BK;
    unsigned voffA[2], voffB[2];
#pragma unroll
    for (int i = 0; i < 2; ++i) { int R, C; stage_rc(tid * 16 + i * 8192, R, C); const int Rb = Epi::PERM ? ((R & ~31) + perm32(R & 31)) : R;
        voffA[i] = (unsigned)(R * K + C) * 2u; voffB[i] = (unsigned)(Rb * K + C) * 2u; }
    const size_t kstep = (size_t)(BK * 2);
    const size_t hstep = (size_t)HALF * K * 2;
    const size_t tstep = 2 * hstep;
    const unsigned ldsw = (unsigned)wid * 1024u;
    const int aoff = lds_byte(wr * 64 + fr, fq * 8), boff = lds_byte(wc * 32 + fr, fq * 8);
#define PG8_SA(b, h) (((b) * 2 + (h)) * HTB)
#define PG8_SB(b, h) ((4 + (b) * 2 + (h)) * HTB)
#define PG8_STAGE(bufoff, gbase, voff) do { _Pragma("unroll") for (int _i = 0; _i < 2; ++_i) \
        __builtin_amdgcn_global_load_lds((const unsigned*)((const char*)(gbase) + (voff)[_i]), (LAS unsigned*)(lds + (bufoff) + ldsw + _i * 8192), 16, 0, 0); } while (0)
#define PG8_LDA(dst, b, h) do { _Pragma("unroll") for (int m = 0; m < 4; ++m) _Pragma("unroll") for (int k = 0; k < 2; ++k) dst[m][k] = *(const LAS bf16x8*)(lds + PG8_SA(b, h) + aoff + m * 2048 + k * 1024); } while (0)
#define PG8_LDB(dst, b, h) do { _Pragma("unroll") for (int n = 0; n < 2; ++n) _Pragma("unroll") for (int k = 0; k < 2; ++k) dst[n][k] = *(const LAS bf16x8*)(lds + PG8_SB(b, h) + boff + n * 2048 + k * 1024); } while (0)
#define PG8_MMA(ai, bj, At, Bt) do { __builtin_amdgcn_s_setprio(1); _Pragma("unroll") for (int m = 0; m < 4; ++m) _Pragma("unroll") for (int n = 0; n < 2; ++n) _Pragma("unroll") for (int k = 0; k < 2; ++k) \
        acc[ai][bj][m][n] = __builtin_amdgcn_mfma_f32_16x16x32_bf16(Bt[n][k], At[m][k], acc[ai][bj][m][n], 0, 0, 0); __builtin_amdgcn_s_setprio(0); } while (0)
#define PG8_WAIT_V(n) asm volatile("s_waitcnt vmcnt(" #n ")" ::: "memory")
#define PG8_WAIT_L(n) asm volatile("s_waitcnt lgkmcnt(" #n ")" ::: "memory")
#define PG8_BAR __builtin_amdgcn_s_barrier()
#define PG8_SCHED __builtin_amdgcn_sched_barrier(0)
    Unit cur, nxt; int ui = 0;
    if (!S.next(0, cur)) return;
    f32x4 acc[2][2][4][2];
#pragma unroll
    for (int a = 0; a < 2; ++a)
#pragma unroll
        for (int b = 0; b < 2; ++b)
#pragma unroll
            for (int m = 0; m < 4; ++m)
#pragma unroll
                for (int n = 0; n < 2; ++n) acc[a][b][m][n] = (f32x4){0.f, 0.f, 0.f, 0.f};
    bf16x8 At[4][2], B0[2][2], B1[2][2];
    const char* cA = (const char*)g.A + (size_t)cur.pm * tstep; const char* cB = (const char*)g.Bt + (size_t)cur.pn * tstep;
    if constexpr (SP2) {
        PG8_STAGE(PG8_SB(0, 0), cB, voffB); PG8_STAGE(PG8_SB(0, 1), cB + hstep, voffB); PG8_STAGE(PG8_SA(0, 0), cA, voffA); PG8_STAGE(PG8_SA(0, 1), cA + hstep, voffA);
        if (wr == 1) PG8_BAR;
        PG8_WAIT_V(2); PG8_BAR;
        PG8_STAGE(PG8_SB(1, 0), cB + kstep, voffB); PG8_STAGE(PG8_SA(1, 0), cA + kstep, voffA); PG8_STAGE(PG8_SB(1, 1), cB + hstep + kstep, voffB);
        PG8_WAIT_V(6); PG8_BAR;
    } else {
        PG8_STAGE(PG8_SB(0, 0), cB, voffB); PG8_STAGE(PG8_SA(0, 0), cA, voffA); PG8_STAGE(PG8_SB(0, 1), cB + hstep, voffB); PG8_STAGE(PG8_SA(0, 1), cA + hstep, voffA);
        if (wr == 1) PG8_BAR;
        PG8_WAIT_V(4); PG8_BAR;
        PG8_STAGE(PG8_SB(1, 0), cB + kstep, voffB); PG8_STAGE(PG8_SA(1, 0), cA + kstep, voffA); PG8_STAGE(PG8_SB(1, 1), cB + hstep + kstep, voffB);
        PG8_WAIT_V(6); PG8_BAR;
    }
    for (;;) {
        const bool has_next = S.next(ui + 1, nxt);
        const char* nA = has_next ? (const char*)g.A + (size_t)nxt.pm * tstep : cA; const char* nB = has_next ? (const char*)g.Bt + (size_t)nxt.pn * tstep : cB;
        for (int t = 0; t < nt; t += 2) {
            const bool last = (t == nt - 2);
            const char* a1 = cA + (size_t)(t + 1) * kstep;
            const char* a2 = last ? nA : cA + (size_t)(t + 2) * kstep; const char* b2 = last ? nB : cB + (size_t)(t + 2) * kstep;
            const char* a3 = a2 + kstep; const char* b3 = b2 + kstep;
            if constexpr (SP2) {
            PG8_LDB(B0, 0, 0); PG8_LDB(B1, 0, 1); PG8_SCHED; PG8_LDA(At, 0, 0); PG8_STAGE(PG8_SA(1, 1), a1 + hstep, voffA);
            PG8_WAIT_V(8); PG8_WAIT_L(0); PG8_BAR; PG8_MMA(0, 0, At, B0); PG8_MMA(0, 1, At, B1); PG8_BAR; PG8_SCHED;
            PG8_LDA(At, 0, 1); PG8_STAGE(PG8_SB(0, 0), b2, voffB); PG8_STAGE(PG8_SB(0, 1), b2 + hstep, voffB); PG8_STAGE(PG8_SA(0, 0), a2, voffA);
            PG8_WAIT_V(8); PG8_WAIT_L(0); PG8_BAR; PG8_MMA(1, 0, At, B0); PG8_MMA(1, 1, At, B1); PG8_BAR; PG8_SCHED;
            PG8_LDB(B0, 1, 0); PG8_LDB(B1, 1, 1); PG8_SCHED; PG8_LDA(At, 1, 0); PG8_STAGE(PG8_SA(0, 1), a2 + hstep, voffA);
            PG8_WAIT_V(8); PG8_WAIT_L(0); PG8_BAR; PG8_MMA(0, 0, At, B0); PG8_MMA(0, 1, At, B1); PG8_BAR; PG8_SCHED;
            PG8_LDA(At, 1, 1); PG8_STAGE(PG8_SB(1, 0), b3, voffB); PG8_STAGE(PG8_SB(1, 1), b3 + hstep, voffB); PG8_STAGE(PG8_SA(1, 0), a3, voffA);
            PG8_WAIT_V(8); PG8_WAIT_L(0); PG8_BAR; PG8_MMA(1, 0, At, B0); PG8_MMA(1, 1, At, B1); PG8_BAR; PG8_SCHED;
            } else {
            PG8_LDB(B0, 0, 0); PG8_SCHED; PG8_LDA(At, 0, 0); PG8_STAGE(PG8_SA(1, 1), a1 + hstep, voffA);
            PG8_WAIT_L(8); PG8_BAR; PG8_WAIT_L(0); PG8_MMA(0, 0, At, B0); PG8_BAR; PG8_SCHED;
            PG8_LDB(B1, 0, 1); PG8_STAGE(PG8_SB(0, 0), b2, voffB);
            PG8_BAR; PG8_WAIT_L(0); PG8_MMA(0, 1, At, B1); PG8_BAR;
            PG8_LDA(At, 0, 1); PG8_STAGE(PG8_SA(0, 0), a2, voffA);
            PG8_BAR; PG8_WAIT_L(0); PG8_MMA(1, 0, At, B0); PG8_BAR; PG8_SCHED;
            PG8_STAGE(PG8_SB(0, 1), b2 + hstep, voffB);
            PG8_WAIT_V(6); PG8_BAR; PG8_MMA(1, 1, At, B1); PG8_BAR;
            PG8_LDB(B0, 1, 0); PG8_SCHED; PG8_LDA(At, 1, 0); PG8_STAGE(PG8_SA(0, 1), a2 + hstep, voffA);
            PG8_WAIT_L(8); PG8_BAR; PG8_WAIT_L(0); PG8_MMA(0, 0, At, B0); PG8_BAR; PG8_SCHED;
            PG8_LDB(B1, 1, 1); PG8_STAGE(PG8_SB(1, 0), b3, voffB);
            PG8_BAR; PG8_WAIT_L(0); PG8_MMA(0, 1, At, B1); PG8_BAR;
            PG8_LDA(At, 1, 1); PG8_STAGE(PG8_SA(1, 0), a3, voffA);
            PG8_BAR; PG8_WAIT_L(0); PG8_MMA(1, 0, At, B0); PG8_BAR; PG8_SCHED;
            PG8_STAGE(PG8_SB(1, 1), b3 + hstep, voffB);
            PG8_WAIT_V(6); PG8_BAR; PG8_MMA(1, 1, At, B1); PG8_BAR;
            }
        }
        if constexpr (ALIGN_EPI) { if (wr == 0) PG8_BAR; }
        E(acc, cur, wr, wc, fr, fq);
        if (!has_next) break;
#pragma unroll
        for (int a = 0; a < 2; ++a)
#pragma unroll
            for (int b = 0; b < 2; ++b)
#pragma unroll
                for (int m = 0; m < 4; ++m)
#pragma unroll
                    for (int n = 0; n < 2; ++n) acc[a][b][m][n] = (f32x4){0.f, 0.f, 0.f, 0.f};
        cur = nxt; cA = nA; cB = nB; ++ui;
        if constexpr (ALIGN_EPI) { if (wr == 1) PG8_BAR; }
    }
    PG8_WAIT_V(0);
    if constexpr (!ALIGN_EPI) { if (wr == 0) PG8_BAR; }
    PG8_BAR;
#undef PG8_SA
#undef PG8_SB
#undef PG8_STAGE
#undef PG8_LDA
#undef PG8_LDB
#undef PG8_MMA
#undef PG8_WAIT_V
#undef PG8_WAIT_L
#undef PG8_BAR
#undef PG8_SCHED
}

struct EpiProj {
    static constexpr bool PERM = true;
    bf16_t* O; int ldc; const float* ssq;
    __device__ __forceinline__ void operator()(const f32x4 (&acc)[2][2][4][2], const Unit& u, int wr, int wc, int fr, int fq) const {
        const int row0 = u.pm * BM + wr * 64 + fr, col0 = u.pn * BM + wc * 32 + 8 * fq;
#pragma unroll
        for (int ai = 0; ai < 2; ++ai)
#pragma unroll
            for (int m = 0; m < 4; ++m) { const int row = row0 + ai * HALF + m * 16; const float rs = row_rstd(ssq, row, fq);
                bf16_t* rowp = O + (size_t)row * ldc + col0;
#pragma unroll
                for (int bj = 0; bj < 2; ++bj) { const f32x4 v0 = acc[ai][bj][m][0] * rs, v1 = acc[ai][bj][m][1] * rs;
                    u32x4 w; w.x = cvtpk(v0[0], v0[1]); w.y = cvtpk(v0[2], v0[3]); w.z = cvtpk(v1[0], v1[1]); w.w = cvtpk(v1[2], v1[3]);
                    *(u32x4*)(rowp + bj * HALF) = w; } }
    }
};
struct EpiSwiGLU {
    static constexpr bool PERM = true;
    bf16_t* O; const float* ssq;
    __device__ __forceinline__ void operator()(const f32x4 (&acc)[2][2][4][2], const Unit& u, int wr, int wc, int fr, int fq) const {
        const int row0 = u.pm * BM + wr * 64 + fr, col0 = u.pn * HALF + wc * 32 + 8 * fq;
#pragma unroll
        for (int ai = 0; ai < 2; ++ai)
#pragma unroll
            for (int m = 0; m < 4; ++m) { const int row = row0 + ai * HALF + m * 16; const float rs = row_rstd(ssq, row, fq);
                float h[8];
#pragma unroll
                for (int n = 0; n < 2; ++n)
#pragma unroll
                    for (int j = 0; j < 4; ++j) { const float gt = acc[ai][0][m][n][j] * rs, up = acc[ai][1][m][n][j] * rs; h[n * 4 + j] = gt * up / (1.0f + __expf(-gt)); }
                u32x4 w; w.x = cvtpk(h[0], h[1]); w.y = cvtpk(h[2], h[3]); w.z = cvtpk(h[4], h[5]); w.w = cvtpk(h[6], h[7]);
                *(u32x4*)(O + (size_t)row * FF + col0) = w; }
    }
};
struct EpiResid {
    static constexpr bool PERM = false;
    float* X; bf16_t* XB; float* ssq;
    __device__ __forceinline__ void operator()(const f32x4 (&acc)[2][2][4][2], const Unit& u, int wr, int wc, int fr, int fq) const {
        const int row0 = u.pm * BM + wr * 64 + fr, col0 = u.pn * BM + wc * 32 + 4 * fq;
#pragma unroll
        for (int ai = 0; ai < 2; ++ai)
#pragma unroll
            for (int m = 0; m < 4; ++m) { const int row = row0 + ai * HALF + m * 16; const size_t off = (size_t)row * DM + col0; float ss = 0.f;
#pragma unroll
                for (int bj = 0; bj < 2; ++bj)
#pragma unroll
                    for (int n = 0; n < 2; ++n) { const size_t o = off + bj * HALF + n * 16; const f32x4 xv = *(const f32x4*)(X + o) + acc[ai][bj][m][n];
                        *(f32x4*)(X + o) = xv; u32x2 w; w.x = cvtpk(xv[0], xv[1]); w.y = cvtpk(xv[2], xv[3]); *(u32x2*)(XB + o) = w;
                        ss += (xv[0] * xv[0] + xv[1] * xv[1]) + (xv[2] * xv[2] + xv[3] * xv[3]); }
                ss = xor32_sum(xor16_sum(ss));
                if (fq == 0) ssq[(size_t)row * 32 + u.pn * 4 + wc] = ss; }
    }
};
template <int MODE> struct EpiLora {
    static constexpr bool PERM = false;
    float* O; const float* bias;
    __device__ __forceinline__ void operator()(const f32x4 (&acc)[2][2][4][2], const Unit& u, int wr, int wc, int fr, int fq) const {
        const int row0 = u.pm * BM + wr * 64 + fr, col0 = u.pn * BM + wc * 32 + 4 * fq;
#pragma unroll
        for (int bj = 0; bj < 2; ++bj)
#pragma unroll
            for (int n = 0; n < 2; ++n) { const int col = col0 + bj * HALF + n * 16;
                f32x4 bv = (f32x4){0.f, 0.f, 0.f, 0.f}; if (MODE != 2) bv = *(const f32x4*)(bias + col);
#pragma unroll
                for (int ai = 0; ai < 2; ++ai)
#pragma unroll
                    for (int m = 0; m < 4; ++m) { const int row = row0 + ai * HALF + m * 16; f32x4 v = acc[ai][bj][m][n] + bv;
                        if (MODE == 0) {
#pragma unroll
                            for (int j = 0; j < 4; ++j) { const float z = -v[j]; const float sp = fmaxf(z, 0.f) + log1pf(__expf(-fabsf(z))); v[j] = __expf(-__expf(-sp - 0.5f)); }
                        } else if (MODE == 1) {
#pragma unroll
                            for (int j = 0; j < 4; ++j) v[j] = sigmoidf_(v[j]);
                        }
                        *(f32x4*)(O + (size_t)row * 1024 + col) = v; } }
    }
};
}

template <int MAP>
__device__ __forceinline__ void transpose_item(const float* W, int K, int N, bf16_t* WT, const float* gk, LAS float* scr, int item, int lane) {
    const int nblk = N / 32, kb = item / nblk, nb = item % nblk, k0 = 64 * kb, n0 = 32 * nb;
    float v[32];
    const float* wp = W + (size_t)(k0 + (lane >> 5)) * N + n0 + (lane & 31);
#pragma unroll
    for (int i = 0; i < 32; ++i) v[i] = __builtin_nontemporal_load(wp + (size_t)(2 * i) * N);
    const int c = lane & 7;
    f32x4 g0 = (f32x4){1.f, 1.f, 1.f, 1.f}, g1 = g0;
    if (gk) { g0 = *(const f32x4*)(gk + k0 + 8 * c); g1 = *(const f32x4*)(gk + k0 + 8 * c + 4); }
#pragma unroll
    for (int i = 0; i < 32; ++i) scr[(2 * i + (lane >> 5)) * 33 + (lane & 31)] = v[i];
    asm volatile("s_waitcnt lgkmcnt(0)" ::: "memory");
#pragma unroll
    for (int j = 0; j < 4; ++j) { const int n = n0 + (lane >> 3) + 8 * j; const LAS float* s = scr + (8 * c) * 33 + (n - n0);
        float sc = 1.f; int drow = n;
        if (MAP == 0) { if (n < 512 || (n >= 1536 && n < 2048)) sc = QSC; }
        if (MAP == 1) { const int hn = n < FF ? n : n - FF; drow = (hn >> 7) * 256 + (n < FF ? 0 : 128) + (hn & 127); }
        const f32x4 h0 = g0 * sc, h1 = g1 * sc;
        u32x4 o; o.x = cvtpk(s[0 * 33] * h0[0], s[1 * 33] * h0[1]); o.y = cvtpk(s[2 * 33] * h0[2], s[3 * 33] * h0[3]); o.z = cvtpk(s[4 * 33] * h1[0], s[5 * 33] * h1[1]); o.w = cvtpk(s[6 * 33] * h1[2], s[7 * 33] * h1[3]);
        *(u32x4*)(WT + (size_t)drow * K + k0 + 8 * c) = o; }
    asm volatile("s_waitcnt lgkmcnt(0)" ::: "memory");
}

constexpr int I_IN = (DM / 64) * (INC / 32), I_OUT = (DM / 64) * (DM / 32), I_GU = (DM / 64) * (GU / 32), I_DN = (FF / 64) * (DM / 32);
constexpr int CONV_ITEMS = I_IN + I_OUT + I_GU + I_DN;
__device__ __forceinline__ void convert_item(KP p, int l, int r, LAS float* scr, int lane) {
    unsigned char* wb = p->ws + WS_W + (size_t)l * LW_STRIDE;
    if (r < I_IN) { transpose_item<0>(p->in[2] + (size_t)l * DM * INC, DM, INC, (bf16_t*)(wb + LW_WIN), p->in[1] + l * DM, scr, r, lane); return; } r -= I_IN;
    if (r < I_OUT) { transpose_item<2>(p->in[17] + (size_t)l * DM * DM, DM, DM, (bf16_t*)(wb + LW_WOUT), nullptr, scr, r, lane); return; } r -= I_OUT;
    if (r < I_GU) { transpose_item<1>(p->in[19] + (size_t)l * DM * GU, DM, GU, (bf16_t*)(wb + LW_WGU), p->in[18] + l * DM, scr, r, lane); return; } r -= I_GU;
    transpose_item<2>(p->in[20] + (size_t)l * FF * DM, FF, DM, (bf16_t*)(wb + LW_WDN), nullptr, scr, r, lane);
}

__device__ __forceinline__ void phase0(KP p, LAS unsigned char* lds, int gw, int NGW, int wave, int lane) {
    LAS float* scr = (LAS float*)(lds + wave * 16384);
    for (int it = gw; it < CONV_ITEMS; it += NGW) convert_item(p, 0, it, scr, lane);
    const int gt = gw * 64 + lane, NGT = NGW * 64;
    for (int l = 0; l < NL; ++l) {
        unsigned char* wb = p->ws + WS_W + (size_t)l * LW_STRIDE;
        bf16_t* w2t = (bf16_t*)(wb + LW_W2T); bf16_t* a2t = (bf16_t*)(wb + LW_A2T); bf16_t* g2t = (bf16_t*)(wb + LW_G2T);
        const float* w2 = p->in[8] + (size_t)l * 96 * 1024; const float* a2 = p->in[10] + (size_t)l * 96 * 1024; const float* g2 = p->in[11] + (size_t)l * 256 * 1024;
        for (int i = gt; i < 1024 * 128; i += NGT) { const int n = i >> 7, k = i & 127;
            w2t[i] = (bf16_t)(cvtpk(k < 96 ? w2[k * 1024 + n] : 0.f, 0.f) & 0xffff); a2t[i] = (bf16_t)(cvtpk(k < 96 ? a2[k * 1024 + n] : 0.f, 0.f) & 0xffff); }
        for (int i = gt; i < 1024 * 256; i += NGT) { const int n = i >> 8, k = i & 255; g2t[i] = (bf16_t)(cvtpk(g2[k * 1024 + n], 0.f) & 0xffff); }
        unsigned* padz = (unsigned*)(wb + LW_WIN + (size_t)INC * DM * 2);
        for (int i = gt; i < (INCP - INC) * DM / 2; i += NGT) padz[i] = 0u;
    }
    const float* x = p->in[0]; float* X = p->out; bf16_t* XB = (bf16_t*)(p->ws + WS_XB); float* ssqA = (float*)(p->ws + WS_SSQA);
    for (int m = gw; m < M; m += NGW) { float ss = 0.f;
#pragma unroll
        for (int j = 0; j < 8; ++j) { const size_t o = (size_t)m * DM + j * 256 + lane * 4; const f32x4 v = *(const f32x4*)(x + o); *(f32x4*)(X + o) = v;
            u32x2 w; w.x = cvtpk(v[0], v[1]); w.y = cvtpk(v[2], v[3]); *(u32x2*)(XB + o) = w; ss += (v[0] * v[0] + v[1] * v[1]) + (v[2] * v[2] + v[3] * v[3]); }
        ss = wave_sum(ss); if (lane < 32) ssqA[(size_t)m * 32 + lane] = lane == 0 ? ss : 0.f; }
}

__device__ __forceinline__ void phase_prep1(KP p, int l, LAS unsigned char* lds, int gw, int NGW, int wave, int lane) {
    const bf16_t* PROJ = (const bf16_t*)(p->ws + WS_PROJ);
    LAS unsigned short* tile = (LAS unsigned short*)(lds + wave * 8448);
    bf16_t* VAT = (bf16_t*)(p->ws + WS_VAT); bf16_t* VBT = (bf16_t*)(p->ws + WS_VBT);
    for (int it = gw; it < 128 * 10; it += NGW) {
        const int tb = it / 10, g = it % 10, t0 = tb * 64; const int cbase = g < 8 ? 1024 + 64 * g : 2176 + 64 * (g - 8);
        bf16_t* dst = g < 8 ? VAT + (size_t)(64 * g) * M : VBT + (size_t)(64 * (g - 8)) * M;
#pragma unroll
        for (int i = 0; i < 8; ++i) { const int row = i * 8 + (lane >> 3), ch = lane & 7; const u32x4 v = *(const u32x4*)(PROJ + (size_t)(t0 + row) * INCP + cbase + 8 * ch);
            LAS unsigned* d = (LAS unsigned*)(tile + row * 66 + 8 * ch); d[0] = v.x; d[1] = v.y; d[2] = v.z; d[3] = v.w; }
        asm volatile("s_waitcnt lgkmcnt(0)" ::: "memory");
#pragma unroll
        for (int i = 0; i < 8; ++i) { const int c = i * 8 + (lane >> 3), tch = lane & 7, j = tch >> 1, hi = tch & 1; unsigned short v[8];
#pragma unroll
            for (int s = 0; s < 8; ++s) v[s] = tile[(16 * j + (s & 3) + 8 * (s >> 2) + 4 * hi) * 66 + c];
            u32x4 o; o.x = v[0] | ((unsigned)v[1] << 16); o.y = v[2] | ((unsigned)v[3] << 16); o.z = v[4] | ((unsigned)v[5] << 16); o.w = v[6] | ((unsigned)v[7] << 16);
            *(u32x4*)(dst + (size_t)c * M + t0 + 16 * j + 8 * hi) = o; }
        asm volatile("s_waitcnt lgkmcnt(0)" ::: "memory");
    }
    const float* mu = p->in[6] + (size_t)l * RWC;
    bf16_t* AW = (bf16_t*)(p->ws + WS_AW); bf16_t* AA = (bf16_t*)(p->ws + WS_AA); bf16_t* AG = (bf16_t*)(p->ws + WS_AG);
    float knmax = 0.f;
    for (int t = gw; t < M; t += NGW) {
        const bf16_t* cur = PROJ + (size_t)t * INCP + RW0;
        {   const u32x4 kv = *(const u32x4*)(PROJ + (size_t)t * INCP + 512 + 8 * lane);
            float a0 = bflo(kv.x), a1 = bfhi(kv.x), a2 = bflo(kv.y), a3 = bfhi(kv.y), a4 = bflo(kv.z), a5 = bfhi(kv.z), a6 = bflo(kv.w), a7 = bfhi(kv.w);
            float ss = (a0 * a0 + a1 * a1) + (a2 * a2 + a3 * a3) + (a4 * a4 + a5 * a5) + (a6 * a6 + a7 * a7);
            ss += dppm<0xB1>(ss); ss += dppm<0x4E>(ss); ss += dppm<0x141>(ss); knmax = fmaxf(knmax, ss); }
        if (lane < 56) { const int j0 = 3072 + 8 * lane;
            const u32x4 c4 = *(const u32x4*)(cur + j0); u32x4 p4 = (u32x4){0u, 0u, 0u, 0u}; if (t > 0) p4 = *(const u32x4*)(cur - INCP + j0);
            const f32x4 m0 = *(const f32x4*)(mu + j0), m1 = *(const f32x4*)(mu + j0 + 4);
            float f[8]; const unsigned cw[4] = {c4.x, c4.y, c4.z, c4.w}, pw[4] = {p4.x, p4.y, p4.z, p4.w};
#pragma unroll
            for (int q = 0; q < 4; ++q) { const float c0 = bflo(cw[q]), c1 = bfhi(cw[q]), p0 = bflo(pw[q]), p1 = bfhi(pw[q]);
                const float mu0 = q < 2 ? m0[2 * q] : m1[2 * q - 4], mu1 = q < 2 ? m0[2 * q + 1] : m1[2 * q - 3];
                f[2 * q] = c0 + (p0 - c0) * mu0; f[2 * q + 1] = c1 + (p1 - c1) * mu1; }
            bf16_t* dstp;
            if (j0 < 3168) { dstp = AW + (size_t)t * 128 + (j0 - 3072);
#pragma unroll
                for (int q = 0; q < 8; ++q) f[q] = tanhf(f[q]); }
            else if (j0 < 3264) { dstp = AA + (size_t)t * 128 + (j0 - 3168); }
            else { dstp = AG + (size_t)t * 256 + (j0 - 3264);
#pragma unroll
                for (int q = 0; q < 8; ++q) f[q] = sigmoidf_(f[q]); }
            u32x4 o; o.x = cvtpk(f[0], f[1]); o.y = cvtpk(f[2], f[3]); o.z = cvtpk(f[4], f[5]); o.w = cvtpk(f[6], f[7]); *(u32x4*)dstp = o; }
        else { const int e = lane - 56; if (e < 4) *(u32x4*)(AW + (size_t)t * 128 + 96 + 8 * e) = (u32x4){0u, 0u, 0u, 0u}; else *(u32x4*)(AA + (size_t)t * 128 + 96 + 8 * (e - 4)) = (u32x4){0u, 0u, 0u, 0u}; }
    }
    {   LAS float* kr = (LAS float*)(lds + 8 * 8448);
        if ((lane & 7) == 0) kr[wave * 8 + (lane >> 3)] = knmax;
        __syncthreads();
        if (wave == 0 && lane < 8) { float m = kr[lane];
#pragma unroll
            for (int w2 = 1; w2 < 8; ++w2) m = fmaxf(m, kr[w2 * 8 + lane]);
            ((float*)(p->ws + WS_KNP))[(size_t)(gw >> 3) * 8 + lane] = m; }
        __syncthreads(); }
}

__device__ __forceinline__ void phase_prep2(KP p, int l, int gw, int NGW, int lane) {
    const float* KR = (const float*)(p->ws + WS_KR); const float* A = (const float*)(p->ws + WS_A);
    float* KF = (float*)(p->ws + WS_KF); float* AN = (float*)(p->ws + WS_AN); float* BB = (float*)(p->ws + WS_BB);
    const float* k_k = p->in[12] + l * 1024; const float* k_a = p->in[13] + l * 1024;
    const int c0 = 16 * lane;
    for (int t = gw; t < M; t += NGW) { const size_t o = (size_t)t * 1024 + c0; float n2 = 0.f; f32x4 kkv[4], kr[4], av[4];
#pragma unroll
        for (int q = 0; q < 4; ++q) { kr[q] = *(const f32x4*)(KR + o + 4 * q); av[q] = *(const f32x4*)(A + o + 4 * q); kkv[q] = kr[q] * *(const f32x4*)(k_k + c0 + 4 * q);
            n2 += (kkv[q][0] * kkv[q][0] + kkv[q][1] * kkv[q][1]) + (kkv[q][2] * kkv[q][2] + kkv[q][3] * kkv[q][3]); }
        n2 = quad_sum(n2); const float inv = 1.0f / fmaxf(sqrtf(n2), 1e-12f);
#pragma unroll
        for (int q = 0; q < 4; ++q) { const f32x4 kk = kkv[q] * inv; const f32x4 ka = *(const f32x4*)(k_a + c0 + 4 * q);
            *(f32x4*)(KF + o + 4 * q) = kr[q] * (1.0f + (av[q] - 1.0f) * ka); *(f32x4*)(AN + o + 4 * q) = -kk; *(f32x4*)(BB + o + 4 * q) = kk * av[q]; }
    }
}

template <int MODE>
__device__ __forceinline__ void scan_task(KP p, int l, LAS unsigned char* wl, int c, int h, int lane) {
    constexpr int NPV = MODE == 0 ? 1 : (MODE == 1 ? 2 : 3);
    constexpr int SB = 4;
    LAS float* vec = (LAS float*)wl;
    LAS float* ybuf = (LAS float*)(wl + 7 * SB * 256);
    const float* DECp = (const float*)(p->ws + WS_DEC); const float* Ap = (const float*)(p->ws + WS_A); const bf16_t* PROJ = (const bf16_t*)(p->ws + WS_PROJ);
    const int rb = lane >> 2, cb = lane & 3, t0 = c * CL;
    f32x2 s[4][8];
    if (MODE == 0) {
#pragma unroll
        for (int r = 0; r < 4; ++r)
#pragma unroll
            for (int q = 0; q < 8; ++q) { s[r][q].x = (4 * rb + r == 16 * cb + 2 * q) ? 1.f : 0.f; s[r][q].y = (4 * rb + r == 16 * cb + 2 * q + 1) ? 1.f : 0.f; }
    } else if (MODE == 1) {
#pragma unroll
        for (int r = 0; r < 4; ++r)
#pragma unroll
            for (int q = 0; q < 8; ++q) s[r][q] = (f32x2){0.f, 0.f};
    } else {
        const float* SI = (const float*)(p->ws + WS_SI) + ((size_t)(h * NCH + c)) * 4096;
#pragma unroll
        for (int x = 0; x < 16; ++x) { const f32x4 v = *(const f32x4*)(SI + (16 * cb + x) * 64 + 4 * rb);
#pragma unroll
            for (int r = 0; r < 4; ++r) { if (x & 1) s[r][x >> 1].y = v[r]; else s[r][x >> 1].x = v[r]; } }
    }
    float lnw = 0.f, lnb = 0.f, rk = 0.f;
    if (MODE == 2) { lnw = p->in[15][l * 1024 + 64 * h + lane]; lnb = p->in[16][l * 1024 + 64 * h + lane]; rk = p->in[14][l * 1024 + 64 * h + lane]; }
    const int lst = lane >> 4, lq = lane & 15;
    const f32x4 kk4 = *(const f32x4*)(p->in[12] + l * 1024 + 64 * h + 4 * lq), ka4 = *(const f32x4*)(p->in[13] + l * 1024 + 64 * h + 4 * lq);
    const size_t goff = (size_t)(t0 + lst) * 1024 + 64 * h + 4 * lq;
    const int pvo[3] = {1024, 2048, 0};
    f32x4 mu4[NPV];
#pragma unroll
    for (int v = 0; v < NPV; ++v) mu4[v] = *(const f32x4*)(p->in[6] + (size_t)l * RWC + pvo[v] + 64 * h + 4 * lq);
    const bf16_t* pj = PROJ + (size_t)(t0 + lst) * INCP + RW0 + 64 * h + 4 * lq;
    const float* Gp = (const float*)(p->ws + WS_G);
    struct Pre { f32x4 dec, a, g; u32x2 cur[NPV], prv[NPV]; };
    Pre pA, pB;
#define SCAN_LOAD(P_, SBI) do { if ((SBI) < CL / SB) { const size_t ro = (size_t)(SB * (SBI)); P_.dec = *(const f32x4*)(DECp + goff + ro * 1024); P_.a = *(const f32x4*)(Ap + goff + ro * 1024); \
        if constexpr (MODE == 2) P_.g = *(const f32x4*)(Gp + goff + ro * 1024); \
        const bool first = (t0 + (int)ro + lst) == 0; \
        _Pragma("unroll") for (int v = 0; v < NPV; ++v) { P_.cur[v] = *(const u32x2*)(pj + ro * INCP + pvo[v]); P_.prv[v] = first ? (u32x2){0u, 0u} : *(const u32x2*)(pj + ro * INCP + pvo[v] - INCP); } } } while (0)
#define SCAN_SHIFT(P_, V) ({ const f32x4 c_ = (f32x4){bflo(P_.cur[V].x), bfhi(P_.cur[V].x), bflo(P_.cur[V].y), bfhi(P_.cur[V].y)}, q_ = (f32x4){bflo(P_.prv[V].x), bfhi(P_.prv[V].x), bflo(P_.prv[V].y), bfhi(P_.prv[V].y)}; c_ + (q_ - c_) * mu4[V]; })
#define SCAN_STAGE(P_) do { const f32x4 kr = SCAN_SHIFT(P_, 0), av = P_.a; const f32x4 kkv = kr * kk4; \
        float n2 = (kkv[0] * kkv[0] + kkv[1] * kkv[1]) + (kkv[2] * kkv[2] + kkv[3] * kkv[3]); n2 = row16_sum(n2); \
        const float inv = 1.0f / fmaxf(sqrtf(n2), 1e-12f); const f32x4 kkn = kkv * inv; \
        LAS float* vw = vec + lst * 64 + 4 * lq; \
        *(LAS f32x4*)(vw + 0 * SB * 64) = P_.dec; *(LAS f32x4*)(vw + 1 * SB * 64) = -kkn; *(LAS f32x4*)(vw + 2 * SB * 64) = kkn * av; \
        if constexpr (MODE != 0) { *(LAS f32x4*)(vw + 3 * SB * 64) = kr * (1.0f + (av - 1.0f) * ka4); *(LAS f32x4*)(vw + 4 * SB * 64) = SCAN_SHIFT(P_, 1); } \
        if constexpr (MODE == 2) { *(LAS f32x4*)(vw + 5 * SB * 64) = SCAN_SHIFT(P_, 2); *(LAS f32x4*)(vw + 6 * SB * 64) = P_.g; } } while (0)
    SCAN_LOAD(pA, 0); SCAN_LOAD(pB, 1);
    for (int sb = 0; sb < CL / SB; ++sb) {
        if (sb & 1) { SCAN_STAGE(pB); SCAN_LOAD(pB, sb + 2); } else { SCAN_STAGE(pA); SCAN_LOAD(pA, sb + 2); }
#pragma unroll 1
        for (int st = 0; st < SB; ++st) {
            const LAS float* vb = vec + st * 64 + 16 * cb;
            float sa[4];
            {   f32x2 a2[8];
#pragma unroll
                for (int q = 0; q < 4; ++q) { const f32x4 y = *(const LAS f32x4*)(vb + 1 * SB * 64 + 4 * q); a2[2 * q] = (f32x2){y[0], y[1]}; a2[2 * q + 1] = (f32x2){y[2], y[3]}; }
#pragma unroll
                for (int r = 0; r < 4; ++r) { f32x2 a = s[r][0] * a2[0];
#pragma unroll
                    for (int q = 1; q < 8; ++q) a = s[r][q] * a2[q] + a;
                    sa[r] = quad_sum(a.x + a.y); } }
            f32x4 vv = (f32x4){0.f, 0.f, 0.f, 0.f};
            if (MODE != 0) vv = *(const LAS f32x4*)(vec + (4 * SB + st) * 64 + 4 * rb);
#pragma unroll
            for (int q = 0; q < 4; ++q) { const f32x4 w4 = *(const LAS f32x4*)(vb + 0 * SB * 64 + 4 * q), b4 = *(const LAS f32x4*)(vb + 2 * SB * 64 + 4 * q);
                const f32x2 w0 = (f32x2){w4[0], w4[1]}, w1 = (f32x2){w4[2], w4[3]}, b0 = (f32x2){b4[0], b4[1]}, b1 = (f32x2){b4[2], b4[3]};
                if (MODE == 0) {
#pragma unroll
                    for (int r = 0; r < 4; ++r) { s[r][2 * q] = s[r][2 * q] * w0 + b0 * sa[r]; s[r][2 * q + 1] = s[r][2 * q + 1] * w1 + b1 * sa[r]; }
                } else { const f32x4 k4 = *(const LAS f32x4*)(vb + 3 * SB * 64 + 4 * q); const f32x2 k0 = (f32x2){k4[0], k4[1]}, k1 = (f32x2){k4[2], k4[3]};
#pragma unroll
                    for (int r = 0; r < 4; ++r) { s[r][2 * q] = s[r][2 * q] * w0 + (b0 * sa[r] + k0 * vv[r]); s[r][2 * q + 1] = s[r][2 * q + 1] * w1 + (b1 * sa[r] + k1 * vv[r]); }
                } }
            if (MODE == 2) {
                f32x2 r2[8];
#pragma unroll
                for (int q = 0; q < 4; ++q) { const f32x4 x = *(const LAS f32x4*)(vb + 5 * SB * 64 + 4 * q); r2[2 * q] = (f32x2){x[0], x[1]}; r2[2 * q + 1] = (f32x2){x[2], x[3]}; }
                f32x4 yv;
#pragma unroll
                for (int r = 0; r < 4; ++r) { f32x2 a = s[r][0] * r2[0];
#pragma unroll
                    for (int q = 1; q < 8; ++q) a = s[r][q] * r2[q] + a;
                    yv[r] = quad_sum(a.x + a.y); }
                if (cb == 0) *(LAS f32x4*)(ybuf + st * 64 + 4 * rb) = yv;
            }
        }
        if (MODE == 2) {
            bf16_t* MIX = (bf16_t*)(p->ws + WS_MIX);
#pragma unroll 1
            for (int st = 0; st < SB; ++st) { const int t = t0 + SB * sb + st;
                const float y = ybuf[st * 64 + lane]; const float rr = vec[(5 * SB + st) * 64 + lane], kk = vec[(3 * SB + st) * 64 + lane], vv = vec[(4 * SB + st) * 64 + lane];
                const float mean = wave_sum(y) * (1.0f / 64.0f); const float d = y - mean; const float var = wave_sum(d * d) * (1.0f / 64.0f);
                const float bon = wave_sum(rr * kk * rk);
                const float g = vec[(6 * SB + st) * 64 + lane];
                const float o = (d * rsqrtf(var + 64e-5f) * lnw + lnb + bon * vv) * g;
                MIX[(size_t)t * DM + 1024 + 64 * h + lane] = (bf16_t)(cvtpk(o, 0.f) & 0xffff); }
        }
    }
    if (MODE == 0) { float* dst = (float*)(p->ws + WS_PB) + ((size_t)(h * NCH + c)) * 4096;
#pragma unroll
        for (int r = 0; r < 4; ++r)
#pragma unroll
            for (int q = 0; q < 4; ++q) *(f32x4*)(dst + (4 * rb + r) * 64 + 16 * cb + 4 * q) = (f32x4){s[r][2 * q].x, s[r][2 * q].y, s[r][2 * q + 1].x, s[r][2 * q + 1].y}; }
    if (MODE == 1) { float* dst = (float*)(p->ws + WS_UB) + ((size_t)(h * NCH + c)) * 4096;
#pragma unroll
        for (int x = 0; x < 16; ++x) { f32x4 v;
#pragma unroll
            for (int r = 0; r < 4; ++r) v[r] = (x & 1) ? s[r][x >> 1].y : s[r][x >> 1].x;
            *(f32x4*)(dst + (16 * cb + x) * 64 + 4 * rb) = v; } }
}

#undef SCAN_LOAD
#undef SCAN_SHIFT
#undef SCAN_STAGE
__device__ __forceinline__ void s2_head(KP p, LAS unsigned char* lds, int h, const int tid) {
    const float* PB = (const float*)(p->ws + WS_PB) + (size_t)h * NCH * 4096; const float* UT = (const float*)(p->ws + WS_UB) + (size_t)h * NCH * 4096;
    float* SI = (float*)(p->ws + WS_SI) + (size_t)h * NCH * 4096;
    const int lane = tid & 63, w = __builtin_amdgcn_readfirstlane(tid >> 6), n = lane & 31, lh = lane >> 5, to = (w >> 1) & 1, ti = w & 1;
    static_assert((NCH - 1) % 3 == 0, "three rotating prefetch buffers");
    if (w >= 4) {
        for (int c = 0; c < NCH - 1; ++c) __syncthreads();
    } else {
        f32x16 sreg, ua, ub, uc2; float pa[32], pb[32], pc2[32];
#pragma unroll
        for (int r = 0; r < 16; ++r) sreg[r] = 0.f;
        const int offu = (32 * to + 4 * lh) * 64 + 32 * ti + n, offp = (4 * lh) * 64 + 32 * to + n;
#define S2_LOAD(CH, U_, P_) do { const int ch_ = (CH) < NCH - 1 ? (CH) : NCH - 2; const float* pb_ = PB + (size_t)ch_ * 4096 + offp; const float* ub_ = UT + (size_t)ch_ * 4096 + offu; \
        _Pragma("unroll") for (int r = 0; r < 16; ++r) { const int cr = ((r & 3) + 8 * (r >> 2)) * 64; U_[r] = ub_[cr]; P_[r] = pb_[cr]; P_[16 + r] = pb_[2048 + cr]; } } while (0)
#define S2_STEP(C, UC_, PC_, UN_, PN_) do { \
        {   float* si = SI + (size_t)(C) * 4096 + offu; \
            _Pragma("unroll") for (int r = 0; r < 16; ++r) si[((r & 3) + 8 * (r >> 2)) * 64] = sreg[r]; } \
        LAS f32x4* ex = (LAS f32x4*)(lds + ((C) & 1) * 16384); \
        _Pragma("unroll") for (int q = 0; q < 4; ++q) ex[(w * 4 + q) * 64 + lane] = (f32x4){sreg[4 * q], sreg[4 * q + 1], sreg[4 * q + 2], sreg[4 * q + 3]}; \
        __syncthreads(); \
        S2_LOAD((C) + 2, UN_, PN_); \
        f32x16 preg; \
        _Pragma("unroll") for (int q = 0; q < 4; ++q) { const f32x4 v = ex[((w ^ 2) * 4 + q) * 64 + lane]; preg[4 * q] = v[0]; preg[4 * q + 1] = v[1]; preg[4 * q + 2] = v[2]; preg[4 * q + 3] = v[3]; } \
        f32x16 acc = UC_; \
        if (to == 0) { \
            _Pragma("unroll") for (int r = 0; r < 16; ++r) acc = __builtin_amdgcn_mfma_f32_32x32x2f32(PC_[r], sreg[r], acc, 0, 0, 0); \
            _Pragma("unroll") for (int r = 0; r < 16; ++r) acc = __builtin_amdgcn_mfma_f32_32x32x2f32(PC_[16 + r], preg[r], acc, 0, 0, 0); \
        } else { \
            _Pragma("unroll") for (int r = 0; r < 16; ++r) acc = __builtin_amdgcn_mfma_f32_32x32x2f32(PC_[r], preg[r], acc, 0, 0, 0); \
            _Pragma("unroll") for (int r = 0; r < 16; ++r) acc = __builtin_amdgcn_mfma_f32_32x32x2f32(PC_[16 + r], sreg[r], acc, 0, 0, 0); } \
        sreg = acc; } while (0)
        S2_LOAD(0, ua, pa); S2_LOAD(1, ub, pb);
#pragma unroll 1
        for (int c = 0; c < NCH - 1; c += 3) {
            S2_STEP(c, ua, pa, uc2, pc2);
            S2_STEP(c + 1, ub, pb, ua, pa);
            S2_STEP(c + 2, uc2, pc2, ub, pb);
        }
        {   float* si = SI + (size_t)(NCH - 1) * 4096 + offu;
#pragma unroll
            for (int r = 0; r < 16; ++r) si[((r & 3) + 8 * (r >> 2)) * 64] = sreg[r]; }
#undef S2_LOAD
#undef S2_STEP
    }
    __syncthreads();
}

template <int DV, bool SWA>
__device__ __forceinline__ void attn_unit(LAS unsigned char* lds, const bf16_t* Q, const bf16_t* Kp, const bf16_t* VT, float slope2, int q0, float sink2,
                                          float* Of32, float* MLp, bf16_t* Obf, const int tid, int kt_lo, int kt_hi, float kn) {
    constexpr int KROW = 144, KTILE = 64 * KROW, VTILE = DV * KROW, BUF = KTILE + VTILE, NVL = DV / 64;
    const int lane = tid & 63, w = __builtin_amdgcn_readfirstlane(tid >> 6), r32 = lane & 31, hi = lane >> 5;
    const int qpos = q0 + 32 * w + r32;
    bf16x8 qf[4];
#pragma unroll
    for (int j = 0; j < 4; ++j) qf[j] = *(const bf16x8*)(Q + (size_t)qpos * INCP + 16 * j + 8 * hi);
    int kt0 = kt_lo, kt1 = kt_hi;
    if (!SWA) {
        float qq = 0.f, qk = 0.f;
#pragma unroll
        for (int j = 0; j < 4; ++j) { const bf16x8 kf = *(const bf16x8*)(Kp + (size_t)qpos * INCP + 16 * j + 8 * hi);
#pragma unroll
            for (int e = 0; e < 8; ++e) { const float qv = bf2f((unsigned short)qf[j][e]), kv = bf2f((unsigned short)kf[e]); qq += qv * qv; qk += qv * kv; } }
        qq = xor32_sum(qq); qk = xor32_sum(qk);
        const float dneed = (sqrtf(qq) * kn - qk + 45.0f) / slope2;
        float kneed = (float)qpos - dneed;
        kneed = fminf(kneed, dppm<0xB1>(kneed)); kneed = fminf(kneed, dppm<0x4E>(kneed)); kneed = fminf(kneed, dppm<0x141>(kneed)); kneed = fminf(kneed, dppm<0x140>(kneed));
        LAS float* red = (LAS float*)(lds + 2 * BUF);
        if ((lane & 15) == 0) red[w * 4 + (lane >> 4)] = kneed;
        __syncthreads();
        float km = red[0];
#pragma unroll
        for (int i = 1; i < 32; ++i) km = fminf(km, red[i]);
        const int ktw = km <= 0.f ? 0 : ((int)km >> 6);
        kt0 = ktw > kt_lo ? ktw : kt_lo;
    }
    const int qlo = q0 + 32 * w, qhi = qlo + 31;
    f32x16 o[DV / 32];
#pragma unroll
    for (int d = 0; d < DV / 32; ++d)
#pragma unroll
        for (int r = 0; r < 16; ++r) o[d][r] = 0.f;
    float mrun = 0.f, lsum = 0.f;
    const int krow = tid >> 3, kch = tid & 7;
    u32x4 kreg, vreg[NVL];
    if (kt0 <= kt1) {   const int k0 = 64 * kt0; kreg = *(const u32x4*)(Kp + (size_t)(k0 + krow) * INCP + 8 * kch);
#pragma unroll
        for (int i = 0; i < NVL; ++i) { const int idx = tid + 512 * i; vreg[i] = *(const u32x4*)(VT + (size_t)(idx >> 3) * M + k0 + 8 * (idx & 7)); } }
    for (int kt = kt0; kt <= kt1; ++kt) {
        LAS unsigned char* buf = lds + ((kt - kt0) & 1) * BUF;
        *(LAS u32x4*)(buf + krow * KROW + 16 * kch) = kreg;
#pragma unroll
        for (int i = 0; i < NVL; ++i) { const int idx = tid + 512 * i; *(LAS u32x4*)(buf + KTILE + (idx >> 3) * KROW + 16 * (idx & 7)) = vreg[i]; }
        __syncthreads();
        if (kt < kt1) { const int k0 = 64 * (kt + 1); kreg = *(const u32x4*)(Kp + (size_t)(k0 + krow) * INCP + 8 * kch);
#pragma unroll
            for (int i = 0; i < NVL; ++i) { const int idx = tid + 512 * i; vreg[i] = *(const u32x4*)(VT + (size_t)(idx >> 3) * M + k0 + 8 * (idx & 7)); } }
        const int k0 = 64 * kt;
        bool act = k0 <= qhi; if (SWA) act = act && (k0 + 63 >= qlo - 127);
        if (act) {
            f32x16 p0, p1;
            {   const float c0 = slope2 * (float)(k0 + 4 * hi - qpos) - mrun, c1 = c0 + 32.0f * slope2;
#pragma unroll
                for (int r = 0; r < 16; ++r) { const float cr = (float)((r & 3) + 8 * (r >> 2)); p0[r] = __builtin_fmaf(slope2, cr, c0); p1[r] = __builtin_fmaf(slope2, cr, c1); } }
#pragma unroll
            for (int j = 0; j < 4; ++j) { const bf16x8 a0 = *(const LAS bf16x8*)(buf + r32 * KROW + 32 * j + 16 * hi), a1 = *(const LAS bf16x8*)(buf + (r32 + 32) * KROW + 32 * j + 16 * hi);
                p0 = __builtin_amdgcn_mfma_f32_32x32x16_bf16(a0, qf[j], p0, 0, 0, 0); p1 = __builtin_amdgcn_mfma_f32_32x32x16_bf16(a1, qf[j], p1, 0, 0, 0); }
            bool need_mask = k0 + 63 > qlo; if (SWA) need_mask = need_mask || (qhi - k0 >= 128);
            if (need_mask) {
#pragma unroll
                for (int r = 0; r < 16; ++r) { const int kv = k0 + (r & 3) + 8 * (r >> 2) + 4 * hi; const int d0 = qpos - kv, d1 = d0 - 32;
                    bool ok0 = d0 >= 0, ok1 = d1 >= 0; if (SWA) { ok0 = ok0 && d0 < 128; ok1 = ok1 && d1 < 128; }
                    p0[r] = ok0 ? p0[r] : -1e30f; p1[r] = ok1 ? p1[r] : -1e30f; } }
            float mx = fmaxf(p0[0], p1[0]);
#pragma unroll
            for (int r = 1; r < 16; ++r) mx = fmaxf(mx, fmaxf(p0[r], p1[r]));
            mx = xor32_max(mx);
            if (__builtin_amdgcn_ballot_w64(mx > 8.0f) != 0ull) {
                const float d = fmaxf(mx, 0.f), f = __builtin_amdgcn_exp2f(-d); mrun += d; lsum *= f;
#pragma unroll
                for (int r = 0; r < 16; ++r) { p0[r] -= d; p1[r] -= d; }
#pragma unroll
                for (int dd = 0; dd < DV / 32; ++dd)
#pragma unroll
                    for (int r = 0; r < 16; ++r) o[dd][r] *= f; }
            float rs = 0.f;
#pragma unroll
            for (int r = 0; r < 16; ++r) { p0[r] = __builtin_amdgcn_exp2f(p0[r]); p1[r] = __builtin_amdgcn_exp2f(p1[r]); rs += p0[r] + p1[r]; }
            lsum += rs;
            u32x4 pw[4];
            pw[0] = (u32x4){cvtpk(p0[0], p0[1]), cvtpk(p0[2], p0[3]), cvtpk(p0[4], p0[5]), cvtpk(p0[6], p0[7])};
            pw[1] = (u32x4){cvtpk(p0[8], p0[9]), cvtpk(p0[10], p0[11]), cvtpk(p0[12], p0[13]), cvtpk(p0[14], p0[15])};
            pw[2] = (u32x4){cvtpk(p1[0], p1[1]), cvtpk(p1[2], p1[3]), cvtpk(p1[4], p1[5]), cvtpk(p1[6], p1[7])};
            pw[3] = (u32x4){cvtpk(p1[8], p1[9]), cvtpk(p1[10], p1[11]), cvtpk(p1[12], p1[13]), cvtpk(p1[14], p1[15])};
#pragma unroll
            for (int d = 0; d < DV / 32; ++d)
#pragma unroll
                for (int j = 0; j < 4; ++j) { const bf16x8 vf = *(const LAS bf16x8*)(buf + KTILE + (32 * d + r32) * KROW + 32 * j + 16 * hi);
                    o[d] = __builtin_amdgcn_mfma_f32_32x32x16_bf16(vf, __builtin_bit_cast(bf16x8, pw[j]), o[d], 0, 0, 0); }
        }
    }
    lsum = xor32_sum(lsum);
    if (SWA) { lsum += __builtin_amdgcn_exp2f(sink2 - mrun);
        const float inv = 1.0f / lsum; bf16_t* op = Obf + (size_t)qpos * DM;
#pragma unroll
        for (int d = 0; d < DV / 32; ++d)
#pragma unroll
            for (int g = 0; g < 4; ++g) { u32x2 wv; wv.x = cvtpk(o[d][4 * g] * inv, o[d][4 * g + 1] * inv); wv.y = cvtpk(o[d][4 * g + 2] * inv, o[d][4 * g + 3] * inv);
                *(u32x2*)(op + 32 * d + 8 * g + 4 * hi) = wv; }
    } else { float* op = Of32 + (size_t)qpos * 1024;
#pragma unroll
        for (int d = 0; d < DV / 32; ++d)
#pragma unroll
            for (int g = 0; g < 4; ++g) *(f32x4*)(op + 32 * d + 8 * g + 4 * hi) = (f32x4){o[d][4 * g], o[d][4 * g + 1], o[d][4 * g + 2], o[d][4 * g + 3]};
        if (hi == 0) *(f32x2*)(MLp + (size_t)qpos * 16) = (f32x2){mrun, lsum};
    }
    __syncthreads();
}

__device__ __forceinline__ void phase_diffcombine(KP p, int l, int gw, int NGW, int lane) {
    const float* lamv = p->in[3] + l * 256;
    const float lambda_init = 0.8f - 0.6f * expf(-0.3f * (float)l);
    const float s1 = wave_sum(lamv[lane] * lamv[64 + lane]), s2 = wave_sum(lamv[128 + lane] * lamv[192 + lane]);
    const float lam = expf(s1) - expf(s2) + lambda_init;
    const float* OD = (const float*)(p->ws + WS_OD); const float* ML = (const float*)(p->ws + WS_ML); bf16_t* MIX = (bf16_t*)(p->ws + WS_MIX);
    const int h = lane >> 4, d0 = (lane & 15) * 8;
    const f32x4 g0 = *(const f32x4*)(p->in[4] + l * 128 + d0), g1 = *(const f32x4*)(p->in[4] + l * 128 + d0 + 4);
    for (int t = gw; t < M; t += NGW) { const int nseg = ((t >> 8) + 8) >> 3;
        f32x4 oc[2][2];
#pragma unroll
        for (int c = 0; c < 2; ++c) {
            f32x2 ml[4]; float mm = -1e30f;
#pragma unroll
            for (int s = 0; s < 4; ++s) if (s < nseg) { ml[s] = *(const f32x2*)(ML + ((size_t)s * M + t) * 16 + h * 4 + c * 2); mm = fmaxf(mm, ml[s].x); }
            f32x4 a0 = (f32x4){0.f, 0.f, 0.f, 0.f}, a1 = a0; float L = 0.f;
#pragma unroll
            for (int s = 0; s < 4; ++s) if (s < nseg) { const float f = exp2f(ml[s].x - mm); L += ml[s].y * f;
                const float* b = OD + ((size_t)s * M + t) * 1024 + h * 256 + c * 128 + d0; a0 += *(const f32x4*)b * f; a1 += *(const f32x4*)(b + 4) * f; }
            const float inv = 1.0f / L; oc[c][0] = a0 * inv; oc[c][1] = a1 * inv; }
        const f32x4 o0 = oc[0][0] - oc[1][0] * lam, o1 = oc[0][1] - oc[1][1] * lam;
        float ss = (o0[0] * o0[0] + o0[1] * o0[1]) + (o0[2] * o0[2] + o0[3] * o0[3]) + (o1[0] * o1[0] + o1[1] * o1[1]) + (o1[2] * o1[2] + o1[3] * o1[3]);
        ss = row16_sum(ss);
        const float r = rsqrtf(ss * (1.0f / 128.0f) + EPS) * (1.0f - lambda_init);
        const f32x4 y0 = o0 * g0 * r, y1 = o1 * g1 * r;
        u32x4 wv; wv.x = cvtpk(y0[0], y0[1]); wv.y = cvtpk(y0[2], y0[3]); wv.z = cvtpk(y1[0], y1[1]); wv.w = cvtpk(y1[2], y1[3]);
        *(u32x4*)(MIX + (size_t)t * DM + h * 128 + d0) = wv; }
}

#define XB_TMO      128
#define XB_XCNT(j)  (256  + 64 * (j))
#define XB_XSUB(j)  (1280 + 64 * (j))
#define XB_XGEN(j)  (2304 + 64 * (j))
#define XB_TOP      3328
#define XB_TOPGEN   3392
#define XCD_BAR_WORDS 3456
#define XB_SPIN_CAP (1u << 22)
__device__ __forceinline__ unsigned xb_ld(unsigned* p)              { return __hip_atomic_load(p, __ATOMIC_RELAXED, __HIP_MEMORY_SCOPE_AGENT); }
__device__ __forceinline__ unsigned xb_add(unsigned* p, unsigned v) { return __hip_atomic_fetch_add(p, v, __ATOMIC_RELAXED, __HIP_MEMORY_SCOPE_AGENT); }
__device__ __forceinline__ unsigned xb_xcc_id() { return (unsigned)__builtin_amdgcn_s_getreg((3 << 11) | 20) & 0xFu; }
#define XB_SPIN(cond, bar) do { unsigned _sp = 0; while (cond) { __builtin_amdgcn_s_sleep(1); \
    if ((++_sp & 255u) == 0u) { if (xb_ld(&(bar)[XB_TMO])) break; if (_sp > XB_SPIN_CAP) { atomicAdd(&(bar)[XB_TMO], 1u); break; } } } } while (0)
__device__ __forceinline__ void xcd_barrier_complete(unsigned* bar, unsigned x, unsigned& nloc, unsigned& nx) {
    const unsigned G = gridDim.x;
    unsigned sum, cnt, mine, sp = 0u;
    for (;;) {
        sum = 0u; cnt = 0u; mine = 0u;
#pragma unroll
        for (unsigned j = 0; j < 16; ++j) { const unsigned c = xb_ld(&bar[XB_XCNT(j)]); sum += c; cnt += (c > 0u) ? 1u : 0u; mine = (j == x) ? c : mine; }
        if (sum == G) break;
        __builtin_amdgcn_s_sleep(1);
        if ((++sp & 255u) == 0u) { if (xb_ld(&bar[XB_TMO])) break; if (sp > XB_SPIN_CAP) { atomicAdd(&bar[XB_TMO], 1u); break; } }
    }
    nloc = mine > 0u ? mine : 1u; nx = cnt > 0u ? cnt : 1u;
}
__device__ __forceinline__ void xcd_barrier(unsigned* bar, volatile LAS unsigned* st, const int tid) {
    asm volatile("s_waitcnt vmcnt(0)" ::: "memory");
    __syncthreads();
    if (tid == 0) {
        const unsigned x = xb_xcc_id();
        __builtin_amdgcn_s_waitcnt(0);
        unsigned nloc = st[0], nx = st[1];
        if (nloc == 0u) { xcd_barrier_complete(bar, x, nloc, nx); st[0] = nloc; st[1] = nx; }
        const unsigned old = xb_add(&bar[XB_XSUB(x)], 1u);
        const unsigned gen = old / nloc;
        if (old + 1u == (gen + 1u) * nloc) {
            __builtin_amdgcn_fence(__ATOMIC_RELEASE, "agent");
            asm volatile("s_waitcnt vmcnt(0)" ::: "memory");
            const unsigned og = xb_add(&bar[XB_TOP], 1u);
            const unsigned tg = og / nx;
            if (og + 1u == (tg + 1u) * nx) xb_add(&bar[XB_TOPGEN], 1u);
            else XB_SPIN(xb_ld(&bar[XB_TOPGEN]) == tg, bar);
            __builtin_amdgcn_fence(__ATOMIC_ACQUIRE, "agent");
            xb_add(&bar[XB_XGEN(x)], 1u);
            asm volatile("s_waitcnt vmcnt(0)" ::: "memory");
        } else {
            XB_SPIN(xb_ld(&bar[XB_XGEN(x)]) == gen, bar);
            __builtin_amdgcn_fence(__ATOMIC_ACQUIRE, "agent");
            asm volatile("s_waitcnt vmcnt(0)" ::: "memory");
        }
    }
    __syncthreads();
}

#ifndef DUPBAR
#define DUPBAR 1
#endif
#define GSYNC() do { FRESH(); for (int rb_ = 0; rb_ < DUPBAR; ++rb_) xcd_barrier((unsigned*)(p->ws + WS_CTL) + 4096, (volatile LAS unsigned*)(lds + LDS_BYTES - 32), tid); } while (0)
#define PTRS() unsigned* ctl = (unsigned*)(p->ws + WS_CTL); bf16_t* XB = (bf16_t*)(p->ws + WS_XB); bf16_t* PROJ = (bf16_t*)(p->ws + WS_PROJ); bf16_t* MIX = (bf16_t*)(p->ws + WS_MIX); bf16_t* H = (bf16_t*)(p->ws + WS_H); \
    float* ssqA = (float*)(p->ws + WS_SSQA); float* ssqB = (float*)(p->ws + WS_SSQB); unsigned char* wb = p->ws + WS_W + (size_t)l * LW_STRIDE; (void)ctl; (void)XB; (void)PROJ; (void)MIX; (void)H; (void)ssqA; (void)ssqB; (void)wb
#define FRESH() KP p = fresh_params(); int G = gridDim.x, bx = blockIdx.x; asm volatile("" : "+s"(G), "+s"(bx)); const int NGW = G * 8; (void)NGW; const int tid = fresh_tid(wave0), lane = tid & 63, wave = __builtin_amdgcn_readfirstlane(tid >> 6), gw = bx * 8 + wave; (void)lane; (void)gw
template <int L> __device__ __forceinline__ void layer_body(LAS unsigned char* lds, const int wave0) {
    constexpr int l = L;

#ifndef DUP1
#define DUP1 1
#endif
        for (int rep = 0; rep < DUP1; ++rep) {   if (rep) GSYNC(); FRESH(); PTRS(); pg8::Gemm g{XB, (const bf16_t*)(wb + LW_WIN), M, INCP, DM}; pg8::StaticOrder S; S.init(M, INCP, G, bx);
            pg8::EpiProj E{PROJ, INCP, ssqA};
            pg8::gemm_phase<pg8::EpiProj, pg8::StaticOrder, true, true>(lds, g, S, E, tid); }
        GSYNC();
#ifndef DUP234
#define DUP234 1
#endif
        for (int rep = 0; rep < DUP234; ++rep) { if (rep) GSYNC(); FRESH(); phase_prep1(p, l, lds, gw, NGW, wave, lane); }
        GSYNC();
        {   FRESH(); PTRS(); pg8::Gemm g{(const bf16_t*)(p->ws + WS_AW), (const bf16_t*)(wb + LW_W2T), M, 1024, 128}; pg8::StaticOrder S; S.init(M, 1024, G, bx);
            pg8::EpiLora<0> E{(float*)(p->ws + WS_DEC), p->in[7] + l * 1024};
            pg8::gemm_phase<pg8::EpiLora<0>, pg8::StaticOrder, true, true>(lds, g, S, E, tid); }
        {   FRESH(); PTRS(); pg8::Gemm g{(const bf16_t*)(p->ws + WS_AA), (const bf16_t*)(wb + LW_A2T), M, 1024, 128}; pg8::StaticOrder S; S.init(M, 1024, G, (bx + 128) % G);
            pg8::EpiLora<1> E{(float*)(p->ws + WS_A), p->in[9] + l * 1024};
            pg8::gemm_phase<pg8::EpiLora<1>, pg8::StaticOrder, true, true>(lds, g, S, E, tid); }
        {   FRESH(); PTRS(); pg8::Gemm g{(const bf16_t*)(p->ws + WS_AG), (const bf16_t*)(wb + LW_G2T), M, 1024, 256}; pg8::StaticOrder S; S.init(M, 1024, G, bx);
            pg8::EpiLora<2> E{(float*)(p->ws + WS_G), nullptr};
            pg8::gemm_phase<pg8::EpiLora<2>, pg8::StaticOrder, true, true>(lds, g, S, E, tid); }
        GSYNC();
        {   FRESH(); LAS unsigned char* wl = lds + wave * 14336;
#ifndef DUP57
#define DUP57 1
#endif
            for (int rep = 0; rep < DUP57; ++rep) for (int it = gw; it < 2 * NCH * 16; it += NGW) { const int mode = it & 1, ch = it >> 1, c = ch % NCH, h = ch / NCH;
                if (mode == 0) scan_task<0>(p, l, wl, c, h, lane); else scan_task<1>(p, l, wl, c, h, lane); } }
        GSYNC();
#ifndef DUP6
#define DUP6 1
#endif
        for (int rep = 0; rep < DUP6; ++rep) {   if (rep) GSYNC(); FRESH(); PTRS(); LAS int* slot = (LAS int*)(lds + LDS_BYTES - 64);
            LAS float* knl = (LAS float*)(lds + LDS_BYTES - 128);
            {   LAS float* kr = (LAS float*)lds; const float* knp = (const float*)(p->ws + WS_KNP); const int g = tid & 7, part = tid >> 3; float m = 0.f;
                for (int b2 = part; b2 < G; b2 += 64) m = fmaxf(m, knp[(size_t)b2 * 8 + g]);
                kr[part * 8 + g] = m; __syncthreads();
                if (tid < 8) { float mm = kr[tid]; for (int q2 = 1; q2 < 64; ++q2) mm = fmaxf(mm, kr[q2 * 8 + tid]); knl[tid] = mm; }
                __syncthreads(); }
            const float* sinks = p->in[5] + l * 8;
            for (;;) {
                if (tid == 0) *slot = (int)atomicAdd(ctl + 64 * (l + 1) + 16 * rep, 1u);
                __syncthreads();
                const int it = *slot;
                __syncthreads();
                if (it >= 656) break;
                if (it < 16) {
#ifndef NO_S2
                    s2_head(p, lds, it, tid);
#endif
                }
                else if (it < 656) { const int d = it - 16, h = 3 - d / 160, u = d % 160, c = u & 1, v = u >> 1; int qb, seg;
                    if (v < 32) { qb = 31 - (v >> 2); seg = v & 3; } else if (v < 56) { const int w2 = v - 32; qb = 23 - w2 / 3; seg = w2 % 3; }
                    else if (v < 72) { const int w2 = v - 56; qb = 15 - (w2 >> 1); seg = w2 & 1; } else { qb = 79 - v; seg = 0; }
                    const float slope2 = exp2f(-2.0f * (float)(h + 1)) * LOG2E;
                    const float kn = sqrtf(knl[h * 2 + c]);
                    const int kt1 = 4 * qb + 3, klo = 32 * seg, khi = (klo + 31 < kt1) ? klo + 31 : kt1;
                    attn_unit<128, false>(lds, PROJ + h * 128 + c * 64, PROJ + 512 + h * 128 + c * 64, (const bf16_t*)(p->ws + WS_VAT) + (size_t)(h * 128) * M, slope2, qb * 256, 0.f,
                                          (float*)(p->ws + WS_OD) + (size_t)seg * M * 1024 + h * 256 + c * 128, (float*)(p->ws + WS_ML) + (size_t)seg * M * 16 + h * 4 + c * 2, nullptr, tid, klo, khi, kn); }
            } }
        GSYNC();
        {   FRESH(); LAS unsigned char* wl = lds + wave * 14336;
            for (int rep = 0; rep < DUP57; ++rep) for (int it = gw; it < NCH * 16; it += NGW) { const int c = it % NCH, h = it / NCH; scan_task<2>(p, l, wl, c, h, lane); }
            phase_diffcombine(p, l, gw, NGW, lane);
            __syncthreads();
            {   PTRS(); LAS int* slot = (LAS int*)(lds + LDS_BYTES - 64); const float* sinks = p->in[5] + l * 8;
                constexpr int NCONV = (l + 1 < NL) ? (CONV_ITEMS + 7) / 8 : 0;
                for (;;) {
                    if (tid == 0) *slot = 656 + (int)atomicAdd(ctl + 64 * (l + 1) + 32, 1u);
                    __syncthreads();
                    const int it = *slot;
                    __syncthreads();
                    if (it >= 912 + NCONV) break;
                    if (it >= 912) { const int r = 8 * (it - 912) + wave; if (r < CONV_ITEMS) convert_item(p, l + 1, r, (LAS float*)(lds + wave * 16384), lane); continue; }
                { const int s = it - 656, hq = s & 7, qb = s >> 3;
                    const int aidx = (hq >> 1) * 3 + (hq & 1);
                    const float slope2 = exp2f(-8.0f * (float)(aidx + 1) / 12.0f) * LOG2E;
                    const int q0 = qb * 256;
                    attn_unit<64, true>(lds, PROJ + 1536 + hq * 64, PROJ + 2048 + (hq >> 2) * 64, (const bf16_t*)(p->ws + WS_VBT) + (size_t)((hq >> 2) * 64) * M, slope2, q0, sinks[hq] * LOG2E,
                                        nullptr, nullptr, MIX + 512 + hq * 64, tid, q0 >= 128 ? (q0 - 128) / 64 : 0, (q0 + 255) / 64, 0.f); }
                } } }
        GSYNC();
        {   FRESH(); PTRS(); pg8::Gemm g{MIX, (const bf16_t*)(wb + LW_WOUT), M, DM, DM}; pg8::StaticOrder S; S.init(M, DM, G, bx);
            pg8::EpiResid E{p->out, XB, ssqB};
            pg8::gemm_phase<pg8::EpiResid, pg8::StaticOrder, true, true>(lds, g, S, E, tid); }
        GSYNC();
        for (int rep = 0; rep < DUP1; ++rep) {   if (rep) GSYNC(); FRESH(); PTRS(); pg8::Gemm g{XB, (const bf16_t*)(wb + LW_WGU), M, GU, DM}; pg8::StaticOrder S; S.init(M, GU, G, bx);
            pg8::EpiSwiGLU E{H, ssqB};
            pg8::gemm_phase<pg8::EpiSwiGLU, pg8::StaticOrder, true, true>(lds, g, S, E, tid); }
        GSYNC();
        {   FRESH(); PTRS(); pg8::Gemm g{H, (const bf16_t*)(wb + LW_WDN), M, DM, FF}; pg8::StaticOrder S; S.init(M, DM, G, bx);
            pg8::EpiResid E{p->out, XB, ssqA};
            pg8::gemm_phase<pg8::EpiResid, pg8::StaticOrder, true, true>(lds, g, S, E, tid); }
        GSYNC();
    }

__global__ void __launch_bounds__(512, 2) fwd_megakernel(Params p_unused) {
    extern __shared__ __attribute__((aligned(16))) unsigned char lds_raw[];
    LAS unsigned char* lds = (LAS unsigned char*)lds_raw;
    cg::grid_group grid = cg::this_grid();
    const int wave0 = __builtin_amdgcn_readfirstlane((int)threadIdx.x >> 6);
    if (threadIdx.x < 16) ((LAS unsigned*)(lds + LDS_BYTES - 64))[threadIdx.x] = 0u;
    if (threadIdx.x == 0) xb_add((unsigned*)(p_unused.ws + WS_CTL) + 4096 + XB_XCNT(xb_xcc_id()), 1u);
    __syncthreads();

#ifndef DUP0
#define DUP0 1
#endif
    for (int rep = 0; rep < DUP0; ++rep) { FRESH(); phase0(p, lds, gw, NGW, wave, lane); __syncthreads(); }
    grid.sync();

    layer_body<0>(lds, wave0); layer_body<1>(lds, wave0); layer_body<2>(lds, wave0); layer_body<3>(lds, wave0);
    {   FRESH(); const int l = 0; PTRS(); const float* gf = p->in[21];
        for (int m = gw; m < M; m += NGW) { const float rs = rsqrtf(wave_sum(lane < 32 ? ssqA[(size_t)m * 32 + lane] : 0.f) * (1.0f / DM) + EPS);
#pragma unroll
            for (int j = 0; j < 8; ++j) { const size_t o = (size_t)m * DM + j * 256 + lane * 4; const f32x4 v = *(const f32x4*)(p->out + o); const f32x4 gv = *(const f32x4*)(gf + j * 256 + lane * 4);
                *(f32x4*)(p->out + o) = v * rs * gv; } } }
}

extern "C" void kernel_launch(void* const* d_in, const int* in_sizes, int n_in, void* d_out, int out_size, void* d_ws, size_t ws_size, hipStream_t stream) {
    static int grid = 0;
    if (grid == 0) {
        if (n_in != 22 || out_size != M * DM || ws_size < WS_END) { fprintf(stderr, "kernel_launch: unexpected shapes (n_in %d out %d ws %zu need %zu)\n", n_in, out_size, ws_size, (size_t)WS_END); grid = -1; return; }
        int dev = 0, cus = 0, per_cu = 0;
        hipGetDevice(&dev); hipDeviceGetAttribute(&cus, hipDeviceAttributeMultiprocessorCount, dev);
        hipFuncSetAttribute((const void*)fwd_megakernel, hipFuncAttributeMaxDynamicSharedMemorySize, LDS_BYTES);
        hipOccupancyMaxActiveBlocksPerMultiprocessor(&per_cu, (const void*)fwd_megakernel, 512, LDS_BYTES);
        if (per_cu < 1) { fprintf(stderr, "kernel_launch: occupancy query says %d blocks per CU\n", per_cu); per_cu = 1; }
        (void)hipGetLastError();
        grid = cus;
    }
    if (grid < 0) return;
    hipMemsetAsync((char*)d_ws + WS_CTL, 0, 65536, stream);
    Params p{};
    for (int i = 0; i < 22; ++i) p.in[i] = (const float*)d_in[i];
    p.out = (float*)d_out; p.ws = (unsigned char*)d_ws;
    void* args[] = {&p};
    hipError_t e = hipLaunchCooperativeKernel((const void*)fwd_megakernel, dim3(grid), dim3(512), args, LDS_BYTES, stream);
    if (e != hipSuccess) fprintf(stderr, "cooperative launch failed: %s (grid %d)\n", hipGetErrorString(e), grid);
}
```

```cpp
#include <hip/hip_runtime.h>
#include <hip/hip_cooperative_groups.h>
#include <cstdio>
#include <cstdint>
namespace cg = cooperative_groups;

#define LAS __attribute__((address_space(3)))
typedef unsigned short bf16_t;
typedef short bf16x8 __attribute__((ext_vector_type(8)));
typedef float f32x4 __attribute__((ext_vector_type(4)));
typedef float f32x2 __attribute__((ext_vector_type(2)));
typedef float f32x16 __attribute__((ext_vector_type(16)));
typedef unsigned u32x4 __attribute__((ext_vector_type(4)));
typedef unsigned u32x2 __attribute__((ext_vector_type(2)));
typedef __bf16 bf16x2_t __attribute__((ext_vector_type(2)));

constexpr int M = 8192, DM = 2048, INC = 5824, INCP = 5888, FF = 5632, GU = 11264, RW0 = 2304, RWC = 3520;
constexpr int NL = 4, NCH = 64, CL = 128;
constexpr float EPS = 1e-5f, LOG2E = 1.4426950408889634f;
constexpr float QSC = 0.125f * LOG2E;

constexpr size_t MiB = 1u << 20;
constexpr size_t SZ_WIN = (size_t)INCP * DM * 2, SZ_WOUT = (size_t)DM * DM * 2, SZ_WGU = (size_t)GU * DM * 2, SZ_WDN = (size_t)DM * FF * 2;
constexpr size_t SZ_W2T = 1024 * 128 * 2, SZ_G2T = 1024 * 256 * 2;
constexpr size_t LW_WIN = 0, LW_WOUT = LW_WIN + SZ_WIN, LW_WGU = LW_WOUT + SZ_WOUT, LW_WDN = LW_WGU + SZ_WGU, LW_W2T = LW_WDN + SZ_WDN,
                 LW_A2T = LW_W2T + SZ_W2T, LW_G2T = LW_A2T + SZ_W2T, LW_STRIDE = LW_G2T + SZ_G2T;
constexpr size_t SZ_F = (size_t)M * 1024 * 4;
constexpr size_t WS_CTL = 0, WS_W = 1 * MiB, WS_XB = WS_W + NL * LW_STRIDE, WS_PROJ = WS_XB + (size_t)M * DM * 2,
                 WS_VAT = WS_PROJ + (size_t)M * INCP * 2, WS_VBT = WS_VAT + (size_t)512 * M * 2, WS_AW = WS_VBT + (size_t)128 * M * 2,
                 WS_AA = WS_AW + (size_t)M * 128 * 2, WS_AG = WS_AA + (size_t)M * 128 * 2, WS_R = WS_AG + (size_t)M * 256 * 2,
                 WS_KR = WS_R + SZ_F, WS_V = WS_KR + SZ_F, WS_DEC = WS_V + SZ_F, WS_A = WS_DEC + SZ_F, WS_G = WS_A + SZ_F,
                 WS_KF = WS_G + SZ_F, WS_AN = WS_KF + SZ_F, WS_BB = WS_AN + SZ_F, WS_PB = WS_BB + SZ_F, WS_UB = WS_PB + SZ_F,
                 WS_SI = WS_UB + SZ_F, WS_OD = WS_SI + SZ_F, WS_ML = WS_OD + 4 * SZ_F, WS_KNP = WS_ML + (size_t)4 * M * 16 * 4, WS_MIX = WS_KNP + 65536, WS_SSQA = WS_MIX + (size_t)M * DM * 2,
                 WS_SSQB = WS_SSQA + (size_t)M * 32 * 4, WS_END = WS_SSQB + (size_t)M * 32 * 4;
constexpr size_t WS_H = WS_PROJ;
static_assert((size_t)M * FF * 2 <= (size_t)M * INCP * 2, "H overlay");

constexpr int LDS_BYTES = 147456;

struct Params { const float* in[22]; float* out; unsigned char* ws; };
typedef const __attribute__((address_space(4))) Params* KP;
__device__ __forceinline__ KP fresh_params() { KP k = (KP)__builtin_amdgcn_kernarg_segment_ptr(); asm volatile("" : "+s"(k)); return k; }

__device__ __forceinline__ unsigned cvtpk(float lo, float hi) { f32x2 v = {lo, hi}; bf16x2_t b = __builtin_convertvector(v, bf16x2_t); return __builtin_bit_cast(unsigned, b); }
__device__ __forceinline__ float bf2f(unsigned short b) { return __builtin_bit_cast(float, (unsigned)b << 16); }
__device__ __forceinline__ float bflo(unsigned w) { return __builtin_bit_cast(float, w << 16); }
__device__ __forceinline__ float bfhi(unsigned w) { return __builtin_bit_cast(float, w & 0xffff0000u); }
template <int CTRL> __device__ __forceinline__ float dppm(float v) { return __builtin_bit_cast(float, __builtin_amdgcn_mov_dpp(__builtin_bit_cast(int, v), CTRL, 0xF, 0xF, true)); }
__device__ __forceinline__ float xor16_sum(float v) { const unsigned b = __builtin_bit_cast(unsigned, v); auto rr = __builtin_amdgcn_permlane16_swap(b, b, false, false); return __builtin_bit_cast(float, (unsigned)rr[0]) + __builtin_bit_cast(float, (unsigned)rr[1]); }
__device__ __forceinline__ float xor32_sum(float v) { const unsigned b = __builtin_bit_cast(unsigned, v); auto rr = __builtin_amdgcn_permlane32_swap(b, b, false, false); return __builtin_bit_cast(float, (unsigned)rr[0]) + __builtin_bit_cast(float, (unsigned)rr[1]); }
__device__ __forceinline__ float xor32_max(float v) { const unsigned b = __builtin_bit_cast(unsigned, v); auto rr = __builtin_amdgcn_permlane32_swap(b, b, false, false); return fmaxf(__builtin_bit_cast(float, (unsigned)rr[0]), __builtin_bit_cast(float, (unsigned)rr[1])); }
__device__ __forceinline__ float row16_sum(float v) { v += dppm<0xB1>(v); v += dppm<0x4E>(v); v += dppm<0x141>(v); v += dppm<0x140>(v); return v; }
__device__ __forceinline__ float wave_sum(float v) { return xor32_sum(xor16_sum(row16_sum(v))); }
__device__ __forceinline__ float dpp_xor1(float v) { return __builtin_bit_cast(float, __builtin_amdgcn_mov_dpp(__builtin_bit_cast(int, v), 0xB1, 0xF, 0xF, true)); }
__device__ __forceinline__ float dpp_xor2(float v) { return __builtin_bit_cast(float, __builtin_amdgcn_mov_dpp(__builtin_bit_cast(int, v), 0x4E, 0xF, 0xF, true)); }
__device__ __forceinline__ float quad_sum(float v) { v += dpp_xor1(v); v += dpp_xor2(v); return v; }
__device__ __forceinline__ float sigmoidf_(float x) { return __builtin_amdgcn_rcpf(1.0f + __expf(-x)); }

__device__ __forceinline__ int fresh_tid(int wave0) { unsigned z = 0u; asm volatile("" : "+v"(z)); int t = wave0 * 64 + (int)__builtin_amdgcn_mbcnt_hi(~0u, __builtin_amdgcn_mbcnt_lo(~0u, z)); asm volatile("" : "+v"(t)); return t; }

__device__ __forceinline__ float row_rstd(const float* ssq, int row, int fq) {
    const float* pp = ssq + (size_t)row * 32 + 8 * fq; const f32x4 a = *(const f32x4*)pp, b = *(const f32x4*)(pp + 4);
    float s = ((a[0] + a[1]) + (a[2] + a[3])) + ((b[0] + b[1]) + (b[2] + b[3]));
    s = xor32_sum(xor16_sum(s));
    return rsqrtf(s * (1.0f / DM) + EPS);
}

namespace pg8 {
constexpr int BM = 256, BK = 64, HALF = 128, HTB = HALF * BK * 2, STAGE_BYTES = 8 * HTB, NXCD = 8, WGM = 8;
__host__ __device__ __forceinline__ int lds_byte(int r, int c) { const int st = (r >> 4) * 2 + (c >> 5), rr = r & 15, cc = c & 31, ob = rr * 64 + cc * 2; return st * 1024 + (ob ^ (((ob >> 9) & 1) << 5)); }
__host__ __device__ __forceinline__ void stage_rc(int b, int& R, int& C) { const int st = b / 1024, sb = b % 1024, swz = sb ^ (((sb >> 9) & 1) << 5); R = (st >> 1) * 16 + swz / 64; C = (st & 1) * 32 + (swz % 64) / 2; }
__host__ __device__ __forceinline__ int perm32(int rho) { const int n = rho >> 4, i = rho & 15; return 8 * (i >> 2) + 4 * n + (i & 3); }
struct Unit { int pm, pn; };
struct Gemm { const bf16_t* A; const bf16_t* Bt; int M, N, K; };
struct StaticOrder {
    int nM, nN, nwg, G, c;
    __host__ __device__ void init(int M_, int N_, int G_, int c_) { nM = M_ / BM; nN = N_ / BM; nwg = nM * nN; G = G_; c = c_; }
    __host__ __device__ bool next(int i, Unit& u) const {
        const long L = (long)i * G + c; if (L >= nwg) return false;
        int wgid = (int)L; { const int q = nwg / NXCD, r = nwg % NXCD, xcd = wgid % NXCD, off = wgid / NXCD; wgid = (xcd < r ? xcd * (q + 1) : r * (q + 1) + (xcd - r) * q) + off; }
        const int nig = WGM * nN, gid = wgid / nig, fm = gid * WGM, gsz = (nM - fm) < WGM ? (nM - fm) : WGM;
        u.pm = fm + ((wgid % nig) % gsz); u.pn = (wgid % nig) / gsz; return true;
    }
};

template <class Epi, class Sched, bool ALIGN_EPI, bool SP2>
__device__ __forceinline__ void gemm_phase(LAS unsigned char* lds, const Gemm g, const Sched& S, const Epi& E, const int tid) {
    const int wid = __builtin_amdgcn_readfirstlane(tid >> 6), lane = tid & 63, wr = wid >> 2, wc = wid & 3, fr = lane & 15, fq = lane >> 4;
    const int K = g.K, nt = K / BK;
    unsigned voffA[2], voffB[2];
#pragma unroll
    for (int i = 0; i < 2; ++i) { int R, C; stage_rc(tid * 16 + i * 8192, R, C); const int Rb = Epi::PERM ? ((R & ~31) + perm32(R & 31)) : R;
        voffA[i] = (unsigned)(R * K + C) * 2u; voffB[i] = (unsigned)(Rb * K + C) * 2u; }
    const size_t kstep = (size_t)(BK * 2);
    const size_t hstep = (size_t)HALF * K * 2;
    const size_t tstep = 2 * hstep;
    const unsigned ldsw = (unsigned)wid * 1024u;
    const int aoff = lds_byte(wr * 64 + fr, fq * 8), boff = lds_byte(wc * 32 + fr, fq * 8);
#define PG8_SA(b, h) (((b) * 2 + (h)) * HTB)
#define PG8_SB(b, h) ((4 + (b) * 2 + (h)) * HTB)
#define PG8_STAGE(bufoff, gbase, voff) do { _Pragma("unroll") for (int _i = 0; _i < 2; ++_i) \
        __builtin_amdgcn_global_load_lds((const unsigned*)((const char*)(gbase) + (voff)[_i]), (LAS unsigned*)(lds + (bufoff) + ldsw + _i * 8192), 16, 0, 0); } while (0)
#define PG8_LDA(dst, b, h) do { _Pragma("unroll") for (int m = 0; m < 4; ++m) _Pragma("unroll") for (int k = 0; k < 2; ++k) dst[m][k] = *(const LAS bf16x8*)(lds + PG8_SA(b, h) + aoff + m * 2048 + k * 1024); } while (0)
#define PG8_LDB(dst, b, h) do { _Pragma("unroll") for (int n = 0; n < 2; ++n) _Pragma("unroll") for (int k = 0; k < 2; ++k) dst[n][k] = *(const LAS bf16x8*)(lds + PG8_SB(b, h) + boff + n * 2048 + k * 1024); } while (0)
#define PG8_MMA(ai, bj, At, Bt) do { __builtin_amdgcn_s_setprio(1); _Pragma("unroll") for (int m = 0; m < 4; ++m) _Pragma("unroll") for (int n = 0; n < 2; ++n) _Pragma("unroll") for (int k = 0; k < 2; ++k) \
        acc[ai][bj][m][n] = __builtin_amdgcn_mfma_f32_16x16x32_bf16(Bt[n][k], At[m][k], acc[ai][bj][m][n], 0, 0, 0); __builtin_amdgcn_s_setprio(0); } while (0)
#define PG8_WAIT_V(n) asm volatile("s_waitcnt vmcnt(" #n ")" ::: "memory")
#define PG8_WAIT_L(n) asm volatile("s_waitcnt lgkmcnt(" #n ")" ::: "memory")
#define PG8_BAR __builtin_amdgcn_s_barrier()
#define PG8_SCHED __builtin_amdgcn_sched_barrier(0)
    Unit cur, nxt; int ui = 0;
    if (!S.next(0, cur)) return;
    f32x4 acc[2][2][4][2];
#pragma unroll
    for (int a = 0; a < 2; ++a)
#pragma unroll
        for (int b = 0; b < 2; ++b)
#pragma unroll
            for (int m = 0; m < 4; ++m)
#pragma unroll
                for (int n = 0; n < 2; ++n) acc[a][b][m][n] = (f32x4){0.f, 0.f, 0.f, 0.f};
    bf16x8 At[4][2], B0[2][2], B1[2][2];
    const char* cA = (const char*)g.A + (size_t)cur.pm * tstep; const char* cB = (const char*)g.Bt + (size_t)cur.pn * tstep;
    if constexpr (SP2) {
        PG8_STAGE(PG8_SB(0, 0), cB, voffB); PG8_STAGE(PG8_SB(0, 1), cB + hstep, voffB); PG8_STAGE(PG8_SA(0, 0), cA, voffA); PG8_STAGE(PG8_SA(0, 1), cA + hstep, voffA);
        if (wr == 1) PG8_BAR;
        PG8_WAIT_V(2); PG8_BAR;
        PG8_STAGE(PG8_SB(1, 0), cB + kstep, voffB); PG8_STAGE(PG8_SA(1, 0), cA + kstep, voffA); PG8_STAGE(PG8_SB(1, 1), cB + hstep + kstep, voffB);
        PG8_WAIT_V(6); PG8_BAR;
    } else {
        PG8_STAGE(PG8_SB(0, 0), cB, voffB); PG8_STAGE(PG8_SA(0, 0), cA, voffA); PG8_STAGE(PG8_SB(0, 1), cB + hstep, voffB); PG8_STAGE(PG8_SA(0, 1), cA + hstep, voffA);
        if (wr == 1) PG8_BAR;
        PG8_WAIT_V(4); PG8_BAR;
        PG8_STAGE(PG8_SB(1, 0), cB + kstep, voffB); PG8_STAGE(PG8_SA(1, 0), cA + kstep, voffA); PG8_STAGE(PG8_SB(1, 1), cB + hstep + kstep, voffB);
        PG8_WAIT_V(6); PG8_BAR;
    }
    for (;;) {
        const bool has_next = S.next(ui + 1, nxt);
        const char* nA = has_next ? (const char*)g.A + (size_t)nxt.pm * tstep : cA; const char* nB = has_next ? (const char*)g.Bt + (size_t)nxt.pn * tstep : cB;
        for (int t = 0; t < nt; t += 2) {
            const bool last = (t == nt - 2);
            const char* a1 = cA + (size_t)(t + 1) * kstep;
            const char* a2 = last ? nA : cA + (size_t)(t + 2) * kstep; const char* b2 = last ? nB : cB + (size_t)(t + 2) * kstep;
            const char* a3 = a2 + kstep; const char* b3 = b2 + kstep;
            if constexpr (SP2) {
            PG8_LDB(B0, 0, 0); PG8_LDB(B1, 0, 1); PG8_SCHED; PG8_LDA(At, 0, 0); PG8_STAGE(PG8_SA(1, 1), a1 + hstep, voffA);
            PG8_WAIT_V(8); PG8_WAIT_L(0); PG8_BAR; PG8_MMA(0, 0, At, B0); PG8_MMA(0, 1, At, B1); PG8_BAR; PG8_SCHED;
            PG8_LDA(At, 0, 1); PG8_STAGE(PG8_SB(0, 0), b2, voffB); PG8_STAGE(PG8_SB(0, 1), b2 + hstep, voffB); PG8_STAGE(PG8_SA(0, 0), a2, voffA);
            PG8_WAIT_V(8); PG8_WAIT_L(0); PG8_BAR; PG8_MMA(1, 0, At, B0); PG8_MMA(1, 1, At, B1); PG8_BAR; PG8_SCHED;
            PG8_LDB(B0, 1, 0); PG8_LDB(B1, 1, 1); PG8_SCHED; PG8_LDA(At, 1, 0); PG8_STAGE(PG8_SA(0, 1), a2 + hstep, voffA);
            PG8_WAIT_V(8); PG8_WAIT_L(0); PG8_BAR; PG8_MMA(0, 0, At, B0); PG8_MMA(0, 1, At, B1); PG8_BAR; PG8_SCHED;
            PG8_LDA(At, 1, 1); PG8_STAGE(PG8_SB(1, 0), b3, voffB); PG8_STAGE(PG8_SB(1, 1), b3 + hstep, voffB); PG8_STAGE(PG8_SA(1, 0), a3, voffA);
            PG8_WAIT_V(8); PG8_WAIT_L(0); PG8_BAR; PG8_MMA(1, 0, At, B0); PG8_MMA(1, 1, At, B1); PG8_BAR; PG8_SCHED;
            } else {
            PG8_LDB(B0, 0, 0); PG8_SCHED; PG8_LDA(At, 0, 0); PG8_STAGE(PG8_SA(1, 1), a1 + hstep, voffA);
            PG8_WAIT_L(8); PG8_BAR; PG8_WAIT_L(0); PG8_MMA(0, 0, At, B0); PG8_BAR; PG8_SCHED;
            PG8_LDB(B1, 0, 1); PG8_STAGE(PG8_SB(0, 0), b2, voffB);
            PG8_BAR; PG8_WAIT_L(0); PG8_MMA(0, 1, At, B1); PG8_BAR;
            PG8_LDA(At, 0, 1); PG8_STAGE(PG8_SA(0, 0), a2, voffA);
            PG8_BAR; PG8_WAIT_L(0); PG8_MMA(1, 0, At, B0); PG8_BAR; PG8_SCHED;
            PG8_STAGE(PG8_SB(0, 1), b2 + hstep, voffB);
            PG8_WAIT_V(6); PG8_BAR; PG8_MMA(1, 1, At, B1); PG8_BAR;
            PG8_LDB(B0, 1, 0); PG8_SCHED; PG8_LDA(At, 1, 0); PG8_STAGE(PG8_SA(0, 1), a2 + hstep, voffA);
            PG8_WAIT_L(8); PG8_BAR; PG8_WAIT_L(0); PG8_MMA(0, 0, At, B0); PG8_BAR; PG8_SCHED;
            PG8_LDB(B1, 1, 1); PG8_STAGE(PG8_SB(1, 0), b3, voffB);
            PG8_BAR; PG8_WAIT_L(0); PG8_MMA(0, 1, At, B1); PG8_BAR;
            PG8_LDA(At, 1, 1); PG8_STAGE(PG8_SA(1, 0), a3, voffA);
            PG8_BAR; PG8_WAIT_L(0); PG8_MMA(1, 0, At, B0); PG8_BAR; PG8_SCHED;
            PG8_STAGE(PG8_SB(1, 1), b3 + hstep, voffB);
            PG8_WAIT_V(6); PG8_BAR; PG8_MMA(1, 1, At, B1); PG8_BAR;
            }
        }
        if constexpr (ALIGN_EPI) { if (wr == 0) PG8_BAR; }
        E(acc, cur, wr, wc, fr, fq);
        if (!has_next) break;
#pragma unroll
        for (int a = 0; a < 2; ++a)
#pragma unroll
            for (int b = 0; b < 2; ++b)
#pragma unroll
                for (int m = 0; m < 4; ++m)
#pragma unroll
                    for (int n = 0; n < 2; ++n) acc[a][b][m][n] = (f32x4){0.f, 0.f, 0.f, 0.f};
        cur = nxt; cA = nA; cB = nB; ++ui;
        if constexpr (ALIGN_EPI) { if (wr == 1) PG8_BAR; }
    }
    PG8_WAIT_V(0);
    if constexpr (!ALIGN_EPI) { if (wr == 0) PG8_BAR; }
    PG8_BAR;
#undef PG8_SA
#undef PG8_SB
#undef PG8_STAGE
#undef PG8_LDA
#undef PG8_LDB
#undef PG8_MMA
#undef PG8_WAIT_V
#undef PG8_WAIT_L
#undef PG8_BAR
#undef PG8_SCHED
}

struct EpiProj {
    static constexpr bool PERM = true;
    bf16_t* O; int ldc; const float* ssq;
    __device__ __forceinline__ void operator()(const f32x4 (&acc)[2][2][4][2], const Unit& u, int wr, int wc, int fr, int fq) const {
        const int row0 = u.pm * BM + wr * 64 + fr, col0 = u.pn * BM + wc * 32 + 8 * fq;
#pragma unroll
        for (int ai = 0; ai < 2; ++ai)
#pragma unroll
            for (int m = 0; m < 4; ++m) { const int row = row0 + ai * HALF + m * 16; const float rs = row_rstd(ssq, row, fq);
                bf16_t* rowp = O + (size_t)row * ldc + col0;
#pragma unroll
                for (int bj = 0; bj < 2; ++bj) { const f32x4 v0 = acc[ai][bj][m][0] * rs, v1 = acc[ai][bj][m][1] * rs;
                    u32x4 w; w.x = cvtpk(v0[0], v0[1]); w.y = cvtpk(v0[2], v0[3]); w.z = cvtpk(v1[0], v1[1]); w.w = cvtpk(v1[2], v1[3]);
                    *(u32x4*)(rowp + bj * HALF) = w; } }
    }
};
struct EpiSwiGLU {
    static constexpr bool PERM = true;
    bf16_t* O; const float* ssq;
    __device__ __forceinline__ void operator()(const f32x4 (&acc)[2][2][4][2], const Unit& u, int wr, int wc, int fr, int fq) const {
        const int row0 = u.pm * BM + wr * 64 + fr, col0 = u.pn * HALF + wc * 32 + 8 * fq;
#pragma unroll
        for (int ai = 0; ai < 2; ++ai)
#pragma unroll
            for (int m = 0; m < 4; ++m) { const int row = row0 + ai * HALF + m * 16; const float rs = row_rstd(ssq, row, fq);
                float h[8];
#pragma unroll
                for (int n = 0; n < 2; ++n)
#pragma unroll
                    for (int j = 0; j < 4; ++j) { const float gt = acc[ai][0][m][n][j] * rs, up = acc[ai][1][m][n][j] * rs; h[n * 4 + j] = gt * up * __builtin_amdgcn_rcpf(1.0f + __expf(-gt)); }
                u32x4 w; w.x = cvtpk(h[0], h[1]); w.y = cvtpk(h[2], h[3]); w.z = cvtpk(h[4], h[5]); w.w = cvtpk(h[6], h[7]);
                *(u32x4*)(O + (size_t)row * FF + col0) = w; }
    }
};
struct EpiResid {
    static constexpr bool PERM = false;
    float* X; bf16_t* XB; float* ssq;
    __device__ __forceinline__ void operator()(const f32x4 (&acc)[2][2][4][2], const Unit& u, int wr, int wc, int fr, int fq) const {
        const int row0 = u.pm * BM + wr * 64 + fr, col0 = u.pn * BM + wc * 32 + 4 * fq;
#pragma unroll
        for (int ai = 0; ai < 2; ++ai)
#pragma unroll
            for (int m = 0; m < 4; ++m) { const int row = row0 + ai * HALF + m * 16; const size_t off = (size_t)row * DM + col0; float ss = 0.f;
#pragma unroll
                for (int bj = 0; bj < 2; ++bj)
#pragma unroll
                    for (int n = 0; n < 2; ++n) { const size_t o = off + bj * HALF + n * 16; const f32x4 xv = *(const f32x4*)(X + o) + acc[ai][bj][m][n];
                        *(f32x4*)(X + o) = xv; u32x2 w; w.x = cvtpk(xv[0], xv[1]); w.y = cvtpk(xv[2], xv[3]); *(u32x2*)(XB + o) = w;
                        ss += (xv[0] * xv[0] + xv[1] * xv[1]) + (xv[2] * xv[2] + xv[3] * xv[3]); }
                ss = xor32_sum(xor16_sum(ss));
                if (fq == 0) ssq[(size_t)row * 32 + u.pn * 4 + wc] = ss; }
    }
};
template <int MODE> struct EpiLora {
    static constexpr bool PERM = false;
    float* O; const float* bias;
    __device__ __forceinline__ void operator()(const f32x4 (&acc)[2][2][4][2], const Unit& u, int wr, int wc, int fr, int fq) const {
        const int row0 = u.pm * BM + wr * 64 + fr, col0 = u.pn * BM + wc * 32 + 4 * fq;
#pragma unroll
        for (int bj = 0; bj < 2; ++bj)
#pragma unroll
            for (int n = 0; n < 2; ++n) { const int col = col0 + bj * HALF + n * 16;
                f32x4 bv = (f32x4){0.f, 0.f, 0.f, 0.f}; if (MODE != 2) bv = *(const f32x4*)(bias + col);
#pragma unroll
                for (int ai = 0; ai < 2; ++ai)
#pragma unroll
                    for (int m = 0; m < 4; ++m) { const int row = row0 + ai * HALF + m * 16; f32x4 v = acc[ai][bj][m][n] + bv;
                        if (MODE == 0) {
#pragma unroll
                            for (int j = 0; j < 4; ++j) { const float z = -v[j]; const float sp = fmaxf(z, 0.f) + __logf(1.0f + __expf(-fabsf(z))); v[j] = __expf(-__expf(-sp - 0.5f)); }
                        } else if (MODE == 1) {
#pragma unroll
                            for (int j = 0; j < 4; ++j) v[j] = sigmoidf_(v[j]);
                        }
                        *(f32x4*)(O + (size_t)row * 1024 + col) = v; } }
    }
};
}

template <int MAP>
__device__ __forceinline__ void transpose_item(const float* W, int K, int N, bf16_t* WT, const float* gk, LAS float* scr, int item, int lane) {
    const int nblk = N / 32, kb = item / nblk, nb = item % nblk, k0 = 64 * kb, n0 = 32 * nb;
    float v[32];
    const float* wp = W + (size_t)(k0 + (lane >> 5)) * N + n0 + (lane & 31);
#pragma unroll
    for (int i = 0; i < 32; ++i) v[i] = __builtin_nontemporal_load(wp + (size_t)(2 * i) * N);
    const int c = lane & 7;
    f32x4 g0 = (f32x4){1.f, 1.f, 1.f, 1.f}, g1 = g0;
    if (gk) { g0 = *(const f32x4*)(gk + k0 + 8 * c); g1 = *(const f32x4*)(gk + k0 + 8 * c + 4); }
#pragma unroll
    for (int i = 0; i < 32; ++i) scr[(2 * i + (lane >> 5)) * 33 + (lane & 31)] = v[i];
    asm volatile("s_waitcnt lgkmcnt(0)" ::: "memory");
#pragma unroll
    for (int j = 0; j < 4; ++j) { const int n = n0 + (lane >> 3) + 8 * j; const LAS float* s = scr + (8 * c) * 33 + (n - n0);
        float sc = 1.f; int drow = n;
        if (MAP == 0) { if (n < 512 || (n >= 1536 && n < 2048)) sc = QSC; }
        if (MAP == 1) { const int hn = n < FF ? n : n - FF; drow = (hn >> 7) * 256 + (n < FF ? 0 : 128) + (hn & 127); }
        const f32x4 h0 = g0 * sc, h1 = g1 * sc;
        u32x4 o; o.x = cvtpk(s[0 * 33] * h0[0], s[1 * 33] * h0[1]); o.y = cvtpk(s[2 * 33] * h0[2], s[3 * 33] * h0[3]); o.z = cvtpk(s[4 * 33] * h1[0], s[5 * 33] * h1[1]); o.w = cvtpk(s[6 * 33] * h1[2], s[7 * 33] * h1[3]);
        *(u32x4*)(WT + (size_t)drow * K + k0 + 8 * c) = o; }
    asm volatile("s_waitcnt lgkmcnt(0)" ::: "memory");
}

constexpr int I_IN = (DM / 64) * (INC / 32), I_OUT = (DM / 64) * (DM / 32), I_GU = (DM / 64) * (GU / 32), I_DN = (FF / 64) * (DM / 32);
constexpr int CONV_ITEMS = I_IN + I_OUT + I_GU + I_DN;
__device__ __forceinline__ void convert_item(KP p, int l, int r, LAS float* scr, int lane) {
    unsigned char* wb = p->ws + WS_W + (size_t)l * LW_STRIDE;
    if (r < I_IN) { transpose_item<0>(p->in[2] + (size_t)l * DM * INC, DM, INC, (bf16_t*)(wb + LW_WIN), p->in[1] + l * DM, scr, r, lane); return; } r -= I_IN;
    if (r < I_OUT) { transpose_item<2>(p->in[17] + (size_t)l * DM * DM, DM, DM, (bf16_t*)(wb + LW_WOUT), nullptr, scr, r, lane); return; } r -= I_OUT;
    if (r < I_GU) { transpose_item<1>(p->in[19] + (size_t)l * DM * GU, DM, GU, (bf16_t*)(wb + LW_WGU), p->in[18] + l * DM, scr, r, lane); return; } r -= I_GU;
    transpose_item<2>(p->in[20] + (size_t)l * FF * DM, FF, DM, (bf16_t*)(wb + LW_WDN), nullptr, scr, r, lane);
}

__device__ __forceinline__ void phase0(KP p, LAS unsigned char* lds, int gw, int NGW, int wave, int lane) {
    LAS float* scr = (LAS float*)(lds + wave * 16384);
    for (int it = gw; it < CONV_ITEMS; it += NGW) convert_item(p, 0, it, scr, lane);
    const int gt = gw * 64 + lane, NGT = NGW * 64;
    for (int l = 0; l < NL; ++l) {
        unsigned char* wb = p->ws + WS_W + (size_t)l * LW_STRIDE;
        bf16_t* w2t = (bf16_t*)(wb + LW_W2T); bf16_t* a2t = (bf16_t*)(wb + LW_A2T); bf16_t* g2t = (bf16_t*)(wb + LW_G2T);
        const float* w2 = p->in[8] + (size_t)l * 96 * 1024; const float* a2 = p->in[10] + (size_t)l * 96 * 1024; const float* g2 = p->in[11] + (size_t)l * 256 * 1024;
        for (int i = gt; i < 1024 * 128; i += NGT) { const int n = i >> 7, k = i & 127;
            w2t[i] = (bf16_t)(cvtpk(k < 96 ? w2[k * 1024 + n] : 0.f, 0.f) & 0xffff); a2t[i] = (bf16_t)(cvtpk(k < 96 ? a2[k * 1024 + n] : 0.f, 0.f) & 0xffff); }
        for (int i = gt; i < 1024 * 256; i += NGT) { const int n = i >> 8, k = i & 255; g2t[i] = (bf16_t)(cvtpk(g2[k * 1024 + n], 0.f) & 0xffff); }
        unsigned* padz = (unsigned*)(wb + LW_WIN + (size_t)INC * DM * 2);
        for (int i = gt; i < (INCP - INC) * DM / 2; i += NGT) padz[i] = 0u;
    }
    const float* x = p->in[0]; float* X = p->out; bf16_t* XB = (bf16_t*)(p->ws + WS_XB); float* ssqA = (float*)(p->ws + WS_SSQA);
    for (int m = gw; m < M; m += NGW) { float ss = 0.f;
#pragma unroll
        for (int j = 0; j < 8; ++j) { const size_t o = (size_t)m * DM + j * 256 + lane * 4; const f32x4 v = *(const f32x4*)(x + o); *(f32x4*)(X + o) = v;
            u32x2 w; w.x = cvtpk(v[0], v[1]); w.y = cvtpk(v[2], v[3]); *(u32x2*)(XB + o) = w; ss += (v[0] * v[0] + v[1] * v[1]) + (v[2] * v[2] + v[3] * v[3]); }
        ss = wave_sum(ss); if (lane < 32) ssqA[(size_t)m * 32 + lane] = lane == 0 ? ss : 0.f; }
}

__device__ __forceinline__ void phase_prep1(KP p, int l, LAS unsigned char* lds, int gw, int NGW, int wave, int lane) {
    const bf16_t* PROJ = (const bf16_t*)(p->ws + WS_PROJ);
    LAS unsigned short* tile = (LAS unsigned short*)(lds + wave * 8448);
    bf16_t* VAT = (bf16_t*)(p->ws + WS_VAT); bf16_t* VBT = (bf16_t*)(p->ws + WS_VBT);
    for (int it = gw; it < 128 * 10; it += NGW) {
        const int tb = it / 10, g = it % 10, t0 = tb * 64; const int cbase = g < 8 ? 1024 + 64 * g : 2176 + 64 * (g - 8);
        bf16_t* dst = g < 8 ? VAT + (size_t)(64 * g) * M : VBT + (size_t)(64 * (g - 8)) * M;
#pragma unroll
        for (int i = 0; i < 8; ++i) { const int row = i * 8 + (lane >> 3), ch = lane & 7; const u32x4 v = *(const u32x4*)(PROJ + (size_t)(t0 + row) * INCP + cbase + 8 * ch);
            LAS unsigned* d = (LAS unsigned*)(tile + row * 66 + 8 * ch); d[0] = v.x; d[1] = v.y; d[2] = v.z; d[3] = v.w; }
        asm volatile("s_waitcnt lgkmcnt(0)" ::: "memory");
#pragma unroll
        for (int i = 0; i < 8; ++i) { const int c = i * 8 + (lane >> 3), tch = lane & 7, j = tch >> 1, hi = tch & 1; unsigned short v[8];
#pragma unroll
            for (int s = 0; s < 8; ++s) v[s] = tile[(16 * j + (s & 3) + 8 * (s >> 2) + 4 * hi) * 66 + c];
            u32x4 o; o.x = v[0] | ((unsigned)v[1] << 16); o.y = v[2] | ((unsigned)v[3] << 16); o.z = v[4] | ((unsigned)v[5] << 16); o.w = v[6] | ((unsigned)v[7] << 16);
            *(u32x4*)(dst + (size_t)c * M + t0 + 16 * j + 8 * hi) = o; }
        asm volatile("s_waitcnt lgkmcnt(0)" ::: "memory");
    }
    const float* mu = p->in[6] + (size_t)l * RWC;
    bf16_t* AW = (bf16_t*)(p->ws + WS_AW); bf16_t* AA = (bf16_t*)(p->ws + WS_AA); bf16_t* AG = (bf16_t*)(p->ws + WS_AG);
    float knmax = 0.f;
    for (int t = gw; t < M; t += NGW) {
        const bf16_t* cur = PROJ + (size_t)t * INCP + RW0;
        {   const u32x4 kv = *(const u32x4*)(PROJ + (size_t)t * INCP + 512 + 8 * lane);
            float a0 = bflo(kv.x), a1 = bfhi(kv.x), a2 = bflo(kv.y), a3 = bfhi(kv.y), a4 = bflo(kv.z), a5 = bfhi(kv.z), a6 = bflo(kv.w), a7 = bfhi(kv.w);
            float ss = (a0 * a0 + a1 * a1) + (a2 * a2 + a3 * a3) + (a4 * a4 + a5 * a5) + (a6 * a6 + a7 * a7);
            ss += dppm<0xB1>(ss); ss += dppm<0x4E>(ss); ss += dppm<0x141>(ss); knmax = fmaxf(knmax, ss); }
        if (lane < 56) { const int j0 = 3072 + 8 * lane;
            const u32x4 c4 = *(const u32x4*)(cur + j0); u32x4 p4 = (u32x4){0u, 0u, 0u, 0u}; if (t > 0) p4 = *(const u32x4*)(cur - INCP + j0);
            const f32x4 m0 = *(const f32x4*)(mu + j0), m1 = *(const f32x4*)(mu + j0 + 4);
            float f[8]; const unsigned cw[4] = {c4.x, c4.y, c4.z, c4.w}, pw[4] = {p4.x, p4.y, p4.z, p4.w};
#pragma unroll
            for (int q = 0; q < 4; ++q) { const float c0 = bflo(cw[q]), c1 = bfhi(cw[q]), p0 = bflo(pw[q]), p1 = bfhi(pw[q]);
                const float mu0 = q < 2 ? m0[2 * q] : m1[2 * q - 4], mu1 = q < 2 ? m0[2 * q + 1] : m1[2 * q - 3];
                f[2 * q] = c0 + (p0 - c0) * mu0; f[2 * q + 1] = c1 + (p1 - c1) * mu1; }
            bf16_t* dstp;
            if (j0 < 3168) { dstp = AW + (size_t)t * 128 + (j0 - 3072);
#pragma unroll
                for (int q = 0; q < 8; ++q) f[q] = tanhf(f[q]); }
            else if (j0 < 3264) { dstp = AA + (size_t)t * 128 + (j0 - 3168); }
            else { dstp = AG + (size_t)t * 256 + (j0 - 3264);
#pragma unroll
                for (int q = 0; q < 8; ++q) f[q] = sigmoidf_(f[q]); }
            u32x4 o; o.x = cvtpk(f[0], f[1]); o.y = cvtpk(f[2], f[3]); o.z = cvtpk(f[4], f[5]); o.w = cvtpk(f[6], f[7]); *(u32x4*)dstp = o; }
        else { const int e = lane - 56; if (e < 4) *(u32x4*)(AW + (size_t)t * 128 + 96 + 8 * e) = (u32x4){0u, 0u, 0u, 0u}; else *(u32x4*)(AA + (size_t)t * 128 + 96 + 8 * (e - 4)) = (u32x4){0u, 0u, 0u, 0u}; }
    }
    {   LAS float* kr = (LAS float*)(lds + 8 * 8448);
        if ((lane & 7) == 0) kr[wave * 8 + (lane >> 3)] = knmax;
        __syncthreads();
        if (wave == 0 && lane < 8) { float m = kr[lane];
#pragma unroll
            for (int w2 = 1; w2 < 8; ++w2) m = fmaxf(m, kr[w2 * 8 + lane]);
            ((float*)(p->ws + WS_KNP))[(size_t)(gw >> 3) * 8 + lane] = m; }
        __syncthreads(); }
}

__device__ __forceinline__ void phase_prep2(KP p, int l, int gw, int NGW, int lane) {
    const float* KR = (const float*)(p->ws + WS_KR); const float* A = (const float*)(p->ws + WS_A);
    float* KF = (float*)(p->ws + WS_KF); float* AN = (float*)(p->ws + WS_AN); float* BB = (float*)(p->ws + WS_BB);
    const float* k_k = p->in[12] + l * 1024; const float* k_a = p->in[13] + l * 1024;
    const int c0 = 16 * lane;
    for (int t = gw; t < M; t += NGW) { const size_t o = (size_t)t * 1024 + c0; float n2 = 0.f; f32x4 kkv[4], kr[4], av[4];
#pragma unroll
        for (int q = 0; q < 4; ++q) { kr[q] = *(const f32x4*)(KR + o + 4 * q); av[q] = *(const f32x4*)(A + o + 4 * q); kkv[q] = kr[q] * *(const f32x4*)(k_k + c0 + 4 * q);
            n2 += (kkv[q][0] * kkv[q][0] + kkv[q][1] * kkv[q][1]) + (kkv[q][2] * kkv[q][2] + kkv[q][3] * kkv[q][3]); }
        n2 = quad_sum(n2); const float inv = 1.0f / fmaxf(sqrtf(n2), 1e-12f);
#pragma unroll
        for (int q = 0; q < 4; ++q) { const f32x4 kk = kkv[q] * inv; const f32x4 ka = *(const f32x4*)(k_a + c0 + 4 * q);
            *(f32x4*)(KF + o + 4 * q) = kr[q] * (1.0f + (av[q] - 1.0f) * ka); *(f32x4*)(AN + o + 4 * q) = -kk; *(f32x4*)(BB + o + 4 * q) = kk * av[q]; }
    }
}

template <int MODE>
__device__ __forceinline__ void scan_task(KP p, int l, LAS unsigned char* wl, int c, int h, int lane) {
    constexpr int NPV = MODE == 0 ? 1 : (MODE == 1 ? 2 : 3);
    constexpr int SB = 4;
    LAS float* vec = (LAS float*)wl;
    LAS float* ybuf = (LAS float*)(wl + 7 * SB * 256);
    const float* DECp = (const float*)(p->ws + WS_DEC); const float* Ap = (const float*)(p->ws + WS_A); const bf16_t* PROJ = (const bf16_t*)(p->ws + WS_PROJ);
    const int rb = lane >> 2, cb = lane & 3, t0 = c * CL;
    f32x2 s[4][8];
    if (MODE == 0) {
#pragma unroll
        for (int r = 0; r < 4; ++r)
#pragma unroll
            for (int q = 0; q < 8; ++q) { s[r][q].x = (4 * rb + r == 16 * cb + 2 * q) ? 1.f : 0.f; s[r][q].y = (4 * rb + r == 16 * cb + 2 * q + 1) ? 1.f : 0.f; }
    } else if (MODE == 1) {
#pragma unroll
        for (int r = 0; r < 4; ++r)
#pragma unroll
            for (int q = 0; q < 8; ++q) s[r][q] = (f32x2){0.f, 0.f};
    } else {
        const float* SI = (const float*)(p->ws + WS_SI) + ((size_t)(h * NCH + c)) * 4096;
#pragma unroll
        for (int x = 0; x < 16; ++x) { const f32x4 v = *(const f32x4*)(SI + (16 * cb + x) * 64 + 4 * rb);
#pragma unroll
            for (int r = 0; r < 4; ++r) { if (x & 1) s[r][x >> 1].y = v[r]; else s[r][x >> 1].x = v[r]; } }
    }
    const int lst = lane >> 4, lq = lane & 15;
    const f32x4 kk4 = *(const f32x4*)(p->in[12] + l * 1024 + 64 * h + 4 * lq), ka4 = *(const f32x4*)(p->in[13] + l * 1024 + 64 * h + 4 * lq);
    f32x4 lnw4 = (f32x4){0.f, 0.f, 0.f, 0.f}, lnb4 = lnw4, rk4 = lnw4;
    if (MODE == 2) { lnw4 = *(const f32x4*)(p->in[15] + l * 1024 + 64 * h + 4 * lq); lnb4 = *(const f32x4*)(p->in[16] + l * 1024 + 64 * h + 4 * lq); rk4 = *(const f32x4*)(p->in[14] + l * 1024 + 64 * h + 4 * lq); }
    const size_t goff = (size_t)(t0 + lst) * 1024 + 64 * h + 4 * lq;
    const int pvo[3] = {1024, 2048, 0};
    f32x4 mu4[NPV];
#pragma unroll
    for (int v = 0; v < NPV; ++v) mu4[v] = *(const f32x4*)(p->in[6] + (size_t)l * RWC + pvo[v] + 64 * h + 4 * lq);
    const bf16_t* pj = PROJ + (size_t)(t0 + lst) * INCP + RW0 + 64 * h + 4 * lq;
    const float* Gp = (const float*)(p->ws + WS_G);
    struct Pre { f32x4 dec, a, g; u32x2 cur[NPV], prv[NPV]; };
    Pre pA, pB;
#define SCAN_LOAD(P_, SBI) do { if ((SBI) < CL / SB) { const size_t ro = (size_t)(SB * (SBI)); P_.dec = *(const f32x4*)(DECp + goff + ro * 1024); P_.a = *(const f32x4*)(Ap + goff + ro * 1024); \
        if constexpr (MODE == 2) P_.g = *(const f32x4*)(Gp + goff + ro * 1024); \
        const bool first = (t0 + (int)ro + lst) == 0; \
        _Pragma("unroll") for (int v = 0; v < NPV; ++v) { P_.cur[v] = *(const u32x2*)(pj + ro * INCP + pvo[v]); P_.prv[v] = first ? (u32x2){0u, 0u} : *(const u32x2*)(pj + ro * INCP + pvo[v] - INCP); } } } while (0)
#define SCAN_SHIFT(P_, V) ({ const f32x4 c_ = (f32x4){bflo(P_.cur[V].x), bfhi(P_.cur[V].x), bflo(P_.cur[V].y), bfhi(P_.cur[V].y)}, q_ = (f32x4){bflo(P_.prv[V].x), bfhi(P_.prv[V].x), bflo(P_.prv[V].y), bfhi(P_.prv[V].y)}; c_ + (q_ - c_) * mu4[V]; })
#define SCAN_STAGE(P_) do { const f32x4 kr = SCAN_SHIFT(P_, 0), av = P_.a; const f32x4 kkv = kr * kk4; \
        float n2 = (kkv[0] * kkv[0] + kkv[1] * kkv[1]) + (kkv[2] * kkv[2] + kkv[3] * kkv[3]); n2 = row16_sum(n2); \
        const float inv = __builtin_amdgcn_rsqf(fmaxf(n2, 1e-24f)); const f32x4 kkn = kkv * inv; \
        LAS float* vw = vec + lst * 64 + 4 * lq; \
        *(LAS f32x4*)(vw + 0 * SB * 64) = P_.dec; *(LAS f32x4*)(vw + 1 * SB * 64) = -kkn; *(LAS f32x4*)(vw + 2 * SB * 64) = kkn * av; \
        if constexpr (MODE != 0) { *(LAS f32x4*)(vw + 3 * SB * 64) = kr * (1.0f + (av - 1.0f) * ka4); *(LAS f32x4*)(vw + 4 * SB * 64) = SCAN_SHIFT(P_, 1); } \
        if constexpr (MODE == 2) { *(LAS f32x4*)(vw + 5 * SB * 64) = SCAN_SHIFT(P_, 2); *(LAS f32x4*)(vw + 6 * SB * 64) = P_.g; } } while (0)
    SCAN_LOAD(pA, 0); SCAN_LOAD(pB, 1);
    for (int sb = 0; sb < CL / SB; ++sb) {
        if (sb & 1) { SCAN_STAGE(pB); SCAN_LOAD(pB, sb + 2); } else { SCAN_STAGE(pA); SCAN_LOAD(pA, sb + 2); }
#pragma unroll 1
        for (int st = 0; st < SB; ++st) {
            const LAS float* vb = vec + st * 64 + 16 * cb;
            float sa[4];
            {   f32x2 a2[8];
#pragma unroll
                for (int q = 0; q < 4; ++q) { const f32x4 y = *(const LAS f32x4*)(vb + 1 * SB * 64 + 4 * q); a2[2 * q] = (f32x2){y[0], y[1]}; a2[2 * q + 1] = (f32x2){y[2], y[3]}; }
#pragma unroll
                for (int r = 0; r < 4; ++r) { f32x2 a = s[r][0] * a2[0];
#pragma unroll
                    for (int q = 1; q < 8; ++q) a = s[r][q] * a2[q] + a;
                    sa[r] = quad_sum(a.x + a.y); } }
            f32x4 vv = (f32x4){0.f, 0.f, 0.f, 0.f};
            if (MODE != 0) vv = *(const LAS f32x4*)(vec + (4 * SB + st) * 64 + 4 * rb);
#pragma unroll
            for (int q = 0; q < 4; ++q) { const f32x4 w4 = *(const LAS f32x4*)(vb + 0 * SB * 64 + 4 * q), b4 = *(const LAS f32x4*)(vb + 2 * SB * 64 + 4 * q);
                const f32x2 w0 = (f32x2){w4[0], w4[1]}, w1 = (f32x2){w4[2], w4[3]}, b0 = (f32x2){b4[0], b4[1]}, b1 = (f32x2){b4[2], b4[3]};
                if (MODE == 0) {
#pragma unroll
                    for (int r = 0; r < 4; ++r) { s[r][2 * q] = s[r][2 * q] * w0 + b0 * sa[r]; s[r][2 * q + 1] = s[r][2 * q + 1] * w1 + b1 * sa[r]; }
                } else { const f32x4 k4 = *(const LAS f32x4*)(vb + 3 * SB * 64 + 4 * q); const f32x2 k0 = (f32x2){k4[0], k4[1]}, k1 = (f32x2){k4[2], k4[3]};
#pragma unroll
                    for (int r = 0; r < 4; ++r) { s[r][2 * q] = s[r][2 * q] * w0 + (b0 * sa[r] + k0 * vv[r]); s[r][2 * q + 1] = s[r][2 * q + 1] * w1 + (b1 * sa[r] + k1 * vv[r]); }
                } }
            if (MODE == 2) {
                f32x2 r2[8];
#pragma unroll
                for (int q = 0; q < 4; ++q) { const f32x4 x = *(const LAS f32x4*)(vb + 5 * SB * 64 + 4 * q); r2[2 * q] = (f32x2){x[0], x[1]}; r2[2 * q + 1] = (f32x2){x[2], x[3]}; }
                f32x4 yv;
#pragma unroll
                for (int r = 0; r < 4; ++r) { f32x2 a = s[r][0] * r2[0];
#pragma unroll
                    for (int q = 1; q < 8; ++q) a = s[r][q] * r2[q] + a;
                    yv[r] = quad_sum(a.x + a.y); }
                if (cb == 0) *(LAS f32x4*)(ybuf + st * 64 + 4 * rb) = yv;
            }
        }
        if (MODE == 2) {
            bf16_t* MIX = (bf16_t*)(p->ws + WS_MIX);
            const int t = t0 + SB * sb + lst; const LAS float* vr = vec + lst * 64 + 4 * lq;
            const f32x4 y = *(const LAS f32x4*)(ybuf + lst * 64 + 4 * lq), rr = *(const LAS f32x4*)(vr + 5 * SB * 64), kk = *(const LAS f32x4*)(vr + 3 * SB * 64),
                        vv = *(const LAS f32x4*)(vr + 4 * SB * 64), g = *(const LAS f32x4*)(vr + 6 * SB * 64);
            const float mean = row16_sum((y[0] + y[1]) + (y[2] + y[3])) * (1.0f / 64.0f);
            const f32x4 d = y - mean;
            const float var = row16_sum((d[0] * d[0] + d[1] * d[1]) + (d[2] * d[2] + d[3] * d[3])) * (1.0f / 64.0f);
            const f32x4 rkk = rr * kk * rk4;
            const float bon = row16_sum((rkk[0] + rkk[1]) + (rkk[2] + rkk[3]));
            const f32x4 o = (d * __builtin_amdgcn_rsqf(var + 64e-5f) * lnw4 + lnb4 + vv * bon) * g;
            u32x2 wv; wv.x = cvtpk(o[0], o[1]); wv.y = cvtpk(o[2], o[3]);
            *(u32x2*)(MIX + (size_t)t * DM + 1024 + 64 * h + 4 * lq) = wv;
        }
    }
    if (MODE == 0) { float* dst = (float*)(p->ws + WS_PB) + ((size_t)(h * NCH + c)) * 4096;
#pragma unroll
        for (int r = 0; r < 4; ++r)
#pragma unroll
            for (int q = 0; q < 4; ++q) *(f32x4*)(dst + (4 * rb + r) * 64 + 16 * cb + 4 * q) = (f32x4){s[r][2 * q].x, s[r][2 * q].y, s[r][2 * q + 1].x, s[r][2 * q + 1].y}; }
    if (MODE == 1) { float* dst = (float*)(p->ws + WS_UB) + ((size_t)(h * NCH + c)) * 4096;
#pragma unroll
        for (int x = 0; x < 16; ++x) { f32x4 v;
#pragma unroll
            for (int r = 0; r < 4; ++r) v[r] = (x & 1) ? s[r][x >> 1].y : s[r][x >> 1].x;
            *(f32x4*)(dst + (16 * cb + x) * 64 + 4 * rb) = v; } }
}

#undef SCAN_LOAD
#undef SCAN_SHIFT
#undef SCAN_STAGE
__device__ __forceinline__ void s2_head(KP p, LAS unsigned char* lds, int h, const int tid) {
    const float* PB = (const float*)(p->ws + WS_PB) + (size_t)h * NCH * 4096; const float* UT = (const float*)(p->ws + WS_UB) + (size_t)h * NCH * 4096;
    float* SI = (float*)(p->ws + WS_SI) + (size_t)h * NCH * 4096;
    const int lane = tid & 63, w = __builtin_amdgcn_readfirstlane(tid >> 6), n = lane & 31, lh = lane >> 5, to = (w >> 1) & 1, ti = w & 1;
    static_assert((NCH - 1) % 3 == 0, "three rotating prefetch buffers");
    if (w >= 4) {
        for (int c = 0; c < NCH - 1; ++c) __syncthreads();
    } else {
        f32x16 sreg, ua, ub, uc2; float pa[32], pb[32], pc2[32];
#pragma unroll
        for (int r = 0; r < 16; ++r) sreg[r] = 0.f;
        const int offu = (32 * to + 4 * lh) * 64 + 32 * ti + n, offp = (4 * lh) * 64 + 32 * to + n;
#define S2_LOAD(CH, U_, P_) do { const int ch_ = (CH) < NCH - 1 ? (CH) : NCH - 2; const float* pb_ = PB + (size_t)ch_ * 4096 + offp; const float* ub_ = UT + (size_t)ch_ * 4096 + offu; \
        _Pragma("unroll") for (int r = 0; r < 16; ++r) { const int cr = ((r & 3) + 8 * (r >> 2)) * 64; U_[r] = ub_[cr]; P_[r] = pb_[cr]; P_[16 + r] = pb_[2048 + cr]; } } while (0)
#define S2_STEP(C, UC_, PC_, UN_, PN_) do { \
        {   float* si = SI + (size_t)(C) * 4096 + offu; \
            _Pragma("unroll") for (int r = 0; r < 16; ++r) si[((r & 3) + 8 * (r >> 2)) * 64] = sreg[r]; } \
        LAS f32x4* ex = (LAS f32x4*)(lds + ((C) & 1) * 16384); \
        _Pragma("unroll") for (int q = 0; q < 4; ++q) ex[(w * 4 + q) * 64 + lane] = (f32x4){sreg[4 * q], sreg[4 * q + 1], sreg[4 * q + 2], sreg[4 * q + 3]}; \
        __syncthreads(); \
        S2_LOAD((C) + 2, UN_, PN_); \
        f32x16 preg; \
        _Pragma("unroll") for (int q = 0; q < 4; ++q) { const f32x4 v = ex[((w ^ 2) * 4 + q) * 64 + lane]; preg[4 * q] = v[0]; preg[4 * q + 1] = v[1]; preg[4 * q + 2] = v[2]; preg[4 * q + 3] = v[3]; } \
        f32x16 acc = UC_; \
        if (to == 0) { \
            _Pragma("unroll") for (int r = 0; r < 16; ++r) acc = __builtin_amdgcn_mfma_f32_32x32x2f32(PC_[r], sreg[r], acc, 0, 0, 0); \
            _Pragma("unroll") for (int r = 0; r < 16; ++r) acc = __builtin_amdgcn_mfma_f32_32x32x2f32(PC_[16 + r], preg[r], acc, 0, 0, 0); \
        } else { \
            _Pragma("unroll") for (int r = 0; r < 16; ++r) acc = __builtin_amdgcn_mfma_f32_32x32x2f32(PC_[r], preg[r], acc, 0, 0, 0); \
            _Pragma("unroll") for (int r = 0; r < 16; ++r) acc = __builtin_amdgcn_mfma_f32_32x32x2f32(PC_[16 + r], sreg[r], acc, 0, 0, 0); } \
        sreg = acc; } while (0)
        S2_LOAD(0, ua, pa); S2_LOAD(1, ub, pb);
#pragma unroll 1
        for (int c = 0; c < NCH - 1; c += 3) {
            S2_STEP(c, ua, pa, uc2, pc2);
            S2_STEP(c + 1, ub, pb, ua, pa);
            S2_STEP(c + 2, uc2, pc2, ub, pb);
        }
        {   float* si = SI + (size_t)(NCH - 1) * 4096 + offu;
#pragma unroll
            for (int r = 0; r < 16; ++r) si[((r & 3) + 8 * (r >> 2)) * 64] = sreg[r]; }
#undef S2_LOAD
#undef S2_STEP
    }
    __syncthreads();
}

template <int DV, bool SWA>
__device__ __forceinline__ void attn_unit(LAS unsigned char* lds, const bf16_t* Q, const bf16_t* Kp, const bf16_t* VT, float slope2, int q0, float sink2,
                                          float* Of32, float* MLp, bf16_t* Obf, const int tid, int kt_lo, int kt_hi, float kn) {
    constexpr int KROW = 144, KTILE = 64 * KROW, VTILE = DV * KROW, BUF = KTILE + VTILE, NVL = DV / 64;
    const int lane = tid & 63, w = __builtin_amdgcn_readfirstlane(tid >> 6), r32 = lane & 31, hi = lane >> 5;
    const int qpos = q0 + 32 * w + r32;
    bf16x8 qf[4];
#pragma unroll
    for (int j = 0; j < 4; ++j) qf[j] = *(const bf16x8*)(Q + (size_t)qpos * INCP + 16 * j + 8 * hi);
    int kt0 = kt_lo, kt1 = kt_hi;
    if (!SWA) {
        float qq = 0.f, qk = 0.f;
#pragma unroll
        for (int j = 0; j < 4; ++j) { const bf16x8 kf = *(const bf16x8*)(Kp + (size_t)qpos * INCP + 16 * j + 8 * hi);
#pragma unroll
            for (int e = 0; e < 8; ++e) { const float qv = bf2f((unsigned short)qf[j][e]), kv = bf2f((unsigned short)kf[e]); qq += qv * qv; qk += qv * kv; } }
        qq = xor32_sum(qq); qk = xor32_sum(qk);
        const float dneed = (sqrtf(qq) * kn - qk + 45.0f) / slope2;
        float kneed = (float)qpos - dneed;
        kneed = fminf(kneed, dppm<0xB1>(kneed)); kneed = fminf(kneed, dppm<0x4E>(kneed)); kneed = fminf(kneed, dppm<0x141>(kneed)); kneed = fminf(kneed, dppm<0x140>(kneed));
        LAS float* red = (LAS float*)(lds + 2 * BUF);
        if ((lane & 15) == 0) red[w * 4 + (lane >> 4)] = kneed;
        __syncthreads();
        float km = red[0];
#pragma unroll
        for (int i = 1; i < 32; ++i) km = fminf(km, red[i]);
        const int ktw = km <= 0.f ? 0 : ((int)km >> 6);
        kt0 = ktw > kt_lo ? ktw : kt_lo;
    }
    const int qlo = q0 + 32 * w, qhi = qlo + 31;
    f32x16 o[DV / 32];
#pragma unroll
    for (int d = 0; d < DV / 32; ++d)
#pragma unroll
        for (int r = 0; r < 16; ++r) o[d][r] = 0.f;
    float mrun = 0.f, lsum = 0.f;
    const int krow = tid >> 3, kch = tid & 7;
    u32x4 kreg, vreg[NVL];
    if (kt0 <= kt1) {   const int k0 = 64 * kt0; kreg = *(const u32x4*)(Kp + (size_t)(k0 + krow) * INCP + 8 * kch);
#pragma unroll
        for (int i = 0; i < NVL; ++i) { const int idx = tid + 512 * i; vreg[i] = *(const u32x4*)(VT + (size_t)(idx >> 3) * M + k0 + 8 * (idx & 7)); } }
    for (int kt = kt0; kt <= kt1; ++kt) {
        LAS unsigned char* buf = lds + ((kt - kt0) & 1) * BUF;
        *(LAS u32x4*)(buf + krow * KROW + 16 * kch) = kreg;
#pragma unroll
        for (int i = 0; i < NVL; ++i) { const int idx = tid + 512 * i; *(LAS u32x4*)(buf + KTILE + (idx >> 3) * KROW + 16 * (idx & 7)) = vreg[i]; }
        __syncthreads();
        if (kt < kt1) { const int k0 = 64 * (kt + 1); kreg = *(const u32x4*)(Kp + (size_t)(k0 + krow) * INCP + 8 * kch);
#pragma unroll
            for (int i = 0; i < NVL; ++i) { const int idx = tid + 512 * i; vreg[i] = *(const u32x4*)(VT + (size_t)(idx >> 3) * M + k0 + 8 * (idx & 7)); } }
        const int k0 = 64 * kt;
        bool act = k0 <= qhi; if (SWA) act = act && (k0 + 63 >= qlo - 127);
        if (act) {
            f32x16 p0, p1;
            {   const float c0 = slope2 * (float)(k0 + 4 * hi - qpos) - mrun, c1 = c0 + 32.0f * slope2;
#pragma unroll
                for (int r = 0; r < 16; ++r) { const float cr = (float)((r & 3) + 8 * (r >> 2)); p0[r] = __builtin_fmaf(slope2, cr, c0); p1[r] = __builtin_fmaf(slope2, cr, c1); } }
#pragma unroll
            for (int j = 0; j < 4; ++j) { const bf16x8 a0 = *(const LAS bf16x8*)(buf + r32 * KROW + 32 * j + 16 * hi), a1 = *(const LAS bf16x8*)(buf + (r32 + 32) * KROW + 32 * j + 16 * hi);
                p0 = __builtin_amdgcn_mfma_f32_32x32x16_bf16(a0, qf[j], p0, 0, 0, 0); p1 = __builtin_amdgcn_mfma_f32_32x32x16_bf16(a1, qf[j], p1, 0, 0, 0); }
            bool need_mask = k0 + 63 > qlo; if (SWA) need_mask = need_mask || (qhi - k0 >= 128);
            if (need_mask) {
#pragma unroll
                for (int r = 0; r < 16; ++r) { const int kv = k0 + (r & 3) + 8 * (r >> 2) + 4 * hi; const int d0 = qpos - kv, d1 = d0 - 32;
                    bool ok0 = d0 >= 0, ok1 = d1 >= 0; if (SWA) { ok0 = ok0 && d0 < 128; ok1 = ok1 && d1 < 128; }
                    p0[r] = ok0 ? p0[r] : -1e30f; p1[r] = ok1 ? p1[r] : -1e30f; } }
            float mx = fmaxf(p0[0], p1[0]);
#pragma unroll
            for (int r = 1; r < 16; ++r) mx = fmaxf(mx, fmaxf(p0[r], p1[r]));
            mx = xor32_max(mx);
            if (__builtin_amdgcn_ballot_w64(mx > 8.0f) != 0ull) {
                const float d = fmaxf(mx, 0.f), f = __builtin_amdgcn_exp2f(-d); mrun += d; lsum *= f;
#pragma unroll
                for (int r = 0; r < 16; ++r) { p0[r] -= d; p1[r] -= d; }
#pragma unroll
                for (int dd = 0; dd < DV / 32; ++dd)
#pragma unroll
                    for (int r = 0; r < 16; ++r) o[dd][r] *= f; }
            float rs = 0.f;
#pragma unroll
            for (int r = 0; r < 16; ++r) { p0[r] = __builtin_amdgcn_exp2f(p0[r]); p1[r] = __builtin_amdgcn_exp2f(p1[r]); rs += p0[r] + p1[r]; }
            lsum += rs;
            u32x4 pw[4];
            pw[0] = (u32x4){cvtpk(p0[0], p0[1]), cvtpk(p0[2], p0[3]), cvtpk(p0[4], p0[5]), cvtpk(p0[6], p0[7])};
            pw[1] = (u32x4){cvtpk(p0[8], p0[9]), cvtpk(p0[10], p0[11]), cvtpk(p0[12], p0[13]), cvtpk(p0[14], p0[15])};
            pw[2] = (u32x4){cvtpk(p1[0], p1[1]), cvtpk(p1[2], p1[3]), cvtpk(p1[4], p1[5]), cvtpk(p1[6], p1[7])};
            pw[3] = (u32x4){cvtpk(p1[8], p1[9]), cvtpk(p1[10], p1[11]), cvtpk(p1[12], p1[13]), cvtpk(p1[14], p1[15])};
#pragma unroll
            for (int d = 0; d < DV / 32; ++d)
#pragma unroll
                for (int j = 0; j < 4; ++j) { const bf16x8 vf = *(const LAS bf16x8*)(buf + KTILE + (32 * d + r32) * KROW + 32 * j + 16 * hi);
                    o[d] = __builtin_amdgcn_mfma_f32_32x32x16_bf16(vf, __builtin_bit_cast(bf16x8, pw[j]), o[d], 0, 0, 0); }
        }
    }
    lsum = xor32_sum(lsum);
    if (SWA) { lsum += __builtin_amdgcn_exp2f(sink2 - mrun);
        const float inv = 1.0f / lsum; bf16_t* op = Obf + (size_t)qpos * DM;
#pragma unroll
        for (int d = 0; d < DV / 32; ++d)
#pragma unroll
            for (int g = 0; g < 4; ++g) { u32x2 wv; wv.x = cvtpk(o[d][4 * g] * inv, o[d][4 * g + 1] * inv); wv.y = cvtpk(o[d][4 * g + 2] * inv, o[d][4 * g + 3] * inv);
                *(u32x2*)(op + 32 * d + 8 * g + 4 * hi) = wv; }
    } else { float* op = Of32 + (size_t)qpos * 1024;
#pragma unroll
        for (int d = 0; d < DV / 32; ++d)
#pragma unroll
            for (int g = 0; g < 4; ++g) *(f32x4*)(op + 32 * d + 8 * g + 4 * hi) = (f32x4){o[d][4 * g], o[d][4 * g + 1], o[d][4 * g + 2], o[d][4 * g + 3]};
        if (hi == 0) *(f32x2*)(MLp + (size_t)qpos * 16) = (f32x2){mrun, lsum};
    }
    __syncthreads();
}

__device__ __forceinline__ void phase_diffcombine(KP p, int l, int gw, int NGW, int lane) {
    const float* lamv = p->in[3] + l * 256;
    const float lambda_init = 0.8f - 0.6f * expf(-0.3f * (float)l);
    const float s1 = wave_sum(lamv[lane] * lamv[64 + lane]), s2 = wave_sum(lamv[128 + lane] * lamv[192 + lane]);
    const float lam = expf(s1) - expf(s2) + lambda_init;
    const float* OD = (const float*)(p->ws + WS_OD); const float* ML = (const float*)(p->ws + WS_ML); bf16_t* MIX = (bf16_t*)(p->ws + WS_MIX);
    const int h = lane >> 4, d0 = (lane & 15) * 8;
    const f32x4 g0 = *(const f32x4*)(p->in[4] + l * 128 + d0), g1 = *(const f32x4*)(p->in[4] + l * 128 + d0 + 4);
    for (int t = gw; t < M; t += NGW) { const int nseg = ((t >> 8) + 8) >> 3;
        f32x4 oc[2][2];
#pragma unroll
        for (int c = 0; c < 2; ++c) {
            f32x2 ml[4]; float mm = -1e30f;
#pragma unroll
            for (int s = 0; s < 4; ++s) if (s < nseg) { ml[s] = *(const f32x2*)(ML + ((size_t)s * M + t) * 16 + h * 4 + c * 2); mm = fmaxf(mm, ml[s].x); }
            f32x4 a0 = (f32x4){0.f, 0.f, 0.f, 0.f}, a1 = a0; float L = 0.f;
#pragma unroll
            for (int s = 0; s < 4; ++s) if (s < nseg) { const float f = exp2f(ml[s].x - mm); L += ml[s].y * f;
                const float* b = OD + ((size_t)s * M + t) * 1024 + h * 256 + c * 128 + d0; a0 += *(const f32x4*)b * f; a1 += *(const f32x4*)(b + 4) * f; }
            const float inv = 1.0f / L; oc[c][0] = a0 * inv; oc[c][1] = a1 * inv; }
        const f32x4 o0 = oc[0][0] - oc[1][0] * lam, o1 = oc[0][1] - oc[1][1] * lam;
        float ss = (o0[0] * o0[0] + o0[1] * o0[1]) + (o0[2] * o0[2] + o0[3] * o0[3]) + (o1[0] * o1[0] + o1[1] * o1[1]) + (o1[2] * o1[2] + o1[3] * o1[3]);
        ss = row16_sum(ss);
        const float r = rsqrtf(ss * (1.0f / 128.0f) + EPS) * (1.0f - lambda_init);
        const f32x4 y0 = o0 * g0 * r, y1 = o1 * g1 * r;
        u32x4 wv; wv.x = cvtpk(y0[0], y0[1]); wv.y = cvtpk(y0[2], y0[3]); wv.z = cvtpk(y1[0], y1[1]); wv.w = cvtpk(y1[2], y1[3]);
        *(u32x4*)(MIX + (size_t)t * DM + h * 128 + d0) = wv; }
}

#define XB_TMO      128
#define XB_XCNT(j)  (256  + 64 * (j))
#define XB_XSUB(j)  (1280 + 64 * (j))
#define XB_XGEN(j)  (2304 + 64 * (j))
#define XB_TOP      3328
#define XB_TOPGEN   3392
#define XCD_BAR_WORDS 3456
#define XB_SPIN_CAP (1u << 22)
__device__ __forceinline__ unsigned xb_ld(unsigned* p)              { return __hip_atomic_load(p, __ATOMIC_RELAXED, __HIP_MEMORY_SCOPE_AGENT); }
__device__ __forceinline__ unsigned xb_add(unsigned* p, unsigned v) { return __hip_atomic_fetch_add(p, v, __ATOMIC_RELAXED, __HIP_MEMORY_SCOPE_AGENT); }
__device__ __forceinline__ unsigned xb_xcc_id() { return (unsigned)__builtin_amdgcn_s_getreg((3 << 11) | 20) & 0xFu; }
#define XB_SPIN(cond, bar) do { unsigned _sp = 0; while (cond) { __builtin_amdgcn_s_sleep(1); \
    if ((++_sp & 255u) == 0u) { if (xb_ld(&(bar)[XB_TMO])) break; if (_sp > XB_SPIN_CAP) { atomicAdd(&(bar)[XB_TMO], 1u); break; } } } } while (0)
__device__ __forceinline__ void xcd_barrier_complete(unsigned* bar, unsigned x, unsigned& nloc, unsigned& nx) {
    const unsigned G = gridDim.x;
    unsigned sum, cnt, mine, sp = 0u;
    for (;;) {
        sum = 0u; cnt = 0u; mine = 0u;
#pragma unroll
        for (unsigned j = 0; j < 16; ++j) { const unsigned c = xb_ld(&bar[XB_XCNT(j)]); sum += c; cnt += (c > 0u) ? 1u : 0u; mine = (j == x) ? c : mine; }
        if (sum == G) break;
        __builtin_amdgcn_s_sleep(1);
        if ((++sp & 255u) == 0u) { if (xb_ld(&bar[XB_TMO])) break; if (sp > XB_SPIN_CAP) { atomicAdd(&bar[XB_TMO], 1u); break; } }
    }
    nloc = mine > 0u ? mine : 1u; nx = cnt > 0u ? cnt : 1u;
}
__device__ __forceinline__ void xcd_barrier(unsigned* bar, volatile LAS unsigned* st, const int tid) {
    asm volatile("s_waitcnt vmcnt(0)" ::: "memory");
    __syncthreads();
    if (tid == 0) {
        const unsigned x = xb_xcc_id();
        __builtin_amdgcn_s_waitcnt(0);
        unsigned nloc = st[0], nx = st[1];
        if (nloc == 0u) { xcd_barrier_complete(bar, x, nloc, nx); st[0] = nloc; st[1] = nx; }
        const unsigned old = xb_add(&bar[XB_XSUB(x)], 1u);
        const unsigned gen = old / nloc;
        if (old + 1u == (gen + 1u) * nloc) {
            __builtin_amdgcn_fence(__ATOMIC_RELEASE, "agent");
            asm volatile("s_waitcnt vmcnt(0)" ::: "memory");
            const unsigned og = xb_add(&bar[XB_TOP], 1u);
            const unsigned tg = og / nx;
            if (og + 1u == (tg + 1u) * nx) xb_add(&bar[XB_TOPGEN], 1u);
            else XB_SPIN(xb_ld(&bar[XB_TOPGEN]) == tg, bar);
            __builtin_amdgcn_fence(__ATOMIC_ACQUIRE, "agent");
            xb_add(&bar[XB_XGEN(x)], 1u);
            asm volatile("s_waitcnt vmcnt(0)" ::: "memory");
        } else {
            XB_SPIN(xb_ld(&bar[XB_XGEN(x)]) == gen, bar);
            __builtin_amdgcn_fence(__ATOMIC_ACQUIRE, "agent");
            asm volatile("s_waitcnt vmcnt(0)" ::: "memory");
        }
    }
    __syncthreads();
}

#ifndef DUPBAR
#define DUPBAR 1
#endif
#define GSYNC() do { FRESH(); for (int rb_ = 0; rb_ < DUPBAR; ++rb_) xcd_barrier((unsigned*)(p->ws + WS_CTL) + 4096, (volatile LAS unsigned*)(lds + LDS_BYTES - 32), tid); } while (0)
#define PTRS() unsigned* ctl = (unsigned*)(p->ws + WS_CTL); bf16_t* XB = (bf16_t*)(p->ws + WS_XB); bf16_t* PROJ = (bf16_t*)(p->ws + WS_PROJ); bf16_t* MIX = (bf16_t*)(p->ws + WS_MIX); bf16_t* H = (bf16_t*)(p->ws + WS_H); \
    float* ssqA = (float*)(p->ws + WS_SSQA); float* ssqB = (float*)(p->ws + WS_SSQB); unsigned char* wb = p->ws + WS_W + (size_t)l * LW_STRIDE; (void)ctl; (void)XB; (void)PROJ; (void)MIX; (void)H; (void)ssqA; (void)ssqB; (void)wb
#define FRESH() KP p = fresh_params(); int G = gridDim.x, bx = blockIdx.x; asm volatile("" : "+s"(G), "+s"(bx)); const int NGW = G * 8; (void)NGW; const int tid = fresh_tid(wave0), lane = tid & 63, wave = __builtin_amdgcn_readfirstlane(tid >> 6), gw = bx * 8 + wave; (void)lane; (void)gw
template <int L> __device__ __forceinline__ void layer_body(LAS unsigned char* lds, const int wave0) {
    constexpr int l = L;

#ifndef DUP1
#define DUP1 1
#endif
        for (int rep = 0; rep < DUP1; ++rep) {   if (rep) GSYNC(); FRESH(); PTRS(); pg8::Gemm g{XB, (const bf16_t*)(wb + LW_WIN), M, INCP, DM}; pg8::StaticOrder S; S.init(M, INCP, G, bx);
            pg8::EpiProj E{PROJ, INCP, ssqA};
            pg8::gemm_phase<pg8::EpiProj, pg8::StaticOrder, true, true>(lds, g, S, E, tid); }
        GSYNC();
#ifndef DUP234
#define DUP234 1
#endif
        for (int rep = 0; rep < DUP234; ++rep) { if (rep) GSYNC(); FRESH(); phase_prep1(p, l, lds, gw, NGW, wave, lane); }
        GSYNC();
        {   FRESH(); PTRS(); pg8::Gemm g{(const bf16_t*)(p->ws + WS_AW), (const bf16_t*)(wb + LW_W2T), M, 1024, 128}; pg8::StaticOrder S; S.init(M, 1024, G, bx);
            pg8::EpiLora<0> E{(float*)(p->ws + WS_DEC), p->in[7] + l * 1024};
            pg8::gemm_phase<pg8::EpiLora<0>, pg8::StaticOrder, true, true>(lds, g, S, E, tid); }
        {   FRESH(); PTRS(); pg8::Gemm g{(const bf16_t*)(p->ws + WS_AA), (const bf16_t*)(wb + LW_A2T), M, 1024, 128}; pg8::StaticOrder S; S.init(M, 1024, G, (bx + 128) % G);
            pg8::EpiLora<1> E{(float*)(p->ws + WS_A), p->in[9] + l * 1024};
            pg8::gemm_phase<pg8::EpiLora<1>, pg8::StaticOrder, true, true>(lds, g, S, E, tid); }
        {   FRESH(); PTRS(); pg8::Gemm g{(const bf16_t*)(p->ws + WS_AG), (const bf16_t*)(wb + LW_G2T), M, 1024, 256}; pg8::StaticOrder S; S.init(M, 1024, G, (bx + 128) % G);
            pg8::EpiLora<2> E{(float*)(p->ws + WS_G), nullptr};
            pg8::gemm_phase<pg8::EpiLora<2>, pg8::StaticOrder, true, true>(lds, g, S, E, tid); }
        GSYNC();
        {   FRESH(); LAS unsigned char* wl = lds + wave * 14336;
#ifndef DUP57
#define DUP57 1
#endif
            for (int rep = 0; rep < DUP57; ++rep) for (int it = gw; it < 2 * NCH * 16; it += NGW) { const int mode = it & 1, ch = it >> 1, c = ch % NCH, h = ch / NCH;
                if (mode == 0) scan_task<0>(p, l, wl, c, h, lane); else scan_task<1>(p, l, wl, c, h, lane); } }
        GSYNC();
#ifndef DUP6
#define DUP6 1
#endif
        for (int rep = 0; rep < DUP6; ++rep) {   if (rep) GSYNC(); FRESH(); PTRS(); LAS int* slot = (LAS int*)(lds + LDS_BYTES - 64);
            LAS float* knl = (LAS float*)(lds + LDS_BYTES - 128);
            {   LAS float* kr = (LAS float*)lds; const float* knp = (const float*)(p->ws + WS_KNP); const int g = tid & 7, part = tid >> 3; float m = 0.f;
                for (int b2 = part; b2 < G; b2 += 64) m = fmaxf(m, knp[(size_t)b2 * 8 + g]);
                kr[part * 8 + g] = m; __syncthreads();
                if (tid < 8) { float mm = kr[tid]; for (int q2 = 1; q2 < 64; ++q2) mm = fmaxf(mm, kr[q2 * 8 + tid]); knl[tid] = mm; }
                __syncthreads(); }
            const float* sinks = p->in[5] + l * 8;
            for (;;) {
                if (tid == 0) *slot = (int)atomicAdd(ctl + 64 * (l + 1) + 16 * rep, 1u);
                __syncthreads();
                const int it = *slot;
                __syncthreads();
                if (it >= 656) break;
                if (it < 16) {
#ifndef NO_S2
                    s2_head(p, lds, it, tid);
#endif
                }
                else if (it < 656) { const int d = it - 16, h = 3 - d / 160, u = d % 160, c = u & 1, v = u >> 1; int qb, seg;
                    if (v < 32) { qb = 31 - (v >> 2); seg = v & 3; } else if (v < 56) { const int w2 = v - 32; qb = 23 - w2 / 3; seg = w2 % 3; }
                    else if (v < 72) { const int w2 = v - 56; qb = 15 - (w2 >> 1); seg = w2 & 1; } else { qb = 79 - v; seg = 0; }
                    const float slope2 = exp2f(-2.0f * (float)(h + 1)) * LOG2E;
                    const float kn = sqrtf(knl[h * 2 + c]);
                    const int kt1 = 4 * qb + 3, klo = 32 * seg, khi = (klo + 31 < kt1) ? klo + 31 : kt1;
                    attn_unit<128, false>(lds, PROJ + h * 128 + c * 64, PROJ + 512 + h * 128 + c * 64, (const bf16_t*)(p->ws + WS_VAT) + (size_t)(h * 128) * M, slope2, qb * 256, 0.f,
                                          (float*)(p->ws + WS_OD) + (size_t)seg * M * 1024 + h * 256 + c * 128, (float*)(p->ws + WS_ML) + (size_t)seg * M * 16 + h * 4 + c * 2, nullptr, tid, klo, khi, kn); }
            } }
        GSYNC();
        {   FRESH(); LAS unsigned char* wl = lds + wave * 14336;
            for (int rep = 0; rep < DUP57; ++rep) for (int it = gw; it < NCH * 16; it += NGW) { const int c = it % NCH, h = it / NCH; scan_task<2>(p, l, wl, c, h, lane); }
            phase_diffcombine(p, l, gw, NGW, lane);
            __syncthreads();
            {   PTRS(); LAS int* slot = (LAS int*)(lds + LDS_BYTES - 64); const float* sinks = p->in[5] + l * 8;
                constexpr int NCONV = (l + 1 < NL) ? (CONV_ITEMS + 7) / 8 : 0;
                for (;;) {
                    if (tid == 0) *slot = 656 + (int)atomicAdd(ctl + 64 * (l + 1) + 32, 1u);
                    __syncthreads();
                    const int it = *slot;
                    __syncthreads();
                    if (it >= 912 + NCONV) break;
                    if (it >= 912) { const int r = 8 * (it - 912) + wave; if (r < CONV_ITEMS) convert_item(p, l + 1, r, (LAS float*)(lds + wave * 16384), lane); continue; }
                { const int s = it - 656, hq = s & 7, qb = s >> 3;
                    const int aidx = (hq >> 1) * 3 + (hq & 1);
                    const float slope2 = exp2f(-8.0f * (float)(aidx + 1) / 12.0f) * LOG2E;
                    const int q0 = qb * 256;
                    attn_unit<64, true>(lds, PROJ + 1536 + hq * 64, PROJ + 2048 + (hq >> 2) * 64, (const bf16_t*)(p->ws + WS_VBT) + (size_t)((hq >> 2) * 64) * M, slope2, q0, sinks[hq] * LOG2E,
                                        nullptr, nullptr, MIX + 512 + hq * 64, tid, q0 >= 128 ? (q0 - 128) / 64 : 0, (q0 + 255) / 64, 0.f); }
                } } }
        GSYNC();
        {   FRESH(); PTRS(); pg8::Gemm g{MIX, (const bf16_t*)(wb + LW_WOUT), M, DM, DM}; pg8::StaticOrder S; S.init(M, DM, G, bx);
            pg8::EpiResid E{p->out, XB, ssqB};
            pg8::gemm_phase<pg8::EpiResid, pg8::StaticOrder, true, true>(lds, g, S, E, tid); }
        GSYNC();
        for (int rep = 0; rep < DUP1; ++rep) {   if (rep) GSYNC(); FRESH(); PTRS(); pg8::Gemm g{XB, (const bf16_t*)(wb + LW_WGU), M, GU, DM}; pg8::StaticOrder S; S.init(M, GU, G, bx);
            pg8::EpiSwiGLU E{H, ssqB};
            pg8::gemm_phase<pg8::EpiSwiGLU, pg8::StaticOrder, true, true>(lds, g, S, E, tid); }
        GSYNC();
        {   FRESH(); PTRS(); pg8::Gemm g{H, (const bf16_t*)(wb + LW_WDN), M, DM, FF}; pg8::StaticOrder S; S.init(M, DM, G, bx);
            pg8::EpiResid E{p->out, XB, ssqA};
            pg8::gemm_phase<pg8::EpiResid, pg8::StaticOrder, true, true>(lds, g, S, E, tid); }
        GSYNC();
    }

__global__ void __launch_bounds__(512, 2) fwd_megakernel(Params p_unused) {
    extern __shared__ __attribute__((aligned(16))) unsigned char lds_raw[];
    LAS unsigned char* lds = (LAS unsigned char*)lds_raw;
    cg::grid_group grid = cg::this_grid();
    const int wave0 = __builtin_amdgcn_readfirstlane((int)threadIdx.x >> 6);
    if (threadIdx.x < 16) ((LAS unsigned*)(lds + LDS_BYTES - 64))[threadIdx.x] = 0u;
    if (threadIdx.x == 0) xb_add((unsigned*)(p_unused.ws + WS_CTL) + 4096 + XB_XCNT(xb_xcc_id()), 1u);
    __syncthreads();

#ifndef DUP0
#define DUP0 1
#endif
    for (int rep = 0; rep < DUP0; ++rep) { FRESH(); phase0(p, lds, gw, NGW, wave, lane); __syncthreads(); }
    grid.sync();

    layer_body<0>(lds, wave0); layer_body<1>(lds, wave0); layer_body<2>(lds, wave0); layer_body<3>(lds, wave0);
    {   FRESH(); const int l = 0; PTRS(); const float* gf = p->in[21];
        for (int m = gw; m < M; m += NGW) { const float rs = rsqrtf(wave_sum(lane < 32 ? ssqA[(size_t)m * 32 + lane] : 0.f) * (1.0f / DM) + EPS);
#pragma unroll
            for (int j = 0; j < 8; ++j) { const size_t o = (size_t)m * DM + j * 256 + lane * 4; const f32x4 v = *(const f32x4*)(p->out + o); const f32x4 gv = *(const f32x4*)(gf + j * 256 + lane * 4);
                *(f32x4*)(p->out + o) = v * rs * gv; } } }
}

extern "C" void kernel_launch(void* const* d_in, const int* in_sizes, int n_in, void* d_out, int out_size, void* d_ws, size_t ws_size, hipStream_t stream) {
    static int grid = 0;
    if (grid == 0) {
        if (n_in != 22 || out_size != M * DM || ws_size < WS_END) { fprintf(stderr, "kernel_launch: unexpected shapes (n_in %d out %d ws %zu need %zu)\n", n_in, out_size, ws_size, (size_t)WS_END); grid = -1; return; }
        int dev = 0, cus = 0, per_cu = 0;
        hipGetDevice(&dev); hipDeviceGetAttribute(&cus, hipDeviceAttributeMultiprocessorCount, dev);
        hipFuncSetAttribute((const void*)fwd_megakernel, hipFuncAttributeMaxDynamicSharedMemorySize, LDS_BYTES);
        hipOccupancyMaxActiveBlocksPerMultiprocessor(&per_cu, (const void*)fwd_megakernel, 512, LDS_BYTES);
        if (per_cu < 1) { fprintf(stderr, "kernel_launch: occupancy query says %d blocks per CU\n", per_cu); per_cu = 1; }
        (void)hipGetLastError();
        grid = cus;
    }
    if (grid < 0) return;
    hipMemsetAsync((char*)d_ws + WS_CTL, 0, 65536, stream);
    Params p{};
    for (int i = 0; i < 22; ++i) p.in[i] = (const float*)d_in[i];
    p.out = (float*)d_out; p.ws = (unsigned char*)d_ws;
    void* args[] = {&p};
    hipError_t e = hipLaunchCooperativeKernel((const void*)fwd_megakernel, dim3(grid), dim3(512), args, LDS_BYTES, stream);
    if (e != hipSuccess) fprintf(stderr, "cooperative launch failed: %s (grid %d)\n", hipGetErrorString(e), grid);
}
```

```cpp
#include <hip/hip_runtime.h>
#include <hip/hip_cooperative_groups.h>
#include <cstdio>
#include <cstdint>
namespace cg = cooperative_groups;

#define LAS __attribute__((address_space(3)))
typedef unsigned short bf16_t;
typedef short bf16x8 __attribute__((ext_vector_type(8)));
typedef float f32x4 __attribute__((ext_vector_type(4)));
typedef float f32x2 __attribute__((ext_vector_type(2)));
typedef float f32x16 __attribute__((ext_vector_type(16)));
typedef unsigned u32x4 __attribute__((ext_vector_type(4)));
typedef unsigned u32x2 __attribute__((ext_vector_type(2)));
typedef __bf16 bf16x2_t __attribute__((ext_vector_type(2)));

constexpr int M = 8192, DM = 2048, INC = 5824, INCP = 5888, FF = 5632, GU = 11264, RW0 = 2304, RWC = 3520;
constexpr int NL = 4, NCH = 64, CL = 128;
constexpr float EPS = 1e-5f, LOG2E = 1.4426950408889634f;
constexpr float QSC = 0.125f * LOG2E;

constexpr size_t MiB = 1u << 20;
constexpr size_t SZ_WIN = (size_t)INCP * DM * 2, SZ_WOUT = (size_t)DM * DM * 2, SZ_WGU = (size_t)GU * DM * 2, SZ_WDN = (size_t)DM * FF * 2;
constexpr size_t SZ_W2T = 1024 * 128 * 2, SZ_G2T = 1024 * 256 * 2;
constexpr size_t LW_WIN = 0, LW_WOUT = LW_WIN + SZ_WIN, LW_WGU = LW_WOUT + SZ_WOUT, LW_WDN = LW_WGU + SZ_WGU, LW_W2T = LW_WDN + SZ_WDN,
                 LW_A2T = LW_W2T + SZ_W2T, LW_G2T = LW_A2T + SZ_W2T, LW_STRIDE = LW_G2T + SZ_G2T;
constexpr size_t SZ_F = (size_t)M * 1024 * 4;
constexpr size_t WS_CTL = 0, WS_W = 1 * MiB, WS_XB = WS_W + NL * LW_STRIDE, WS_PROJ = WS_XB + (size_t)M * DM * 2,
                 WS_VAT = WS_PROJ + (size_t)M * INCP * 2, WS_VBT = WS_VAT + (size_t)512 * M * 2, WS_AW = WS_VBT + (size_t)128 * M * 2,
                 WS_AA = WS_AW + (size_t)M * 128 * 2, WS_AG = WS_AA + (size_t)M * 128 * 2, WS_R = WS_AG + (size_t)M * 256 * 2,
                 WS_KR = WS_R + SZ_F, WS_V = WS_KR + SZ_F, WS_DEC = WS_V + SZ_F, WS_A = WS_DEC + SZ_F, WS_G = WS_A + SZ_F,
                 WS_KF = WS_G + SZ_F, WS_AN = WS_KF + SZ_F, WS_BB = WS_AN + SZ_F, WS_PB = WS_BB + SZ_F, WS_UB = WS_PB + SZ_F,
                 WS_SI = WS_UB + SZ_F, WS_OD = WS_SI + SZ_F, WS_ML = WS_OD + 4 * SZ_F, WS_KNP = WS_ML + (size_t)4 * M * 16 * 4, WS_MIX = WS_KNP + 65536, WS_SSQA = WS_MIX + (size_t)M * DM * 2,
                 WS_SSQB = WS_SSQA + (size_t)M * 32 * 4, WS_END = WS_SSQB + (size_t)M * 32 * 4;
constexpr size_t WS_H = WS_PROJ;
static_assert((size_t)M * FF * 2 <= (size_t)M * INCP * 2, "H overlay");

constexpr int LDS_BYTES = 147456;

struct Params { const float* in[22]; float* out; unsigned char* ws; };
typedef const __attribute__((address_space(4))) Params* KP;
__device__ __forceinline__ KP fresh_params() { KP k = (KP)__builtin_amdgcn_kernarg_segment_ptr(); asm volatile("" : "+s"(k)); return k; }

__device__ __forceinline__ unsigned cvtpk(float lo, float hi) { f32x2 v = {lo, hi}; bf16x2_t b = __builtin_convertvector(v, bf16x2_t); return __builtin_bit_cast(unsigned, b); }
__device__ __forceinline__ float bf2f(unsigned short b) { return __builtin_bit_cast(float, (unsigned)b << 16); }
__device__ __forceinline__ float bflo(unsigned w) { return __builtin_bit_cast(float, w << 16); }
__device__ __forceinline__ float bfhi(unsigned w) { return __builtin_bit_cast(float, w & 0xffff0000u); }
template <int CTRL> __device__ __forceinline__ float dppm(float v) { return __builtin_bit_cast(float, __builtin_amdgcn_mov_dpp(__builtin_bit_cast(int, v), CTRL, 0xF, 0xF, true)); }
__device__ __forceinline__ float xor16_sum(float v) { const unsigned b = __builtin_bit_cast(unsigned, v); auto rr = __builtin_amdgcn_permlane16_swap(b, b, false, false); return __builtin_bit_cast(float, (unsigned)rr[0]) + __builtin_bit_cast(float, (unsigned)rr[1]); }
__device__ __forceinline__ float xor32_sum(float v) { const unsigned b = __builtin_bit_cast(unsigned, v); auto rr = __builtin_amdgcn_permlane32_swap(b, b, false, false); return __builtin_bit_cast(float, (unsigned)rr[0]) + __builtin_bit_cast(float, (unsigned)rr[1]); }
__device__ __forceinline__ float xor32_max(float v) { const unsigned b = __builtin_bit_cast(unsigned, v); auto rr = __builtin_amdgcn_permlane32_swap(b, b, false, false); return fmaxf(__builtin_bit_cast(float, (unsigned)rr[0]), __builtin_bit_cast(float, (unsigned)rr[1])); }
__device__ __forceinline__ float row16_sum(float v) { v += dppm<0xB1>(v); v += dppm<0x4E>(v); v += dppm<0x141>(v); v += dppm<0x140>(v); return v; }
__device__ __forceinline__ float wave_sum(float v) { return xor32_sum(xor16_sum(row16_sum(v))); }
__device__ __forceinline__ float dpp_xor1(float v) { return __builtin_bit_cast(float, __builtin_amdgcn_mov_dpp(__builtin_bit_cast(int, v), 0xB1, 0xF, 0xF, true)); }
__device__ __forceinline__ float dpp_xor2(float v) { return __builtin_bit_cast(float, __builtin_amdgcn_mov_dpp(__builtin_bit_cast(int, v), 0x4E, 0xF, 0xF, true)); }
__device__ __forceinline__ float quad_sum(float v) { v += dpp_xor1(v); v += dpp_xor2(v); return v; }
__device__ __forceinline__ float sigmoidf_(float x) { return __builtin_amdgcn_rcpf(1.0f + __expf(-x)); }

__device__ __forceinline__ int fresh_tid(int wave0) { unsigned z = 0u; asm volatile("" : "+v"(z)); int t = wave0 * 64 + (int)__builtin_amdgcn_mbcnt_hi(~0u, __builtin_amdgcn_mbcnt_lo(~0u, z)); asm volatile("" : "+v"(t)); return t; }

__device__ __forceinline__ float row_rstd(const float* ssq, int row, int fq) {
    const float* pp = ssq + (size_t)row * 32 + 8 * fq; const f32x4 a = *(const f32x4*)pp, b = *(const f32x4*)(pp + 4);
    float s = ((a[0] + a[1]) + (a[2] + a[3])) + ((b[0] + b[1]) + (b[2] + b[3]));
    s = xor32_sum(xor16_sum(s));
    return rsqrtf(s * (1.0f / DM) + EPS);
}

namespace pg8 {
constexpr int BM = 256, BK = 64, HALF = 128, HTB = HALF * BK * 2, STAGE_BYTES = 8 * HTB, NXCD = 8, WGM = 8;
__host__ __device__ __forceinline__ int lds_byte(int r, int c) { const int st = (r >> 4) * 2 + (c >> 5), rr = r & 15, cc = c & 31, ob = rr * 64 + cc * 2; return st * 1024 + (ob ^ (((ob >> 9) & 1) << 5)); }
__host__ __device__ __forceinline__ void stage_rc(int b, int& R, int& C) { const int st = b / 1024, sb = b % 1024, swz = sb ^ (((sb >> 9) & 1) << 5); R = (st >> 1) * 16 + swz / 64; C = (st & 1) * 32 + (swz % 64) / 2; }
__host__ __device__ __forceinline__ int perm32(int rho) { const int n = rho >> 4, i = rho & 15; return 8 * (i >> 2) + 4 * n + (i & 3); }
struct Unit { int pm, pn; };
struct Gemm { const bf16_t* A; const bf16_t* Bt; int M, N, K; };
struct StaticOrder {
    int nM, nN, nwg, G, c;
    __host__ __device__ void init(int M_, int N_, int G_, int c_) { nM = M_ / BM; nN = N_ / BM; nwg = nM * nN; G = G_; c = c_; }
    __host__ __device__ bool next(int i, Unit& u) const {
        const long L = (long)i * G + c; if (L >= nwg) return false;
        int wgid = (int)L; { const int q = nwg / NXCD, r = nwg % NXCD, xcd = wgid % NXCD, off = wgid / NXCD; wgid = (xcd < r ? xcd * (q + 1) : r * (q + 1) + (xcd - r) * q) + off; }
        const int nig = WGM * nN, gid = wgid / nig, fm = gid * WGM, gsz = (nM - fm) < WGM ? (nM - fm) : WGM;
        u.pm = fm + ((wgid % nig) % gsz); u.pn = (wgid % nig) / gsz; return true;
    }
};

template <class Epi, class Sched, bool ALIGN_EPI, bool SP2>
__device__ __forceinline__ void gemm_phase(LAS unsigned char* lds, const Gemm g, const Sched& S, const Epi& E, const int tid) {
    const int wid = __builtin_amdgcn_readfirstlane(tid >> 6), lane = tid & 63, wr = wid >> 2, wc = wid & 3, fr = lane & 15, fq = lane >> 4;
    const int K = g.K, nt = K / BK;
    unsigned voffA[2], voffB[2];
#pragma unroll
    for (int i = 0; i < 2; ++i) { int R, C; stage_rc(tid * 16 + i * 8192, R, C); const int Rb = Epi::PERM ? ((R & ~31) + perm32(R & 31)) : R;
        voffA[i] = (unsigned)(R * K + C) * 2u; voffB[i] = (unsigned)(Rb * K + C) * 2u; }
    const size_t kstep = (size_t)(BK * 2);
    const size_t hstep = (size_t)HALF * K * 2;
    const size_t tstep = 2 * hstep;
    const unsigned ldsw = (unsigned)wid * 1024u;
    const int aoff = lds_byte(wr * 64 + fr, fq * 8), boff = lds_byte(wc * 32 + fr, fq * 8);
#define PG8_SA(b, h) (((b) * 2 + (h)) * HTB)
#define PG8_SB(b, h) ((4 + (b) * 2 + (h)) * HTB)
#define PG8_STAGE(bufoff, gbase, voff) do { _Pragma("unroll") for (int _i = 0; _i < 2; ++_i) \
        __builtin_amdgcn_global_load_lds((const unsigned*)((const char*)(gbase) + (voff)[_i]), (LAS unsigned*)(lds + (bufoff) + ldsw + _i * 8192), 16, 0, 0); } while (0)
#define PG8_LDA(dst, b, h) do { _Pragma("unroll") for (int m = 0; m < 4; ++m) _Pragma("unroll") for (int k = 0; k < 2; ++k) dst[m][k] = *(const LAS bf16x8*)(lds + PG8_SA(b, h) + aoff + m * 2048 + k * 1024); } while (0)
#define PG8_LDB(dst, b, h) do { _Pragma("unroll") for (int n = 0; n < 2; ++n) _Pragma("unroll") for (int k = 0; k < 2; ++k) dst[n][k] = *(const LAS bf16x8*)(lds + PG8_SB(b, h) + boff + n * 2048 + k * 1024); } while (0)
#define PG8_MMA(ai, bj, At, Bt) do { __builtin_amdgcn_s_setprio(1); _Pragma("unroll") for (int m = 0; m < 4; ++m) _Pragma("unroll") for (int n = 0; n < 2; ++n) _Pragma("unroll") for (int k = 0; k < 2; ++k) \
        acc[ai][bj][m][n] = __builtin_amdgcn_mfma_f32_16x16x32_bf16(Bt[n][k], At[m][k], acc[ai][bj][m][n], 0, 0, 0); __builtin_amdgcn_s_setprio(0); } while (0)
#define PG8_WAIT_V(n) asm volatile("s_waitcnt vmcnt(" #n ")" ::: "memory")
#define PG8_WAIT_L(n) asm volatile("s_waitcnt lgkmcnt(" #n ")" ::: "memory")
#define PG8_BAR __builtin_amdgcn_s_barrier()
#define PG8_SCHED __builtin_amdgcn_sched_barrier(0)
    Unit cur, nxt; int ui = 0;
    if (!S.next(0, cur)) return;
    f32x4 acc[2][2][4][2];
#pragma unroll
    for (int a = 0; a < 2; ++a)
#pragma unroll
        for (int b = 0; b < 2; ++b)
#pragma unroll
            for (int m = 0; m < 4; ++m)
#pragma unroll
                for (int n = 0; n < 2; ++n) acc[a][b][m][n] = (f32x4){0.f, 0.f, 0.f, 0.f};
    bf16x8 At[4][2], B0[2][2], B1[2][2];
    const char* cA = (const char*)g.A + (size_t)cur.pm * tstep; const char* cB = (const char*)g.Bt + (size_t)cur.pn * tstep;
    if constexpr (SP2) {
        PG8_STAGE(PG8_SB(0, 0), cB, voffB); PG8_STAGE(PG8_SB(0, 1), cB + hstep, voffB); PG8_STAGE(PG8_SA(0, 0), cA, voffA); PG8_STAGE(PG8_SA(0, 1), cA + hstep, voffA);
        if (wr == 1) PG8_BAR;
        PG8_WAIT_V(2); PG8_BAR;
        PG8_STAGE(PG8_SB(1, 0), cB + kstep, voffB); PG8_STAGE(PG8_SA(1, 0), cA + kstep, voffA); PG8_STAGE(PG8_SB(1, 1), cB + hstep + kstep, voffB);
        PG8_WAIT_V(6); PG8_BAR;
    } else {
        PG8_STAGE(PG8_SB(0, 0), cB, voffB); PG8_STAGE(PG8_SA(0, 0), cA, voffA); PG8_STAGE(PG8_SB(0, 1), cB + hstep, voffB); PG8_STAGE(PG8_SA(0, 1), cA + hstep, voffA);
        if (wr == 1) PG8_BAR;
        PG8_WAIT_V(4); PG8_BAR;
        PG8_STAGE(PG8_SB(1, 0), cB + kstep, voffB); PG8_STAGE(PG8_SA(1, 0), cA + kstep, voffA); PG8_STAGE(PG8_SB(1, 1), cB + hstep + kstep, voffB);
        PG8_WAIT_V(6); PG8_BAR;
    }
    for (;;) {
        const bool has_next = S.next(ui + 1, nxt);
        const char* nA = has_next ? (const char*)g.A + (size_t)nxt.pm * tstep : cA; const char* nB = has_next ? (const char*)g.Bt + (size_t)nxt.pn * tstep : cB;
        for (int t = 0; t < nt; t += 2) {
            const bool last = (t == nt - 2);
            const char* a1 = cA + (size_t)(t + 1) * kstep;
            const char* a2 = last ? nA : cA + (size_t)(t + 2) * kstep; const char* b2 = last ? nB : cB + (size_t)(t + 2) * kstep;
            const char* a3 = a2 + kstep; const char* b3 = b2 + kstep;
            if constexpr (SP2) {
            PG8_LDB(B0, 0, 0); PG8_LDB(B1, 0, 1); PG8_SCHED; PG8_LDA(At, 0, 0); PG8_STAGE(PG8_SA(1, 1), a1 + hstep, voffA);
            PG8_WAIT_V(8); PG8_WAIT_L(0); PG8_BAR; PG8_MMA(0, 0, At, B0); PG8_MMA(0, 1, At, B1); PG8_BAR; PG8_SCHED;
            PG8_LDA(At, 0, 1); PG8_STAGE(PG8_SB(0, 0), b2, voffB); PG8_STAGE(PG8_SB(0, 1), b2 + hstep, voffB); PG8_STAGE(PG8_SA(0, 0), a2, voffA);
            PG8_WAIT_V(8); PG8_WAIT_L(0); PG8_BAR; PG8_MMA(1, 0, At, B0); PG8_MMA(1, 1, At, B1); PG8_BAR; PG8_SCHED;
            PG8_LDB(B0, 1, 0); PG8_LDB(B1, 1, 1); PG8_SCHED; PG8_LDA(At, 1, 0); PG8_STAGE(PG8_SA(0, 1), a2 + hstep, voffA);
            PG8_WAIT_V(8); PG8_WAIT_L(0); PG8_BAR; PG8_MMA(0, 0, At, B0); PG8_MMA(0, 1, At, B1); PG8_BAR; PG8_SCHED;
            PG8_LDA(At, 1, 1); PG8_STAGE(PG8_SB(1, 0), b3, voffB); PG8_STAGE(PG8_SB(1, 1), b3 + hstep, voffB); PG8_STAGE(PG8_SA(1, 0), a3, voffA);
            PG8_WAIT_V(8); PG8_WAIT_L(0); PG8_BAR; PG8_MMA(1, 0, At, B0); PG8_MMA(1, 1, At, B1); PG8_BAR; PG8_SCHED;
            } else {
            PG8_LDB(B0, 0, 0); PG8_SCHED; PG8_LDA(At, 0, 0); PG8_STAGE(PG8_SA(1, 1), a1 + hstep, voffA);
            PG8_WAIT_L(8); PG8_BAR; PG8_WAIT_L(0); PG8_MMA(0, 0, At, B0); PG8_BAR; PG8_SCHED;
            PG8_LDB(B1, 0, 1); PG8_STAGE(PG8_SB(0, 0), b2, voffB);
            PG8_BAR; PG8_WAIT_L(0); PG8_MMA(0, 1, At, B1); PG8_BAR;
            PG8_LDA(At, 0, 1); PG8_STAGE(PG8_SA(0, 0), a2, voffA);
            PG8_BAR; PG8_WAIT_L(0); PG8_MMA(1, 0, At, B0); PG8_BAR; PG8_SCHED;
            PG8_STAGE(PG8_SB(0, 1), b2 + hstep, voffB);
            PG8_WAIT_V(6); PG8_BAR; PG8_MMA(1, 1, At, B1); PG8_BAR;
            PG8_LDB(B0, 1, 0); PG8_SCHED; PG8_LDA(At, 1, 0); PG8_STAGE(PG8_SA(0, 1), a2 + hstep, voffA);
            PG8_WAIT_L(8); PG8_BAR; PG8_WAIT_L(0); PG8_MMA(0, 0, At, B0); PG8_BAR; PG8_SCHED;
            PG8_LDB(B1, 1, 1); PG8_STAGE(PG8_SB(1, 0), b3, voffB);
            PG8_BAR; PG8_WAIT_L(0); PG8_MMA(0, 1, At, B1); PG8_BAR;
            PG8_LDA(At, 1, 1); PG8_STAGE(PG8_SA(1, 0), a3, voffA);
            PG8_BAR; PG8_WAIT_L(0); PG8_MMA(1, 0, At, B0); PG8_BAR; PG8_SCHED;
            PG8_STAGE(PG8_SB(1, 1), b3 + hstep, voffB);
            PG8_WAIT_V(6); PG8_BAR; PG8_MMA(1, 1, At, B1); PG8_BAR;
            }
        }
        if constexpr (ALIGN_EPI) { if (wr == 0) PG8_BAR; }
        E(acc, cur, wr, wc, fr, fq);
        if (!has_next) break;
#pragma unroll
        for (int a = 0; a < 2; ++a)
#pragma unroll
            for (int b = 0; b < 2; ++b)
#pragma unroll
                for (int m = 0; m < 4; ++m)
#pragma unroll
                    for (int n = 0; n < 2; ++n) acc[a][b][m][n] = (f32x4){0.f, 0.f, 0.f, 0.f};
        cur = nxt; cA = nA; cB = nB; ++ui;
        if constexpr (ALIGN_EPI) { if (wr == 1) PG8_BAR; }
    }
    PG8_WAIT_V(0);
    if constexpr (!ALIGN_EPI) { if (wr == 0) PG8_BAR; }
    PG8_BAR;
#undef PG8_SA
#undef PG8_SB
#undef PG8_STAGE
#undef PG8_LDA
#undef PG8_LDB
#undef PG8_MMA
#undef PG8_WAIT_V
#undef PG8_WAIT_L
#undef PG8_BAR
#undef PG8_SCHED
}

struct EpiProj {
    static constexpr bool PERM = true;
    bf16_t* O; int ldc; const float* ssq;
    __device__ __forceinline__ void operator()(const f32x4 (&acc)[2][2][4][2], const Unit& u, int wr, int wc, int fr, int fq) const {
        const int row0 = u.pm * BM + wr * 64 + fr, col0 = u.pn * BM + wc * 32 + 8 * fq;
#pragma unroll
        for (int ai = 0; ai < 2; ++ai)
#pragma unroll
            for (int m = 0; m < 4; ++m) { const int row = row0 + ai * HALF + m * 16; const float rs = row_rstd(ssq, row, fq);
                bf16_t* rowp = O + (size_t)row * ldc + col0;
#pragma unroll
                for (int bj = 0; bj < 2; ++bj) { const f32x4 v0 = acc[ai][bj][m][0] * rs, v1 = acc[ai][bj][m][1] * rs;
                    u32x4 w; w.x = cvtpk(v0[0], v0[1]); w.y = cvtpk(v0[2], v0[3]); w.z = cvtpk(v1[0], v1[1]); w.w = cvtpk(v1[2], v1[3]);
                    *(u32x4*)(rowp + bj * HALF) = w; } }
    }
};
struct EpiSwiGLU {
    static constexpr bool PERM = true;
    bf16_t* O; const float* ssq;
    __device__ __forceinline__ void operator()(const f32x4 (&acc)[2][2][4][2], const Unit& u, int wr, int wc, int fr, int fq) const {
        const int row0 = u.pm * BM + wr * 64 + fr, col0 = u.pn * HALF + wc * 32 + 8 * fq;
#pragma unroll
        for (int ai = 0; ai < 2; ++ai)
#pragma unroll
            for (int m = 0; m < 4; ++m) { const int row = row0 + ai * HALF + m * 16; const float rs = row_rstd(ssq, row, fq);
                float h[8];
#pragma unroll
                for (int n = 0; n < 2; ++n)
#pragma unroll
                    for (int j = 0; j < 4; ++j) { const float gt = acc[ai][0][m][n][j] * rs, up = acc[ai][1][m][n][j] * rs; h[n * 4 + j] = gt * up * __builtin_amdgcn_rcpf(1.0f + __expf(-gt)); }
                u32x4 w; w.x = cvtpk(h[0], h[1]); w.y = cvtpk(h[2], h[3]); w.z = cvtpk(h[4], h[5]); w.w = cvtpk(h[6], h[7]);
                *(u32x4*)(O + (size_t)row * FF + col0) = w; }
    }
};
struct EpiResid {
    static constexpr bool PERM = false;
    float* X; bf16_t* XB; float* ssq;
    __device__ __forceinline__ void operator()(const f32x4 (&acc)[2][2][4][2], const Unit& u, int wr, int wc, int fr, int fq) const {
        const int row0 = u.pm * BM + wr * 64 + fr, col0 = u.pn * BM + wc * 32 + 4 * fq;
#pragma unroll
        for (int ai = 0; ai < 2; ++ai)
#pragma unroll
            for (int m = 0; m < 4; ++m) { const int row = row0 + ai * HALF + m * 16; const size_t off = (size_t)row * DM + col0; float ss = 0.f;
#pragma unroll
                for (int bj = 0; bj < 2; ++bj)
#pragma unroll
                    for (int n = 0; n < 2; ++n) { const size_t o = off + bj * HALF + n * 16; const f32x4 xv = *(const f32x4*)(X + o) + acc[ai][bj][m][n];
                        *(f32x4*)(X + o) = xv; u32x2 w; w.x = cvtpk(xv[0], xv[1]); w.y = cvtpk(xv[2], xv[3]); *(u32x2*)(XB + o) = w;
                        ss += (xv[0] * xv[0] + xv[1] * xv[1]) + (xv[2] * xv[2] + xv[3] * xv[3]); }
                ss = xor32_sum(xor16_sum(ss));
                if (fq == 0) ssq[(size_t)row * 32 + u.pn * 4 + wc] = ss; }
    }
};
template <int MODE> struct EpiLora {
    static constexpr bool PERM = false;
    float* O; const float* bias;
    __device__ __forceinline__ void operator()(const f32x4 (&acc)[2][2][4][2], const Unit& u, int wr, int wc, int fr, int fq) const {
        const int row0 = u.pm * BM + wr * 64 + fr, col0 = u.pn * BM + wc * 32 + 4 * fq;
#pragma unroll
        for (int bj = 0; bj < 2; ++bj)
#pragma unroll
            for (int n = 0; n < 2; ++n) { const int col = col0 + bj * HALF + n * 16;
                f32x4 bv = (f32x4){0.f, 0.f, 0.f, 0.f}; if (MODE != 2) bv = *(const f32x4*)(bias + col);
#pragma unroll
                for (int ai = 0; ai < 2; ++ai)
#pragma unroll
                    for (int m = 0; m < 4; ++m) { const int row = row0 + ai * HALF + m * 16; f32x4 v = acc[ai][bj][m][n] + bv;
                        if (MODE == 0) {
#pragma unroll
                            for (int j = 0; j < 4; ++j) { const float z = -v[j]; const float sp = fmaxf(z, 0.f) + __logf(1.0f + __expf(-fabsf(z))); v[j] = __expf(-__expf(-sp - 0.5f)); }
                        } else if (MODE == 1) {
#pragma unroll
                            for (int j = 0; j < 4; ++j) v[j] = sigmoidf_(v[j]);
                        }
                        *(f32x4*)(O + (size_t)row * 1024 + col) = v; } }
    }
};
}

template <int MAP>
__device__ __forceinline__ void transpose_item(const float* W, int K, int N, bf16_t* WT, const float* gk, LAS float* scr, int item, int lane) {
    const int nblk = N / 32, kb = item / nblk, nb = item % nblk, k0 = 64 * kb, n0 = 32 * nb;
    float v[32];
    const float* wp = W + (size_t)(k0 + (lane >> 5)) * N + n0 + (lane & 31);
#pragma unroll
    for (int i = 0; i < 32; ++i) v[i] = __builtin_nontemporal_load(wp + (size_t)(2 * i) * N);
    const int c = lane & 7;
    f32x4 g0 = (f32x4){1.f, 1.f, 1.f, 1.f}, g1 = g0;
    if (gk) { g0 = *(const f32x4*)(gk + k0 + 8 * c); g1 = *(const f32x4*)(gk + k0 + 8 * c + 4); }
#pragma unroll
    for (int i = 0; i < 32; ++i) scr[(2 * i + (lane >> 5)) * 33 + (lane & 31)] = v[i];
    asm volatile("s_waitcnt lgkmcnt(0)" ::: "memory");
#pragma unroll
    for (int j = 0; j < 4; ++j) { const int n = n0 + (lane >> 3) + 8 * j; const LAS float* s = scr + (8 * c) * 33 + (n - n0);
        float sc = 1.f; int drow = n;
        if (MAP == 0) { if (n < 512 || (n >= 1536 && n < 2048)) sc = QSC; }
        if (MAP == 1) { const int hn = n < FF ? n : n - FF; drow = (hn >> 7) * 256 + (n < FF ? 0 : 128) + (hn & 127); }
        const f32x4 h0 = g0 * sc, h1 = g1 * sc;
        u32x4 o; o.x = cvtpk(s[0 * 33] * h0[0], s[1 * 33] * h0[1]); o.y = cvtpk(s[2 * 33] * h0[2], s[3 * 33] * h0[3]); o.z = cvtpk(s[4 * 33] * h1[0], s[5 * 33] * h1[1]); o.w = cvtpk(s[6 * 33] * h1[2], s[7 * 33] * h1[3]);
        *(u32x4*)(WT + (size_t)drow * K + k0 + 8 * c) = o; }
    asm volatile("s_waitcnt lgkmcnt(0)" ::: "memory");
}

constexpr int I_IN = (DM / 64) * (INC / 32), I_OUT = (DM / 64) * (DM / 32), I_GU = (DM / 64) * (GU / 32), I_DN = (FF / 64) * (DM / 32);
constexpr int CONV_ITEMS = I_IN + I_OUT + I_GU + I_DN;
__device__ __forceinline__ void convert_item(KP p, int l, int r, LAS float* scr, int lane) {
    unsigned char* wb = p->ws + WS_W + (size_t)l * LW_STRIDE;
    if (r < I_IN) { transpose_item<0>(p->in[2] + (size_t)l * DM * INC, DM, INC, (bf16_t*)(wb + LW_WIN), p->in[1] + l * DM, scr, r, lane); return; } r -= I_IN;
    if (r < I_OUT) { transpose_item<2>(p->in[17] + (size_t)l * DM * DM, DM, DM, (bf16_t*)(wb + LW_WOUT), nullptr, scr, r, lane); return; } r -= I_OUT;
    if (r < I_GU) { transpose_item<1>(p->in[19] + (size_t)l * DM * GU, DM, GU, (bf16_t*)(wb + LW_WGU), p->in[18] + l * DM, scr, r, lane); return; } r -= I_GU;
    transpose_item<2>(p->in[20] + (size_t)l * FF * DM, FF, DM, (bf16_t*)(wb + LW_WDN), nullptr, scr, r, lane);
}

__device__ __forceinline__ void phase0(KP p, LAS unsigned char* lds, int gw, int NGW, int wave, int lane) {
    LAS float* scr = (LAS float*)(lds + wave * 16384);
    for (int it = gw; it < CONV_ITEMS; it += NGW) convert_item(p, 0, it, scr, lane);
    const int gt = gw * 64 + lane, NGT = NGW * 64;
    for (int l = 0; l < NL; ++l) {
        unsigned char* wb = p->ws + WS_W + (size_t)l * LW_STRIDE;
        bf16_t* w2t = (bf16_t*)(wb + LW_W2T); bf16_t* a2t = (bf16_t*)(wb + LW_A2T); bf16_t* g2t = (bf16_t*)(wb + LW_G2T);
        const float* w2 = p->in[8] + (size_t)l * 96 * 1024; const float* a2 = p->in[10] + (size_t)l * 96 * 1024; const float* g2 = p->in[11] + (size_t)l * 256 * 1024;
        for (int i = gt; i < 1024 * 128; i += NGT) { const int n = i >> 7, k = i & 127;
            w2t[i] = (bf16_t)(cvtpk(k < 96 ? w2[k * 1024 + n] : 0.f, 0.f) & 0xffff); a2t[i] = (bf16_t)(cvtpk(k < 96 ? a2[k * 1024 + n] : 0.f, 0.f) & 0xffff); }
        for (int i = gt; i < 1024 * 256; i += NGT) { const int n = i >> 8, k = i & 255; g2t[i] = (bf16_t)(cvtpk(g2[k * 1024 + n], 0.f) & 0xffff); }
        unsigned* padz = (unsigned*)(wb + LW_WIN + (size_t)INC * DM * 2);
        for (int i = gt; i < (INCP - INC) * DM / 2; i += NGT) padz[i] = 0u;
    }
    const float* x = p->in[0]; float* X = p->out; bf16_t* XB = (bf16_t*)(p->ws + WS_XB); float* ssqA = (float*)(p->ws + WS_SSQA);
    for (int m = gw; m < M; m += NGW) { float ss = 0.f;
#pragma unroll
        for (int j = 0; j < 8; ++j) { const size_t o = (size_t)m * DM + j * 256 + lane * 4; const f32x4 v = *(const f32x4*)(x + o); *(f32x4*)(X + o) = v;
            u32x2 w; w.x = cvtpk(v[0], v[1]); w.y = cvtpk(v[2], v[3]); *(u32x2*)(XB + o) = w; ss += (v[0] * v[0] + v[1] * v[1]) + (v[2] * v[2] + v[3] * v[3]); }
        ss = wave_sum(ss); if (lane < 32) ssqA[(size_t)m * 32 + lane] = lane == 0 ? ss : 0.f; }
}

__device__ __forceinline__ void phase_prep1(KP p, int l, LAS unsigned char* lds, int gw, int NGW, int wave, int lane) {
    const bf16_t* PROJ = (const bf16_t*)(p->ws + WS_PROJ);
    LAS unsigned short* tile = (LAS unsigned short*)(lds + wave * 8448);
    bf16_t* VAT = (bf16_t*)(p->ws + WS_VAT); bf16_t* VBT = (bf16_t*)(p->ws + WS_VBT);
    for (int it = gw; it < 128 * 10; it += NGW) {
        const int tb = it / 10, g = it % 10, t0 = tb * 64; const int cbase = g < 8 ? 1024 + 64 * g : 2176 + 64 * (g - 8);
        bf16_t* dst = g < 8 ? VAT + (size_t)(64 * g) * M : VBT + (size_t)(64 * (g - 8)) * M;
#pragma unroll
        for (int i = 0; i < 8; ++i) { const int row = i * 8 + (lane >> 3), ch = lane & 7; const u32x4 v = *(const u32x4*)(PROJ + (size_t)(t0 + row) * INCP + cbase + 8 * ch);
            LAS unsigned* d = (LAS unsigned*)(tile + row * 66 + 8 * ch); d[0] = v.x; d[1] = v.y; d[2] = v.z; d[3] = v.w; }
        asm volatile("s_waitcnt lgkmcnt(0)" ::: "memory");
#pragma unroll
        for (int i = 0; i < 8; ++i) { const int c = i * 8 + (lane >> 3), tch = lane & 7, j = tch >> 1, hi = tch & 1; unsigned short v[8];
#pragma unroll
            for (int s = 0; s < 8; ++s) v[s] = tile[(16 * j + (s & 3) + 8 * (s >> 2) + 4 * hi) * 66 + c];
            u32x4 o; o.x = v[0] | ((unsigned)v[1] << 16); o.y = v[2] | ((unsigned)v[3] << 16); o.z = v[4] | ((unsigned)v[5] << 16); o.w = v[6] | ((unsigned)v[7] << 16);
            *(u32x4*)(dst + (size_t)c * M + t0 + 16 * j + 8 * hi) = o; }
        asm volatile("s_waitcnt lgkmcnt(0)" ::: "memory");
    }
    const float* mu = p->in[6] + (size_t)l * RWC;
    bf16_t* AW = (bf16_t*)(p->ws + WS_AW); bf16_t* AA = (bf16_t*)(p->ws + WS_AA); bf16_t* AG = (bf16_t*)(p->ws + WS_AG);
    float knmax = 0.f;
    for (int t = gw; t < M; t += NGW) {
        const bf16_t* cur = PROJ + (size_t)t * INCP + RW0;
        {   const u32x4 kv = *(const u32x4*)(PROJ + (size_t)t * INCP + 512 + 8 * lane);
            float a0 = bflo(kv.x), a1 = bfhi(kv.x), a2 = bflo(kv.y), a3 = bfhi(kv.y), a4 = bflo(kv.z), a5 = bfhi(kv.z), a6 = bflo(kv.w), a7 = bfhi(kv.w);
            float ss = (a0 * a0 + a1 * a1) + (a2 * a2 + a3 * a3) + (a4 * a4 + a5 * a5) + (a6 * a6 + a7 * a7);
            ss += dppm<0xB1>(ss); ss += dppm<0x4E>(ss); ss += dppm<0x141>(ss); knmax = fmaxf(knmax, ss); }
        if (lane < 56) { const int j0 = 3072 + 8 * lane;
            const u32x4 c4 = *(const u32x4*)(cur + j0); u32x4 p4 = (u32x4){0u, 0u, 0u, 0u}; if (t > 0) p4 = *(const u32x4*)(cur - INCP + j0);
            const f32x4 m0 = *(const f32x4*)(mu + j0), m1 = *(const f32x4*)(mu + j0 + 4);
            float f[8]; const unsigned cw[4] = {c4.x, c4.y, c4.z, c4.w}, pw[4] = {p4.x, p4.y, p4.z, p4.w};
#pragma unroll
            for (int q = 0; q < 4; ++q) { const float c0 = bflo(cw[q]), c1 = bfhi(cw[q]), p0 = bflo(pw[q]), p1 = bfhi(pw[q]);
                const float mu0 = q < 2 ? m0[2 * q] : m1[2 * q - 4], mu1 = q < 2 ? m0[2 * q + 1] : m1[2 * q - 3];
                f[2 * q] = c0 + (p0 - c0) * mu0; f[2 * q + 1] = c1 + (p1 - c1) * mu1; }
            bf16_t* dstp;
            if (j0 < 3168) { dstp = AW + (size_t)t * 128 + (j0 - 3072);
#pragma unroll
                for (int q = 0; q < 8; ++q) f[q] = tanhf(f[q]); }
            else if (j0 < 3264) { dstp = AA + (size_t)t * 128 + (j0 - 3168); }
            else { dstp = AG + (size_t)t * 256 + (j0 - 3264);
#pragma unroll
                for (int q = 0; q < 8; ++q) f[q] = sigmoidf_(f[q]); }
            u32x4 o; o.x = cvtpk(f[0], f[1]); o.y = cvtpk(f[2], f[3]); o.z = cvtpk(f[4], f[5]); o.w = cvtpk(f[6], f[7]); *(u32x4*)dstp = o; }
        else { const int e = lane - 56; if (e < 4) *(u32x4*)(AW + (size_t)t * 128 + 96 + 8 * e) = (u32x4){0u, 0u, 0u, 0u}; else *(u32x4*)(AA + (size_t)t * 128 + 96 + 8 * (e - 4)) = (u32x4){0u, 0u, 0u, 0u}; }
    }
    {   LAS float* kr = (LAS float*)(lds + 8 * 8448);
        if ((lane & 7) == 0) kr[wave * 8 + (lane >> 3)] = knmax;
        __syncthreads();
        if (wave == 0 && lane < 8) { float m = kr[lane];
#pragma unroll
            for (int w2 = 1; w2 < 8; ++w2) m = fmaxf(m, kr[w2 * 8 + lane]);
            ((float*)(p->ws + WS_KNP))[(size_t)(gw >> 3) * 8 + lane] = m; }
        __syncthreads(); }
}

__device__ __forceinline__ void phase_prep2(KP p, int l, int gw, int NGW, int lane) {
    const float* KR = (const float*)(p->ws + WS_KR); const float* A = (const float*)(p->ws + WS_A);
    float* KF = (float*)(p->ws + WS_KF); float* AN = (float*)(p->ws + WS_AN); float* BB = (float*)(p->ws + WS_BB);
    const float* k_k = p->in[12] + l * 1024; const float* k_a = p->in[13] + l * 1024;
    const int c0 = 16 * lane;
    for (int t = gw; t < M; t += NGW) { const size_t o = (size_t)t * 1024 + c0; float n2 = 0.f; f32x4 kkv[4], kr[4], av[4];
#pragma unroll
        for (int q = 0; q < 4; ++q) { kr[q] = *(const f32x4*)(KR + o + 4 * q); av[q] = *(const f32x4*)(A + o + 4 * q); kkv[q] = kr[q] * *(const f32x4*)(k_k + c0 + 4 * q);
            n2 += (kkv[q][0] * kkv[q][0] + kkv[q][1] * kkv[q][1]) + (kkv[q][2] * kkv[q][2] + kkv[q][3] * kkv[q][3]); }
        n2 = quad_sum(n2); const float inv = 1.0f / fmaxf(sqrtf(n2), 1e-12f);
#pragma unroll
        for (int q = 0; q < 4; ++q) { const f32x4 kk = kkv[q] * inv; const f32x4 ka = *(const f32x4*)(k_a + c0 + 4 * q);
            *(f32x4*)(KF + o + 4 * q) = kr[q] * (1.0f + (av[q] - 1.0f) * ka); *(f32x4*)(AN + o + 4 * q) = -kk; *(f32x4*)(BB + o + 4 * q) = kk * av[q]; }
    }
}

template <int MODE>
__device__ __forceinline__ void scan_task(KP p, int l, LAS unsigned char* wl, int c, int h, int lane) {
    constexpr int NPV = MODE == 0 ? 1 : (MODE == 1 ? 2 : 3);
    constexpr int SB = 4;
    LAS float* vec = (LAS float*)wl;
    LAS float* ybuf = (LAS float*)(wl + 7 * SB * 256);
    const float* DECp = (const float*)(p->ws + WS_DEC); const float* Ap = (const float*)(p->ws + WS_A); const bf16_t* PROJ = (const bf16_t*)(p->ws + WS_PROJ);
    const int rb = lane >> 2, cb = lane & 3, t0 = c * CL;
    f32x2 s[4][8];
    if (MODE == 0) {
#pragma unroll
        for (int r = 0; r < 4; ++r)
#pragma unroll
            for (int q = 0; q < 8; ++q) { s[r][q].x = (4 * rb + r == 16 * cb + 2 * q) ? 1.f : 0.f; s[r][q].y = (4 * rb + r == 16 * cb + 2 * q + 1) ? 1.f : 0.f; }
    } else if (MODE == 1) {
#pragma unroll
        for (int r = 0; r < 4; ++r)
#pragma unroll
            for (int q = 0; q < 8; ++q) s[r][q] = (f32x2){0.f, 0.f};
    } else {
        const float* SI = (const float*)(p->ws + WS_SI) + ((size_t)(h * NCH + c)) * 4096;
#pragma unroll
        for (int x = 0; x < 16; ++x) { const f32x4 v = *(const f32x4*)(SI + (16 * cb + x) * 64 + 4 * rb);
#pragma unroll
            for (int r = 0; r < 4; ++r) { if (x & 1) s[r][x >> 1].y = v[r]; else s[r][x >> 1].x = v[r]; } }
    }
    const int lst = lane >> 4, lq = lane & 15;
    const f32x4 kk4 = *(const f32x4*)(p->in[12] + l * 1024 + 64 * h + 4 * lq), ka4 = *(const f32x4*)(p->in[13] + l * 1024 + 64 * h + 4 * lq);
    f32x4 lnw4 = (f32x4){0.f, 0.f, 0.f, 0.f}, lnb4 = lnw4, rk4 = lnw4;
    if (MODE == 2) { lnw4 = *(const f32x4*)(p->in[15] + l * 1024 + 64 * h + 4 * lq); lnb4 = *(const f32x4*)(p->in[16] + l * 1024 + 64 * h + 4 * lq); rk4 = *(const f32x4*)(p->in[14] + l * 1024 + 64 * h + 4 * lq); }
    const size_t goff = (size_t)(t0 + lst) * 1024 + 64 * h + 4 * lq;
    const int pvo[3] = {1024, 2048, 0};
    f32x4 mu4[NPV];
#pragma unroll
    for (int v = 0; v < NPV; ++v) mu4[v] = *(const f32x4*)(p->in[6] + (size_t)l * RWC + pvo[v] + 64 * h + 4 * lq);
    const bf16_t* pj = PROJ + (size_t)(t0 + lst) * INCP + RW0 + 64 * h + 4 * lq;
    const float* Gp = (const float*)(p->ws + WS_G);
    struct Pre { f32x4 dec, a, g; u32x2 cur[NPV], prv[NPV]; };
    Pre pA, pB;
#define SCAN_LOAD(P_, SBI) do { if ((SBI) < CL / SB) { const size_t ro = (size_t)(SB * (SBI)); P_.dec = *(const f32x4*)(DECp + goff + ro * 1024); P_.a = *(const f32x4*)(Ap + goff + ro * 1024); \
        if constexpr (MODE == 2) P_.g = *(const f32x4*)(Gp + goff + ro * 1024); \
        const bool first = (t0 + (int)ro + lst) == 0; \
        _Pragma("unroll") for (int v = 0; v < NPV; ++v) { P_.cur[v] = *(const u32x2*)(pj + ro * INCP + pvo[v]); P_.prv[v] = first ? (u32x2){0u, 0u} : *(const u32x2*)(pj + ro * INCP + pvo[v] - INCP); } } } while (0)
#define SCAN_SHIFT(P_, V) ({ const f32x4 c_ = (f32x4){bflo(P_.cur[V].x), bfhi(P_.cur[V].x), bflo(P_.cur[V].y), bfhi(P_.cur[V].y)}, q_ = (f32x4){bflo(P_.prv[V].x), bfhi(P_.prv[V].x), bflo(P_.prv[V].y), bfhi(P_.prv[V].y)}; c_ + (q_ - c_) * mu4[V]; })
#define SCAN_STAGE(P_) do { const f32x4 kr = SCAN_SHIFT(P_, 0), av = P_.a; const f32x4 kkv = kr * kk4; \
        float n2 = (kkv[0] * kkv[0] + kkv[1] * kkv[1]) + (kkv[2] * kkv[2] + kkv[3] * kkv[3]); n2 = row16_sum(n2); \
        const float inv = __builtin_amdgcn_rsqf(fmaxf(n2, 1e-24f)); const f32x4 kkn = kkv * inv; \
        LAS float* vw = vec + lst * 64 + 4 * lq; \
        *(LAS f32x4*)(vw + 0 * SB * 64) = P_.dec; *(LAS f32x4*)(vw + 1 * SB * 64) = -kkn; *(LAS f32x4*)(vw + 2 * SB * 64) = kkn * av; \
        if constexpr (MODE != 0) { *(LAS f32x4*)(vw + 3 * SB * 64) = kr * (1.0f + (av - 1.0f) * ka4); *(LAS f32x4*)(vw + 4 * SB * 64) = SCAN_SHIFT(P_, 1); } \
        if constexpr (MODE == 2) { *(LAS f32x4*)(vw + 5 * SB * 64) = SCAN_SHIFT(P_, 2); *(LAS f32x4*)(vw + 6 * SB * 64) = P_.g; } } while (0)
    SCAN_LOAD(pA, 0); SCAN_LOAD(pB, 1);
    for (int sb = 0; sb < CL / SB; ++sb) {
        if (sb & 1) { SCAN_STAGE(pB); SCAN_LOAD(pB, sb + 2); } else { SCAN_STAGE(pA); SCAN_LOAD(pA, sb + 2); }
#pragma unroll 1
        for (int st = 0; st < SB; ++st) {
            const LAS float* vb = vec + st * 64 + 16 * cb;
            float sa[4];
            {   f32x2 a2[8];
#pragma unroll
                for (int q = 0; q < 4; ++q) { const f32x4 y = *(const LAS f32x4*)(vb + 1 * SB * 64 + 4 * q); a2[2 * q] = (f32x2){y[0], y[1]}; a2[2 * q + 1] = (f32x2){y[2], y[3]}; }
#pragma unroll
                for (int r = 0; r < 4; ++r) { f32x2 a = s[r][0] * a2[0];
#pragma unroll
                    for (int q = 1; q < 8; ++q) a = s[r][q] * a2[q] + a;
                    sa[r] = quad_sum(a.x + a.y); } }
            f32x4 vv = (f32x4){0.f, 0.f, 0.f, 0.f};
            if (MODE != 0) vv = *(const LAS f32x4*)(vec + (4 * SB + st) * 64 + 4 * rb);
#pragma unroll
            for (int q = 0; q < 4; ++q) { const f32x4 w4 = *(const LAS f32x4*)(vb + 0 * SB * 64 + 4 * q), b4 = *(const LAS f32x4*)(vb + 2 * SB * 64 + 4 * q);
                const f32x2 w0 = (f32x2){w4[0], w4[1]}, w1 = (f32x2){w4[2], w4[3]}, b0 = (f32x2){b4[0], b4[1]}, b1 = (f32x2){b4[2], b4[3]};
                if (MODE == 0) {
#pragma unroll
                    for (int r = 0; r < 4; ++r) { s[r][2 * q] = s[r][2 * q] * w0 + b0 * sa[r]; s[r][2 * q + 1] = s[r][2 * q + 1] * w1 + b1 * sa[r]; }
                } else { const f32x4 k4 = *(const LAS f32x4*)(vb + 3 * SB * 64 + 4 * q); const f32x2 k0 = (f32x2){k4[0], k4[1]}, k1 = (f32x2){k4[2], k4[3]};
#pragma unroll
                    for (int r = 0; r < 4; ++r) { s[r][2 * q] = s[r][2 * q] * w0 + (b0 * sa[r] + k0 * vv[r]); s[r][2 * q + 1] = s[r][2 * q + 1] * w1 + (b1 * sa[r] + k1 * vv[r]); }
                } }
            if (MODE == 2) {
                f32x2 r2[8];
#pragma unroll
                for (int q = 0; q < 4; ++q) { const f32x4 x = *(const LAS f32x4*)(vb + 5 * SB * 64 + 4 * q); r2[2 * q] = (f32x2){x[0], x[1]}; r2[2 * q + 1] = (f32x2){x[2], x[3]}; }
                f32x4 yv;
#pragma unroll
                for (int r = 0; r < 4; ++r) { f32x2 a = s[r][0] * r2[0];
#pragma unroll
                    for (int q = 1; q < 8; ++q) a = s[r][q] * r2[q] + a;
                    yv[r] = quad_sum(a.x + a.y); }
                if (cb == 0) *(LAS f32x4*)(ybuf + st * 64 + 4 * rb) = yv;
            }
        }
        if (MODE == 2) {
            bf16_t* MIX = (bf16_t*)(p->ws + WS_MIX);
            const int t = t0 + SB * sb + lst; const LAS float* vr = vec + lst * 64 + 4 * lq;
            const f32x4 y = *(const LAS f32x4*)(ybuf + lst * 64 + 4 * lq), rr = *(const LAS f32x4*)(vr + 5 * SB * 64), kk = *(const LAS f32x4*)(vr + 3 * SB * 64),
                        vv = *(const LAS f32x4*)(vr + 4 * SB * 64), g = *(const LAS f32x4*)(vr + 6 * SB * 64);
            const float mean = row16_sum((y[0] + y[1]) + (y[2] + y[3])) * (1.0f / 64.0f);
            const f32x4 d = y - mean;
            const float var = row16_sum((d[0] * d[0] + d[1] * d[1]) + (d[2] * d[2] + d[3] * d[3])) * (1.0f / 64.0f);
            const f32x4 rkk = rr * kk * rk4;
            const float bon = row16_sum((rkk[0] + rkk[1]) + (rkk[2] + rkk[3]));
            const f32x4 o = (d * __builtin_amdgcn_rsqf(var + 64e-5f) * lnw4 + lnb4 + vv * bon) * g;
            u32x2 wv; wv.x = cvtpk(o[0], o[1]); wv.y = cvtpk(o[2], o[3]);
            *(u32x2*)(MIX + (size_t)t * DM + 1024 + 64 * h + 4 * lq) = wv;
        }
    }
    if (MODE == 0) { float* dst = (float*)(p->ws + WS_PB) + ((size_t)(h * NCH + c)) * 4096;
#pragma unroll
        for (int r = 0; r < 4; ++r)
#pragma unroll
            for (int q = 0; q < 4; ++q) *(f32x4*)(dst + (4 * rb + r) * 64 + 16 * cb + 4 * q) = (f32x4){s[r][2 * q].x, s[r][2 * q].y, s[r][2 * q + 1].x, s[r][2 * q + 1].y}; }
    if (MODE == 1) { float* dst = (float*)(p->ws + WS_UB) + ((size_t)(h * NCH + c)) * 4096;
#pragma unroll
        for (int x = 0; x < 16; ++x) { f32x4 v;
#pragma unroll
            for (int r = 0; r < 4; ++r) v[r] = (x & 1) ? s[r][x >> 1].y : s[r][x >> 1].x;
            *(f32x4*)(dst + (16 * cb + x) * 64 + 4 * rb) = v; } }
}

#undef SCAN_LOAD
#undef SCAN_SHIFT
#undef SCAN_STAGE
__device__ __forceinline__ void s2_head(KP p, LAS unsigned char* lds, int h, const int tid) {
    const float* PB = (const float*)(p->ws + WS_PB) + (size_t)h * NCH * 4096; const float* UT = (const float*)(p->ws + WS_UB) + (size_t)h * NCH * 4096;
    float* SI = (float*)(p->ws + WS_SI) + (size_t)h * NCH * 4096;
    const int lane = tid & 63, w = __builtin_amdgcn_readfirstlane(tid >> 6), n = lane & 31, lh = lane >> 5, to = (w >> 1) & 1, ti = w & 1;
    static_assert((NCH - 1) % 3 == 0, "three rotating prefetch buffers");
    if (w >= 4) {
        for (int c = 0; c < NCH - 1; ++c) __syncthreads();
    } else {
        f32x16 sreg, ua, ub, uc2; float pa[32], pb[32], pc2[32];
#pragma unroll
        for (int r = 0; r < 16; ++r) sreg[r] = 0.f;
        const int offu = (32 * to + 4 * lh) * 64 + 32 * ti + n, offp = (4 * lh) * 64 + 32 * to + n;
#define S2_LOAD(CH, U_, P_) do { const int ch_ = (CH) < NCH - 1 ? (CH) : NCH - 2; const float* pb_ = PB + (size_t)ch_ * 4096 + offp; const float* ub_ = UT + (size_t)ch_ * 4096 + offu; \
        _Pragma("unroll") for (int r = 0; r < 16; ++r) { const int cr = ((r & 3) + 8 * (r >> 2)) * 64; U_[r] = ub_[cr]; P_[r] = pb_[cr]; P_[16 + r] = pb_[2048 + cr]; } } while (0)
#define S2_STEP(C, UC_, PC_, UN_, PN_) do { \
        {   float* si = SI + (size_t)(C) * 4096 + offu; \
            _Pragma("unroll") for (int r = 0; r < 16; ++r) si[((r & 3) + 8 * (r >> 2)) * 64] = sreg[r]; } \
        LAS f32x4* ex = (LAS f32x4*)(lds + ((C) & 1) * 16384); \
        _Pragma("unroll") for (int q = 0; q < 4; ++q) ex[(w * 4 + q) * 64 + lane] = (f32x4){sreg[4 * q], sreg[4 * q + 1], sreg[4 * q + 2], sreg[4 * q + 3]}; \
        __syncthreads(); \
        S2_LOAD((C) + 2, UN_, PN_); \
        f32x16 preg; \
        _Pragma("unroll") for (int q = 0; q < 4; ++q) { const f32x4 v = ex[((w ^ 2) * 4 + q) * 64 + lane]; preg[4 * q] = v[0]; preg[4 * q + 1] = v[1]; preg[4 * q + 2] = v[2]; preg[4 * q + 3] = v[3]; } \
        f32x16 acc = UC_; \
        if (to == 0) { \
            _Pragma("unroll") for (int r = 0; r < 16; ++r) acc = __builtin_amdgcn_mfma_f32_32x32x2f32(PC_[r], sreg[r], acc, 0, 0, 0); \
            _Pragma("unroll") for (int r = 0; r < 16; ++r) acc = __builtin_amdgcn_mfma_f32_32x32x2f32(PC_[16 + r], preg[r], acc, 0, 0, 0); \
        } else { \
            _Pragma("unroll") for (int r = 0; r < 16; ++r) acc = __builtin_amdgcn_mfma_f32_32x32x2f32(PC_[r], preg[r], acc, 0, 0, 0); \
            _Pragma("unroll") for (int r = 0; r < 16; ++r) acc = __builtin_amdgcn_mfma_f32_32x32x2f32(PC_[16 + r], sreg[r], acc, 0, 0, 0); } \
        sreg = acc; } while (0)
        S2_LOAD(0, ua, pa); S2_LOAD(1, ub, pb);
#pragma unroll 1
        for (int c = 0; c < NCH - 1; c += 3) {
            S2_STEP(c, ua, pa, uc2, pc2);
            S2_STEP(c + 1, ub, pb, ua, pa);
            S2_STEP(c + 2, uc2, pc2, ub, pb);
        }
        {   float* si = SI + (size_t)(NCH - 1) * 4096 + offu;
#pragma unroll
            for (int r = 0; r < 16; ++r) si[((r & 3) + 8 * (r >> 2)) * 64] = sreg[r]; }
#undef S2_LOAD
#undef S2_STEP
    }
    __syncthreads();
}

template <int DV, bool SWA>
__device__ __forceinline__ void attn_unit(LAS unsigned char* lds, const bf16_t* Q, const bf16_t* Kp, const bf16_t* VT, float slope2, int q0, float sink2,
                                          float* Of32, float* MLp, bf16_t* Obf, const int tid, int kt_lo, int kt_hi, float kn) {
    constexpr int KROW = 144, KTILE = 64 * KROW, VTILE = DV * KROW, BUF = KTILE + VTILE, NVL = DV / 64;
    const int lane = tid & 63, w = __builtin_amdgcn_readfirstlane(tid >> 6), r32 = lane & 31, hi = lane >> 5;
    const int qpos = q0 + 32 * w + r32;
    bf16x8 qf[4];
#pragma unroll
    for (int j = 0; j < 4; ++j) qf[j] = *(const bf16x8*)(Q + (size_t)qpos * INCP + 16 * j + 8 * hi);
    int kt0 = kt_lo, kt1 = kt_hi;
    if (!SWA) {
        float qq = 0.f, qk = 0.f;
#pragma unroll
        for (int j = 0; j < 4; ++j) { const bf16x8 kf = *(const bf16x8*)(Kp + (size_t)qpos * INCP + 16 * j + 8 * hi);
#pragma unroll
            for (int e = 0; e < 8; ++e) { const float qv = bf2f((unsigned short)qf[j][e]), kv = bf2f((unsigned short)kf[e]); qq += qv * qv; qk += qv * kv; } }
        qq = xor32_sum(qq); qk = xor32_sum(qk);
        const float dneed = (sqrtf(qq) * kn - qk + 45.0f) / slope2;
        float kneed = (float)qpos - dneed;
        kneed = fminf(kneed, dppm<0xB1>(kneed)); kneed = fminf(kneed, dppm<0x4E>(kneed)); kneed = fminf(kneed, dppm<0x141>(kneed)); kneed = fminf(kneed, dppm<0x140>(kneed));
        LAS float* red = (LAS float*)(lds + 2 * BUF);
        if ((lane & 15) == 0) red[w * 4 + (lane >> 4)] = kneed;
        __syncthreads();
        float km = red[0];
#pragma unroll
        for (int i = 1; i < 32; ++i) km = fminf(km, red[i]);
        const int ktw = km <= 0.f ? 0 : ((int)km >> 6);
        kt0 = ktw > kt_lo ? ktw : kt_lo;
    }
    const int qlo = q0 + 32 * w, qhi = qlo + 31;
    f32x16 o[DV / 32];
#pragma unroll
    for (int d = 0; d < DV / 32; ++d)
#pragma unroll
        for (int r = 0; r < 16; ++r) o[d][r] = 0.f;
    float mrun = 0.f, lsum = 0.f;
    const int krow = tid >> 3, kch = tid & 7;
    u32x4 kreg, vreg[NVL];
    if (kt0 <= kt1) {   const int k0 = 64 * kt0; kreg = *(const u32x4*)(Kp + (size_t)(k0 + krow) * INCP + 8 * kch);
#pragma unroll
        for (int i = 0; i < NVL; ++i) { const int idx = tid + 512 * i; vreg[i] = *(const u32x4*)(VT + (size_t)(idx >> 3) * M + k0 + 8 * (idx & 7)); } }
    for (int kt = kt0; kt <= kt1; ++kt) {
        LAS unsigned char* buf = lds + ((kt - kt0) & 1) * BUF;
        *(LAS u32x4*)(buf + krow * KROW + 16 * kch) = kreg;
#pragma unroll
        for (int i = 0; i < NVL; ++i) { const int idx = tid + 512 * i; *(LAS u32x4*)(buf + KTILE + (idx >> 3) * KROW + 16 * (idx & 7)) = vreg[i]; }
        __syncthreads();
        if (kt < kt1) { const int k0 = 64 * (kt + 1); kreg = *(const u32x4*)(Kp + (size_t)(k0 + krow) * INCP + 8 * kch);
#pragma unroll
            for (int i = 0; i < NVL; ++i) { const int idx = tid + 512 * i; vreg[i] = *(const u32x4*)(VT + (size_t)(idx >> 3) * M + k0 + 8 * (idx & 7)); } }
        const int k0 = 64 * kt;
        bool act = k0 <= qhi; if (SWA) act = act && (k0 + 63 >= qlo - 127);
        if (act) {
            f32x16 p0, p1;
            {   const float c0 = slope2 * (float)(k0 + 4 * hi - qpos) - mrun, c1 = c0 + 32.0f * slope2;
#pragma unroll
                for (int r = 0; r < 16; ++r) { const float cr = (float)((r & 3) + 8 * (r >> 2)); p0[r] = __builtin_fmaf(slope2, cr, c0); p1[r] = __builtin_fmaf(slope2, cr, c1); } }
#pragma unroll
            for (int j = 0; j < 4; ++j) { const bf16x8 a0 = *(const LAS bf16x8*)(buf + r32 * KROW + 32 * j + 16 * hi), a1 = *(const LAS bf16x8*)(buf + (r32 + 32) * KROW + 32 * j + 16 * hi);
                p0 = __builtin_amdgcn_mfma_f32_32x32x16_bf16(a0, qf[j], p0, 0, 0, 0); p1 = __builtin_amdgcn_mfma_f32_32x32x16_bf16(a1, qf[j], p1, 0, 0, 0); }
            bool need_mask = k0 + 63 > qlo; if (SWA) need_mask = need_mask || (qhi - k0 >= 128);
            if (need_mask) {
#pragma unroll
                for (int r = 0; r < 16; ++r) { const int kv = k0 + (r & 3) + 8 * (r >> 2) + 4 * hi; const int d0 = qpos - kv, d1 = d0 - 32;
                    bool ok0 = d0 >= 0, ok1 = d1 >= 0; if (SWA) { ok0 = ok0 && d0 < 128; ok1 = ok1 && d1 < 128; }
                    p0[r] = ok0 ? p0[r] : -1e30f; p1[r] = ok1 ? p1[r] : -1e30f; } }
            float mx = fmaxf(p0[0], p1[0]);
#pragma unroll
            for (int r = 1; r < 16; ++r) mx = fmaxf(mx, fmaxf(p0[r], p1[r]));
            mx = xor32_max(mx);
            if (__builtin_amdgcn_ballot_w64(mx > 8.0f) != 0ull) {
                const float d = fmaxf(mx, 0.f), f = __builtin_amdgcn_exp2f(-d); mrun += d; lsum *= f;
#pragma unroll
                for (int r = 0; r < 16; ++r) { p0[r] -= d; p1[r] -= d; }
#pragma unroll
                for (int dd = 0; dd < DV / 32; ++dd)
#pragma unroll
                    for (int r = 0; r < 16; ++r) o[dd][r] *= f; }
            float rs = 0.f;
#pragma unroll
            for (int r = 0; r < 16; ++r) { p0[r] = __builtin_amdgcn_exp2f(p0[r]); p1[r] = __builtin_amdgcn_exp2f(p1[r]); rs += p0[r] + p1[r]; }
            lsum += rs;
            u32x4 pw[4];
            pw[0] = (u32x4){cvtpk(p0[0], p0[1]), cvtpk(p0[2], p0[3]), cvtpk(p0[4], p0[5]), cvtpk(p0[6], p0[7])};
            pw[1] = (u32x4){cvtpk(p0[8], p0[9]), cvtpk(p0[10], p0[11]), cvtpk(p0[12], p0[13]), cvtpk(p0[14], p0[15])};
            pw[2] = (u32x4){cvtpk(p1[0], p1[1]), cvtpk(p1[2], p1[3]), cvtpk(p1[4], p1[5]), cvtpk(p1[6], p1[7])};
            pw[3] = (u32x4){cvtpk(p1[8], p1[9]), cvtpk(p1[10], p1[11]), cvtpk(p1[12], p1[13]), cvtpk(p1[14], p1[15])};
#pragma unroll
            for (int d = 0; d < DV / 32; ++d)
#pragma unroll
                for (int j = 0; j < 4; ++j) { const bf16x8 vf = *(const LAS bf16x8*)(buf + KTILE + (32 * d + r32) * KROW + 32 * j + 16 * hi);
                    o[d] = __builtin_amdgcn_mfma_f32_32x32x16_bf16(vf, __builtin_bit_cast(bf16x8, pw[j]), o[d], 0, 0, 0); }
        }
    }
    lsum = xor32_sum(lsum);
    if (SWA) { lsum += __builtin_amdgcn_exp2f(sink2 - mrun);
        const float inv = 1.0f / lsum; bf16_t* op = Obf + (size_t)qpos * DM;
#pragma unroll
        for (int d = 0; d < DV / 32; ++d)
#pragma unroll
            for (int g = 0; g < 4; ++g) { u32x2 wv; wv.x = cvtpk(o[d][4 * g] * inv, o[d][4 * g + 1] * inv); wv.y = cvtpk(o[d][4 * g + 2] * inv, o[d][4 * g + 3] * inv);
                *(u32x2*)(op + 32 * d + 8 * g + 4 * hi) = wv; }
    } else { float* op = Of32 + (size_t)qpos * 1024;
#pragma unroll
        for (int d = 0; d < DV / 32; ++d)
#pragma unroll
            for (int g = 0; g < 4; ++g) *(f32x4*)(op + 32 * d + 8 * g + 4 * hi) = (f32x4){o[d][4 * g], o[d][4 * g + 1], o[d][4 * g + 2], o[d][4 * g + 3]};
        if (hi == 0) *(f32x2*)(MLp + (size_t)qpos * 16) = (f32x2){mrun, lsum};
    }
    __syncthreads();
}

__device__ __forceinline__ void phase_diffcombine(KP p, int l, int gw, int NGW, int lane) {
    const float* lamv = p->in[3] + l * 256;
    const float lambda_init = 0.8f - 0.6f * expf(-0.3f * (float)l);
    const float s1 = wave_sum(lamv[lane] * lamv[64 + lane]), s2 = wave_sum(lamv[128 + lane] * lamv[192 + lane]);
    const float lam = expf(s1) - expf(s2) + lambda_init;
    const float* OD = (const float*)(p->ws + WS_OD); const float* ML = (const float*)(p->ws + WS_ML); bf16_t* MIX = (bf16_t*)(p->ws + WS_MIX);
    const int h = lane >> 4, d0 = (lane & 15) * 8;
    const f32x4 g0 = *(const f32x4*)(p->in[4] + l * 128 + d0), g1 = *(const f32x4*)(p->in[4] + l * 128 + d0 + 4);
    for (int t = gw; t < M; t += NGW) { const int nseg = ((t >> 8) + 8) >> 3;
        f32x4 oc[2][2];
#pragma unroll
        for (int c = 0; c < 2; ++c) {
            f32x2 ml[4]; float mm = -1e30f;
#pragma unroll
            for (int s = 0; s < 4; ++s) if (s < nseg) { ml[s] = *(const f32x2*)(ML + ((size_t)s * M + t) * 16 + h * 4 + c * 2); mm = fmaxf(mm, ml[s].x); }
            f32x4 a0 = (f32x4){0.f, 0.f, 0.f, 0.f}, a1 = a0; float L = 0.f;
#pragma unroll
            for (int s = 0; s < 4; ++s) if (s < nseg) { const float f = exp2f(ml[s].x - mm); L += ml[s].y * f;
                const float* b = OD + ((size_t)s * M + t) * 1024 + h * 256 + c * 128 + d0; a0 += *(const f32x4*)b * f; a1 += *(const f32x4*)(b + 4) * f; }
            const float inv = 1.0f / L; oc[c][0] = a0 * inv; oc[c][1] = a1 * inv; }
        const f32x4 o0 = oc[0][0] - oc[1][0] * lam, o1 = oc[0][1] - oc[1][1] * lam;
        float ss = (o0[0] * o0[0] + o0[1] * o0[1]) + (o0[2] * o0[2] + o0[3] * o0[3]) + (o1[0] * o1[0] + o1[1] * o1[1]) + (o1[2] * o1[2] + o1[3] * o1[3]);
        ss = row16_sum(ss);
        const float r = rsqrtf(ss * (1.0f / 128.0f) + EPS) * (1.0f - lambda_init);
        const f32x4 y0 = o0 * g0 * r, y1 = o1 * g1 * r;
        u32x4 wv; wv.x = cvtpk(y0[0], y0[1]); wv.y = cvtpk(y0[2], y0[3]); wv.z = cvtpk(y1[0], y1[1]); wv.w = cvtpk(y1[2], y1[3]);
        *(u32x4*)(MIX + (size_t)t * DM + h * 128 + d0) = wv; }
}

#define XB_TMO      128
#define XB_XCNT(j)  (256  + 64 * (j))
#define XB_XSUB(j)  (1280 + 64 * (j))
#define XB_XGEN(j)  (2304 + 64 * (j))
#define XB_TOP      3328
#define XB_TOPGEN   3392
#define XCD_BAR_WORDS 3456
#define XB_SPIN_CAP (1u << 22)
__device__ __forceinline__ unsigned xb_ld(unsigned* p)              { return __hip_atomic_load(p, __ATOMIC_RELAXED, __HIP_MEMORY_SCOPE_AGENT); }
__device__ __forceinline__ unsigned xb_add(unsigned* p, unsigned v) { return __hip_atomic_fetch_add(p, v, __ATOMIC_RELAXED, __HIP_MEMORY_SCOPE_AGENT); }
__device__ __forceinline__ unsigned xb_xcc_id() { return (unsigned)__builtin_amdgcn_s_getreg((3 << 11) | 20) & 0xFu; }
#define XB_SPIN(cond, bar) do { unsigned _sp = 0; while (cond) { __builtin_amdgcn_s_sleep(1); \
    if ((++_sp & 255u) == 0u) { if (xb_ld(&(bar)[XB_TMO])) break; if (_sp > XB_SPIN_CAP) { atomicAdd(&(bar)[XB_TMO], 1u); break; } } } } while (0)
__device__ __forceinline__ void xcd_barrier_complete(unsigned* bar, unsigned x, unsigned& nloc, unsigned& nx) {
    const unsigned G = gridDim.x;
    unsigned sum, cnt, mine, sp = 0u;
    for (;;) {
        sum = 0u; cnt = 0u; mine = 0u;
#pragma unroll
        for (unsigned j = 0; j < 16; ++j) { const unsigned c = xb_ld(&bar[XB_XCNT(j)]); sum += c; cnt += (c > 0u) ? 1u : 0u; mine = (j == x) ? c : mine; }
        if (sum == G) break;
        __builtin_amdgcn_s_sleep(1);
        if ((++sp & 255u) == 0u) { if (xb_ld(&bar[XB_TMO])) break; if (sp > XB_SPIN_CAP) { atomicAdd(&bar[XB_TMO], 1u); break; } }
    }
    nloc = mine > 0u ? mine : 1u; nx = cnt > 0u ? cnt : 1u;
}
__device__ __forceinline__ void xcd_barrier(unsigned* bar, volatile LAS unsigned* st, const int tid) {
    asm volatile("s_waitcnt vmcnt(0)" ::: "memory");
    __syncthreads();
    if (tid == 0) {
        const unsigned x = xb_xcc_id();
        __builtin_amdgcn_s_waitcnt(0);
        unsigned nloc = st[0], nx = st[1];
        if (nloc == 0u) { xcd_barrier_complete(bar, x, nloc, nx); st[0] = nloc; st[1] = nx; }
        const unsigned old = xb_add(&bar[XB_XSUB(x)], 1u);
        const unsigned gen = old / nloc;
        if (old + 1u == (gen + 1u) * nloc) {
            __builtin_amdgcn_fence(__ATOMIC_RELEASE, "agent");
            asm volatile("s_waitcnt vmcnt(0)" ::: "memory");
            const unsigned og = xb_add(&bar[XB_TOP], 1u);
            const unsigned tg = og / nx;
            if (og + 1u == (tg + 1u) * nx) xb_add(&bar[XB_TOPGEN], 1u);
            else XB_SPIN(xb_ld(&bar[XB_TOPGEN]) == tg, bar);
            __builtin_amdgcn_fence(__ATOMIC_ACQUIRE, "agent");
            xb_add(&bar[XB_XGEN(x)], 1u);
            asm volatile("s_waitcnt vmcnt(0)" ::: "memory");
        } else {
            XB_SPIN(xb_ld(&bar[XB_XGEN(x)]) == gen, bar);
            __builtin_amdgcn_fence(__ATOMIC_ACQUIRE, "agent");
            asm volatile("s_waitcnt vmcnt(0)" ::: "memory");
        }
    }
    __syncthreads();
}

#ifndef DUPBAR
#define DUPBAR 1
#endif
#define GSYNC() do { FRESH(); for (int rb_ = 0; rb_ < DUPBAR; ++rb_) xcd_barrier((unsigned*)(p->ws + WS_CTL) + 4096, (volatile LAS unsigned*)(lds + LDS_BYTES - 32), tid); } while (0)
#define PTRS() unsigned* ctl = (unsigned*)(p->ws + WS_CTL); bf16_t* XB = (bf16_t*)(p->ws + WS_XB); bf16_t* PROJ = (bf16_t*)(p->ws + WS_PROJ); bf16_t* MIX = (bf16_t*)(p->ws + WS_MIX); bf16_t* H = (bf16_t*)(p->ws + WS_H); \
    float* ssqA = (float*)(p->ws + WS_SSQA); float* ssqB = (float*)(p->ws + WS_SSQB); unsigned char* wb = p->ws + WS_W + (size_t)l * LW_STRIDE; (void)ctl; (void)XB; (void)PROJ; (void)MIX; (void)H; (void)ssqA; (void)ssqB; (void)wb
#define FRESH() KP p = fresh_params(); int G = gridDim.x, bx = blockIdx.x; asm volatile("" : "+s"(G), "+s"(bx)); const int NGW = G * 8; (void)NGW; const int tid = fresh_tid(wave0), lane = tid & 63, wave = __builtin_amdgcn_readfirstlane(tid >> 6), gw = bx * 8 + wave; (void)lane; (void)gw
template <int L> __device__ __forceinline__ void layer_body(LAS unsigned char* lds, const int wave0) {
    constexpr int l = L;

#ifndef DUP1
#define DUP1 1
#endif
        for (int rep = 0; rep < DUP1; ++rep) {   if (rep) GSYNC(); FRESH(); PTRS(); pg8::Gemm g{XB, (const bf16_t*)(wb + LW_WIN), M, INCP, DM}; pg8::StaticOrder S; S.init(M, INCP, G, bx);
            pg8::EpiProj E{PROJ, INCP, ssqA};
            pg8::gemm_phase<pg8::EpiProj, pg8::StaticOrder, true, true>(lds, g, S, E, tid); }
        GSYNC();
#ifndef DUP234
#define DUP234 1
#endif
        for (int rep = 0; rep < DUP234; ++rep) { if (rep) GSYNC(); FRESH(); phase_prep1(p, l, lds, gw, NGW, wave, lane); }
        GSYNC();
        {   FRESH(); PTRS(); pg8::Gemm g{(const bf16_t*)(p->ws + WS_AW), (const bf16_t*)(wb + LW_W2T), M, 1024, 128}; pg8::StaticOrder S; S.init(M, 1024, G, bx);
            pg8::EpiLora<0> E{(float*)(p->ws + WS_DEC), p->in[7] + l * 1024};
            pg8::gemm_phase<pg8::EpiLora<0>, pg8::StaticOrder, true, true>(lds, g, S, E, tid); }
        {   FRESH(); PTRS(); pg8::Gemm g{(const bf16_t*)(p->ws + WS_AA), (const bf16_t*)(wb + LW_A2T), M, 1024, 128}; pg8::StaticOrder S; S.init(M, 1024, G, (bx + 128) % G);
            pg8::EpiLora<1> E{(float*)(p->ws + WS_A), p->in[9] + l * 1024};
            pg8::gemm_phase<pg8::EpiLora<1>, pg8::StaticOrder, true, true>(lds, g, S, E, tid); }
        {   FRESH(); PTRS(); pg8::Gemm g{(const bf16_t*)(p->ws + WS_AG), (const bf16_t*)(wb + LW_G2T), M, 1024, 256}; pg8::StaticOrder S; S.init(M, 1024, G, (bx + 128) % G);
            pg8::EpiLora<2> E{(float*)(p->ws + WS_G), nullptr};
            pg8::gemm_phase<pg8::EpiLora<2>, pg8::StaticOrder, true, true>(lds, g, S, E, tid); }
        GSYNC();
        {   FRESH(); LAS unsigned char* wl = lds + wave * 14336;
#ifndef DUP57
#define DUP57 1
#endif
            for (int rep = 0; rep < DUP57; ++rep) for (int it = gw; it < 2 * NCH * 16; it += NGW) { const int mode = it & 1, ch = it >> 1, c = ch % NCH, h = ch / NCH;
                if (mode == 0) scan_task<0>(p, l, wl, c, h, lane); else scan_task<1>(p, l, wl, c, h, lane); } }
        GSYNC();
#ifndef DUP6
#define DUP6 1
#endif
        for (int rep = 0; rep < DUP6; ++rep) {   if (rep) GSYNC(); FRESH(); PTRS(); LAS int* slot = (LAS int*)(lds + LDS_BYTES - 64);
            LAS float* knl = (LAS float*)(lds + LDS_BYTES - 128);
            {   LAS float* kr = (LAS float*)lds; const float* knp = (const float*)(p->ws + WS_KNP); const int g = tid & 7, part = tid >> 3; float m = 0.f;
                for (int b2 = part; b2 < G; b2 += 64) m = fmaxf(m, knp[(size_t)b2 * 8 + g]);
                kr[part * 8 + g] = m; __syncthreads();
                if (tid < 8) { float mm = kr[tid]; for (int q2 = 1; q2 < 64; ++q2) mm = fmaxf(mm, kr[q2 * 8 + tid]); knl[tid] = mm; }
                __syncthreads(); }
            const float* sinks = p->in[5] + l * 8;
            for (;;) {
                if (tid == 0) *slot = (int)atomicAdd(ctl + 64 * (l + 1) + 16 * rep, 1u);
                __syncthreads();
                const int it = *slot;
                __syncthreads();
                if (it >= 912) break;
                if (it < 16) {
#ifndef NO_S2
                    s2_head(p, lds, it, tid);
#endif
                }
                else if (it < 656) { const int d = it - 16, h = 3 - d / 160, u = d % 160, c = u & 1, v = u >> 1; int qb, seg;
                    if (v < 32) { qb = 31 - (v >> 2); seg = v & 3; } else if (v < 56) { const int w2 = v - 32; qb = 23 - w2 / 3; seg = w2 % 3; }
                    else if (v < 72) { const int w2 = v - 56; qb = 15 - (w2 >> 1); seg = w2 & 1; } else { qb = 79 - v; seg = 0; }
                    const float slope2 = exp2f(-2.0f * (float)(h + 1)) * LOG2E;
                    const float kn = sqrtf(knl[h * 2 + c]);
                    const int kt1 = 4 * qb + 3, klo = 32 * seg, khi = (klo + 31 < kt1) ? klo + 31 : kt1;
                    attn_unit<128, false>(lds, PROJ + h * 128 + c * 64, PROJ + 512 + h * 128 + c * 64, (const bf16_t*)(p->ws + WS_VAT) + (size_t)(h * 128) * M, slope2, qb * 256, 0.f,
                                          (float*)(p->ws + WS_OD) + (size_t)seg * M * 1024 + h * 256 + c * 128, (float*)(p->ws + WS_ML) + (size_t)seg * M * 16 + h * 4 + c * 2, nullptr, tid, klo, khi, kn); }
                else { const int s = it - 656, hq = s & 7, qb = s >> 3;
                    const int aidx = (hq >> 1) * 3 + (hq & 1);
                    const float slope2 = exp2f(-8.0f * (float)(aidx + 1) / 12.0f) * LOG2E;
                    const int q0 = qb * 256;
                    attn_unit<64, true>(lds, PROJ + 1536 + hq * 64, PROJ + 2048 + (hq >> 2) * 64, (const bf16_t*)(p->ws + WS_VBT) + (size_t)((hq >> 2) * 64) * M, slope2, q0, sinks[hq] * LOG2E,
                                        nullptr, nullptr, MIX + 512 + hq * 64, tid, q0 >= 128 ? (q0 - 128) / 64 : 0, (q0 + 255) / 64, 0.f); }
            } }
        GSYNC();
        {   FRESH();
            if (wave < 4) {
                LAS unsigned char* wl = lds + wave * 14336;
                for (int rep = 0; rep < DUP57; ++rep) for (int it = bx * 4 + wave; it < NCH * 16; it += G * 4) { const int c = it % NCH, h = it / NCH; scan_task<2>(p, l, wl, c, h, lane); }
            } else {
                phase_diffcombine(p, l, bx * 4 + (wave - 4), G * 4, lane);
                if (l + 1 < NL) { LAS float* scr = (LAS float*)(lds + 4 * 14336 + (wave - 4) * 8448);
                    for (int r = bx * 4 + (wave - 4); r < CONV_ITEMS; r += G * 4) convert_item(p, l + 1 < NL ? l + 1 : l, r, scr, lane); }
            } }
        GSYNC();
        {   FRESH(); PTRS(); pg8::Gemm g{MIX, (const bf16_t*)(wb + LW_WOUT), M, DM, DM}; pg8::StaticOrder S; S.init(M, DM, G, bx);
            pg8::EpiResid E{p->out, XB, ssqB};
            pg8::gemm_phase<pg8::EpiResid, pg8::StaticOrder, true, true>(lds, g, S, E, tid); }
        GSYNC();
        for (int rep = 0; rep < DUP1; ++rep) {   if (rep) GSYNC(); FRESH(); PTRS(); pg8::Gemm g{XB, (const bf16_t*)(wb + LW_WGU), M, GU, DM}; pg8::StaticOrder S; S.init(M, GU, G, bx);
            pg8::EpiSwiGLU E{H, ssqB};
            pg8::gemm_phase<pg8::EpiSwiGLU, pg8::StaticOrder, true, true>(lds, g, S, E, tid); }
        GSYNC();
        {   FRESH(); PTRS(); pg8::Gemm g{H, (const bf16_t*)(wb + LW_WDN), M, DM, FF}; pg8::StaticOrder S; S.init(M, DM, G, bx);
            pg8::EpiResid E{p->out, XB, ssqA};
            pg8::gemm_phase<pg8::EpiResid, pg8::StaticOrder, true, true>(lds, g, S, E, tid); }
        GSYNC();
    }

__global__ void __launch_bounds__(512, 2) fwd_megakernel(Params p_unused) {
    extern __shared__ __attribute__((aligned(16))) unsigned char lds_raw[];
    LAS unsigned char* lds = (LAS unsigned char*)lds_raw;
    cg::grid_group grid = cg::this_grid();
    const int wave0 = __builtin_amdgcn_readfirstlane((int)threadIdx.x >> 6);
    if (threadIdx.x < 16) ((LAS unsigned*)(lds + LDS_BYTES - 64))[threadIdx.x] = 0u;
    if (threadIdx.x == 0) xb_add((unsigned*)(p_unused.ws + WS_CTL) + 4096 + XB_XCNT(xb_xcc_id()), 1u);
    __syncthreads();

#ifndef DUP0
#define DUP0 1
#endif
    for (int rep = 0; rep < DUP0; ++rep) { FRESH(); phase0(p, lds, gw, NGW, wave, lane); __syncthreads(); }
    grid.sync();

    layer_body<0>(lds, wave0); layer_body<1>(lds, wave0); layer_body<2>(lds, wave0); layer_body<3>(lds, wave0);
    {   FRESH(); const int l = 0; PTRS(); const float* gf = p->in[21];
        for (int m = gw; m < M; m += NGW) { const float rs = rsqrtf(wave_sum(lane < 32 ? ssqA[(size_t)m * 32 + lane] : 0.f) * (1.0f / DM) + EPS);
#pragma unroll
            for (int j = 0; j < 8; ++j) { const size_t o = (size_t)m * DM + j * 256 + lane * 4; const f32x4 v = *(const f32x4*)(p->out + o); const f32x4 gv = *(const f32x4*)(gf + j * 256 + lane * 4);
                *(f32x4*)(p->out + o) = v * rs * gv; } } }
}

extern "C" void kernel_launch(void* const* d_in, const int* in_sizes, int n_in, void* d_out, int out_size, void* d_ws, size_t ws_size, hipStream_t stream) {
    static int grid = 0;
    if (grid == 0) {
        if (n_in != 22 || out_size != M * DM || ws_size < WS_END) { fprintf(stderr, "kernel_launch: unexpected shapes (n_in %d out %d ws %zu need %zu)\n", n_in, out_size, ws_size, (size_t)WS_END); grid = -1; return; }
        int dev = 0, cus = 0, per_cu = 0;
        hipGetDevice(&dev); hipDeviceGetAttribute(&cus, hipDeviceAttributeMultiprocessorCount, dev);
        hipFuncSetAttribute((const void*)fwd_megakernel, hipFuncAttributeMaxDynamicSharedMemorySize, LDS_BYTES);
        hipOccupancyMaxActiveBlocksPerMultiprocessor(&per_cu, (const void*)fwd_megakernel, 512, LDS_BYTES);
        if (per_cu < 1) { fprintf(stderr, "kernel_launch: occupancy query says %d blocks per CU\n", per_cu); per_cu = 1; }
        (void)hipGetLastError();
        grid = cus;
    }
    if (grid < 0) return;
    hipMemsetAsync((char*)d_ws + WS_CTL, 0, 65536, stream);
    Params p{};
    for (int i = 0; i < 22; ++i) p.in[i] = (const float*)d_in[i];
    p.out = (float*)d_out; p.ws = (unsigned char*)d_ws;
    void* args[] = {&p};
    hipError_t e = hipLaunchCooperativeKernel((const void*)fwd_megakernel, dim3(grid), dim3(512), args, LDS_BYTES, stream);
    if (e != hipSuccess) fprintf(stderr, "cooperative launch failed: %s (grid %d)\n", hipGetErrorString(e), grid);
}
```

```cpp
#include <hip/hip_runtime.h>
#include <hip/hip_cooperative_groups.h>
#include <cstdio>
#include <cstdint>
namespace cg = cooperative_groups;

#define LAS __attribute__((address_space(3)))
typedef unsigned short bf16_t;
typedef short bf16x8 __attribute__((ext_vector_type(8)));
typedef float f32x4 __attribute__((ext_vector_type(4)));
typedef float f32x2 __attribute__((ext_vector_type(2)));
typedef float f32x16 __attribute__((ext_vector_type(16)));
typedef unsigned u32x4 __attribute__((ext_vector_type(4)));
typedef unsigned u32x2 __attribute__((ext_vector_type(2)));
typedef __bf16 bf16x2_t __attribute__((ext_vector_type(2)));

constexpr int M = 8192, DM = 2048, INC = 5824, INCP = 5888, FF = 5632, GU = 11264, RW0 = 2304, RWC = 3520;
constexpr int NL = 4, NCH = 64, CL = 128;
constexpr float EPS = 1e-5f, LOG2E = 1.4426950408889634f;
constexpr float QSC = 0.125f * LOG2E;

constexpr size_t MiB = 1u << 20;
constexpr size_t SZ_WIN = (size_t)INCP * DM * 2, SZ_WOUT = (size_t)DM * DM * 2, SZ_WGU = (size_t)GU * DM * 2, SZ_WDN = (size_t)DM * FF * 2;
constexpr size_t SZ_W2T = 1024 * 128 * 2, SZ_G2T = 1024 * 256 * 2;
constexpr size_t LW_WIN = 0, LW_WOUT = LW_WIN + SZ_WIN, LW_WGU = LW_WOUT + SZ_WOUT, LW_WDN = LW_WGU + SZ_WGU, LW_W2T = LW_WDN + SZ_WDN,
                 LW_A2T = LW_W2T + SZ_W2T, LW_G2T = LW_A2T + SZ_W2T, LW_STRIDE = LW_G2T + SZ_G2T;
constexpr size_t SZ_F = (size_t)M * 1024 * 4;
constexpr size_t WS_CTL = 0, WS_W = 1 * MiB, WS_XB = WS_W + NL * LW_STRIDE, WS_PROJ = WS_XB + (size_t)M * DM * 2,
                 WS_VAT = WS_PROJ + (size_t)M * INCP * 2, WS_VBT = WS_VAT + (size_t)512 * M * 2, WS_AW = WS_VBT + (size_t)128 * M * 2,
                 WS_AA = WS_AW + (size_t)M * 128 * 2, WS_AG = WS_AA + (size_t)M * 128 * 2, WS_R = WS_AG + (size_t)M * 256 * 2,
                 WS_KR = WS_R + SZ_F, WS_V = WS_KR + SZ_F, WS_DEC = WS_V + SZ_F, WS_A = WS_DEC + SZ_F, WS_G = WS_A + SZ_F,
                 WS_KF = WS_G + SZ_F, WS_AN = WS_KF + SZ_F, WS_BB = WS_AN + SZ_F, WS_PB = WS_BB + SZ_F, WS_UB = WS_PB + SZ_F,
                 WS_SI = WS_UB + SZ_F, WS_OD = WS_SI + SZ_F, WS_ML = WS_OD + 4 * SZ_F, WS_KNP = WS_ML + (size_t)4 * M * 16 * 4, WS_MIX = WS_KNP + 65536, WS_SSQA = WS_MIX + (size_t)M * DM * 2,
                 WS_SSQB = WS_SSQA + (size_t)M * 32 * 4, WS_END = WS_SSQB + (size_t)M * 32 * 4;
constexpr size_t WS_H = WS_PROJ;
static_assert((size_t)M * FF * 2 <= (size_t)M * INCP * 2, "H overlay");

constexpr int LDS_BYTES = 147456;

struct Params { const float* in[22]; float* out; unsigned char* ws; };
typedef const __attribute__((address_space(4))) Params* KP;
__device__ __forceinline__ KP fresh_params() { KP k = (KP)__builtin_amdgcn_kernarg_segment_ptr(); asm volatile("" : "+s"(k)); return k; }

__device__ __forceinline__ unsigned cvtpk(float lo, float hi) { f32x2 v = {lo, hi}; bf16x2_t b = __builtin_convertvector(v, bf16x2_t); return __builtin_bit_cast(unsigned, b); }
__device__ __forceinline__ float bf2f(unsigned short b) { return __builtin_bit_cast(float, (unsigned)b << 16); }
__device__ __forceinline__ float bflo(unsigned w) { return __builtin_bit_cast(float, w << 16); }
__device__ __forceinline__ float bfhi(unsigned w) { return __builtin_bit_cast(float, w & 0xffff0000u); }
template <int CTRL> __device__ __forceinline__ float dppm(float v) { return __builtin_bit_cast(float, __builtin_amdgcn_mov_dpp(__builtin_bit_cast(int, v), CTRL, 0xF, 0xF, true)); }
__device__ __forceinline__ float xor16_sum(float v) { const unsigned b = __builtin_bit_cast(unsigned, v); auto rr = __builtin_amdgcn_permlane16_swap(b, b, false, false); return __builtin_bit_cast(float, (unsigned)rr[0]) + __builtin_bit_cast(float, (unsigned)rr[1]); }
__device__ __forceinline__ float xor32_sum(float v) { const unsigned b = __builtin_bit_cast(unsigned, v); auto rr = __builtin_amdgcn_permlane32_swap(b, b, false, false); return __builtin_bit_cast(float, (unsigned)rr[0]) + __builtin_bit_cast(float, (unsigned)rr[1]); }
__device__ __forceinline__ float xor32_max(float v) { const unsigned b = __builtin_bit_cast(unsigned, v); auto rr = __builtin_amdgcn_permlane32_swap(b, b, false, false); return fmaxf(__builtin_bit_cast(float, (unsigned)rr[0]), __builtin_bit_cast(float, (unsigned)rr[1])); }
__device__ __forceinline__ float row16_sum(float v) { v += dppm<0xB1>(v); v += dppm<0x4E>(v); v += dppm<0x141>(v); v += dppm<0x140>(v); return v; }
__device__ __forceinline__ float wave_sum(float v) { return xor32_sum(xor16_sum(row16_sum(v))); }
__device__ __forceinline__ float dpp_xor1(float v) { return __builtin_bit_cast(float, __builtin_amdgcn_mov_dpp(__builtin_bit_cast(int, v), 0xB1, 0xF, 0xF, true)); }
__device__ __forceinline__ float dpp_xor2(float v) { return __builtin_bit_cast(float, __builtin_amdgcn_mov_dpp(__builtin_bit_cast(int, v), 0x4E, 0xF, 0xF, true)); }
__device__ __forceinline__ float quad_sum(float v) { v += dpp_xor1(v); v += dpp_xor2(v); return v; }
__device__ __forceinline__ float sigmoidf_(float x) { return __builtin_amdgcn_rcpf(1.0f + __expf(-x)); }

__device__ __forceinline__ int fresh_tid(int wave0) { unsigned z = 0u; asm volatile("" : "+v"(z)); int t = wave0 * 64 + (int)__builtin_amdgcn_mbcnt_hi(~0u, __builtin_amdgcn_mbcnt_lo(~0u, z)); asm volatile("" : "+v"(t)); return t; }

__device__ __forceinline__ float row_rstd(const float* ssq, int row, int fq) {
    const float* pp = ssq + (size_t)row * 32 + 8 * fq; const f32x4 a = *(const f32x4*)pp, b = *(const f32x4*)(pp + 4);
    float s = ((a[0] + a[1]) + (a[2] + a[3])) + ((b[0] + b[1]) + (b[2] + b[3]));
    s = xor32_sum(xor16_sum(s));
    return rsqrtf(s * (1.0f / DM) + EPS);
}

namespace pg8 {
constexpr int BM = 256, BK = 64, HALF = 128, HTB = HALF * BK * 2, STAGE_BYTES = 8 * HTB, NXCD = 8, WGM = 8;
__host__ __device__ __forceinline__ int lds_byte(int r, int c) { const int st = (r >> 4) * 2 + (c >> 5), rr = r & 15, cc = c & 31, ob = rr * 64 + cc * 2; return st * 1024 + (ob ^ (((ob >> 9) & 1) << 5)); }
__host__ __device__ __forceinline__ void stage_rc(int b, int& R, int& C) { const int st = b / 1024, sb = b % 1024, swz = sb ^ (((sb >> 9) & 1) << 5); R = (st >> 1) * 16 + swz / 64; C = (st & 1) * 32 + (swz % 64) / 2; }
__host__ __device__ __forceinline__ int perm32(int rho) { const int n = rho >> 4, i = rho & 15; return 8 * (i >> 2) + 4 * n + (i & 3); }
struct Unit { int pm, pn; };
struct Gemm { const bf16_t* A; const bf16_t* Bt; int M, N, K; };
struct StaticOrder {
    int nM, nN, nwg, G, c;
    __host__ __device__ void init(int M_, int N_, int G_, int c_) { nM = M_ / BM; nN = N_ / BM; nwg = nM * nN; G = G_; c = c_; }
    __host__ __device__ bool next(int i, Unit& u) const {
        const long L = (long)i * G + c; if (L >= nwg) return false;
        int wgid = (int)L; { const int q = nwg / NXCD, r = nwg % NXCD, xcd = wgid % NXCD, off = wgid / NXCD; wgid = (xcd < r ? xcd * (q + 1) : r * (q + 1) + (xcd - r) * q) + off; }
        const int nig = WGM * nN, gid = wgid / nig, fm = gid * WGM, gsz = (nM - fm) < WGM ? (nM - fm) : WGM;
        u.pm = fm + ((wgid % nig) % gsz); u.pn = (wgid % nig) / gsz; return true;
    }
};

template <class Epi, class Sched, bool ALIGN_EPI, bool SP2>
__device__ __forceinline__ void gemm_phase(LAS unsigned char* lds, const Gemm g, const Sched& S, const Epi& E, const int tid) {
    const int wid = __builtin_amdgcn_readfirstlane(tid >> 6), lane = tid & 63, wr = wid >> 2, wc = wid & 3, fr = lane & 15, fq = lane >> 4;
    const int K = g.K, nt = K / BK;
    unsigned voffA[2], voffB[2];
#pragma unroll
    for (int i = 0; i < 2; ++i) { int R, C; stage_rc(tid * 16 + i * 8192, R, C); const int Rb = Epi::PERM ? ((R & ~31) + perm32(R & 31)) : R;
        voffA[i] = (unsigned)(R * K + C) * 2u; voffB[i] = (unsigned)(Rb * K + C) * 2u; }
    const size_t kstep = (size_t)(BK * 2);
    const size_t hstep = (size_t)HALF * K * 2;
    const size_t tstep = 2 * hstep;
    const unsigned ldsw = (unsigned)wid * 1024u;
    const int aoff = lds_byte(wr * 64 + fr, fq * 8), boff = lds_byte(wc * 32 + fr, fq * 8);
#define PG8_SA(b, h) (((b) * 2 + (h)) * HTB)
#define PG8_SB(b, h) ((4 + (b) * 2 + (h)) * HTB)
#define PG8_STAGE(bufoff, gbase, voff) do { _Pragma("unroll") for (int _i = 0; _i < 2; ++_i) \
        __builtin_amdgcn_global_load_lds((const unsigned*)((const char*)(gbase) + (voff)[_i]), (LAS unsigned*)(lds + (bufoff) + ldsw + _i * 8192), 16, 0, 0); } while (0)
#define PG8_LDA(dst, b, h) do { _Pragma("unroll") for (int m = 0; m < 4; ++m) _Pragma("unroll") for (int k = 0; k < 2; ++k) dst[m][k] = *(const LAS bf16x8*)(lds + PG8_SA(b, h) + aoff + m * 2048 + k * 1024); } while (0)
#define PG8_LDB(dst, b, h) do { _Pragma("unroll") for (int n = 0; n < 2; ++n) _Pragma("unroll") for (int k = 0; k < 2; ++k) dst[n][k] = *(const LAS bf16x8*)(lds + PG8_SB(b, h) + boff + n * 2048 + k * 1024); } while (0)
#define PG8_MMA(ai, bj, At, Bt) do { __builtin_amdgcn_s_setprio(1); _Pragma("unroll") for (int m = 0; m < 4; ++m) _Pragma("unroll") for (int n = 0; n < 2; ++n) _Pragma("unroll") for (int k = 0; k < 2; ++k) \
        acc[ai][bj][m][n] = __builtin_amdgcn_mfma_f32_16x16x32_bf16(Bt[n][k], At[m][k], acc[ai][bj][m][n], 0, 0, 0); __builtin_amdgcn_s_setprio(0); } while (0)
#define PG8_WAIT_V(n) asm volatile("s_waitcnt vmcnt(" #n ")" ::: "memory")
#define PG8_WAIT_L(n) asm volatile("s_waitcnt lgkmcnt(" #n ")" ::: "memory")
#define PG8_BAR __builtin_amdgcn_s_barrier()
#define PG8_SCHED __builtin_amdgcn_sched_barrier(0)
    Unit cur, nxt; int ui = 0;
    if (!S.next(0, cur)) return;
    f32x4 acc[2][2][4][2];
#pragma unroll
    for (int a = 0; a < 2; ++a)
#pragma unroll
        for (int b = 0; b < 2; ++b)
#pragma unroll
            for (int m = 0; m < 4; ++m)
#pragma unroll
                for (int n = 0; n < 2; ++n) acc[a][b][m][n] = (f32x4){0.f, 0.f, 0.f, 0.f};
    bf16x8 At[4][2], B0[2][2], B1[2][2];
    const char* cA = (const char*)g.A + (size_t)cur.pm * tstep; const char* cB = (const char*)g.Bt + (size_t)cur.pn * tstep;
    if constexpr (SP2) {
        PG8_STAGE(PG8_SB(0, 0), cB, voffB); PG8_STAGE(PG8_SB(0, 1), cB + hstep, voffB); PG8_STAGE(PG8_SA(0, 0), cA, voffA); PG8_STAGE(PG8_SA(0, 1), cA + hstep, voffA);
        if (wr == 1) PG8_BAR;
        PG8_WAIT_V(2); PG8_BAR;
        PG8_STAGE(PG8_SB(1, 0), cB + kstep, voffB); PG8_STAGE(PG8_SA(1, 0), cA + kstep, voffA); PG8_STAGE(PG8_SB(1, 1), cB + hstep + kstep, voffB);
        PG8_WAIT_V(6); PG8_BAR;
    } else {
        PG8_STAGE(PG8_SB(0, 0), cB, voffB); PG8_STAGE(PG8_SA(0, 0), cA, voffA); PG8_STAGE(PG8_SB(0, 1), cB + hstep, voffB); PG8_STAGE(PG8_SA(0, 1), cA + hstep, voffA);
        if (wr == 1) PG8_BAR;
        PG8_WAIT_V(4); PG8_BAR;
        PG8_STAGE(PG8_SB(1, 0), cB + kstep, voffB); PG8_STAGE(PG8_SA(1, 0), cA + kstep, voffA); PG8_STAGE(PG8_SB(1, 1), cB + hstep + kstep, voffB);
        PG8_WAIT_V(6); PG8_BAR;
    }
    for (;;) {
        const bool has_next = S.next(ui + 1, nxt);
        const char* nA = has_next ? (const char*)g.A + (size_t)nxt.pm * tstep : cA; const char* nB = has_next ? (const char*)g.Bt + (size_t)nxt.pn * tstep : cB;
        for (int t = 0; t < nt; t += 2) {
            const bool last = (t == nt - 2);
            const char* a1 = cA + (size_t)(t + 1) * kstep;
            const char* a2 = last ? nA : cA + (size_t)(t + 2) * kstep; const char* b2 = last ? nB : cB + (size_t)(t + 2) * kstep;
            const char* a3 = a2 + kstep; const char* b3 = b2 + kstep;
            if constexpr (SP2) {
            PG8_LDB(B0, 0, 0); PG8_LDB(B1, 0, 1); PG8_SCHED; PG8_LDA(At, 0, 0); PG8_STAGE(PG8_SA(1, 1), a1 + hstep, voffA);
            PG8_WAIT_V(8); PG8_WAIT_L(0); PG8_BAR; PG8_MMA(0, 0, At, B0); PG8_MMA(0, 1, At, B1); PG8_BAR; PG8_SCHED;
            PG8_LDA(At, 0, 1); PG8_STAGE(PG8_SB(0, 0), b2, voffB); PG8_STAGE(PG8_SB(0, 1), b2 + hstep, voffB); PG8_STAGE(PG8_SA(0, 0), a2, voffA);
            PG8_WAIT_V(8); PG8_WAIT_L(0); PG8_BAR; PG8_MMA(1, 0, At, B0); PG8_MMA(1, 1, At, B1); PG8_BAR; PG8_SCHED;
            PG8_LDB(B0, 1, 0); PG8_LDB(B1, 1, 1); PG8_SCHED; PG8_LDA(At, 1, 0); PG8_STAGE(PG8_SA(0, 1), a2 + hstep, voffA);
            PG8_WAIT_V(8); PG8_WAIT_L(0); PG8_BAR; PG8_MMA(0, 0, At, B0); PG8_MMA(0, 1, At, B1); PG8_BAR; PG8_SCHED;
            PG8_LDA(At, 1, 1); PG8_STAGE(PG8_SB(1, 0), b3, voffB); PG8_STAGE(PG8_SB(1, 1), b3 + hstep, voffB); PG8_STAGE(PG8_SA(1, 0), a3, voffA);
            PG8_WAIT_V(8); PG8_WAIT_L(0); PG8_BAR; PG8_MMA(1, 0, At, B0); PG8_MMA(1, 1, At, B1); PG8_BAR; PG8_SCHED;
            } else {
            PG8_LDB(B0, 0, 0); PG8_SCHED; PG8_LDA(At, 0, 0); PG8_STAGE(PG8_SA(1, 1), a1 + hstep, voffA);
            PG8_WAIT_L(8); PG8_BAR; PG8_WAIT_L(0); PG8_MMA(0, 0, At, B0); PG8_BAR; PG8_SCHED;
            PG8_LDB(B1, 0, 1); PG8_STAGE(PG8_SB(0, 0), b2, voffB);
            PG8_BAR; PG8_WAIT_L(0); PG8_MMA(0, 1, At, B1); PG8_BAR;
            PG8_LDA(At, 0, 1); PG8_STAGE(PG8_SA(0, 0), a2, voffA);
            PG8_BAR; PG8_WAIT_L(0); PG8_MMA(1, 0, At, B0); PG8_BAR; PG8_SCHED;
            PG8_STAGE(PG8_SB(0, 1), b2 + hstep, voffB);
            PG8_WAIT_V(6); PG8_BAR; PG8_MMA(1, 1, At, B1); PG8_BAR;
            PG8_LDB(B0, 1, 0); PG8_SCHED; PG8_LDA(At, 1, 0); PG8_STAGE(PG8_SA(0, 1), a2 + hstep, voffA);
            PG8_WAIT_L(8); PG8_BAR; PG8_WAIT_L(0); PG8_MMA(0, 0, At, B0); PG8_BAR; PG8_SCHED;
            PG8_LDB(B1, 1, 1); PG8_STAGE(PG8_SB(1, 0), b3, voffB);
            PG8_BAR; PG8_WAIT_L(0); PG8_MMA(0, 1, At, B1); PG8_BAR;
            PG8_LDA(At, 1, 1); PG8_STAGE(PG8_SA(1, 0), a3, voffA);
            PG8_BAR; PG8_WAIT_L(0); PG8_MMA(1, 0, At, B0); PG8_BAR; PG8_SCHED;
            PG8_STAGE(PG8_SB(1, 1), b3 + hstep, voffB);
            PG8_WAIT_V(6); PG8_BAR; PG8_MMA(1, 1, At, B1); PG8_BAR;
            }
        }
        if constexpr (ALIGN_EPI) { if (wr == 0) PG8_BAR; }
        E(acc, cur, wr, wc, fr, fq);
        if (!has_next) break;
#pragma unroll
        for (int a = 0; a < 2; ++a)
#pragma unroll
            for (int b = 0; b < 2; ++b)
#pragma unroll
                for (int m = 0; m < 4; ++m)
#pragma unroll
                    for (int n = 0; n < 2; ++n) acc[a][b][m][n] = (f32x4){0.f, 0.f, 0.f, 0.f};
        cur = nxt; cA = nA; cB = nB; ++ui;
        if constexpr (ALIGN_EPI) { if (wr == 1) PG8_BAR; }
    }
    PG8_WAIT_V(0);
    if constexpr (!ALIGN_EPI) { if (wr == 0) PG8_BAR; }
    PG8_BAR;
#undef PG8_SA
#undef PG8_SB
#undef PG8_STAGE
#undef PG8_LDA
#undef PG8_LDB
#undef PG8_MMA
#undef PG8_WAIT_V
#undef PG8_WAIT_L
#undef PG8_BAR
#undef PG8_SCHED
}

struct EpiProj {
    static constexpr bool PERM = true;
    bf16_t* O; int ldc; const float* ssq;
    __device__ __forceinline__ void operator()(const f32x4 (&acc)[2][2][4][2], const Unit& u, int wr, int wc, int fr, int fq) const {
        const int row0 = u.pm * BM + wr * 64 + fr, col0 = u.pn * BM + wc * 32 + 8 * fq;
#pragma unroll
        for (int ai = 0; ai < 2; ++ai)
#pragma unroll
            for (int m = 0; m < 4; ++m) { const int row = row0 + ai * HALF + m * 16; const float rs = row_rstd(ssq, row, fq);
                bf16_t* rowp = O + (size_t)row * ldc + col0;
#pragma unroll
                for (int bj = 0; bj < 2; ++bj) { const f32x4 v0 = acc[ai][bj][m][0] * rs, v1 = acc[ai][bj][m][1] * rs;
                    u32x4 w; w.x = cvtpk(v0[0], v0[1]); w.y = cvtpk(v0[2], v0[3]); w.z = cvtpk(v1[0], v1[1]); w.w = cvtpk(v1[2], v1[3]);
                    *(u32x4*)(rowp + bj * HALF) = w; } }
    }
};
struct EpiSwiGLU {
    static constexpr bool PERM = true;
    bf16_t* O; const float* ssq;
    __device__ __forceinline__ void operator()(const f32x4 (&acc)[2][2][4][2], const Unit& u, int wr, int wc, int fr, int fq) const {
        const int row0 = u.pm * BM + wr * 64 + fr, col0 = u.pn * HALF + wc * 32 + 8 * fq;
#pragma unroll
        for (int ai = 0; ai < 2; ++ai)
#pragma unroll
            for (int m = 0; m < 4; ++m) { const int row = row0 + ai * HALF + m * 16; const float rs = row_rstd(ssq, row, fq);
                float h[8];
#pragma unroll
                for (int n = 0; n < 2; ++n)
#pragma unroll
                    for (int j = 0; j < 4; ++j) { const float gt = acc[ai][0][m][n][j] * rs, up = acc[ai][1][m][n][j] * rs; h[n * 4 + j] = gt * up * __builtin_amdgcn_rcpf(1.0f + __expf(-gt)); }
                u32x4 w; w.x = cvtpk(h[0], h[1]); w.y = cvtpk(h[2], h[3]); w.z = cvtpk(h[4], h[5]); w.w = cvtpk(h[6], h[7]);
                *(u32x4*)(O + (size_t)row * FF + col0) = w; }
    }
};
struct EpiResid {
    static constexpr bool PERM = false;
    float* X; bf16_t* XB; float* ssq;
    __device__ __forceinline__ void operator()(const f32x4 (&acc)[2][2][4][2], const Unit& u, int wr, int wc, int fr, int fq) const {
        const int row0 = u.pm * BM + wr * 64 + fr, col0 = u.pn * BM + wc * 32 + 4 * fq;
#pragma unroll
        for (int ai = 0; ai < 2; ++ai)
#pragma unroll
            for (int m = 0; m < 4; ++m) { const int row = row0 + ai * HALF + m * 16; const size_t off = (size_t)row * DM + col0; float ss = 0.f;
#pragma unroll
                for (int bj = 0; bj < 2; ++bj)
#pragma unroll
                    for (int n = 0; n < 2; ++n) { const size_t o = off + bj * HALF + n * 16; const f32x4 xv = *(const f32x4*)(X + o) + acc[ai][bj][m][n];
                        *(f32x4*)(X + o) = xv; u32x2 w; w.x = cvtpk(xv[0], xv[1]); w.y = cvtpk(xv[2], xv[3]); *(u32x2*)(XB + o) = w;
                        ss += (xv[0] * xv[0] + xv[1] * xv[1]) + (xv[2] * xv[2] + xv[3] * xv[3]); }
                ss = xor32_sum(xor16_sum(ss));
                if (fq == 0) ssq[(size_t)row * 32 + u.pn * 4 + wc] = ss; }
    }
};
template <int MODE> struct EpiLora {
    static constexpr bool PERM = false;
    float* O; const float* bias;
    __device__ __forceinline__ void operator()(const f32x4 (&acc)[2][2][4][2], const Unit& u, int wr, int wc, int fr, int fq) const {
        const int row0 = u.pm * BM + wr * 64 + fr, col0 = u.pn * BM + wc * 32 + 4 * fq;
#pragma unroll
        for (int bj = 0; bj < 2; ++bj)
#pragma unroll
            for (int n = 0; n < 2; ++n) { const int col = col0 + bj * HALF + n * 16;
                f32x4 bv = (f32x4){0.f, 0.f, 0.f, 0.f}; if (MODE != 2) bv = *(const f32x4*)(bias + col);
#pragma unroll
                for (int ai = 0; ai < 2; ++ai)
#pragma unroll
                    for (int m = 0; m < 4; ++m) { const int row = row0 + ai * HALF + m * 16; f32x4 v = acc[ai][bj][m][n] + bv;
                        if (MODE == 0) {
#pragma unroll
                            for (int j = 0; j < 4; ++j) { const float z = -v[j]; const float sp = fmaxf(z, 0.f) + __logf(1.0f + __expf(-fabsf(z))); v[j] = __expf(-__expf(-sp - 0.5f)); }
                        } else if (MODE == 1) {
#pragma unroll
                            for (int j = 0; j < 4; ++j) v[j] = sigmoidf_(v[j]);
                        }
                        *(f32x4*)(O + (size_t)row * 1024 + col) = v; } }
    }
};
}

template <int MAP>
__device__ __forceinline__ void transpose_item(const float* W, int K, int N, bf16_t* WT, const float* gk, LAS float* scr, int item, int lane) {
    const int nblk = N / 32, kb = item / nblk, nb = item % nblk, k0 = 64 * kb, n0 = 32 * nb;
    float v[32];
    const float* wp = W + (size_t)(k0 + (lane >> 5)) * N + n0 + (lane & 31);
#pragma unroll
    for (int i = 0; i < 32; ++i) v[i] = __builtin_nontemporal_load(wp + (size_t)(2 * i) * N);
    const int c = lane & 7;
    f32x4 g0 = (f32x4){1.f, 1.f, 1.f, 1.f}, g1 = g0;
    if (gk) { g0 = *(const f32x4*)(gk + k0 + 8 * c); g1 = *(const f32x4*)(gk + k0 + 8 * c + 4); }
#pragma unroll
    for (int i = 0; i < 32; ++i) scr[(2 * i + (lane >> 5)) * 33 + (lane & 31)] = v[i];
    asm volatile("s_waitcnt lgkmcnt(0)" ::: "memory");
#pragma unroll
    for (int j = 0; j < 4; ++j) { const int n = n0 + (lane >> 3) + 8 * j; const LAS float* s = scr + (8 * c) * 33 + (n - n0);
        float sc = 1.f; int drow = n;
        if (MAP == 0) { if (n < 512 || (n >= 1536 && n < 2048)) sc = QSC; }
        if (MAP == 1) { const int hn = n < FF ? n : n - FF; drow = (hn >> 7) * 256 + (n < FF ? 0 : 128) + (hn & 127); }
        const f32x4 h0 = g0 * sc, h1 = g1 * sc;
        u32x4 o; o.x = cvtpk(s[0 * 33] * h0[0], s[1 * 33] * h0[1]); o.y = cvtpk(s[2 * 33] * h0[2], s[3 * 33] * h0[3]); o.z = cvtpk(s[4 * 33] * h1[0], s[5 * 33] * h1[1]); o.w = cvtpk(s[6 * 33] * h1[2], s[7 * 33] * h1[3]);
        *(u32x4*)(WT + (size_t)drow * K + k0 + 8 * c) = o; }
    asm volatile("s_waitcnt lgkmcnt(0)" ::: "memory");
}

constexpr int I_IN = (DM / 64) * (INC / 32), I_OUT = (DM / 64) * (DM / 32), I_GU = (DM / 64) * (GU / 32), I_DN = (FF / 64) * (DM / 32);
constexpr int CONV_ITEMS = I_IN + I_OUT + I_GU + I_DN;
__device__ __forceinline__ void convert_item(KP p, int l, int r, LAS float* scr, int lane) {
    unsigned char* wb = p->ws + WS_W + (size_t)l * LW_STRIDE;
    if (r < I_IN) { transpose_item<0>(p->in[2] + (size_t)l * DM * INC, DM, INC, (bf16_t*)(wb + LW_WIN), p->in[1] + l * DM, scr, r, lane); return; } r -= I_IN;
    if (r < I_OUT) { transpose_item<2>(p->in[17] + (size_t)l * DM * DM, DM, DM, (bf16_t*)(wb + LW_WOUT), nullptr, scr, r, lane); return; } r -= I_OUT;
    if (r < I_GU) { transpose_item<1>(p->in[19] + (size_t)l * DM * GU, DM, GU, (bf16_t*)(wb + LW_WGU), p->in[18] + l * DM, scr, r, lane); return; } r -= I_GU;
    transpose_item<2>(p->in[20] + (size_t)l * FF * DM, FF, DM, (bf16_t*)(wb + LW_WDN), nullptr, scr, r, lane);
}

__device__ __forceinline__ void phase0(KP p, LAS unsigned char* lds, int gw, int NGW, int wave, int lane) {
    LAS float* scr = (LAS float*)(lds + wave * 16384);
    for (int it = gw; it < CONV_ITEMS; it += NGW) convert_item(p, 0, it, scr, lane);
    const int gt = gw * 64 + lane, NGT = NGW * 64;
    for (int l = 0; l < NL; ++l) {
        unsigned char* wb = p->ws + WS_W + (size_t)l * LW_STRIDE;
        bf16_t* w2t = (bf16_t*)(wb + LW_W2T); bf16_t* a2t = (bf16_t*)(wb + LW_A2T); bf16_t* g2t = (bf16_t*)(wb + LW_G2T);
        const float* w2 = p->in[8] + (size_t)l * 96 * 1024; const float* a2 = p->in[10] + (size_t)l * 96 * 1024; const float* g2 = p->in[11] + (size_t)l * 256 * 1024;
        for (int i = gt; i < 1024 * 128; i += NGT) { const int n = i >> 7, k = i & 127;
            w2t[i] = (bf16_t)(cvtpk(k < 96 ? w2[k * 1024 + n] : 0.f, 0.f) & 0xffff); a2t[i] = (bf16_t)(cvtpk(k < 96 ? a2[k * 1024 + n] : 0.f, 0.f) & 0xffff); }
        for (int i = gt; i < 1024 * 256; i += NGT) { const int n = i >> 8, k = i & 255; g2t[i] = (bf16_t)(cvtpk(g2[k * 1024 + n], 0.f) & 0xffff); }
        unsigned* padz = (unsigned*)(wb + LW_WIN + (size_t)INC * DM * 2);
        for (int i = gt; i < (INCP - INC) * DM / 2; i += NGT) padz[i] = 0u;
    }
    const float* x = p->in[0]; float* X = p->out; bf16_t* XB = (bf16_t*)(p->ws + WS_XB); float* ssqA = (float*)(p->ws + WS_SSQA);
    for (int m = gw; m < M; m += NGW) { float ss = 0.f;
#pragma unroll
        for (int j = 0; j < 8; ++j) { const size_t o = (size_t)m * DM + j * 256 + lane * 4; const f32x4 v = *(const f32x4*)(x + o); *(f32x4*)(X + o) = v;
            u32x2 w; w.x = cvtpk(v[0], v[1]); w.y = cvtpk(v[2], v[3]); *(u32x2*)(XB + o) = w; ss += (v[0] * v[0] + v[1] * v[1]) + (v[2] * v[2] + v[3] * v[3]); }
        ss = wave_sum(ss); if (lane < 32) ssqA[(size_t)m * 32 + lane] = lane == 0 ? ss : 0.f; }
}

__device__ __forceinline__ void phase_prep1(KP p, int l, LAS unsigned char* lds, int gw, int NGW, int wave, int lane) {
    const bf16_t* PROJ = (const bf16_t*)(p->ws + WS_PROJ);
    LAS unsigned short* tile = (LAS unsigned short*)(lds + wave * 8448);
    bf16_t* VAT = (bf16_t*)(p->ws + WS_VAT); bf16_t* VBT = (bf16_t*)(p->ws + WS_VBT);
    for (int it = gw; it < 128 * 10; it += NGW) {
        const int tb = it / 10, g = it % 10, t0 = tb * 64; const int cbase = g < 8 ? 1024 + 64 * g : 2176 + 64 * (g - 8);
        bf16_t* dst = g < 8 ? VAT + (size_t)(64 * g) * M : VBT + (size_t)(64 * (g - 8)) * M;
#pragma unroll
        for (int i = 0; i < 8; ++i) { const int row = i * 8 + (lane >> 3), ch = lane & 7; const u32x4 v = *(const u32x4*)(PROJ + (size_t)(t0 + row) * INCP + cbase + 8 * ch);
            LAS unsigned* d = (LAS unsigned*)(tile + row * 66 + 8 * ch); d[0] = v.x; d[1] = v.y; d[2] = v.z; d[3] = v.w; }
        asm volatile("s_waitcnt lgkmcnt(0)" ::: "memory");
#pragma unroll
        for (int i = 0; i < 8; ++i) { const int c = i * 8 + (lane >> 3), tch = lane & 7, j = tch >> 1, hi = tch & 1; unsigned short v[8];
#pragma unroll
            for (int s = 0; s < 8; ++s) v[s] = tile[(16 * j + (s & 3) + 8 * (s >> 2) + 4 * hi) * 66 + c];
            u32x4 o; o.x = v[0] | ((unsigned)v[1] << 16); o.y = v[2] | ((unsigned)v[3] << 16); o.z = v[4] | ((unsigned)v[5] << 16); o.w = v[6] | ((unsigned)v[7] << 16);
            *(u32x4*)(dst + (size_t)c * M + t0 + 16 * j + 8 * hi) = o; }
        asm volatile("s_waitcnt lgkmcnt(0)" ::: "memory");
    }
    const float* mu = p->in[6] + (size_t)l * RWC;
    bf16_t* AW = (bf16_t*)(p->ws + WS_AW); bf16_t* AA = (bf16_t*)(p->ws + WS_AA); bf16_t* AG = (bf16_t*)(p->ws + WS_AG);
    float knmax = 0.f;
    for (int t = gw; t < M; t += NGW) {
        const bf16_t* cur = PROJ + (size_t)t * INCP + RW0;
        {   const u32x4 kv = *(const u32x4*)(PROJ + (size_t)t * INCP + 512 + 8 * lane);
            float a0 = bflo(kv.x), a1 = bfhi(kv.x), a2 = bflo(kv.y), a3 = bfhi(kv.y), a4 = bflo(kv.z), a5 = bfhi(kv.z), a6 = bflo(kv.w), a7 = bfhi(kv.w);
            float ss = (a0 * a0 + a1 * a1) + (a2 * a2 + a3 * a3) + (a4 * a4 + a5 * a5) + (a6 * a6 + a7 * a7);
            ss += dppm<0xB1>(ss); ss += dppm<0x4E>(ss); ss += dppm<0x141>(ss); knmax = fmaxf(knmax, ss); }
        if (lane < 56) { const int j0 = 3072 + 8 * lane;
            const u32x4 c4 = *(const u32x4*)(cur + j0); u32x4 p4 = (u32x4){0u, 0u, 0u, 0u}; if (t > 0) p4 = *(const u32x4*)(cur - INCP + j0);
            const f32x4 m0 = *(const f32x4*)(mu + j0), m1 = *(const f32x4*)(mu + j0 + 4);
            float f[8]; const unsigned cw[4] = {c4.x, c4.y, c4.z, c4.w}, pw[4] = {p4.x, p4.y, p4.z, p4.w};
#pragma unroll
            for (int q = 0; q < 4; ++q) { const float c0 = bflo(cw[q]), c1 = bfhi(cw[q]), p0 = bflo(pw[q]), p1 = bfhi(pw[q]);
                const float mu0 = q < 2 ? m0[2 * q] : m1[2 * q - 4], mu1 = q < 2 ? m0[2 * q + 1] : m1[2 * q - 3];
                f[2 * q] = c0 + (p0 - c0) * mu0; f[2 * q + 1] = c1 + (p1 - c1) * mu1; }
            bf16_t* dstp;
            if (j0 < 3168) { dstp = AW + (size_t)t * 128 + (j0 - 3072);
#pragma unroll
                for (int q = 0; q < 8; ++q) f[q] = tanhf(f[q]); }
            else if (j0 < 3264) { dstp = AA + (size_t)t * 128 + (j0 - 3168); }
            else { dstp = AG + (size_t)t * 256 + (j0 - 3264);
#pragma unroll
                for (int q = 0; q < 8; ++q) f[q] = sigmoidf_(f[q]); }
            u32x4 o; o.x = cvtpk(f[0], f[1]); o.y = cvtpk(f[2], f[3]); o.z = cvtpk(f[4], f[5]); o.w = cvtpk(f[6], f[7]); *(u32x4*)dstp = o; }
        else { const int e = lane - 56; if (e < 4) *(u32x4*)(AW + (size_t)t * 128 + 96 + 8 * e) = (u32x4){0u, 0u, 0u, 0u}; else *(u32x4*)(AA + (size_t)t * 128 + 96 + 8 * (e - 4)) = (u32x4){0u, 0u, 0u, 0u}; }
    }
    {   LAS float* kr = (LAS float*)(lds + 8 * 8448);
        if ((lane & 7) == 0) kr[wave * 8 + (lane >> 3)] = knmax;
        __syncthreads();
        if (wave == 0 && lane < 8) { float m = kr[lane];
#pragma unroll
            for (int w2 = 1; w2 < 8; ++w2) m = fmaxf(m, kr[w2 * 8 + lane]);
            ((float*)(p->ws + WS_KNP))[(size_t)(gw >> 3) * 8 + lane] = m; }
        __syncthreads(); }
}

__device__ __forceinline__ void phase_prep2(KP p, int l, int gw, int NGW, int lane) {
    const float* KR = (const float*)(p->ws + WS_KR); const float* A = (const float*)(p->ws + WS_A);
    float* KF = (float*)(p->ws + WS_KF); float* AN = (float*)(p->ws + WS_AN); float* BB = (float*)(p->ws + WS_BB);
    const float* k_k = p->in[12] + l * 1024; const float* k_a = p->in[13] + l * 1024;
    const int c0 = 16 * lane;
    for (int t = gw; t < M; t += NGW) { const size_t o = (size_t)t * 1024 + c0; float n2 = 0.f; f32x4 kkv[4], kr[4], av[4];
#pragma unroll
        for (int q = 0; q < 4; ++q) { kr[q] = *(const f32x4*)(KR + o + 4 * q); av[q] = *(const f32x4*)(A + o + 4 * q); kkv[q] = kr[q] * *(const f32x4*)(k_k + c0 + 4 * q);
            n2 += (kkv[q][0] * kkv[q][0] + kkv[q][1] * kkv[q][1]) + (kkv[q][2] * kkv[q][2] + kkv[q][3] * kkv[q][3]); }
        n2 = quad_sum(n2); const float inv = 1.0f / fmaxf(sqrtf(n2), 1e-12f);
#pragma unroll
        for (int q = 0; q < 4; ++q) { const f32x4 kk = kkv[q] * inv; const f32x4 ka = *(const f32x4*)(k_a + c0 + 4 * q);
            *(f32x4*)(KF + o + 4 * q) = kr[q] * (1.0f + (av[q] - 1.0f) * ka); *(f32x4*)(AN + o + 4 * q) = -kk; *(f32x4*)(BB + o + 4 * q) = kk * av[q]; }
    }
}

template <int MODE>
__device__ __forceinline__ void scan_task(KP p, int l, LAS unsigned char* wl, int c, int h, int lane) {
    constexpr int NPV = MODE == 0 ? 1 : (MODE == 1 ? 2 : 3);
    constexpr int SB = 4;
    LAS float* vec = (LAS float*)wl;
    LAS float* ybuf = (LAS float*)(wl + 7 * SB * 256);
    const float* DECp = (const float*)(p->ws + WS_DEC); const float* Ap = (const float*)(p->ws + WS_A); const bf16_t* PROJ = (const bf16_t*)(p->ws + WS_PROJ);
    const int rb = lane >> 2, cb = lane & 3, t0 = c * CL;
    f32x2 s[4][8];
    if (MODE == 0) {
#pragma unroll
        for (int r = 0; r < 4; ++r)
#pragma unroll
            for (int q = 0; q < 8; ++q) { s[r][q].x = (4 * rb + r == 16 * cb + 2 * q) ? 1.f : 0.f; s[r][q].y = (4 * rb + r == 16 * cb + 2 * q + 1) ? 1.f : 0.f; }
    } else if (MODE == 1) {
#pragma unroll
        for (int r = 0; r < 4; ++r)
#pragma unroll
            for (int q = 0; q < 8; ++q) s[r][q] = (f32x2){0.f, 0.f};
    } else {
        const float* SI = (const float*)(p->ws + WS_SI) + ((size_t)(h * NCH + c)) * 4096;
#pragma unroll
        for (int x = 0; x < 16; ++x) { const f32x4 v = *(const f32x4*)(SI + (16 * cb + x) * 64 + 4 * rb);
#pragma unroll
            for (int r = 0; r < 4; ++r) { if (x & 1) s[r][x >> 1].y = v[r]; else s[r][x >> 1].x = v[r]; } }
    }
    const int lst = lane >> 4, lq = lane & 15;
    const f32x4 kk4 = *(const f32x4*)(p->in[12] + l * 1024 + 64 * h + 4 * lq), ka4 = *(const f32x4*)(p->in[13] + l * 1024 + 64 * h + 4 * lq);
    f32x4 lnw4 = (f32x4){0.f, 0.f, 0.f, 0.f}, lnb4 = lnw4, rk4 = lnw4;
    if (MODE == 2) { lnw4 = *(const f32x4*)(p->in[15] + l * 1024 + 64 * h + 4 * lq); lnb4 = *(const f32x4*)(p->in[16] + l * 1024 + 64 * h + 4 * lq); rk4 = *(const f32x4*)(p->in[14] + l * 1024 + 64 * h + 4 * lq); }
    const size_t goff = (size_t)(t0 + lst) * 1024 + 64 * h + 4 * lq;
    const int pvo[3] = {1024, 2048, 0};
    f32x4 mu4[NPV];
#pragma unroll
    for (int v = 0; v < NPV; ++v) mu4[v] = *(const f32x4*)(p->in[6] + (size_t)l * RWC + pvo[v] + 64 * h + 4 * lq);
    const bf16_t* pj = PROJ + (size_t)(t0 + lst) * INCP + RW0 + 64 * h + 4 * lq;
    const float* Gp = (const float*)(p->ws + WS_G);
    struct Pre { f32x4 dec, a, g; u32x2 cur[NPV], prv[NPV]; };
    Pre pA, pB;
#define SCAN_LOAD(P_, SBI) do { if ((SBI) < CL / SB) { const size_t ro = (size_t)(SB * (SBI)); P_.dec = *(const f32x4*)(DECp + goff + ro * 1024); P_.a = *(const f32x4*)(Ap + goff + ro * 1024); \
        if constexpr (MODE == 2) P_.g = *(const f32x4*)(Gp + goff + ro * 1024); \
        const bool first = (t0 + (int)ro + lst) == 0; \
        _Pragma("unroll") for (int v = 0; v < NPV; ++v) { P_.cur[v] = *(const u32x2*)(pj + ro * INCP + pvo[v]); P_.prv[v] = first ? (u32x2){0u, 0u} : *(const u32x2*)(pj + ro * INCP + pvo[v] - INCP); } } } while (0)
#define SCAN_SHIFT(P_, V) ({ const f32x4 c_ = (f32x4){bflo(P_.cur[V].x), bfhi(P_.cur[V].x), bflo(P_.cur[V].y), bfhi(P_.cur[V].y)}, q_ = (f32x4){bflo(P_.prv[V].x), bfhi(P_.prv[V].x), bflo(P_.prv[V].y), bfhi(P_.prv[V].y)}; c_ + (q_ - c_) * mu4[V]; })
#define SCAN_STAGE(P_) do { const f32x4 kr = SCAN_SHIFT(P_, 0), av = P_.a; const f32x4 kkv = kr * kk4; \
        float n2 = (kkv[0] * kkv[0] + kkv[1] * kkv[1]) + (kkv[2] * kkv[2] + kkv[3] * kkv[3]); n2 = row16_sum(n2); \
        const float inv = __builtin_amdgcn_rsqf(fmaxf(n2, 1e-24f)); const f32x4 kkn = kkv * inv; \
        LAS float* vw = vec + lst * 64 + 4 * lq; \
        *(LAS f32x4*)(vw + 0 * SB * 64) = P_.dec; *(LAS f32x4*)(vw + 1 * SB * 64) = -kkn; *(LAS f32x4*)(vw + 2 * SB * 64) = kkn * av; \
        if constexpr (MODE != 0) { *(LAS f32x4*)(vw + 3 * SB * 64) = kr * (1.0f + (av - 1.0f) * ka4); *(LAS f32x4*)(vw + 4 * SB * 64) = SCAN_SHIFT(P_, 1); } \
        if constexpr (MODE == 2) { *(LAS f32x4*)(vw + 5 * SB * 64) = SCAN_SHIFT(P_, 2); *(LAS f32x4*)(vw + 6 * SB * 64) = P_.g; } } while (0)
    SCAN_LOAD(pA, 0); SCAN_LOAD(pB, 1);
    for (int sb = 0; sb < CL / SB; ++sb) {
        if (sb & 1) { SCAN_STAGE(pB); SCAN_LOAD(pB, sb + 2); } else { SCAN_STAGE(pA); SCAN_LOAD(pA, sb + 2); }
#pragma unroll 1
        for (int st = 0; st < SB; ++st) {
            const LAS float* vb = vec + st * 64 + 16 * cb;
            float sa[4];
            {   f32x2 a2[8];
#pragma unroll
                for (int q = 0; q < 4; ++q) { const f32x4 y = *(const LAS f32x4*)(vb + 1 * SB * 64 + 4 * q); a2[2 * q] = (f32x2){y[0], y[1]}; a2[2 * q + 1] = (f32x2){y[2], y[3]}; }
                f32x2 c0[4];
#pragma unroll
                for (int r = 0; r < 4; ++r) c0[r] = s[r][0] * a2[0];
#pragma unroll
                for (int q = 1; q < 8; ++q)
#pragma unroll
                    for (int r = 0; r < 4; ++r) c0[r] = s[r][q] * a2[q] + c0[r];
                float e[4];
#pragma unroll
                for (int r = 0; r < 4; ++r) e[r] = c0[r].x + c0[r].y;
#pragma unroll
                for (int r = 0; r < 4; ++r) e[r] += dpp_xor1(e[r]);
#pragma unroll
                for (int r = 0; r < 4; ++r) sa[r] = e[r] + dpp_xor2(e[r]); }
            f32x4 vv = (f32x4){0.f, 0.f, 0.f, 0.f};
            if (MODE != 0) vv = *(const LAS f32x4*)(vec + (4 * SB + st) * 64 + 4 * rb);
#pragma unroll
            for (int q = 0; q < 4; ++q) { const f32x4 w4 = *(const LAS f32x4*)(vb + 0 * SB * 64 + 4 * q), b4 = *(const LAS f32x4*)(vb + 2 * SB * 64 + 4 * q);
                const f32x2 w0 = (f32x2){w4[0], w4[1]}, w1 = (f32x2){w4[2], w4[3]}, b0 = (f32x2){b4[0], b4[1]}, b1 = (f32x2){b4[2], b4[3]};
                f32x2 k0 = (f32x2){0.f, 0.f}, k1 = k0;
                if (MODE != 0) { const f32x4 k4 = *(const LAS f32x4*)(vb + 3 * SB * 64 + 4 * q); k0 = (f32x2){k4[0], k4[1]}; k1 = (f32x2){k4[2], k4[3]}; }
#pragma unroll
                for (int hf = 0; hf < 2; ++hf) { const f32x2 bh = hf ? b1 : b0, kh = hf ? k1 : k0, wh = hf ? w1 : w0;
                    f32x2 tt[4];
#pragma unroll
                    for (int r = 0; r < 4; ++r) tt[r] = bh * sa[r];
                    if (MODE != 0) {
#pragma unroll
                        for (int r = 0; r < 4; ++r) tt[r] = kh * vv[r] + tt[r]; }
#pragma unroll
                    for (int r = 0; r < 4; ++r) s[r][2 * q + hf] = s[r][2 * q + hf] * wh + tt[r]; } }
            if (MODE == 2) {
                f32x2 r2[8];
#pragma unroll
                for (int q = 0; q < 4; ++q) { const f32x4 x = *(const LAS f32x4*)(vb + 5 * SB * 64 + 4 * q); r2[2 * q] = (f32x2){x[0], x[1]}; r2[2 * q + 1] = (f32x2){x[2], x[3]}; }
                f32x4 yv;
                f32x2 c0[4];
#pragma unroll
                for (int r = 0; r < 4; ++r) c0[r] = s[r][0] * r2[0];
#pragma unroll
                for (int q = 1; q < 8; ++q)
#pragma unroll
                    for (int r = 0; r < 4; ++r) c0[r] = s[r][q] * r2[q] + c0[r];
                float e[4];
#pragma unroll
                for (int r = 0; r < 4; ++r) e[r] = c0[r].x + c0[r].y;
#pragma unroll
                for (int r = 0; r < 4; ++r) e[r] += dpp_xor1(e[r]);
#pragma unroll
                for (int r = 0; r < 4; ++r) yv[r] = e[r] + dpp_xor2(e[r]);
                if (cb == 0) *(LAS f32x4*)(ybuf + st * 64 + 4 * rb) = yv;
            }
        }
        if (MODE == 2) {
            bf16_t* MIX = (bf16_t*)(p->ws + WS_MIX);
            const int t = t0 + SB * sb + lst; const LAS float* vr = vec + lst * 64 + 4 * lq;
            const f32x4 y = *(const LAS f32x4*)(ybuf + lst * 64 + 4 * lq), rr = *(const LAS f32x4*)(vr + 5 * SB * 64), kk = *(const LAS f32x4*)(vr + 3 * SB * 64),
                        vv = *(const LAS f32x4*)(vr + 4 * SB * 64), g = *(const LAS f32x4*)(vr + 6 * SB * 64);
            const float mean = row16_sum((y[0] + y[1]) + (y[2] + y[3])) * (1.0f / 64.0f);
            const f32x4 d = y - mean;
            const float var = row16_sum((d[0] * d[0] + d[1] * d[1]) + (d[2] * d[2] + d[3] * d[3])) * (1.0f / 64.0f);
            const f32x4 rkk = rr * kk * rk4;
            const float bon = row16_sum((rkk[0] + rkk[1]) + (rkk[2] + rkk[3]));
            const f32x4 o = (d * __builtin_amdgcn_rsqf(var + 64e-5f) * lnw4 + lnb4 + vv * bon) * g;
            u32x2 wv; wv.x = cvtpk(o[0], o[1]); wv.y = cvtpk(o[2], o[3]);
            *(u32x2*)(MIX + (size_t)t * DM + 1024 + 64 * h + 4 * lq) = wv;
        }
    }
    if (MODE == 0) { float* dst = (float*)(p->ws + WS_PB) + ((size_t)(h * NCH + c)) * 4096;
#pragma unroll
        for (int r = 0; r < 4; ++r)
#pragma unroll
            for (int q = 0; q < 4; ++q) *(f32x4*)(dst + (4 * rb + r) * 64 + 16 * cb + 4 * q) = (f32x4){s[r][2 * q].x, s[r][2 * q].y, s[r][2 * q + 1].x, s[r][2 * q + 1].y}; }
    if (MODE == 1) { float* dst = (float*)(p->ws + WS_UB) + ((size_t)(h * NCH + c)) * 4096;
#pragma unroll
        for (int x = 0; x < 16; ++x) { f32x4 v;
#pragma unroll
            for (int r = 0; r < 4; ++r) v[r] = (x & 1) ? s[r][x >> 1].y : s[r][x >> 1].x;
            *(f32x4*)(dst + (16 * cb + x) * 64 + 4 * rb) = v; } }
}

#undef SCAN_LOAD
#undef SCAN_SHIFT
#undef SCAN_STAGE
__device__ __forceinline__ void s2_head(KP p, LAS unsigned char* lds, int h, int ti, const int tid) {
    const float* PB = (const float*)(p->ws + WS_PB) + (size_t)h * NCH * 4096; const float* UT = (const float*)(p->ws + WS_UB) + (size_t)h * NCH * 4096;
    float* SI = (float*)(p->ws + WS_SI) + (size_t)h * NCH * 4096;
    const int lane = tid & 63, w = __builtin_amdgcn_readfirstlane(tid >> 6), n = lane & 31, lh = lane >> 5, to = (w >> 1) & 1, tj = w & 1;
    static_assert((NCH - 1) % 3 == 0, "three rotating prefetch buffers");
    if (w >= 4) {
        for (int c = 0; c < NCH - 1; ++c) __syncthreads();
    } else {
        f32x16 breg, ua, ub, uc2; float pa[16], pb[16], pc2[16];
#pragma unroll
        for (int r = 0; r < 16; ++r) breg[r] = 0.f;
        const int offu = (32 * to + 4 * lh) * 64 + 32 * ti + n, offp = (32 * tj + 4 * lh) * 64 + 32 * to + n, offs = (32 * tj + 4 * lh) * 64 + 32 * ti + n;
#define S2_LOAD(CH, U_, P_) do { const int ch_ = (CH) < NCH - 1 ? (CH) : NCH - 2; const float* pb_ = PB + (size_t)ch_ * 4096 + offp; const float* ub_ = UT + (size_t)ch_ * 4096 + offu; \
        _Pragma("unroll") for (int r = 0; r < 16; ++r) { const int cr = ((r & 3) + 8 * (r >> 2)) * 64; U_[r] = tj == 0 ? ub_[cr] : 0.f; P_[r] = pb_[cr]; } } while (0)
#define S2_STEP(C, UC_, PC_, UN_, PN_) do { \
        if (to == 0) { float* si = SI + (size_t)(C) * 4096 + offs; \
            _Pragma("unroll") for (int r = 0; r < 16; ++r) si[((r & 3) + 8 * (r >> 2)) * 64] = breg[r]; } \
        f32x16 acc = UC_; \
        _Pragma("unroll") for (int r = 0; r < 16; ++r) acc = __builtin_amdgcn_mfma_f32_32x32x2f32(PC_[r], breg[r], acc, 0, 0, 0); \
        LAS f32x4* ex = (LAS f32x4*)(lds + ((C) & 1) * 16384); \
        _Pragma("unroll") for (int q = 0; q < 4; ++q) ex[(w * 4 + q) * 64 + lane] = (f32x4){acc[4 * q], acc[4 * q + 1], acc[4 * q + 2], acc[4 * q + 3]}; \
        __syncthreads(); \
        S2_LOAD((C) + 2, UN_, PN_); \
        _Pragma("unroll") for (int q = 0; q < 4; ++q) { const f32x4 v0 = ex[((tj * 2) * 4 + q) * 64 + lane], v1 = ex[((tj * 2 + 1) * 4 + q) * 64 + lane]; \
            breg[4 * q] = v0[0] + v1[0]; breg[4 * q + 1] = v0[1] + v1[1]; breg[4 * q + 2] = v0[2] + v1[2]; breg[4 * q + 3] = v0[3] + v1[3]; } } while (0)
        S2_LOAD(0, ua, pa); S2_LOAD(1, ub, pb);
#pragma unroll 1
        for (int c = 0; c < NCH - 1; c += 3) {
            S2_STEP(c, ua, pa, uc2, pc2);
            S2_STEP(c + 1, ub, pb, ua, pa);
            S2_STEP(c + 2, uc2, pc2, ub, pb);
        }
        if (to == 0) { float* si = SI + (size_t)(NCH - 1) * 4096 + offs;
#pragma unroll
            for (int r = 0; r < 16; ++r) si[((r & 3) + 8 * (r >> 2)) * 64] = breg[r]; }
#undef S2_LOAD
#undef S2_STEP
    }
    __syncthreads();
}

template <int DV, bool SWA>
__device__ __forceinline__ void attn_unit(LAS unsigned char* lds, const bf16_t* Q, const bf16_t* Kp, const bf16_t* VT, float slope2, int q0, float sink2,
                                          float* Of32, float* MLp, bf16_t* Obf, const int tid, int kt_lo, int kt_hi, float kn) {
    constexpr int KROW = 144, KTILE = 64 * KROW, VTILE = DV * KROW, BUF = KTILE + VTILE, NVL = DV / 64;
    const int lane = tid & 63, w = __builtin_amdgcn_readfirstlane(tid >> 6), r32 = lane & 31, hi = lane >> 5;
    const int qpos = q0 + 32 * w + r32;
    bf16x8 qf[4];
#pragma unroll
    for (int j = 0; j < 4; ++j) qf[j] = *(const bf16x8*)(Q + (size_t)qpos * INCP + 16 * j + 8 * hi);
    int kt0 = kt_lo, kt1 = kt_hi;
    if (!SWA) {
        float qq = 0.f, qk = 0.f;
#pragma unroll
        for (int j = 0; j < 4; ++j) { const bf16x8 kf = *(const bf16x8*)(Kp + (size_t)qpos * INCP + 16 * j + 8 * hi);
#pragma unroll
            for (int e = 0; e < 8; ++e) { const float qv = bf2f((unsigned short)qf[j][e]), kv = bf2f((unsigned short)kf[e]); qq += qv * qv; qk += qv * kv; } }
        qq = xor32_sum(qq); qk = xor32_sum(qk);
        const float dneed = (sqrtf(qq) * kn - qk + 45.0f) / slope2;
        float kneed = (float)qpos - dneed;
        kneed = fminf(kneed, dppm<0xB1>(kneed)); kneed = fminf(kneed, dppm<0x4E>(kneed)); kneed = fminf(kneed, dppm<0x141>(kneed)); kneed = fminf(kneed, dppm<0x140>(kneed));
        LAS float* red = (LAS float*)(lds + 2 * BUF);
        if ((lane & 15) == 0) red[w * 4 + (lane >> 4)] = kneed;
        __syncthreads();
        float km = red[0];
#pragma unroll
        for (int i = 1; i < 32; ++i) km = fminf(km, red[i]);
        const int ktw = km <= 0.f ? 0 : ((int)km >> 6);
        kt0 = ktw > kt_lo ? ktw : kt_lo;
    }
    const int qlo = q0 + 32 * w, qhi = qlo + 31;
    f32x16 o[DV / 32];
#pragma unroll
    for (int d = 0; d < DV / 32; ++d)
#pragma unroll
        for (int r = 0; r < 16; ++r) o[d][r] = 0.f;
    float mrun = 0.f, lsum = 0.f;
    const int krow = tid >> 3, kch = tid & 7;
    u32x4 kreg, vreg[NVL];
    if (kt0 <= kt1) {   const int k0 = 64 * kt0; kreg = *(const u32x4*)(Kp + (size_t)(k0 + krow) * INCP + 8 * kch);
#pragma unroll
        for (int i = 0; i < NVL; ++i) { const int idx = tid + 512 * i; vreg[i] = *(const u32x4*)(VT + (size_t)(idx >> 3) * M + k0 + 8 * (idx & 7)); } }
    for (int kt = kt0; kt <= kt1; ++kt) {
        LAS unsigned char* buf = lds + ((kt - kt0) & 1) * BUF;
        *(LAS u32x4*)(buf + krow * KROW + 16 * kch) = kreg;
#pragma unroll
        for (int i = 0; i < NVL; ++i) { const int idx = tid + 512 * i; *(LAS u32x4*)(buf + KTILE + (idx >> 3) * KROW + 16 * (idx & 7)) = vreg[i]; }
        __syncthreads();
        if (kt < kt1) { const int k0 = 64 * (kt + 1); kreg = *(const u32x4*)(Kp + (size_t)(k0 + krow) * INCP + 8 * kch);
#pragma unroll
            for (int i = 0; i < NVL; ++i) { const int idx = tid + 512 * i; vreg[i] = *(const u32x4*)(VT + (size_t)(idx >> 3) * M + k0 + 8 * (idx & 7)); } }
        const int k0 = 64 * kt;
        bool act = k0 <= qhi; if (SWA) act = act && (k0 + 63 >= qlo - 127);
        if (act) {
            f32x16 p0, p1;
            {   const float c0 = slope2 * (float)(k0 + 4 * hi - qpos) - mrun, c1 = c0 + 32.0f * slope2;
#pragma unroll
                for (int r = 0; r < 16; ++r) { const float cr = (float)((r & 3) + 8 * (r >> 2)); p0[r] = __builtin_fmaf(slope2, cr, c0); p1[r] = __builtin_fmaf(slope2, cr, c1); } }
#pragma unroll
            for (int j = 0; j < 4; ++j) { const bf16x8 a0 = *(const LAS bf16x8*)(buf + r32 * KROW + 32 * j + 16 * hi), a1 = *(const LAS bf16x8*)(buf + (r32 + 32) * KROW + 32 * j + 16 * hi);
                p0 = __builtin_amdgcn_mfma_f32_32x32x16_bf16(a0, qf[j], p0, 0, 0, 0); p1 = __builtin_amdgcn_mfma_f32_32x32x16_bf16(a1, qf[j], p1, 0, 0, 0); }
            bool need_mask = k0 + 63 > qlo; if (SWA) need_mask = need_mask || (qhi - k0 >= 128);
            if (need_mask) {
#pragma unroll
                for (int r = 0; r < 16; ++r) { const int kv = k0 + (r & 3) + 8 * (r >> 2) + 4 * hi; const int d0 = qpos - kv, d1 = d0 - 32;
                    bool ok0 = d0 >= 0, ok1 = d1 >= 0; if (SWA) { ok0 = ok0 && d0 < 128; ok1 = ok1 && d1 < 128; }
                    p0[r] = ok0 ? p0[r] : -1e30f; p1[r] = ok1 ? p1[r] : -1e30f; } }
            float mx = fmaxf(p0[0], p1[0]);
#pragma unroll
            for (int r = 1; r < 16; ++r) mx = fmaxf(mx, fmaxf(p0[r], p1[r]));
            mx = xor32_max(mx);
            if (__builtin_amdgcn_ballot_w64(mx > 8.0f) != 0ull) {
                const float d = fmaxf(mx, 0.f), f = __builtin_amdgcn_exp2f(-d); mrun += d; lsum *= f;
#pragma unroll
                for (int r = 0; r < 16; ++r) { p0[r] -= d; p1[r] -= d; }
#pragma unroll
                for (int dd = 0; dd < DV / 32; ++dd)
#pragma unroll
                    for (int r = 0; r < 16; ++r) o[dd][r] *= f; }
            float rs = 0.f;
#pragma unroll
            for (int r = 0; r < 16; ++r) { p0[r] = __builtin_amdgcn_exp2f(p0[r]); p1[r] = __builtin_amdgcn_exp2f(p1[r]); rs += p0[r] + p1[r]; }
            lsum += rs;
            u32x4 pw[4];
            pw[0] = (u32x4){cvtpk(p0[0], p0[1]), cvtpk(p0[2], p0[3]), cvtpk(p0[4], p0[5]), cvtpk(p0[6], p0[7])};
            pw[1] = (u32x4){cvtpk(p0[8], p0[9]), cvtpk(p0[10], p0[11]), cvtpk(p0[12], p0[13]), cvtpk(p0[14], p0[15])};
            pw[2] = (u32x4){cvtpk(p1[0], p1[1]), cvtpk(p1[2], p1[3]), cvtpk(p1[4], p1[5]), cvtpk(p1[6], p1[7])};
            pw[3] = (u32x4){cvtpk(p1[8], p1[9]), cvtpk(p1[10], p1[11]), cvtpk(p1[12], p1[13]), cvtpk(p1[14], p1[15])};
#pragma unroll
            for (int d = 0; d < DV / 32; ++d)
#pragma unroll
                for (int j = 0; j < 4; ++j) { const bf16x8 vf = *(const LAS bf16x8*)(buf + KTILE + (32 * d + r32) * KROW + 32 * j + 16 * hi);
                    o[d] = __builtin_amdgcn_mfma_f32_32x32x16_bf16(vf, __builtin_bit_cast(bf16x8, pw[j]), o[d], 0, 0, 0); }
        }
    }
    lsum = xor32_sum(lsum);
    if (SWA) { lsum += __builtin_amdgcn_exp2f(sink2 - mrun);
        const float inv = 1.0f / lsum; bf16_t* op = Obf + (size_t)qpos * DM;
#pragma unroll
        for (int d = 0; d < DV / 32; ++d)
#pragma unroll
            for (int g = 0; g < 4; ++g) { u32x2 wv; wv.x = cvtpk(o[d][4 * g] * inv, o[d][4 * g + 1] * inv); wv.y = cvtpk(o[d][4 * g + 2] * inv, o[d][4 * g + 3] * inv);
                *(u32x2*)(op + 32 * d + 8 * g + 4 * hi) = wv; }
    } else { float* op = Of32 + (size_t)qpos * 1024;
#pragma unroll
        for (int d = 0; d < DV / 32; ++d)
#pragma unroll
            for (int g = 0; g < 4; ++g) *(f32x4*)(op + 32 * d + 8 * g + 4 * hi) = (f32x4){o[d][4 * g], o[d][4 * g + 1], o[d][4 * g + 2], o[d][4 * g + 3]};
        if (hi == 0) *(f32x2*)(MLp + (size_t)qpos * 16) = (f32x2){mrun, lsum};
    }
    __syncthreads();
}

__device__ __forceinline__ void phase_diffcombine(KP p, int l, int gw, int NGW, int lane) {
    const float* lamv = p->in[3] + l * 256;
    const float lambda_init = 0.8f - 0.6f * expf(-0.3f * (float)l);
    const float s1 = wave_sum(lamv[lane] * lamv[64 + lane]), s2 = wave_sum(lamv[128 + lane] * lamv[192 + lane]);
    const float lam = expf(s1) - expf(s2) + lambda_init;
    const float* OD = (const float*)(p->ws + WS_OD); const float* ML = (const float*)(p->ws + WS_ML); bf16_t* MIX = (bf16_t*)(p->ws + WS_MIX);
    const int h = lane >> 4, d0 = (lane & 15) * 8;
    const f32x4 g0 = *(const f32x4*)(p->in[4] + l * 128 + d0), g1 = *(const f32x4*)(p->in[4] + l * 128 + d0 + 4);
    for (int t = gw; t < M; t += NGW) { const int nseg = ((t >> 8) + 8) >> 3;
        f32x4 oc[2][2];
#pragma unroll
        for (int c = 0; c < 2; ++c) {
            f32x2 ml[4]; float mm = -1e30f;
#pragma unroll
            for (int s = 0; s < 4; ++s) if (s < nseg) { ml[s] = *(const f32x2*)(ML + ((size_t)s * M + t) * 16 + h * 4 + c * 2); mm = fmaxf(mm, ml[s].x); }
            f32x4 a0 = (f32x4){0.f, 0.f, 0.f, 0.f}, a1 = a0; float L = 0.f;
#pragma unroll
            for (int s = 0; s < 4; ++s) if (s < nseg) { const float f = exp2f(ml[s].x - mm); L += ml[s].y * f;
                const float* b = OD + ((size_t)s * M + t) * 1024 + h * 256 + c * 128 + d0; a0 += *(const f32x4*)b * f; a1 += *(const f32x4*)(b + 4) * f; }
            const float inv = 1.0f / L; oc[c][0] = a0 * inv; oc[c][1] = a1 * inv; }
        const f32x4 o0 = oc[0][0] - oc[1][0] * lam, o1 = oc[0][1] - oc[1][1] * lam;
        float ss = (o0[0] * o0[0] + o0[1] * o0[1]) + (o0[2] * o0[2] + o0[3] * o0[3]) + (o1[0] * o1[0] + o1[1] * o1[1]) + (o1[2] * o1[2] + o1[3] * o1[3]);
        ss = row16_sum(ss);
        const float r = rsqrtf(ss * (1.0f / 128.0f) + EPS) * (1.0f - lambda_init);
        const f32x4 y0 = o0 * g0 * r, y1 = o1 * g1 * r;
        u32x4 wv; wv.x = cvtpk(y0[0], y0[1]); wv.y = cvtpk(y0[2], y0[3]); wv.z = cvtpk(y1[0], y1[1]); wv.w = cvtpk(y1[2], y1[3]);
        *(u32x4*)(MIX + (size_t)t * DM + h * 128 + d0) = wv; }
}

#define XB_TMO      128
#define XB_XCNT(j)  (256  + 64 * (j))
#define XB_XSUB(j)  (1280 + 64 * (j))
#define XB_XGEN(j)  (2304 + 64 * (j))
#define XB_TOP      3328
#define XB_TOPGEN   3392
#define XCD_BAR_WORDS 3456
#define XB_SPIN_CAP (1u << 22)
__device__ __forceinline__ unsigned xb_ld(unsigned* p)              { return __hip_atomic_load(p, __ATOMIC_RELAXED, __HIP_MEMORY_SCOPE_AGENT); }
__device__ __forceinline__ unsigned xb_add(unsigned* p, unsigned v) { return __hip_atomic_fetch_add(p, v, __ATOMIC_RELAXED, __HIP_MEMORY_SCOPE_AGENT); }
__device__ __forceinline__ unsigned xb_xcc_id() { return (unsigned)__builtin_amdgcn_s_getreg((3 << 11) | 20) & 0xFu; }
#define XB_SPIN(cond, bar) do { unsigned _sp = 0; while (cond) { __builtin_amdgcn_s_sleep(1); \
    if ((++_sp & 255u) == 0u) { if (xb_ld(&(bar)[XB_TMO])) break; if (_sp > XB_SPIN_CAP) { atomicAdd(&(bar)[XB_TMO], 1u); break; } } } } while (0)
__device__ __forceinline__ void xcd_barrier_complete(unsigned* bar, unsigned x, unsigned& nloc, unsigned& nx) {
    const unsigned G = gridDim.x;
    unsigned sum, cnt, mine, sp = 0u;
    for (;;) {
        sum = 0u; cnt = 0u; mine = 0u;
#pragma unroll
        for (unsigned j = 0; j < 16; ++j) { const unsigned c = xb_ld(&bar[XB_XCNT(j)]); sum += c; cnt += (c > 0u) ? 1u : 0u; mine = (j == x) ? c : mine; }
        if (sum == G) break;
        __builtin_amdgcn_s_sleep(1);
        if ((++sp & 255u) == 0u) { if (xb_ld(&bar[XB_TMO])) break; if (sp > XB_SPIN_CAP) { atomicAdd(&bar[XB_TMO], 1u); break; } }
    }
    nloc = mine > 0u ? mine : 1u; nx = cnt > 0u ? cnt : 1u;
}
__device__ __forceinline__ void xcd_barrier(unsigned* bar, volatile LAS unsigned* st, const int tid) {
    asm volatile("s_waitcnt vmcnt(0)" ::: "memory");
    __syncthreads();
    if (tid == 0) {
        const unsigned x = xb_xcc_id();
        __builtin_amdgcn_s_waitcnt(0);
        unsigned nloc = st[0], nx = st[1];
        if (nloc == 0u) { xcd_barrier_complete(bar, x, nloc, nx); st[0] = nloc; st[1] = nx; }
        const unsigned old = xb_add(&bar[XB_XSUB(x)], 1u);
        const unsigned gen = old / nloc;
        if (old + 1u == (gen + 1u) * nloc) {
            __builtin_amdgcn_fence(__ATOMIC_RELEASE, "agent");
            asm volatile("s_waitcnt vmcnt(0)" ::: "memory");
            const unsigned og = xb_add(&bar[XB_TOP], 1u);
            const unsigned tg = og / nx;
            if (og + 1u == (tg + 1u) * nx) xb_add(&bar[XB_TOPGEN], 1u);
            else XB_SPIN(xb_ld(&bar[XB_TOPGEN]) == tg, bar);
            __builtin_amdgcn_fence(__ATOMIC_ACQUIRE, "agent");
            xb_add(&bar[XB_XGEN(x)], 1u);
            asm volatile("s_waitcnt vmcnt(0)" ::: "memory");
        } else {
            XB_SPIN(xb_ld(&bar[XB_XGEN(x)]) == gen, bar);
            __builtin_amdgcn_fence(__ATOMIC_ACQUIRE, "agent");
            asm volatile("s_waitcnt vmcnt(0)" ::: "memory");
        }
    }
    __syncthreads();
}

#ifndef DUPBAR
#define DUPBAR 1
#endif
#define GSYNC() do { FRESH(); for (int rb_ = 0; rb_ < DUPBAR; ++rb_) xcd_barrier((unsigned*)(p->ws + WS_CTL) + 4096, (volatile LAS unsigned*)(lds + LDS_BYTES - 32), tid); } while (0)
#define PTRS() unsigned* ctl = (unsigned*)(p->ws + WS_CTL); bf16_t* XB = (bf16_t*)(p->ws + WS_XB); bf16_t* PROJ = (bf16_t*)(p->ws + WS_PROJ); bf16_t* MIX = (bf16_t*)(p->ws + WS_MIX); bf16_t* H = (bf16_t*)(p->ws + WS_H); \
    float* ssqA = (float*)(p->ws + WS_SSQA); float* ssqB = (float*)(p->ws + WS_SSQB); unsigned char* wb = p->ws + WS_W + (size_t)l * LW_STRIDE; (void)ctl; (void)XB; (void)PROJ; (void)MIX; (void)H; (void)ssqA; (void)ssqB; (void)wb
#define FRESH() KP p = fresh_params(); int G = gridDim.x, bx = blockIdx.x; asm volatile("" : "+s"(G), "+s"(bx)); const int NGW = G * 8; (void)NGW; const int tid = fresh_tid(wave0), lane = tid & 63, wave = __builtin_amdgcn_readfirstlane(tid >> 6), gw = bx * 8 + wave; (void)lane; (void)gw
template <int L> __device__ __forceinline__ void layer_body(LAS unsigned char* lds, const int wave0) {
    constexpr int l = L;

#ifndef DUP1
#define DUP1 1
#endif
        for (int rep = 0; rep < DUP1; ++rep) {   if (rep) GSYNC(); FRESH(); PTRS(); pg8::Gemm g{XB, (const bf16_t*)(wb + LW_WIN), M, INCP, DM}; pg8::StaticOrder S; S.init(M, INCP, G, bx);
            pg8::EpiProj E{PROJ, INCP, ssqA};
            pg8::gemm_phase<pg8::EpiProj, pg8::StaticOrder, true, true>(lds, g, S, E, tid); }
        GSYNC();
#ifndef DUP234
#define DUP234 1
#endif
        for (int rep = 0; rep < DUP234; ++rep) { if (rep) GSYNC(); FRESH(); phase_prep1(p, l, lds, gw, NGW, wave, lane); }
        GSYNC();
        {   FRESH(); PTRS(); pg8::Gemm g{(const bf16_t*)(p->ws + WS_AW), (const bf16_t*)(wb + LW_W2T), M, 1024, 128}; pg8::StaticOrder S; S.init(M, 1024, G, bx);
            pg8::EpiLora<0> E{(float*)(p->ws + WS_DEC), p->in[7] + l * 1024};
            pg8::gemm_phase<pg8::EpiLora<0>, pg8::StaticOrder, true, true>(lds, g, S, E, tid); }
        {   FRESH(); PTRS(); pg8::Gemm g{(const bf16_t*)(p->ws + WS_AA), (const bf16_t*)(wb + LW_A2T), M, 1024, 128}; pg8::StaticOrder S; S.init(M, 1024, G, (bx + 128) % G);
            pg8::EpiLora<1> E{(float*)(p->ws + WS_A), p->in[9] + l * 1024};
            pg8::gemm_phase<pg8::EpiLora<1>, pg8::StaticOrder, true, true>(lds, g, S, E, tid); }
        {   FRESH(); PTRS(); pg8::Gemm g{(const bf16_t*)(p->ws + WS_AG), (const bf16_t*)(wb + LW_G2T), M, 1024, 256}; pg8::StaticOrder S; S.init(M, 1024, G, (bx + 128) % G);
            pg8::EpiLora<2> E{(float*)(p->ws + WS_G), nullptr};
            pg8::gemm_phase<pg8::EpiLora<2>, pg8::StaticOrder, true, true>(lds, g, S, E, tid); }
        GSYNC();
        {   FRESH(); LAS unsigned char* wl = lds + wave * 14336;
#ifndef DUP57
#define DUP57 1
#endif
#ifndef DUP5
#define DUP5 1
#endif
            for (int rep = 0; rep < DUP57 * DUP5; ++rep) for (int it = gw; it < 2 * NCH * 16; it += NGW) { const int mode = it & 1, ch = it >> 1, c = ch % NCH, h = ch / NCH;
                if (mode == 0) scan_task<0>(p, l, wl, c, h, lane); else scan_task<1>(p, l, wl, c, h, lane); } }
        GSYNC();
#ifndef DUP6
#define DUP6 1
#endif
        for (int rep = 0; rep < DUP6; ++rep) {   if (rep) GSYNC(); FRESH(); PTRS(); LAS int* slot = (LAS int*)(lds + LDS_BYTES - 64);
            LAS float* knl = (LAS float*)(lds + LDS_BYTES - 128);
            {   LAS float* kr = (LAS float*)lds; const float* knp = (const float*)(p->ws + WS_KNP); const int g = tid & 7, part = tid >> 3; float m = 0.f;
                for (int b2 = part; b2 < G; b2 += 64) m = fmaxf(m, knp[(size_t)b2 * 8 + g]);
                kr[part * 8 + g] = m; __syncthreads();
                if (tid < 8) { float mm = kr[tid]; for (int q2 = 1; q2 < 64; ++q2) mm = fmaxf(mm, kr[q2 * 8 + tid]); knl[tid] = mm; }
                __syncthreads(); }
            const float* sinks = p->in[5] + l * 8;
            for (;;) {
                if (tid == 0) *slot = (int)atomicAdd(ctl + 64 * (l + 1) + 16 * rep, 1u);
                __syncthreads();
                const int it = *slot;
                __syncthreads();
                if (it >= 928) break;
                if (it < 32) {
#ifndef NO_S2
                    s2_head(p, lds, it >> 1, it & 1, tid);
#endif
                }
                else if (it < 672) { const int d = it - 32, h = 3 - d / 160, u = d % 160, c = u & 1, v = u >> 1; int qb, seg;
                    if (v < 32) { qb = 31 - (v >> 2); seg = v & 3; } else if (v < 56) { const int w2 = v - 32; qb = 23 - w2 / 3; seg = w2 % 3; }
                    else if (v < 72) { const int w2 = v - 56; qb = 15 - (w2 >> 1); seg = w2 & 1; } else { qb = 79 - v; seg = 0; }
                    const float slope2 = exp2f(-2.0f * (float)(h + 1)) * LOG2E;
                    const float kn = sqrtf(knl[h * 2 + c]);
                    const int kt1 = 4 * qb + 3, klo = 32 * seg, khi = (klo + 31 < kt1) ? klo + 31 : kt1;
                    attn_unit<128, false>(lds, PROJ + h * 128 + c * 64, PROJ + 512 + h * 128 + c * 64, (const bf16_t*)(p->ws + WS_VAT) + (size_t)(h * 128) * M, slope2, qb * 256, 0.f,
                                          (float*)(p->ws + WS_OD) + (size_t)seg * M * 1024 + h * 256 + c * 128, (float*)(p->ws + WS_ML) + (size_t)seg * M * 16 + h * 4 + c * 2, nullptr, tid, klo, khi, kn); }
                else { const int s = it - 672, hq = s & 7, qb = s >> 3;
                    const int aidx = (hq >> 1) * 3 + (hq & 1);
                    const float slope2 = exp2f(-8.0f * (float)(aidx + 1) / 12.0f) * LOG2E;
                    const int q0 = qb * 256;
                    attn_unit<64, true>(lds, PROJ + 1536 + hq * 64, PROJ + 2048 + (hq >> 2) * 64, (const bf16_t*)(p->ws + WS_VBT) + (size_t)((hq >> 2) * 64) * M, slope2, q0, sinks[hq] * LOG2E,
                                        nullptr, nullptr, MIX + 512 + hq * 64, tid, q0 >= 128 ? (q0 - 128) / 64 : 0, (q0 + 255) / 64, 0.f); }
            } }
        GSYNC();
        {   FRESH();
            if (wave < 4) {
                LAS unsigned char* wl = lds + wave * 14336;
                for (int rep = 0; rep < DUP57; ++rep) for (int it = bx * 4 + wave; it < NCH * 16; it += G * 4) { const int c = it % NCH, h = it / NCH; scan_task<2>(p, l, wl, c, h, lane); }
            } else {
                phase_diffcombine(p, l, bx * 4 + (wave - 4), G * 4, lane);
                if (l + 1 < NL) { LAS float* scr = (LAS float*)(lds + 4 * 14336 + (wave - 4) * 8448);
                    for (int r = bx * 4 + (wave - 4); r < CONV_ITEMS; r += G * 4) convert_item(p, l + 1 < NL ? l + 1 : l, r, scr, lane); }
            } }
        GSYNC();
        {   FRESH(); PTRS(); pg8::Gemm g{MIX, (const bf16_t*)(wb + LW_WOUT), M, DM, DM}; pg8::StaticOrder S; S.init(M, DM, G, bx);
            pg8::EpiResid E{p->out, XB, ssqB};
            pg8::gemm_phase<pg8::EpiResid, pg8::StaticOrder, true, true>(lds, g, S, E, tid); }
        GSYNC();
        for (int rep = 0; rep < DUP1; ++rep) {   if (rep) GSYNC(); FRESH(); PTRS(); pg8::Gemm g{XB, (const bf16_t*)(wb + LW_WGU), M, GU, DM}; pg8::StaticOrder S; S.init(M, GU, G, bx);
            pg8::EpiSwiGLU E{H, ssqB};
            pg8::gemm_phase<pg8::EpiSwiGLU, pg8::StaticOrder, true, true>(lds, g, S, E, tid); }
        GSYNC();
        {   FRESH(); PTRS(); pg8::Gemm g{H, (const bf16_t*)(wb + LW_WDN), M, DM, FF}; pg8::StaticOrder S; S.init(M, DM, G, bx);
            pg8::EpiResid E{p->out, XB, ssqA};
            pg8::gemm_phase<pg8::EpiResid, pg8::StaticOrder, true, true>(lds, g, S, E, tid); }
        GSYNC();
    }

__global__ void __launch_bounds__(512, 2) fwd_megakernel(Params p_unused) {
    extern __shared__ __attribute__((aligned(16))) unsigned char lds_raw[];
    LAS unsigned char* lds = (LAS unsigned char*)lds_raw;
    cg::grid_group grid = cg::this_grid();
    const int wave0 = __builtin_amdgcn_readfirstlane((int)threadIdx.x >> 6);
    if (threadIdx.x < 16) ((LAS unsigned*)(lds + LDS_BYTES - 64))[threadIdx.x] = 0u;
    if (threadIdx.x == 0) xb_add((unsigned*)(p_unused.ws + WS_CTL) + 4096 + XB_XCNT(xb_xcc_id()), 1u);
    __syncthreads();

#ifndef DUP0
#define DUP0 1
#endif
    for (int rep = 0; rep < DUP0; ++rep) { FRESH(); phase0(p, lds, gw, NGW, wave, lane); __syncthreads(); }
    grid.sync();

    layer_body<0>(lds, wave0); layer_body<1>(lds, wave0); layer_body<2>(lds, wave0); layer_body<3>(lds, wave0);
    {   FRESH(); const int l = 0; PTRS(); const float* gf = p->in[21];
        for (int m = gw; m < M; m += NGW) { const float rs = rsqrtf(wave_sum(lane < 32 ? ssqA[(size_t)m * 32 + lane] : 0.f) * (1.0f / DM) + EPS);
#pragma unroll
            for (int j = 0; j < 8; ++j) { const size_t o = (size_t)m * DM + j * 256 + lane * 4; const f32x4 v = *(const f32x4*)(p->out + o); const f32x4 gv = *(const f32x4*)(gf + j * 256 + lane * 4);
                *(f32x4*)(p->out + o) = v * rs * gv; } } }
}

extern "C" void kernel_launch(void* const* d_in, const int* in_sizes, int n_in, void* d_out, int out_size, void* d_ws, size_t ws_size, hipStream_t stream) {
    static int grid = 0;
    if (grid == 0) {
        if (n_in != 22 || out_size != M * DM || ws_size < WS_END) { fprintf(stderr, "kernel_launch: unexpected shapes (n_in %d out %d ws %zu need %zu)\n", n_in, out_size, ws_size, (size_t)WS_END); grid = -1; return; }
        int dev = 0, cus = 0, per_cu = 0;
        hipGetDevice(&dev); hipDeviceGetAttribute(&cus, hipDeviceAttributeMultiprocessorCount, dev);
        hipFuncSetAttribute((const void*)fwd_megakernel, hipFuncAttributeMaxDynamicSharedMemorySize, LDS_BYTES);
        hipOccupancyMaxActiveBlocksPerMultiprocessor(&per_cu, (const void*)fwd_megakernel, 512, LDS_BYTES);
        if (per_cu < 1) { fprintf(stderr, "kernel_launch: occupancy query says %d blocks per CU\n", per_cu); per_cu = 1; }
        (void)hipGetLastError();
        grid = cus;
    }
    if (grid < 0) return;
    hipMemsetAsync((char*)d_ws + WS_CTL, 0, 65536, stream);
    Params p{};
    for (int i = 0; i < 22; ++i) p.in[i] = (const float*)d_in[i];
    p.out = (float*)d_out; p.ws = (unsigned char*)d_ws;
    void* args[] = {&p};
    hipError_t e = hipLaunchCooperativeKernel((const void*)fwd_megakernel, dim3(grid), dim3(512), args, LDS_BYTES, stream);
    if (e != hipSuccess) fprintf(stderr, "cooperative launch failed: %s (grid %d)\n", hipGetErrorString(e), grid);
}
```

```cpp
#include <hip/hip_runtime.h>
#include <hip/hip_cooperative_groups.h>
#include <cstdio>
#include <cstdint>
namespace cg = cooperative_groups;

#define LAS __attribute__((address_space(3)))
typedef unsigned short bf16_t;
typedef short bf16x8 __attribute__((ext_vector_type(8)));
typedef float f32x4 __attribute__((ext_vector_type(4)));
typedef float f32x2 __attribute__((ext_vector_type(2)));
typedef float f32x16 __attribute__((ext_vector_type(16)));
typedef unsigned u32x4 __attribute__((ext_vector_type(4)));
typedef unsigned u32x2 __attribute__((ext_vector_type(2)));
typedef __bf16 bf16x2_t __attribute__((ext_vector_type(2)));

constexpr int M = 8192, DM = 2048, INC = 5824, INCP = 5888, FF = 5632, GU = 11264, RW0 = 2304, RWC = 3520;
constexpr int NL = 4, NCH = 64, CL = 128;
constexpr float EPS = 1e-5f, LOG2E = 1.4426950408889634f;
constexpr float QSC = 0.125f * LOG2E;

constexpr size_t MiB = 1u << 20;
constexpr size_t SZ_WIN = (size_t)INCP * DM * 2, SZ_WOUT = (size_t)DM * DM * 2, SZ_WGU = (size_t)GU * DM * 2, SZ_WDN = (size_t)DM * FF * 2;
constexpr size_t SZ_W2T = 1024 * 128 * 2, SZ_G2T = 1024 * 256 * 2;
constexpr size_t LW_WIN = 0, LW_WOUT = LW_WIN + SZ_WIN, LW_WGU = LW_WOUT + SZ_WOUT, LW_WDN = LW_WGU + SZ_WGU, LW_W2T = LW_WDN + SZ_WDN,
                 LW_A2T = LW_W2T + SZ_W2T, LW_G2T = LW_A2T + SZ_W2T, LW_STRIDE = LW_G2T + SZ_G2T;
constexpr size_t SZ_F = (size_t)M * 1024 * 4;
constexpr size_t WS_CTL = 0, WS_W = 1 * MiB, WS_XB = WS_W + NL * LW_STRIDE, WS_PROJ = WS_XB + (size_t)M * DM * 2,
                 WS_VAT = WS_PROJ + (size_t)M * INCP * 2, WS_VBT = WS_VAT + (size_t)512 * M * 2, WS_AW = WS_VBT + (size_t)128 * M * 2,
                 WS_AA = WS_AW + (size_t)M * 128 * 2, WS_AG = WS_AA + (size_t)M * 128 * 2, WS_R = WS_AG + (size_t)M * 256 * 2,
                 WS_KR = WS_R + SZ_F, WS_V = WS_KR + SZ_F, WS_DEC = WS_V + SZ_F, WS_A = WS_DEC + SZ_F, WS_G = WS_A + SZ_F,
                 WS_KF = WS_G + SZ_F, WS_AN = WS_KF + SZ_F, WS_BB = WS_AN + SZ_F, WS_PB = WS_BB + SZ_F, WS_UB = WS_PB + SZ_F,
                 WS_SI = WS_UB + SZ_F, WS_OD = WS_SI + SZ_F, WS_ML = WS_OD + 4 * SZ_F, WS_KNP = WS_ML + (size_t)4 * M * 16 * 4, WS_MIX = WS_KNP + 65536, WS_SSQA = WS_MIX + (size_t)M * DM * 2,
                 WS_SSQB = WS_SSQA + (size_t)M * 32 * 4, WS_END = WS_SSQB + (size_t)M * 32 * 4;
constexpr size_t WS_H = WS_PROJ;
static_assert((size_t)M * FF * 2 <= (size_t)M * INCP * 2, "H overlay");

constexpr int LDS_BYTES = 147456;

struct Params { const float* in[22]; float* out; unsigned char* ws; };
typedef const __attribute__((address_space(4))) Params* KP;
__device__ __forceinline__ KP fresh_params() { KP k = (KP)__builtin_amdgcn_kernarg_segment_ptr(); asm volatile("" : "+s"(k)); return k; }

__device__ __forceinline__ unsigned cvtpk(float lo, float hi) { f32x2 v = {lo, hi}; bf16x2_t b = __builtin_convertvector(v, bf16x2_t); return __builtin_bit_cast(unsigned, b); }
__device__ __forceinline__ float bf2f(unsigned short b) { return __builtin_bit_cast(float, (unsigned)b << 16); }
__device__ __forceinline__ float bflo(unsigned w) { return __builtin_bit_cast(float, w << 16); }
__device__ __forceinline__ float bfhi(unsigned w) { return __builtin_bit_cast(float, w & 0xffff0000u); }
template <int CTRL> __device__ __forceinline__ float dppm(float v) { return __builtin_bit_cast(float, __builtin_amdgcn_mov_dpp(__builtin_bit_cast(int, v), CTRL, 0xF, 0xF, true)); }
__device__ __forceinline__ float xor16_sum(float v) { const unsigned b = __builtin_bit_cast(unsigned, v); auto rr = __builtin_amdgcn_permlane16_swap(b, b, false, false); return __builtin_bit_cast(float, (unsigned)rr[0]) + __builtin_bit_cast(float, (unsigned)rr[1]); }
__device__ __forceinline__ float xor32_sum(float v) { const unsigned b = __builtin_bit_cast(unsigned, v); auto rr = __builtin_amdgcn_permlane32_swap(b, b, false, false); return __builtin_bit_cast(float, (unsigned)rr[0]) + __builtin_bit_cast(float, (unsigned)rr[1]); }
__device__ __forceinline__ float xor32_max(float v) { const unsigned b = __builtin_bit_cast(unsigned, v); auto rr = __builtin_amdgcn_permlane32_swap(b, b, false, false); return fmaxf(__builtin_bit_cast(float, (unsigned)rr[0]), __builtin_bit_cast(float, (unsigned)rr[1])); }
__device__ __forceinline__ float row16_sum(float v) { v += dppm<0xB1>(v); v += dppm<0x4E>(v); v += dppm<0x141>(v); v += dppm<0x140>(v); return v; }
__device__ __forceinline__ float wave_sum(float v) { return xor32_sum(xor16_sum(row16_sum(v))); }
__device__ __forceinline__ float dpp_xor1(float v) { return __builtin_bit_cast(float, __builtin_amdgcn_mov_dpp(__builtin_bit_cast(int, v), 0xB1, 0xF, 0xF, true)); }
__device__ __forceinline__ float dpp_xor2(float v) { return __builtin_bit_cast(float, __builtin_amdgcn_mov_dpp(__builtin_bit_cast(int, v), 0x4E, 0xF, 0xF, true)); }
__device__ __forceinline__ float quad_sum(float v) { v += dpp_xor1(v); v += dpp_xor2(v); return v; }
__device__ __forceinline__ float sigmoidf_(float x) { return __builtin_amdgcn_rcpf(1.0f + __expf(-x)); }

__device__ __forceinline__ int fresh_tid(int wave0) { unsigned z = 0u; asm volatile("" : "+v"(z)); int t = wave0 * 64 + (int)__builtin_amdgcn_mbcnt_hi(~0u, __builtin_amdgcn_mbcnt_lo(~0u, z)); asm volatile("" : "+v"(t)); return t; }

__device__ __forceinline__ float row_rstd(const float* ssq, int row, int fq) {
    const float* pp = ssq + (size_t)row * 32 + 8 * fq; const f32x4 a = *(const f32x4*)pp, b = *(const f32x4*)(pp + 4);
    float s = ((a[0] + a[1]) + (a[2] + a[3])) + ((b[0] + b[1]) + (b[2] + b[3]));
    s = xor32_sum(xor16_sum(s));
    return rsqrtf(s * (1.0f / DM) + EPS);
}

namespace pg8 {
constexpr int BM = 256, BK = 64, HALF = 128, HTB = HALF * BK * 2, STAGE_BYTES = 8 * HTB, NXCD = 8, WGM = 8;
__host__ __device__ __forceinline__ int lds_byte(int r, int c) { const int st = (r >> 4) * 2 + (c >> 5), rr = r & 15, cc = c & 31, ob = rr * 64 + cc * 2; return st * 1024 + (ob ^ (((ob >> 9) & 1) << 5)); }
__host__ __device__ __forceinline__ void stage_rc(int b, int& R, int& C) { const int st = b / 1024, sb = b % 1024, swz = sb ^ (((sb >> 9) & 1) << 5); R = (st >> 1) * 16 + swz / 64; C = (st & 1) * 32 + (swz % 64) / 2; }
__host__ __device__ __forceinline__ int perm32(int rho) { const int n = rho >> 4, i = rho & 15; return 8 * (i >> 2) + 4 * n + (i & 3); }
struct Unit { int pm, pn; };
struct Gemm { const bf16_t* A; const bf16_t* Bt; int M, N, K; };
struct StaticOrder {
    int nM, nN, nwg, G, c;
    __host__ __device__ void init(int M_, int N_, int G_, int c_) { nM = M_ / BM; nN = N_ / BM; nwg = nM * nN; G = G_; c = c_; }
    __host__ __device__ bool next(int i, Unit& u) const {
        const long L = (long)i * G + c; if (L >= nwg) return false;
        int wgid = (int)L; { const int q = nwg / NXCD, r = nwg % NXCD, xcd = wgid % NXCD, off = wgid / NXCD; wgid = (xcd < r ? xcd * (q + 1) : r * (q + 1) + (xcd - r) * q) + off; }
        const int nig = WGM * nN, gid = wgid / nig, fm = gid * WGM, gsz = (nM - fm) < WGM ? (nM - fm) : WGM;
        u.pm = fm + ((wgid % nig) % gsz); u.pn = (wgid % nig) / gsz; return true;
    }
};

template <class Epi, class Sched, bool ALIGN_EPI, bool SP2>
__device__ __forceinline__ void gemm_phase(LAS unsigned char* lds, const Gemm g, const Sched& S, const Epi& E, const int tid) {
    const int wid = __builtin_amdgcn_readfirstlane(tid >> 6), lane = tid & 63, wr = wid >> 2, wc = wid & 3, fr = lane & 15, fq = lane >> 4;
    const int K = g.K, nt = K / BK;
    unsigned voffA[2], voffB[2];
#pragma unroll
    for (int i = 0; i < 2; ++i) { int R, C; stage_rc(tid * 16 + i * 8192, R, C); const int Rb = Epi::PERM ? ((R & ~31) + perm32(R & 31)) : R;
        voffA[i] = (unsigned)(R * K + C) * 2u; voffB[i] = (unsigned)(Rb * K + C) * 2u; }
    const size_t kstep = (size_t)(BK * 2);
    const size_t hstep = (size_t)HALF * K * 2;
    const size_t tstep = 2 * hstep;
    const unsigned ldsw = (unsigned)wid * 1024u;
    const int aoff = lds_byte(wr * 64 + fr, fq * 8), boff = lds_byte(wc * 32 + fr, fq * 8);
#define PG8_SA(b, h) (((b) * 2 + (h)) * HTB)
#define PG8_SB(b, h) ((4 + (b) * 2 + (h)) * HTB)
#define PG8_STAGE(bufoff, gbase, voff) do { _Pragma("unroll") for (int _i = 0; _i < 2; ++_i) \
        __builtin_amdgcn_global_load_lds((const unsigned*)((const char*)(gbase) + (voff)[_i]), (LAS unsigned*)(lds + (bufoff) + ldsw + _i * 8192), 16, 0, 0); } while (0)
#define PG8_LDA(dst, b, h) do { _Pragma("unroll") for (int m = 0; m < 4; ++m) _Pragma("unroll") for (int k = 0; k < 2; ++k) dst[m][k] = *(const LAS bf16x8*)(lds + PG8_SA(b, h) + aoff + m * 2048 + k * 1024); } while (0)
#define PG8_LDB(dst, b, h) do { _Pragma("unroll") for (int n = 0; n < 2; ++n) _Pragma("unroll") for (int k = 0; k < 2; ++k) dst[n][k] = *(const LAS bf16x8*)(lds + PG8_SB(b, h) + boff + n * 2048 + k * 1024); } while (0)
#define PG8_MMA(ai, bj, At, Bt) do { __builtin_amdgcn_s_setprio(1); _Pragma("unroll") for (int m = 0; m < 4; ++m) _Pragma("unroll") for (int n = 0; n < 2; ++n) _Pragma("unroll") for (int k = 0; k < 2; ++k) \
        acc[ai][bj][m][n] = __builtin_amdgcn_mfma_f32_16x16x32_bf16(Bt[n][k], At[m][k], acc[ai][bj][m][n], 0, 0, 0); __builtin_amdgcn_s_setprio(0); } while (0)
#define PG8_WAIT_V(n) asm volatile("s_waitcnt vmcnt(" #n ")" ::: "memory")
#define PG8_WAIT_L(n) asm volatile("s_waitcnt lgkmcnt(" #n ")" ::: "memory")
#define PG8_BAR __builtin_amdgcn_s_barrier()
#define PG8_SCHED __builtin_amdgcn_sched_barrier(0)
    Unit cur, nxt; int ui = 0;
    if (!S.next(0, cur)) return;
    f32x4 acc[2][2][4][2];
#pragma unroll
    for (int a = 0; a < 2; ++a)
#pragma unroll
        for (int b = 0; b < 2; ++b)
#pragma unroll
            for (int m = 0; m < 4; ++m)
#pragma unroll
                for (int n = 0; n < 2; ++n) acc[a][b][m][n] = (f32x4){0.f, 0.f, 0.f, 0.f};
    bf16x8 At[4][2], B0[2][2], B1[2][2];
    const char* cA = (const char*)g.A + (size_t)cur.pm * tstep; const char* cB = (const char*)g.Bt + (size_t)cur.pn * tstep;
    if constexpr (SP2) {
        PG8_STAGE(PG8_SB(0, 0), cB, voffB); PG8_STAGE(PG8_SB(0, 1), cB + hstep, voffB); PG8_STAGE(PG8_SA(0, 0), cA, voffA); PG8_STAGE(PG8_SA(0, 1), cA + hstep, voffA);
        if (wr == 1) PG8_BAR;
        PG8_WAIT_V(2); PG8_BAR;
        PG8_STAGE(PG8_SB(1, 0), cB + kstep, voffB); PG8_STAGE(PG8_SA(1, 0), cA + kstep, voffA); PG8_STAGE(PG8_SB(1, 1), cB + hstep + kstep, voffB);
        PG8_WAIT_V(6); PG8_BAR;
    } else {
        PG8_STAGE(PG8_SB(0, 0), cB, voffB); PG8_STAGE(PG8_SA(0, 0), cA, voffA); PG8_STAGE(PG8_SB(0, 1), cB + hstep, voffB); PG8_STAGE(PG8_SA(0, 1), cA + hstep, voffA);
        if (wr == 1) PG8_BAR;
        PG8_WAIT_V(4); PG8_BAR;
        PG8_STAGE(PG8_SB(1, 0), cB + kstep, voffB); PG8_STAGE(PG8_SA(1, 0), cA + kstep, voffA); PG8_STAGE(PG8_SB(1, 1), cB + hstep + kstep, voffB);
        PG8_WAIT_V(6); PG8_BAR;
    }
    for (;;) {
        const bool has_next = S.next(ui + 1, nxt);
        const char* nA = has_next ? (const char*)g.A + (size_t)nxt.pm * tstep : cA; const char* nB = has_next ? (const char*)g.Bt + (size_t)nxt.pn * tstep : cB;
        for (int t = 0; t < nt; t += 2) {
            const bool last = (t == nt - 2);
            const char* a1 = cA + (size_t)(t + 1) * kstep;
            const char* a2 = last ? nA : cA + (size_t)(t + 2) * kstep; const char* b2 = last ? nB : cB + (size_t)(t + 2) * kstep;
            const char* a3 = a2 + kstep; const char* b3 = b2 + kstep;
            if constexpr (SP2) {
            PG8_LDB(B0, 0, 0); PG8_LDB(B1, 0, 1); PG8_SCHED; PG8_LDA(At, 0, 0); PG8_STAGE(PG8_SA(1, 1), a1 + hstep, voffA);
            PG8_WAIT_V(8); PG8_WAIT_L(0); PG8_BAR; PG8_MMA(0, 0, At, B0); PG8_MMA(0, 1, At, B1); PG8_BAR; PG8_SCHED;
            PG8_LDA(At, 0, 1); PG8_STAGE(PG8_SB(0, 0), b2, voffB); PG8_STAGE(PG8_SB(0, 1), b2 + hstep, voffB); PG8_STAGE(PG8_SA(0, 0), a2, voffA);
            PG8_WAIT_V(8); PG8_WAIT_L(0); PG8_BAR; PG8_MMA(1, 0, At, B0); PG8_MMA(1, 1, At, B1); PG8_BAR; PG8_SCHED;
            PG8_LDB(B0, 1, 0); PG8_LDB(B1, 1, 1); PG8_SCHED; PG8_LDA(At, 1, 0); PG8_STAGE(PG8_SA(0, 1), a2 + hstep, voffA);
            PG8_WAIT_V(8); PG8_WAIT_L(0); PG8_BAR; PG8_MMA(0, 0, At, B0); PG8_MMA(0, 1, At, B1); PG8_BAR; PG8_SCHED;
            PG8_LDA(At, 1, 1); PG8_STAGE(PG8_SB(1, 0), b3, voffB); PG8_STAGE(PG8_SB(1, 1), b3 + hstep, voffB); PG8_STAGE(PG8_SA(1, 0), a3, voffA);
            PG8_WAIT_V(8); PG8_WAIT_L(0); PG8_BAR; PG8_MMA(1, 0, At, B0); PG8_MMA(1, 1, At, B1); PG8_BAR; PG8_SCHED;
            } else {
            PG8_LDB(B0, 0, 0); PG8_SCHED; PG8_LDA(At, 0, 0); PG8_STAGE(PG8_SA(1, 1), a1 + hstep, voffA);
            PG8_WAIT_L(8); PG8_BAR; PG8_WAIT_L(0); PG8_MMA(0, 0, At, B0); PG8_BAR; PG8_SCHED;
            PG8_LDB(B1, 0, 1); PG8_STAGE(PG8_SB(0, 0), b2, voffB);
            PG8_BAR; PG8_WAIT_L(0); PG8_MMA(0, 1, At, B1); PG8_BAR;
            PG8_LDA(At, 0, 1); PG8_STAGE(PG8_SA(0, 0), a2, voffA);
            PG8_BAR; PG8_WAIT_L(0); PG8_MMA(1, 0, At, B0); PG8_BAR; PG8_SCHED;
            PG8_STAGE(PG8_SB(0, 1), b2 + hstep, voffB);
            PG8_WAIT_V(6); PG8_BAR; PG8_MMA(1, 1, At, B1); PG8_BAR;
            PG8_LDB(B0, 1, 0); PG8_SCHED; PG8_LDA(At, 1, 0); PG8_STAGE(PG8_SA(0, 1), a2 + hstep, voffA);
            PG8_WAIT_L(8); PG8_BAR; PG8_WAIT_L(0); PG8_MMA(0, 0, At, B0); PG8_BAR; PG8_SCHED;
            PG8_LDB(B1, 1, 1); PG8_STAGE(PG8_SB(1, 0), b3, voffB);
            PG8_BAR; PG8_WAIT_L(0); PG8_MMA(0, 1, At, B1); PG8_BAR;
            PG8_LDA(At, 1, 1); PG8_STAGE(PG8_SA(1, 0), a3, voffA);
            PG8_BAR; PG8_WAIT_L(0); PG8_MMA(1, 0, At, B0); PG8_BAR; PG8_SCHED;
            PG8_STAGE(PG8_SB(1, 1), b3 + hstep, voffB);
            PG8_WAIT_V(6); PG8_BAR; PG8_MMA(1, 1, At, B1); PG8_BAR;
            }
        }
        if constexpr (ALIGN_EPI) { if (wr == 0) PG8_BAR; }
        E(acc, cur, wr, wc, fr, fq);
        if (!has_next) break;
#pragma unroll
        for (int a = 0; a < 2; ++a)
#pragma unroll
            for (int b = 0; b < 2; ++b)
#pragma unroll
                for (int m = 0; m < 4; ++m)
#pragma unroll
                    for (int n = 0; n < 2; ++n) acc[a][b][m][n] = (f32x4){0.f, 0.f, 0.f, 0.f};
        cur = nxt; cA = nA; cB = nB; ++ui;
        if constexpr (ALIGN_EPI) { if (wr == 1) PG8_BAR; }
    }
    PG8_WAIT_V(0);
    if constexpr (!ALIGN_EPI) { if (wr == 0) PG8_BAR; }
    PG8_BAR;
#undef PG8_SA
#undef PG8_SB
#undef PG8_STAGE
#undef PG8_LDA
#undef PG8_LDB
#undef PG8_MMA
#undef PG8_WAIT_V
#undef PG8_WAIT_L
#undef PG8_BAR
#undef PG8_SCHED
}

struct EpiProj {
    static constexpr bool PERM = true;
    bf16_t* O; int ldc; const float* ssq;
    __device__ __forceinline__ void operator()(const f32x4 (&acc)[2][2][4][2], const Unit& u, int wr, int wc, int fr, int fq) const {
        const int row0 = u.pm * BM + wr * 64 + fr, col0 = u.pn * BM + wc * 32 + 8 * fq;
#pragma unroll
        for (int ai = 0; ai < 2; ++ai)
#pragma unroll
            for (int m = 0; m < 4; ++m) { const int row = row0 + ai * HALF + m * 16; const float rs = row_rstd(ssq, row, fq);
                bf16_t* rowp = O + (size_t)row * ldc + col0;
#pragma unroll
                for (int bj = 0; bj < 2; ++bj) { const f32x4 v0 = acc[ai][bj][m][0] * rs, v1 = acc[ai][bj][m][1] * rs;
                    u32x4 w; w.x = cvtpk(v0[0], v0[1]); w.y = cvtpk(v0[2], v0[3]); w.z = cvtpk(v1[0], v1[1]); w.w = cvtpk(v1[2], v1[3]);
                    *(u32x4*)(rowp + bj * HALF) = w; } }
    }
};
struct EpiSwiGLU {
    static constexpr bool PERM = true;
    bf16_t* O; const float* ssq;
    __device__ __forceinline__ void operator()(const f32x4 (&acc)[2][2][4][2], const Unit& u, int wr, int wc, int fr, int fq) const {
        const int row0 = u.pm * BM + wr * 64 + fr, col0 = u.pn * HALF + wc * 32 + 8 * fq;
#pragma unroll
        for (int ai = 0; ai < 2; ++ai)
#pragma unroll
            for (int m = 0; m < 4; ++m) { const int row = row0 + ai * HALF + m * 16; const float rs = row_rstd(ssq, row, fq);
                float h[8];
#pragma unroll
                for (int n = 0; n < 2; ++n)
#pragma unroll
                    for (int j = 0; j < 4; ++j) { const float gt = acc[ai][0][m][n][j] * rs, up = acc[ai][1][m][n][j] * rs; h[n * 4 + j] = gt * up * __builtin_amdgcn_rcpf(1.0f + __expf(-gt)); }
                u32x4 w; w.x = cvtpk(h[0], h[1]); w.y = cvtpk(h[2], h[3]); w.z = cvtpk(h[4], h[5]); w.w = cvtpk(h[6], h[7]);
                *(u32x4*)(O + (size_t)row * FF + col0) = w; }
    }
};
struct EpiResid {
    static constexpr bool PERM = false;
    float* X; bf16_t* XB; float* ssq;
    __device__ __forceinline__ void operator()(const f32x4 (&acc)[2][2][4][2], const Unit& u, int wr, int wc, int fr, int fq) const {
        const int row0 = u.pm * BM + wr * 64 + fr, col0 = u.pn * BM + wc * 32 + 4 * fq;
#pragma unroll
        for (int ai = 0; ai < 2; ++ai)
#pragma unroll
            for (int m = 0; m < 4; ++m) { const int row = row0 + ai * HALF + m * 16; const size_t off = (size_t)row * DM + col0; float ss = 0.f;
#pragma unroll
                for (int bj = 0; bj < 2; ++bj)
#pragma unroll
                    for (int n = 0; n < 2; ++n) { const size_t o = off + bj * HALF + n * 16; const f32x4 xv = *(const f32x4*)(X + o) + acc[ai][bj][m][n];
                        *(f32x4*)(X + o) = xv; u32x2 w; w.x = cvtpk(xv[0], xv[1]); w.y = cvtpk(xv[2], xv[3]); *(u32x2*)(XB + o) = w;
                        ss += (xv[0] * xv[0] + xv[1] * xv[1]) + (xv[2] * xv[2] + xv[3] * xv[3]); }
                ss = xor32_sum(xor16_sum(ss));
                if (fq == 0) ssq[(size_t)row * 32 + u.pn * 4 + wc] = ss; }
    }
};
template <int MODE> struct EpiLora {
    static constexpr bool PERM = false;
    float* O; const float* bias;
    __device__ __forceinline__ void operator()(const f32x4 (&acc)[2][2][4][2], const Unit& u, int wr, int wc, int fr, int fq) const {
        const int row0 = u.pm * BM + wr * 64 + fr, col0 = u.pn * BM + wc * 32 + 4 * fq;
#pragma unroll
        for (int bj = 0; bj < 2; ++bj)
#pragma unroll
            for (int n = 0; n < 2; ++n) { const int col = col0 + bj * HALF + n * 16;
                f32x4 bv = (f32x4){0.f, 0.f, 0.f, 0.f}; if (MODE != 2) bv = *(const f32x4*)(bias + col);
#pragma unroll
                for (int ai = 0; ai < 2; ++ai)
#pragma unroll
                    for (int m = 0; m < 4; ++m) { const int row = row0 + ai * HALF + m * 16; f32x4 v = acc[ai][bj][m][n] + bv;
                        if (MODE == 0) {
#pragma unroll
                            for (int j = 0; j < 4; ++j) { const float z = -v[j]; const float sp = fmaxf(z, 0.f) + __logf(1.0f + __expf(-fabsf(z))); v[j] = __expf(-__expf(-sp - 0.5f)); }
                        } else if (MODE == 1) {
#pragma unroll
                            for (int j = 0; j < 4; ++j) v[j] = sigmoidf_(v[j]);
                        }
                        *(f32x4*)(O + (size_t)row * 1024 + col) = v; } }
    }
};
}

template <int MAP>
__device__ __forceinline__ void transpose_item(const float* W, int K, int N, bf16_t* WT, const float* gk, LAS float* scr, int item, int lane) {
    const int nblk = N / 32, kb = item / nblk, nb = item % nblk, k0 = 64 * kb, n0 = 32 * nb;
    float v[32];
    const float* wp = W + (size_t)(k0 + (lane >> 5)) * N + n0 + (lane & 31);
#pragma unroll
    for (int i = 0; i < 32; ++i) v[i] = __builtin_nontemporal_load(wp + (size_t)(2 * i) * N);
    const int c = lane & 7;
    f32x4 g0 = (f32x4){1.f, 1.f, 1.f, 1.f}, g1 = g0;
    if (gk) { g0 = *(const f32x4*)(gk + k0 + 8 * c); g1 = *(const f32x4*)(gk + k0 + 8 * c + 4); }
#pragma unroll
    for (int i = 0; i < 32; ++i) scr[(2 * i + (lane >> 5)) * 33 + (lane & 31)] = v[i];
    asm volatile("s_waitcnt lgkmcnt(0)" ::: "memory");
#pragma unroll
    for (int j = 0; j < 4; ++j) { const int n = n0 + (lane >> 3) + 8 * j; const LAS float* s = scr + (8 * c) * 33 + (n - n0);
        float sc = 1.f; int drow = n;
        if (MAP == 0) { if (n < 512 || (n >= 1536 && n < 2048)) sc = QSC; }
        if (MAP == 1) { const int hn = n < FF ? n : n - FF; drow = (hn >> 7) * 256 + (n < FF ? 0 : 128) + (hn & 127); }
        const f32x4 h0 = g0 * sc, h1 = g1 * sc;
        u32x4 o; o.x = cvtpk(s[0 * 33] * h0[0], s[1 * 33] * h0[1]); o.y = cvtpk(s[2 * 33] * h0[2], s[3 * 33] * h0[3]); o.z = cvtpk(s[4 * 33] * h1[0], s[5 * 33] * h1[1]); o.w = cvtpk(s[6 * 33] * h1[2], s[7 * 33] * h1[3]);
        *(u32x4*)(WT + (size_t)drow * K + k0 + 8 * c) = o; }
    asm volatile("s_waitcnt lgkmcnt(0)" ::: "memory");
}

constexpr int I_IN = (DM / 64) * (INC / 32), I_OUT = (DM / 64) * (DM / 32), I_GU = (DM / 64) * (GU / 32), I_DN = (FF / 64) * (DM / 32);
constexpr int CONV_ITEMS = I_IN + I_OUT + I_GU + I_DN;
__device__ __forceinline__ void convert_item(KP p, int l, int r, LAS float* scr, int lane) {
    unsigned char* wb = p->ws + WS_W + (size_t)l * LW_STRIDE;
    if (r < I_IN) { transpose_item<0>(p->in[2] + (size_t)l * DM * INC, DM, INC, (bf16_t*)(wb + LW_WIN), p->in[1] + l * DM, scr, r, lane); return; } r -= I_IN;
    if (r < I_OUT) { transpose_item<2>(p->in[17] + (size_t)l * DM * DM, DM, DM, (bf16_t*)(wb + LW_WOUT), nullptr, scr, r, lane); return; } r -= I_OUT;
    if (r < I_GU) { transpose_item<1>(p->in[19] + (size_t)l * DM * GU, DM, GU, (bf16_t*)(wb + LW_WGU), p->in[18] + l * DM, scr, r, lane); return; } r -= I_GU;
    transpose_item<2>(p->in[20] + (size_t)l * FF * DM, FF, DM, (bf16_t*)(wb + LW_WDN), nullptr, scr, r, lane);
}

__device__ __forceinline__ void phase0(KP p, LAS unsigned char* lds, int gw, int NGW, int wave, int lane) {
    LAS float* scr = (LAS float*)(lds + wave * 16384);
    for (int it = gw; it < CONV_ITEMS; it += NGW) convert_item(p, 0, it, scr, lane);
    const int gt = gw * 64 + lane, NGT = NGW * 64;
    for (int l = 0; l < NL; ++l) {
        unsigned char* wb = p->ws + WS_W + (size_t)l * LW_STRIDE;
        bf16_t* w2t = (bf16_t*)(wb + LW_W2T); bf16_t* a2t = (bf16_t*)(wb + LW_A2T); bf16_t* g2t = (bf16_t*)(wb + LW_G2T);
        const float* w2 = p->in[8] + (size_t)l * 96 * 1024; const float* a2 = p->in[10] + (size_t)l * 96 * 1024; const float* g2 = p->in[11] + (size_t)l * 256 * 1024;
        for (int i = gt; i < 1024 * 128; i += NGT) { const int n = i >> 7, k = i & 127;
            w2t[i] = (bf16_t)(cvtpk(k < 96 ? w2[k * 1024 + n] : 0.f, 0.f) & 0xffff); a2t[i] = (bf16_t)(cvtpk(k < 96 ? a2[k * 1024 + n] : 0.f, 0.f) & 0xffff); }
        for (int i = gt; i < 1024 * 256; i += NGT) { const int n = i >> 8, k = i & 255; g2t[i] = (bf16_t)(cvtpk(g2[k * 1024 + n], 0.f) & 0xffff); }
        unsigned* padz = (unsigned*)(wb + LW_WIN + (size_t)INC * DM * 2);
        for (int i = gt; i < (INCP - INC) * DM / 2; i += NGT) padz[i] = 0u;
    }
    const float* x = p->in[0]; float* X = p->out; bf16_t* XB = (bf16_t*)(p->ws + WS_XB); float* ssqA = (float*)(p->ws + WS_SSQA);
    for (int m = gw; m < M; m += NGW) { float ss = 0.f;
#pragma unroll
        for (int j = 0; j < 8; ++j) { const size_t o = (size_t)m * DM + j * 256 + lane * 4; const f32x4 v = *(const f32x4*)(x + o); *(f32x4*)(X + o) = v;
            u32x2 w; w.x = cvtpk(v[0], v[1]); w.y = cvtpk(v[2], v[3]); *(u32x2*)(XB + o) = w; ss += (v[0] * v[0] + v[1] * v[1]) + (v[2] * v[2] + v[3] * v[3]); }
        ss = wave_sum(ss); if (lane < 32) ssqA[(size_t)m * 32 + lane] = lane == 0 ? ss : 0.f; }
}

__device__ __forceinline__ void phase_prep1(KP p, int l, LAS unsigned char* lds, int gw, int NGW, int wave, int lane) {
    const bf16_t* PROJ = (const bf16_t*)(p->ws + WS_PROJ);
    LAS unsigned short* tile = (LAS unsigned short*)(lds + wave * 8448);
    bf16_t* VAT = (bf16_t*)(p->ws + WS_VAT); bf16_t* VBT = (bf16_t*)(p->ws + WS_VBT);
    for (int it = gw; it < 128 * 10; it += NGW) {
        const int tb = it / 10, g = it % 10, t0 = tb * 64; const int cbase = g < 8 ? 1024 + 64 * g : 2176 + 64 * (g - 8);
        bf16_t* dst = g < 8 ? VAT + (size_t)(64 * g) * M : VBT + (size_t)(64 * (g - 8)) * M;
#pragma unroll
        for (int i = 0; i < 8; ++i) { const int row = i * 8 + (lane >> 3), ch = lane & 7; const u32x4 v = *(const u32x4*)(PROJ + (size_t)(t0 + row) * INCP + cbase + 8 * ch);
            LAS unsigned* d = (LAS unsigned*)(tile + row * 66 + 8 * ch); d[0] = v.x; d[1] = v.y; d[2] = v.z; d[3] = v.w; }
        asm volatile("s_waitcnt lgkmcnt(0)" ::: "memory");
#pragma unroll
        for (int i = 0; i < 8; ++i) { const int c = i * 8 + (lane >> 3), tch = lane & 7, j = tch >> 1, hi = tch & 1; unsigned short v[8];
#pragma unroll
            for (int s = 0; s < 8; ++s) v[s] = tile[(16 * j + (s & 3) + 8 * (s >> 2) + 4 * hi) * 66 + c];
            u32x4 o; o.x = v[0] | ((unsigned)v[1] << 16); o.y = v[2] | ((unsigned)v[3] << 16); o.z = v[4] | ((unsigned)v[5] << 16); o.w = v[6] | ((unsigned)v[7] << 16);
            *(u32x4*)(dst + (size_t)c * M + t0 + 16 * j + 8 * hi) = o; }
        asm volatile("s_waitcnt lgkmcnt(0)" ::: "memory");
    }
    const float* mu = p->in[6] + (size_t)l * RWC;
    bf16_t* AW = (bf16_t*)(p->ws + WS_AW); bf16_t* AA = (bf16_t*)(p->ws + WS_AA); bf16_t* AG = (bf16_t*)(p->ws + WS_AG);
    float knmax = 0.f;
    for (int t = gw; t < M; t += NGW) {
        const bf16_t* cur = PROJ + (size_t)t * INCP + RW0;
        {   const u32x4 kv = *(const u32x4*)(PROJ + (size_t)t * INCP + 512 + 8 * lane);
            float a0 = bflo(kv.x), a1 = bfhi(kv.x), a2 = bflo(kv.y), a3 = bfhi(kv.y), a4 = bflo(kv.z), a5 = bfhi(kv.z), a6 = bflo(kv.w), a7 = bfhi(kv.w);
            float ss = (a0 * a0 + a1 * a1) + (a2 * a2 + a3 * a3) + (a4 * a4 + a5 * a5) + (a6 * a6 + a7 * a7);
            ss += dppm<0xB1>(ss); ss += dppm<0x4E>(ss); ss += dppm<0x141>(ss); knmax = fmaxf(knmax, ss); }
        if (lane < 56) { const int j0 = 3072 + 8 * lane;
            const u32x4 c4 = *(const u32x4*)(cur + j0); u32x4 p4 = (u32x4){0u, 0u, 0u, 0u}; if (t > 0) p4 = *(const u32x4*)(cur - INCP + j0);
            const f32x4 m0 = *(const f32x4*)(mu + j0), m1 = *(const f32x4*)(mu + j0 + 4);
            float f[8]; const unsigned cw[4] = {c4.x, c4.y, c4.z, c4.w}, pw[4] = {p4.x, p4.y, p4.z, p4.w};
#pragma unroll
            for (int q = 0; q < 4; ++q) { const float c0 = bflo(cw[q]), c1 = bfhi(cw[q]), p0 = bflo(pw[q]), p1 = bfhi(pw[q]);
                const float mu0 = q < 2 ? m0[2 * q] : m1[2 * q - 4], mu1 = q < 2 ? m0[2 * q + 1] : m1[2 * q - 3];
                f[2 * q] = c0 + (p0 - c0) * mu0; f[2 * q + 1] = c1 + (p1 - c1) * mu1; }
            bf16_t* dstp;
            if (j0 < 3168) { dstp = AW + (size_t)t * 128 + (j0 - 3072);
#pragma unroll
                for (int q = 0; q < 8; ++q) f[q] = tanhf(f[q]); }
            else if (j0 < 3264) { dstp = AA + (size_t)t * 128 + (j0 - 3168); }
            else { dstp = AG + (size_t)t * 256 + (j0 - 3264);
#pragma unroll
                for (int q = 0; q < 8; ++q) f[q] = sigmoidf_(f[q]); }
            u32x4 o; o.x = cvtpk(f[0], f[1]); o.y = cvtpk(f[2], f[3]); o.z = cvtpk(f[4], f[5]); o.w = cvtpk(f[6], f[7]); *(u32x4*)dstp = o; }
        else { const int e = lane - 56; if (e < 4) *(u32x4*)(AW + (size_t)t * 128 + 96 + 8 * e) = (u32x4){0u, 0u, 0u, 0u}; else *(u32x4*)(AA + (size_t)t * 128 + 96 + 8 * (e - 4)) = (u32x4){0u, 0u, 0u, 0u}; }
    }
    {   LAS float* kr = (LAS float*)(lds + 8 * 8448);
        if ((lane & 7) == 0) kr[wave * 8 + (lane >> 3)] = knmax;
        __syncthreads();
        if (wave == 0 && lane < 8) { float m = kr[lane];
#pragma unroll
            for (int w2 = 1; w2 < 8; ++w2) m = fmaxf(m, kr[w2 * 8 + lane]);
            ((float*)(p->ws + WS_KNP))[(size_t)(gw >> 3) * 8 + lane] = m; }
        __syncthreads(); }
}

__device__ __forceinline__ void phase_prep2(KP p, int l, int gw, int NGW, int lane) {
    const float* KR = (const float*)(p->ws + WS_KR); const float* A = (const float*)(p->ws + WS_A);
    float* KF = (float*)(p->ws + WS_KF); float* AN = (float*)(p->ws + WS_AN); float* BB = (float*)(p->ws + WS_BB);
    const float* k_k = p->in[12] + l * 1024; const float* k_a = p->in[13] + l * 1024;
    const int c0 = 16 * lane;
    for (int t = gw; t < M; t += NGW) { const size_t o = (size_t)t * 1024 + c0; float n2 = 0.f; f32x4 kkv[4], kr[4], av[4];
#pragma unroll
        for (int q = 0; q < 4; ++q) { kr[q] = *(const f32x4*)(KR + o + 4 * q); av[q] = *(const f32x4*)(A + o + 4 * q); kkv[q] = kr[q] * *(const f32x4*)(k_k + c0 + 4 * q);
            n2 += (kkv[q][0] * kkv[q][0] + kkv[q][1] * kkv[q][1]) + (kkv[q][2] * kkv[q][2] + kkv[q][3] * kkv[q][3]); }
        n2 = quad_sum(n2); const float inv = 1.0f / fmaxf(sqrtf(n2), 1e-12f);
#pragma unroll
        for (int q = 0; q < 4; ++q) { const f32x4 kk = kkv[q] * inv; const f32x4 ka = *(const f32x4*)(k_a + c0 + 4 * q);
            *(f32x4*)(KF + o + 4 * q) = kr[q] * (1.0f + (av[q] - 1.0f) * ka); *(f32x4*)(AN + o + 4 * q) = -kk; *(f32x4*)(BB + o + 4 * q) = kk * av[q]; }
    }
}

template <int MODE>
__device__ __forceinline__ void scan_task(KP p, int l, LAS unsigned char* wl, int c, int h, int lane) {
    constexpr int NPV = MODE == 0 ? 1 : (MODE == 1 ? 2 : 3);
    constexpr int SB = 4;
    LAS float* vec = (LAS float*)wl;
    LAS float* ybuf = (LAS float*)(wl + 7 * SB * 256);
    const float* DECp = (const float*)(p->ws + WS_DEC); const float* Ap = (const float*)(p->ws + WS_A); const bf16_t* PROJ = (const bf16_t*)(p->ws + WS_PROJ);
    const int rb = lane >> 2, cb = lane & 3, t0 = c * CL;
    f32x2 s[4][8];
    if (MODE == 0) {
#pragma unroll
        for (int r = 0; r < 4; ++r)
#pragma unroll
            for (int q = 0; q < 8; ++q) { s[r][q].x = (4 * rb + r == 16 * cb + 2 * q) ? 1.f : 0.f; s[r][q].y = (4 * rb + r == 16 * cb + 2 * q + 1) ? 1.f : 0.f; }
    } else if (MODE == 1) {
#pragma unroll
        for (int r = 0; r < 4; ++r)
#pragma unroll
            for (int q = 0; q < 8; ++q) s[r][q] = (f32x2){0.f, 0.f};
    } else {
        const float* SI = (const float*)(p->ws + WS_SI) + ((size_t)(h * NCH + c)) * 4096;
#pragma unroll
        for (int x = 0; x < 16; ++x) { const f32x4 v = *(const f32x4*)(SI + (16 * cb + x) * 64 + 4 * rb);
#pragma unroll
            for (int r = 0; r < 4; ++r) { if (x & 1) s[r][x >> 1].y = v[r]; else s[r][x >> 1].x = v[r]; } }
    }
    const int lst = lane >> 4, lq = lane & 15;
    const f32x4 kk4 = *(const f32x4*)(p->in[12] + l * 1024 + 64 * h + 4 * lq), ka4 = *(const f32x4*)(p->in[13] + l * 1024 + 64 * h + 4 * lq);
    f32x4 lnw4 = (f32x4){0.f, 0.f, 0.f, 0.f}, lnb4 = lnw4, rk4 = lnw4;
    if (MODE == 2) { lnw4 = *(const f32x4*)(p->in[15] + l * 1024 + 64 * h + 4 * lq); lnb4 = *(const f32x4*)(p->in[16] + l * 1024 + 64 * h + 4 * lq); rk4 = *(const f32x4*)(p->in[14] + l * 1024 + 64 * h + 4 * lq); }
    const size_t goff = (size_t)(t0 + lst) * 1024 + 64 * h + 4 * lq;
    const int pvo[3] = {1024, 2048, 0};
    f32x4 mu4[NPV];
#pragma unroll
    for (int v = 0; v < NPV; ++v) mu4[v] = *(const f32x4*)(p->in[6] + (size_t)l * RWC + pvo[v] + 64 * h + 4 * lq);
    const bf16_t* pj = PROJ + (size_t)(t0 + lst) * INCP + RW0 + 64 * h + 4 * lq;
    const float* Gp = (const float*)(p->ws + WS_G);
    struct Pre { f32x4 dec, a, g; u32x2 cur[NPV], prv[NPV]; };
    Pre pA, pB;
#define SCAN_LOAD(P_, SBI) do { if ((SBI) < CL / SB) { const size_t ro = (size_t)(SB * (SBI)); P_.dec = *(const f32x4*)(DECp + goff + ro * 1024); P_.a = *(const f32x4*)(Ap + goff + ro * 1024); \
        if constexpr (MODE == 2) P_.g = *(const f32x4*)(Gp + goff + ro * 1024); \
        const bool first = (t0 + (int)ro + lst) == 0; \
        _Pragma("unroll") for (int v = 0; v < NPV; ++v) { P_.cur[v] = *(const u32x2*)(pj + ro * INCP + pvo[v]); P_.prv[v] = first ? (u32x2){0u, 0u} : *(const u32x2*)(pj + ro * INCP + pvo[v] - INCP); } } } while (0)
#define SCAN_SHIFT(P_, V) ({ const f32x4 c_ = (f32x4){bflo(P_.cur[V].x), bfhi(P_.cur[V].x), bflo(P_.cur[V].y), bfhi(P_.cur[V].y)}, q_ = (f32x4){bflo(P_.prv[V].x), bfhi(P_.prv[V].x), bflo(P_.prv[V].y), bfhi(P_.prv[V].y)}; c_ + (q_ - c_) * mu4[V]; })
#define SCAN_STAGE(P_) do { const f32x4 kr = SCAN_SHIFT(P_, 0), av = P_.a; const f32x4 kkv = kr * kk4; \
        float n2 = (kkv[0] * kkv[0] + kkv[1] * kkv[1]) + (kkv[2] * kkv[2] + kkv[3] * kkv[3]); n2 = row16_sum(n2); \
        const float inv = __builtin_amdgcn_rsqf(fmaxf(n2, 1e-24f)); const f32x4 kkn = kkv * inv; \
        LAS float* vw = vec + lst * 64 + 4 * lq; \
        *(LAS f32x4*)(vw + 0 * SB * 64) = P_.dec; *(LAS f32x4*)(vw + 1 * SB * 64) = -kkn; *(LAS f32x4*)(vw + 2 * SB * 64) = kkn * av; \
        if constexpr (MODE != 0) { *(LAS f32x4*)(vw + 3 * SB * 64) = kr * (1.0f + (av - 1.0f) * ka4); *(LAS f32x4*)(vw + 4 * SB * 64) = SCAN_SHIFT(P_, 1); } \
        if constexpr (MODE == 2) { *(LAS f32x4*)(vw + 5 * SB * 64) = SCAN_SHIFT(P_, 2); *(LAS f32x4*)(vw + 6 * SB * 64) = P_.g; } } while (0)
    SCAN_LOAD(pA, 0); SCAN_LOAD(pB, 1);
    float gam = 1.0f;
    LAS float* gbuf = ybuf + SB * 64;
    for (int sb = 0; sb < CL / SB; ++sb) {
        if (sb & 1) { SCAN_STAGE(pB); SCAN_LOAD(pB, sb + 2); } else { SCAN_STAGE(pA); SCAN_LOAD(pA, sb + 2); }
#pragma unroll
        for (int st = 0; st < SB; ++st) { const float w_ = vec[(0 * SB + st) * 64 + lane]; const float gprev = gam; gam *= w_; const float ginv = __builtin_amdgcn_rcpf(gam);
            vec[(1 * SB + st) * 64 + lane] *= gprev; vec[(2 * SB + st) * 64 + lane] *= ginv;
            if (MODE != 0) vec[(3 * SB + st) * 64 + lane] *= ginv;
            if (MODE == 2) vec[(5 * SB + st) * 64 + lane] *= gam; }
#pragma unroll 1
        for (int st = 0; st < SB; ++st) {
            const LAS float* vb = vec + st * 64 + 16 * cb;
            float sa[4];
            {   f32x2 a2[8];
#pragma unroll
                for (int q = 0; q < 4; ++q) { const f32x4 y = *(const LAS f32x4*)(vb + 1 * SB * 64 + 4 * q); a2[2 * q] = (f32x2){y[0], y[1]}; a2[2 * q + 1] = (f32x2){y[2], y[3]}; }
                f32x2 c0[4];
#pragma unroll
                for (int r = 0; r < 4; ++r) c0[r] = s[r][0] * a2[0];
#pragma unroll
                for (int q = 1; q < 8; ++q)
#pragma unroll
                    for (int r = 0; r < 4; ++r) c0[r] = s[r][q] * a2[q] + c0[r];
                float e[4];
#pragma unroll
                for (int r = 0; r < 4; ++r) e[r] = c0[r].x + c0[r].y;
#pragma unroll
                for (int r = 0; r < 4; ++r) e[r] += dpp_xor1(e[r]);
#pragma unroll
                for (int r = 0; r < 4; ++r) sa[r] = e[r] + dpp_xor2(e[r]); }
            f32x4 vv = (f32x4){0.f, 0.f, 0.f, 0.f};
            if (MODE != 0) vv = *(const LAS f32x4*)(vec + (4 * SB + st) * 64 + 4 * rb);
#pragma unroll
            for (int q = 0; q < 4; ++q) { const f32x4 b4 = *(const LAS f32x4*)(vb + 2 * SB * 64 + 4 * q);
                const f32x2 b0 = (f32x2){b4[0], b4[1]}, b1 = (f32x2){b4[2], b4[3]};
#pragma unroll
                for (int r = 0; r < 4; ++r) { s[r][2 * q] = b0 * sa[r] + s[r][2 * q]; s[r][2 * q + 1] = b1 * sa[r] + s[r][2 * q + 1]; }
                if (MODE != 0) { const f32x4 k4 = *(const LAS f32x4*)(vb + 3 * SB * 64 + 4 * q); const f32x2 k0 = (f32x2){k4[0], k4[1]}, k1 = (f32x2){k4[2], k4[3]};
#pragma unroll
                    for (int r = 0; r < 4; ++r) { s[r][2 * q] = k0 * vv[r] + s[r][2 * q]; s[r][2 * q + 1] = k1 * vv[r] + s[r][2 * q + 1]; } } }
            if (MODE == 2) {
                f32x2 r2[8];
#pragma unroll
                for (int q = 0; q < 4; ++q) { const f32x4 x = *(const LAS f32x4*)(vb + 5 * SB * 64 + 4 * q); r2[2 * q] = (f32x2){x[0], x[1]}; r2[2 * q + 1] = (f32x2){x[2], x[3]}; }
                f32x4 yv;
                f32x2 c0[4];
#pragma unroll
                for (int r = 0; r < 4; ++r) c0[r] = s[r][0] * r2[0];
#pragma unroll
                for (int q = 1; q < 8; ++q)
#pragma unroll
                    for (int r = 0; r < 4; ++r) c0[r] = s[r][q] * r2[q] + c0[r];
                float e[4];
#pragma unroll
                for (int r = 0; r < 4; ++r) e[r] = c0[r].x + c0[r].y;
#pragma unroll
                for (int r = 0; r < 4; ++r) e[r] += dpp_xor1(e[r]);
#pragma unroll
                for (int r = 0; r < 4; ++r) yv[r] = e[r] + dpp_xor2(e[r]);
                if (cb == 0) *(LAS f32x4*)(ybuf + st * 64 + 4 * rb) = yv;
            }
        }
        if ((sb & 15) == 15) {
            gbuf[lane] = gam; gam = 1.0f;
#pragma unroll
            for (int q = 0; q < 4; ++q) { const f32x4 g4 = *(const LAS f32x4*)(gbuf + 16 * cb + 4 * q); const f32x2 g0 = (f32x2){g4[0], g4[1]}, g1 = (f32x2){g4[2], g4[3]};
#pragma unroll
                for (int r = 0; r < 4; ++r) { s[r][2 * q] = s[r][2 * q] * g0; s[r][2 * q + 1] = s[r][2 * q + 1] * g1; } } }
        if (MODE == 2) {
            bf16_t* MIX = (bf16_t*)(p->ws + WS_MIX);
            const int t = t0 + SB * sb + lst; const LAS float* vr = vec + lst * 64 + 4 * lq;
            const f32x4 y = *(const LAS f32x4*)(ybuf + lst * 64 + 4 * lq), rr = *(const LAS f32x4*)(vr + 5 * SB * 64), kk = *(const LAS f32x4*)(vr + 3 * SB * 64),
                        vv = *(const LAS f32x4*)(vr + 4 * SB * 64), g = *(const LAS f32x4*)(vr + 6 * SB * 64);
            const float mean = row16_sum((y[0] + y[1]) + (y[2] + y[3])) * (1.0f / 64.0f);
            const f32x4 d = y - mean;
            const float var = row16_sum((d[0] * d[0] + d[1] * d[1]) + (d[2] * d[2] + d[3] * d[3])) * (1.0f / 64.0f);
            const f32x4 rkk = rr * kk * rk4;
            const float bon = row16_sum((rkk[0] + rkk[1]) + (rkk[2] + rkk[3]));
            const f32x4 o = (d * __builtin_amdgcn_rsqf(var + 64e-5f) * lnw4 + lnb4 + vv * bon) * g;
            u32x2 wv; wv.x = cvtpk(o[0], o[1]); wv.y = cvtpk(o[2], o[3]);
            *(u32x2*)(MIX + (size_t)t * DM + 1024 + 64 * h + 4 * lq) = wv;
        }
    }
    if (MODE == 0) { float* dst = (float*)(p->ws + WS_PB) + ((size_t)(h * NCH + c)) * 4096;
#pragma unroll
        for (int r = 0; r < 4; ++r)
#pragma unroll
            for (int q = 0; q < 4; ++q) *(f32x4*)(dst + (4 * rb + r) * 64 + 16 * cb + 4 * q) = (f32x4){s[r][2 * q].x, s[r][2 * q].y, s[r][2 * q + 1].x, s[r][2 * q + 1].y}; }
    if (MODE == 1) { float* dst = (float*)(p->ws + WS_UB) + ((size_t)(h * NCH + c)) * 4096;
#pragma unroll
        for (int x = 0; x < 16; ++x) { f32x4 v;
#pragma unroll
            for (int r = 0; r < 4; ++r) v[r] = (x & 1) ? s[r][x >> 1].y : s[r][x >> 1].x;
            *(f32x4*)(dst + (16 * cb + x) * 64 + 4 * rb) = v; } }
}

#undef SCAN_LOAD
#undef SCAN_SHIFT
#undef SCAN_STAGE
__device__ __forceinline__ void s2_head(KP p, LAS unsigned char* lds, int h, int ti, const int tid) {
    const float* PB = (const float*)(p->ws + WS_PB) + (size_t)h * NCH * 4096; const float* UT = (const float*)(p->ws + WS_UB) + (size_t)h * NCH * 4096;
    float* SI = (float*)(p->ws + WS_SI) + (size_t)h * NCH * 4096;
    const int lane = tid & 63, w = __builtin_amdgcn_readfirstlane(tid >> 6), n = lane & 31, lh = lane >> 5, to = (w >> 1) & 1, tj = w & 1;
    static_assert((NCH - 1) % 3 == 0, "three rotating prefetch buffers");
    if (w >= 4) {
        for (int c = 0; c < NCH - 1; ++c) __syncthreads();
    } else {
        f32x16 breg, ua, ub, uc2; float pa[16], pb[16], pc2[16];
#pragma unroll
        for (int r = 0; r < 16; ++r) breg[r] = 0.f;
        const int offu = (32 * to + 4 * lh) * 64 + 32 * ti + n, offp = (32 * tj + 4 * lh) * 64 + 32 * to + n, offs = (32 * tj + 4 * lh) * 64 + 32 * ti + n;
#define S2_LOAD(CH, U_, P_) do { const int ch_ = (CH) < NCH - 1 ? (CH) : NCH - 2; const float* pb_ = PB + (size_t)ch_ * 4096 + offp; const float* ub_ = UT + (size_t)ch_ * 4096 + offu; \
        _Pragma("unroll") for (int r = 0; r < 16; ++r) { const int cr = ((r & 3) + 8 * (r >> 2)) * 64; U_[r] = tj == 0 ? ub_[cr] : 0.f; P_[r] = pb_[cr]; } } while (0)
#define S2_STEP(C, UC_, PC_, UN_, PN_) do { \
        if (to == 0) { float* si = SI + (size_t)(C) * 4096 + offs; \
            _Pragma("unroll") for (int r = 0; r < 16; ++r) si[((r & 3) + 8 * (r >> 2)) * 64] = breg[r]; } \
        f32x16 acc = UC_; \
        _Pragma("unroll") for (int r = 0; r < 16; ++r) acc = __builtin_amdgcn_mfma_f32_32x32x2f32(PC_[r], breg[r], acc, 0, 0, 0); \
        LAS f32x4* ex = (LAS f32x4*)(lds + ((C) & 1) * 16384); \
        _Pragma("unroll") for (int q = 0; q < 4; ++q) ex[(w * 4 + q) * 64 + lane] = (f32x4){acc[4 * q], acc[4 * q + 1], acc[4 * q + 2], acc[4 * q + 3]}; \
        __syncthreads(); \
        S2_LOAD((C) + 2, UN_, PN_); \
        _Pragma("unroll") for (int q = 0; q < 4; ++q) { const f32x4 v0 = ex[((tj * 2) * 4 + q) * 64 + lane], v1 = ex[((tj * 2 + 1) * 4 + q) * 64 + lane]; \
            breg[4 * q] = v0[0] + v1[0]; breg[4 * q + 1] = v0[1] + v1[1]; breg[4 * q + 2] = v0[2] + v1[2]; breg[4 * q + 3] = v0[3] + v1[3]; } } while (0)
        S2_LOAD(0, ua, pa); S2_LOAD(1, ub, pb);
#pragma unroll 1
        for (int c = 0; c < NCH - 1; c += 3) {
            S2_STEP(c, ua, pa, uc2, pc2);
            S2_STEP(c + 1, ub, pb, ua, pa);
            S2_STEP(c + 2, uc2, pc2, ub, pb);
        }
        if (to == 0) { float* si = SI + (size_t)(NCH - 1) * 4096 + offs;
#pragma unroll
            for (int r = 0; r < 16; ++r) si[((r & 3) + 8 * (r >> 2)) * 64] = breg[r]; }
#undef S2_LOAD
#undef S2_STEP
    }
    __syncthreads();
}

template <int DV, bool SWA>
__device__ __forceinline__ void attn_unit(LAS unsigned char* lds, const bf16_t* Q, const bf16_t* Kp, const bf16_t* VT, float slope2, int q0, float sink2,
                                          float* Of32, float* MLp, bf16_t* Obf, const int tid, int kt_lo, int kt_hi, float kn) {
    constexpr int KROW = 144, KTILE = 64 * KROW, VTILE = DV * KROW, BUF = KTILE + VTILE, NVL = DV / 64;
    const int lane = tid & 63, w = __builtin_amdgcn_readfirstlane(tid >> 6), r32 = lane & 31, hi = lane >> 5;
    const int qpos = q0 + 32 * w + r32;
    bf16x8 qf[4];
#pragma unroll
    for (int j = 0; j < 4; ++j) qf[j] = *(const bf16x8*)(Q + (size_t)qpos * INCP + 16 * j + 8 * hi);
    int kt0 = kt_lo, kt1 = kt_hi;
    if (!SWA) {
        float qq = 0.f, qk = 0.f;
#pragma unroll
        for (int j = 0; j < 4; ++j) { const bf16x8 kf = *(const bf16x8*)(Kp + (size_t)qpos * INCP + 16 * j + 8 * hi);
#pragma unroll
            for (int e = 0; e < 8; ++e) { const float qv = bf2f((unsigned short)qf[j][e]), kv = bf2f((unsigned short)kf[e]); qq += qv * qv; qk += qv * kv; } }
        qq = xor32_sum(qq); qk = xor32_sum(qk);
        const float dneed = (sqrtf(qq) * kn - qk + 45.0f) / slope2;
        float kneed = (float)qpos - dneed;
        kneed = fminf(kneed, dppm<0xB1>(kneed)); kneed = fminf(kneed, dppm<0x4E>(kneed)); kneed = fminf(kneed, dppm<0x141>(kneed)); kneed = fminf(kneed, dppm<0x140>(kneed));
        LAS float* red = (LAS float*)(lds + 2 * BUF);
        if ((lane & 15) == 0) red[w * 4 + (lane >> 4)] = kneed;
        __syncthreads();
        float km = red[0];
#pragma unroll
        for (int i = 1; i < 32; ++i) km = fminf(km, red[i]);
        const int ktw = km <= 0.f ? 0 : ((int)km >> 6);
        kt0 = ktw > kt_lo ? ktw : kt_lo;
    }
    const int qlo = q0 + 32 * w, qhi = qlo + 31;
    f32x16 o[DV / 32];
#pragma unroll
    for (int d = 0; d < DV / 32; ++d)
#pragma unroll
        for (int r = 0; r < 16; ++r) o[d][r] = 0.f;
    float mrun = 0.f, lsum = 0.f;
    const int krow = tid >> 3, kch = tid & 7;
    u32x4 kreg, vreg[NVL];
    if (kt0 <= kt1) {   const int k0 = 64 * kt0; kreg = *(const u32x4*)(Kp + (size_t)(k0 + krow) * INCP + 8 * kch);
#pragma unroll
        for (int i = 0; i < NVL; ++i) { const int idx = tid + 512 * i; vreg[i] = *(const u32x4*)(VT + (size_t)(idx >> 3) * M + k0 + 8 * (idx & 7)); } }
    for (int kt = kt0; kt <= kt1; ++kt) {
        LAS unsigned char* buf = lds + ((kt - kt0) & 1) * BUF;
        *(LAS u32x4*)(buf + krow * KROW + 16 * kch) = kreg;
#pragma unroll
        for (int i = 0; i < NVL; ++i) { const int idx = tid + 512 * i; *(LAS u32x4*)(buf + KTILE + (idx >> 3) * KROW + 16 * (idx & 7)) = vreg[i]; }
        __syncthreads();
        if (kt < kt1) { const int k0 = 64 * (kt + 1); kreg = *(const u32x4*)(Kp + (size_t)(k0 + krow) * INCP + 8 * kch);
#pragma unroll
            for (int i = 0; i < NVL; ++i) { const int idx = tid + 512 * i; vreg[i] = *(const u32x4*)(VT + (size_t)(idx >> 3) * M + k0 + 8 * (idx & 7)); } }
        const int k0 = 64 * kt;
        bool act = k0 <= qhi; if (SWA) act = act && (k0 + 63 >= qlo - 127);
        if (act) {
            f32x16 p0, p1;
            {   const float c0 = slope2 * (float)(k0 + 4 * hi - qpos) - mrun, c1 = c0 + 32.0f * slope2;
#pragma unroll
                for (int r = 0; r < 16; ++r) { const float cr = (float)((r & 3) + 8 * (r >> 2)); p0[r] = __builtin_fmaf(slope2, cr, c0); p1[r] = __builtin_fmaf(slope2, cr, c1); } }
#pragma unroll
            for (int j = 0; j < 4; ++j) { const bf16x8 a0 = *(const LAS bf16x8*)(buf + r32 * KROW + 32 * j + 16 * hi), a1 = *(const LAS bf16x8*)(buf + (r32 + 32) * KROW + 32 * j + 16 * hi);
                p0 = __builtin_amdgcn_mfma_f32_32x32x16_bf16(a0, qf[j], p0, 0, 0, 0); p1 = __builtin_amdgcn_mfma_f32_32x32x16_bf16(a1, qf[j], p1, 0, 0, 0); }
            bool need_mask = k0 + 63 > qlo; if (SWA) need_mask = need_mask || (qhi - k0 >= 128);
            if (need_mask) {
#pragma unroll
                for (int r = 0; r < 16; ++r) { const int kv = k0 + (r & 3) + 8 * (r >> 2) + 4 * hi; const int d0 = qpos - kv, d1 = d0 - 32;
                    bool ok0 = d0 >= 0, ok1 = d1 >= 0; if (SWA) { ok0 = ok0 && d0 < 128; ok1 = ok1 && d1 < 128; }
                    p0[r] = ok0 ? p0[r] : -1e30f; p1[r] = ok1 ? p1[r] : -1e30f; } }
            float mx = fmaxf(p0[0], p1[0]);
#pragma unroll
            for (int r = 1; r < 16; ++r) mx = fmaxf(mx, fmaxf(p0[r], p1[r]));
            mx = xor32_max(mx);
            if (__builtin_amdgcn_ballot_w64(mx > 8.0f) != 0ull) {
                const float d = fmaxf(mx, 0.f), f = __builtin_amdgcn_exp2f(-d); mrun += d; lsum *= f;
#pragma unroll
                for (int r = 0; r < 16; ++r) { p0[r] -= d; p1[r] -= d; }
#pragma unroll
                for (int dd = 0; dd < DV / 32; ++dd)
#pragma unroll
                    for (int r = 0; r < 16; ++r) o[dd][r] *= f; }
            float rs = 0.f;
#pragma unroll
            for (int r = 0; r < 16; ++r) { p0[r] = __builtin_amdgcn_exp2f(p0[r]); p1[r] = __builtin_amdgcn_exp2f(p1[r]); rs += p0[r] + p1[r]; }
            lsum += rs;
            u32x4 pw[4];
            pw[0] = (u32x4){cvtpk(p0[0], p0[1]), cvtpk(p0[2], p0[3]), cvtpk(p0[4], p0[5]), cvtpk(p0[6], p0[7])};
            pw[1] = (u32x4){cvtpk(p0[8], p0[9]), cvtpk(p0[10], p0[11]), cvtpk(p0[12], p0[13]), cvtpk(p0[14], p0[15])};
            pw[2] = (u32x4){cvtpk(p1[0], p1[1]), cvtpk(p1[2], p1[3]), cvtpk(p1[4], p1[5]), cvtpk(p1[6], p1[7])};
            pw[3] = (u32x4){cvtpk(p1[8], p1[9]), cvtpk(p1[10], p1[11]), cvtpk(p1[12], p1[13]), cvtpk(p1[14], p1[15])};
#pragma unroll
            for (int d = 0; d < DV / 32; ++d)
#pragma unroll
                for (int j = 0; j < 4; ++j) { const bf16x8 vf = *(const LAS bf16x8*)(buf + KTILE + (32 * d + r32) * KROW + 32 * j + 16 * hi);
                    o[d] = __builtin_amdgcn_mfma_f32_32x32x16_bf16(vf, __builtin_bit_cast(bf16x8, pw[j]), o[d], 0, 0, 0); }
        }
    }
    lsum = xor32_sum(lsum);
    if (SWA) { lsum += __builtin_amdgcn_exp2f(sink2 - mrun);
        const float inv = 1.0f / lsum; bf16_t* op = Obf + (size_t)qpos * DM;
#pragma unroll
        for (int d = 0; d < DV / 32; ++d)
#pragma unroll
            for (int g = 0; g < 4; ++g) { u32x2 wv; wv.x = cvtpk(o[d][4 * g] * inv, o[d][4 * g + 1] * inv); wv.y = cvtpk(o[d][4 * g + 2] * inv, o[d][4 * g + 3] * inv);
                *(u32x2*)(op + 32 * d + 8 * g + 4 * hi) = wv; }
    } else { float* op = Of32 + (size_t)qpos * 1024;
#pragma unroll
        for (int d = 0; d < DV / 32; ++d)
#pragma unroll
            for (int g = 0; g < 4; ++g) *(f32x4*)(op + 32 * d + 8 * g + 4 * hi) = (f32x4){o[d][4 * g], o[d][4 * g + 1], o[d][4 * g + 2], o[d][4 * g + 3]};
        if (hi == 0) *(f32x2*)(MLp + (size_t)qpos * 16) = (f32x2){mrun, lsum};
    }
    __syncthreads();
}

__device__ __forceinline__ void phase_diffcombine(KP p, int l, int gw, int NGW, int lane) {
    const float* lamv = p->in[3] + l * 256;
    const float lambda_init = 0.8f - 0.6f * expf(-0.3f * (float)l);
    const float s1 = wave_sum(lamv[lane] * lamv[64 + lane]), s2 = wave_sum(lamv[128 + lane] * lamv[192 + lane]);
    const float lam = expf(s1) - expf(s2) + lambda_init;
    const float* OD = (const float*)(p->ws + WS_OD); const float* ML = (const float*)(p->ws + WS_ML); bf16_t* MIX = (bf16_t*)(p->ws + WS_MIX);
    const int h = lane >> 4, d0 = (lane & 15) * 8;
    const f32x4 g0 = *(const f32x4*)(p->in[4] + l * 128 + d0), g1 = *(const f32x4*)(p->in[4] + l * 128 + d0 + 4);
    for (int t = gw; t < M; t += NGW) { const int nseg = ((t >> 8) + 8) >> 3;
        f32x4 oc[2][2];
#pragma unroll
        for (int c = 0; c < 2; ++c) {
            f32x2 ml[4]; float mm = -1e30f;
#pragma unroll
            for (int s = 0; s < 4; ++s) if (s < nseg) { ml[s] = *(const f32x2*)(ML + ((size_t)s * M + t) * 16 + h * 4 + c * 2); mm = fmaxf(mm, ml[s].x); }
            f32x4 a0 = (f32x4){0.f, 0.f, 0.f, 0.f}, a1 = a0; float L = 0.f;
#pragma unroll
            for (int s = 0; s < 4; ++s) if (s < nseg) { const float f = exp2f(ml[s].x - mm); L += ml[s].y * f;
                const float* b = OD + ((size_t)s * M + t) * 1024 + h * 256 + c * 128 + d0; a0 += *(const f32x4*)b * f; a1 += *(const f32x4*)(b + 4) * f; }
            const float inv = 1.0f / L; oc[c][0] = a0 * inv; oc[c][1] = a1 * inv; }
        const f32x4 o0 = oc[0][0] - oc[1][0] * lam, o1 = oc[0][1] - oc[1][1] * lam;
        float ss = (o0[0] * o0[0] + o0[1] * o0[1]) + (o0[2] * o0[2] + o0[3] * o0[3]) + (o1[0] * o1[0] + o1[1] * o1[1]) + (o1[2] * o1[2] + o1[3] * o1[3]);
        ss = row16_sum(ss);
        const float r = rsqrtf(ss * (1.0f / 128.0f) + EPS) * (1.0f - lambda_init);
        const f32x4 y0 = o0 * g0 * r, y1 = o1 * g1 * r;
        u32x4 wv; wv.x = cvtpk(y0[0], y0[1]); wv.y = cvtpk(y0[2], y0[3]); wv.z = cvtpk(y1[0], y1[1]); wv.w = cvtpk(y1[2], y1[3]);
        *(u32x4*)(MIX + (size_t)t * DM + h * 128 + d0) = wv; }
}

#define XB_TMO      128
#define XB_XCNT(j)  (256  + 64 * (j))
#define XB_XSUB(j)  (1280 + 64 * (j))
#define XB_XGEN(j)  (2304 + 64 * (j))
#define XB_TOP      3328
#define XB_TOPGEN   3392
#define XCD_BAR_WORDS 3456
#define XB_SPIN_CAP (1u << 22)
__device__ __forceinline__ unsigned xb_ld(unsigned* p)              { return __hip_atomic_load(p, __ATOMIC_RELAXED, __HIP_MEMORY_SCOPE_AGENT); }
__device__ __forceinline__ unsigned xb_add(unsigned* p, unsigned v) { return __hip_atomic_fetch_add(p, v, __ATOMIC_RELAXED, __HIP_MEMORY_SCOPE_AGENT); }
__device__ __forceinline__ unsigned xb_xcc_id() { return (unsigned)__builtin_amdgcn_s_getreg((3 << 11) | 20) & 0xFu; }
#define XB_SPIN(cond, bar) do { unsigned _sp = 0; while (cond) { __builtin_amdgcn_s_sleep(1); \
    if ((++_sp & 255u) == 0u) { if (xb_ld(&(bar)[XB_TMO])) break; if (_sp > XB_SPIN_CAP) { atomicAdd(&(bar)[XB_TMO], 1u); break; } } } } while (0)
__device__ __forceinline__ void xcd_barrier_complete(unsigned* bar, unsigned x, unsigned& nloc, unsigned& nx) {
    const unsigned G = gridDim.x;
    unsigned sum, cnt, mine, sp = 0u;
    for (;;) {
        sum = 0u; cnt = 0u; mine = 0u;
#pragma unroll
        for (unsigned j = 0; j < 16; ++j) { const unsigned c = xb_ld(&bar[XB_XCNT(j)]); sum += c; cnt += (c > 0u) ? 1u : 0u; mine = (j == x) ? c : mine; }
        if (sum == G) break;
        __builtin_amdgcn_s_sleep(1);
        if ((++sp & 255u) == 0u) { if (xb_ld(&bar[XB_TMO])) break; if (sp > XB_SPIN_CAP) { atomicAdd(&bar[XB_TMO], 1u); break; } }
    }
    nloc = mine > 0u ? mine : 1u; nx = cnt > 0u ? cnt : 1u;
}
__device__ __forceinline__ void xcd_barrier(unsigned* bar, volatile LAS unsigned* st, const int tid) {
    asm volatile("s_waitcnt vmcnt(0)" ::: "memory");
    __syncthreads();
    if (tid == 0) {
        const unsigned x = xb_xcc_id();
        __builtin_amdgcn_s_waitcnt(0);
        unsigned nloc = st[0], nx = st[1];
        if (nloc == 0u) { xcd_barrier_complete(bar, x, nloc, nx); st[0] = nloc; st[1] = nx; }
        const unsigned old = xb_add(&bar[XB_XSUB(x)], 1u);
        const unsigned gen = old / nloc;
        if (old + 1u == (gen + 1u) * nloc) {
            __builtin_amdgcn_fence(__ATOMIC_RELEASE, "agent");
            asm volatile("s_waitcnt vmcnt(0)" ::: "memory");
            const unsigned og = xb_add(&bar[XB_TOP], 1u);
            const unsigned tg = og / nx;
            if (og + 1u == (tg + 1u) * nx) xb_add(&bar[XB_TOPGEN], 1u);
            else XB_SPIN(xb_ld(&bar[XB_TOPGEN]) == tg, bar);
            __builtin_amdgcn_fence(__ATOMIC_ACQUIRE, "agent");
            xb_add(&bar[XB_XGEN(x)], 1u);
            asm volatile("s_waitcnt vmcnt(0)" ::: "memory");
        } else {
            XB_SPIN(xb_ld(&bar[XB_XGEN(x)]) == gen, bar);
            __builtin_amdgcn_fence(__ATOMIC_ACQUIRE, "agent");
            asm volatile("s_waitcnt vmcnt(0)" ::: "memory");
        }
    }
    __syncthreads();
}

#ifndef DUPBAR
#define DUPBAR 1
#endif
#define GSYNC() do { FRESH(); for (int rb_ = 0; rb_ < DUPBAR; ++rb_) xcd_barrier((unsigned*)(p->ws + WS_CTL) + 4096, (volatile LAS unsigned*)(lds + LDS_BYTES - 32), tid); } while (0)
#define PTRS() unsigned* ctl = (unsigned*)(p->ws + WS_CTL); bf16_t* XB = (bf16_t*)(p->ws + WS_XB); bf16_t* PROJ = (bf16_t*)(p->ws + WS_PROJ); bf16_t* MIX = (bf16_t*)(p->ws + WS_MIX); bf16_t* H = (bf16_t*)(p->ws + WS_H); \
    float* ssqA = (float*)(p->ws + WS_SSQA); float* ssqB = (float*)(p->ws + WS_SSQB); unsigned char* wb = p->ws + WS_W + (size_t)l * LW_STRIDE; (void)ctl; (void)XB; (void)PROJ; (void)MIX; (void)H; (void)ssqA; (void)ssqB; (void)wb
#define FRESH() KP p = fresh_params(); int G = gridDim.x, bx = blockIdx.x; asm volatile("" : "+s"(G), "+s"(bx)); const int NGW = G * 8; (void)NGW; const int tid = fresh_tid(wave0), lane = tid & 63, wave = __builtin_amdgcn_readfirstlane(tid >> 6), gw = bx * 8 + wave; (void)lane; (void)gw
template <int L> __device__ __forceinline__ void layer_body(LAS unsigned char* lds, const int wave0) {
    constexpr int l = L;

#ifndef DUP1
#define DUP1 1
#endif
        for (int rep = 0; rep < DUP1; ++rep) {   if (rep) GSYNC(); FRESH(); PTRS(); pg8::Gemm g{XB, (const bf16_t*)(wb + LW_WIN), M, INCP, DM}; pg8::StaticOrder S; S.init(M, INCP, G, bx);
            pg8::EpiProj E{PROJ, INCP, ssqA};
            pg8::gemm_phase<pg8::EpiProj, pg8::StaticOrder, true, true>(lds, g, S, E, tid); }
        GSYNC();
#ifndef DUP234
#define DUP234 1
#endif
        for (int rep = 0; rep < DUP234; ++rep) { if (rep) GSYNC(); FRESH(); phase_prep1(p, l, lds, gw, NGW, wave, lane); }
        GSYNC();
        {   FRESH(); PTRS(); pg8::Gemm g{(const bf16_t*)(p->ws + WS_AW), (const bf16_t*)(wb + LW_W2T), M, 1024, 128}; pg8::StaticOrder S; S.init(M, 1024, G, bx);
            pg8::EpiLora<0> E{(float*)(p->ws + WS_DEC), p->in[7] + l * 1024};
            pg8::gemm_phase<pg8::EpiLora<0>, pg8::StaticOrder, true, true>(lds, g, S, E, tid); }
        {   FRESH(); PTRS(); pg8::Gemm g{(const bf16_t*)(p->ws + WS_AA), (const bf16_t*)(wb + LW_A2T), M, 1024, 128}; pg8::StaticOrder S; S.init(M, 1024, G, (bx + 128) % G);
            pg8::EpiLora<1> E{(float*)(p->ws + WS_A), p->in[9] + l * 1024};
            pg8::gemm_phase<pg8::EpiLora<1>, pg8::StaticOrder, true, true>(lds, g, S, E, tid); }
        {   FRESH(); PTRS(); pg8::Gemm g{(const bf16_t*)(p->ws + WS_AG), (const bf16_t*)(wb + LW_G2T), M, 1024, 256}; pg8::StaticOrder S; S.init(M, 1024, G, (bx + 128) % G);
            pg8::EpiLora<2> E{(float*)(p->ws + WS_G), nullptr};
            pg8::gemm_phase<pg8::EpiLora<2>, pg8::StaticOrder, true, true>(lds, g, S, E, tid); }
        GSYNC();
        {   FRESH(); LAS unsigned char* wl = lds + wave * 14336;
#ifndef DUP57
#define DUP57 1
#endif
#ifndef DUP5
#define DUP5 1
#endif
            for (int rep = 0; rep < DUP57 * DUP5; ++rep) for (int it = gw; it < 2 * NCH * 16; it += NGW) { const int mode = it & 1, ch = it >> 1, c = ch % NCH, h = ch / NCH;
                if (mode == 0) scan_task<0>(p, l, wl, c, h, lane); else scan_task<1>(p, l, wl, c, h, lane); } }
        GSYNC();
#ifndef DUP6
#define DUP6 1
#endif
        for (int rep = 0; rep < DUP6; ++rep) {   if (rep) GSYNC(); FRESH(); PTRS(); LAS int* slot = (LAS int*)(lds + LDS_BYTES - 64);
            LAS float* knl = (LAS float*)(lds + LDS_BYTES - 128);
            {   LAS float* kr = (LAS float*)lds; const float* knp = (const float*)(p->ws + WS_KNP); const int g = tid & 7, part = tid >> 3; float m = 0.f;
                for (int b2 = part; b2 < G; b2 += 64) m = fmaxf(m, knp[(size_t)b2 * 8 + g]);
                kr[part * 8 + g] = m; __syncthreads();
                if (tid < 8) { float mm = kr[tid]; for (int q2 = 1; q2 < 64; ++q2) mm = fmaxf(mm, kr[q2 * 8 + tid]); knl[tid] = mm; }
                __syncthreads(); }
            const float* sinks = p->in[5] + l * 8;
            for (;;) {
                if (tid == 0) *slot = (int)atomicAdd(ctl + 64 * (l + 1) + 16 * rep, 1u);
                __syncthreads();
                const int it = *slot;
                __syncthreads();
                if (it >= 928) break;
                if (it < 32) {
#ifndef NO_S2
                    s2_head(p, lds, it >> 1, it & 1, tid);
#endif
                }
                else if (it < 672) { const int d = it - 32, h = 3 - d / 160, u = d % 160, c = u & 1, v = u >> 1; int qb, seg;
                    if (v < 32) { qb = 31 - (v >> 2); seg = v & 3; } else if (v < 56) { const int w2 = v - 32; qb = 23 - w2 / 3; seg = w2 % 3; }
                    else if (v < 72) { const int w2 = v - 56; qb = 15 - (w2 >> 1); seg = w2 & 1; } else { qb = 79 - v; seg = 0; }
                    const float slope2 = exp2f(-2.0f * (float)(h + 1)) * LOG2E;
                    const float kn = sqrtf(knl[h * 2 + c]);
                    const int kt1 = 4 * qb + 3, klo = 32 * seg, khi = (klo + 31 < kt1) ? klo + 31 : kt1;
                    attn_unit<128, false>(lds, PROJ + h * 128 + c * 64, PROJ + 512 + h * 128 + c * 64, (const bf16_t*)(p->ws + WS_VAT) + (size_t)(h * 128) * M, slope2, qb * 256, 0.f,
                                          (float*)(p->ws + WS_OD) + (size_t)seg * M * 1024 + h * 256 + c * 128, (float*)(p->ws + WS_ML) + (size_t)seg * M * 16 + h * 4 + c * 2, nullptr, tid, klo, khi, kn); }
                else { const int s = it - 672, hq = s & 7, qb = s >> 3;
                    const int aidx = (hq >> 1) * 3 + (hq & 1);
                    const float slope2 = exp2f(-8.0f * (float)(aidx + 1) / 12.0f) * LOG2E;
                    const int q0 = qb * 256;
                    attn_unit<64, true>(lds, PROJ + 1536 + hq * 64, PROJ + 2048 + (hq >> 2) * 64, (const bf16_t*)(p->ws + WS_VBT) + (size_t)((hq >> 2) * 64) * M, slope2, q0, sinks[hq] * LOG2E,
                                        nullptr, nullptr, MIX + 512 + hq * 64, tid, q0 >= 128 ? (q0 - 128) / 64 : 0, (q0 + 255) / 64, 0.f); }
            } }
        GSYNC();
        {   FRESH();
            if (wave < 4) {
                LAS unsigned char* wl = lds + wave * 14336;
                for (int rep = 0; rep < DUP57; ++rep) for (int it = bx * 4 + wave; it < NCH * 16; it += G * 4) { const int c = it % NCH, h = it / NCH; scan_task<2>(p, l, wl, c, h, lane); }
            } else {
                phase_diffcombine(p, l, bx * 4 + (wave - 4), G * 4, lane);
                if (l + 1 < NL) { LAS float* scr = (LAS float*)(lds + 4 * 14336 + (wave - 4) * 8448);
                    for (int r = bx * 4 + (wave - 4); r < CONV_ITEMS; r += G * 4) convert_item(p, l + 1 < NL ? l + 1 : l, r, scr, lane); }
            } }
        GSYNC();
        {   FRESH(); PTRS(); pg8::Gemm g{MIX, (const bf16_t*)(wb + LW_WOUT), M, DM, DM}; pg8::StaticOrder S; S.init(M, DM, G, bx);
            pg8::EpiResid E{p->out, XB, ssqB};
            pg8::gemm_phase<pg8::EpiResid, pg8::StaticOrder, true, true>(lds, g, S, E, tid); }
        GSYNC();
        for (int rep = 0; rep < DUP1; ++rep) {   if (rep) GSYNC(); FRESH(); PTRS(); pg8::Gemm g{XB, (const bf16_t*)(wb + LW_WGU), M, GU, DM}; pg8::StaticOrder S; S.init(M, GU, G, bx);
            pg8::EpiSwiGLU E{H, ssqB};
            pg8::gemm_phase<pg8::EpiSwiGLU, pg8::StaticOrder, true, true>(lds, g, S, E, tid); }
        GSYNC();
        {   FRESH(); PTRS(); pg8::Gemm g{H, (const bf16_t*)(wb + LW_WDN), M, DM, FF}; pg8::StaticOrder S; S.init(M, DM, G, bx);
            pg8::EpiResid E{p->out, XB, ssqA};
            pg8::gemm_phase<pg8::EpiResid, pg8::StaticOrder, true, true>(lds, g, S, E, tid); }
        GSYNC();
    }

__global__ void __launch_bounds__(512, 2) fwd_megakernel(Params p_unused) {
    extern __shared__ __attribute__((aligned(16))) unsigned char lds_raw[];
    LAS unsigned char* lds = (LAS unsigned char*)lds_raw;
    cg::grid_group grid = cg::this_grid();
    const int wave0 = __builtin_amdgcn_readfirstlane((int)threadIdx.x >> 6);
    if (threadIdx.x < 16) ((LAS unsigned*)(lds + LDS_BYTES - 64))[threadIdx.x] = 0u;
    if (threadIdx.x == 0) xb_add((unsigned*)(p_unused.ws + WS_CTL) + 4096 + XB_XCNT(xb_xcc_id()), 1u);
    __syncthreads();

#ifndef DUP0
#define DUP0 1
#endif
    for (int rep = 0; rep < DUP0; ++rep) { FRESH(); phase0(p, lds, gw, NGW, wave, lane); __syncthreads(); }
    grid.sync();

    layer_body<0>(lds, wave0); layer_body<1>(lds, wave0); layer_body<2>(lds, wave0); layer_body<3>(lds, wave0);
    {   FRESH(); const int l = 0; PTRS(); const float* gf = p->in[21];
        for (int m = gw; m < M; m += NGW) { const float rs = rsqrtf(wave_sum(lane < 32 ? ssqA[(size_t)m * 32 + lane] : 0.f) * (1.0f / DM) + EPS);
#pragma unroll
            for (int j = 0; j < 8; ++j) { const size_t o = (size_t)m * DM + j * 256 + lane * 4; const f32x4 v = *(const f32x4*)(p->out + o); const f32x4 gv = *(const f32x4*)(gf + j * 256 + lane * 4);
                *(f32x4*)(p->out + o) = v * rs * gv; } } }
}

extern "C" void kernel_launch(void* const* d_in, const int* in_sizes, int n_in, void* d_out, int out_size, void* d_ws, size_t ws_size, hipStream_t stream) {
    static int grid = 0;
    if (grid == 0) {
        if (n_in != 22 || out_size != M * DM || ws_size < WS_END) { fprintf(stderr, "kernel_launch: unexpected shapes (n_in %d out %d ws %zu need %zu)\n", n_in, out_size, ws_size, (size_t)WS_END); grid = -1; return; }
        int dev = 0, cus = 0, per_cu = 0;
        hipGetDevice(&dev); hipDeviceGetAttribute(&cus, hipDeviceAttributeMultiprocessorCount, dev);
        hipFuncSetAttribute((const void*)fwd_megakernel, hipFuncAttributeMaxDynamicSharedMemorySize, LDS_BYTES);
        hipOccupancyMaxActiveBlocksPerMultiprocessor(&per_cu, (const void*)fwd_megakernel, 512, LDS_BYTES);
        if (per_cu < 1) { fprintf(stderr, "kernel_launch: occupancy query says %d blocks per CU\n", per_cu); per_cu = 1; }
        (void)hipGetLastError();
        grid = cus;
    }
    if (grid < 0) return;
    hipMemsetAsync((char*)d_ws + WS_CTL, 0, 65536, stream);
    Params p{};
    for (int i = 0; i < 22; ++i) p.in[i] = (const float*)d_in[i];
    p.out = (float*)d_out; p.ws = (unsigned char*)d_ws;
    void* args[] = {&p};
    hipError_t e = hipLaunchCooperativeKernel((const void*)fwd_megakernel, dim3(grid), dim3(512), args, LDS_BYTES, stream);
    if (e != hipSuccess) fprintf(stderr, "cooperative launch failed: %s (grid %d)\n", hipGetErrorString(e), grid);
}
```

```cpp
#include <hip/hip_runtime.h>
#include <hip/hip_cooperative_groups.h>
#include <cstdio>
#include <cstdint>
namespace cg = cooperative_groups;

#define LAS __attribute__((address_space(3)))
typedef unsigned short bf16_t;
typedef short bf16x8 __attribute__((ext_vector_type(8)));
typedef float f32x4 __attribute__((ext_vector_type(4)));
typedef float f32x2 __attribute__((ext_vector_type(2)));
typedef float f32x16 __attribute__((ext_vector_type(16)));
typedef unsigned u32x4 __attribute__((ext_vector_type(4)));
typedef unsigned u32x2 __attribute__((ext_vector_type(2)));
typedef __bf16 bf16x2_t __attribute__((ext_vector_type(2)));

constexpr int M = 8192, DM = 2048, INC = 5824, INCP = 5888, FF = 5632, GU = 11264, RW0 = 2304, RWC = 3520;
constexpr int NL = 4, NCH = 64, CL = 128;
constexpr float EPS = 1e-5f, LOG2E = 1.4426950408889634f;
constexpr float QSC = 0.125f * LOG2E;

constexpr size_t MiB = 1u << 20;
constexpr size_t SZ_WIN = (size_t)INCP * DM * 2, SZ_WOUT = (size_t)DM * DM * 2, SZ_WGU = (size_t)GU * DM * 2, SZ_WDN = (size_t)DM * FF * 2;
constexpr size_t SZ_W2T = 1024 * 128 * 2, SZ_G2T = 1024 * 256 * 2;
constexpr size_t LW_WIN = 0, LW_WOUT = LW_WIN + SZ_WIN, LW_WGU = LW_WOUT + SZ_WOUT, LW_WDN = LW_WGU + SZ_WGU, LW_W2T = LW_WDN + SZ_WDN,
                 LW_A2T = LW_W2T + SZ_W2T, LW_G2T = LW_A2T + SZ_W2T, LW_STRIDE = LW_G2T + SZ_G2T;
constexpr size_t SZ_F = (size_t)M * 1024 * 4;
constexpr size_t WS_CTL = 0, WS_W = 1 * MiB, WS_XB = WS_W + NL * LW_STRIDE, WS_PROJ = WS_XB + (size_t)M * DM * 2,
                 WS_VAT = WS_PROJ + (size_t)M * INCP * 2, WS_VBT = WS_VAT + (size_t)512 * M * 2, WS_AW = WS_VBT + (size_t)128 * M * 2,
                 WS_AA = WS_AW + (size_t)M * 128 * 2, WS_AG = WS_AA + (size_t)M * 128 * 2, WS_R = WS_AG + (size_t)M * 256 * 2,
                 WS_KR = WS_R + SZ_F, WS_V = WS_KR + SZ_F, WS_DEC = WS_V + SZ_F, WS_A = WS_DEC + SZ_F, WS_G = WS_A + SZ_F,
                 WS_KF = WS_G + SZ_F, WS_AN = WS_KF + SZ_F, WS_BB = WS_AN + SZ_F, WS_PB = WS_BB + SZ_F, WS_UB = WS_PB + SZ_F,
                 WS_SI = WS_UB + SZ_F, WS_OD = WS_SI + SZ_F, WS_ML = WS_OD + 4 * SZ_F, WS_KNP = WS_ML + (size_t)4 * M * 16 * 4, WS_MIX = WS_KNP + 65536, WS_SSQA = WS_MIX + (size_t)M * DM * 2,
                 WS_SSQB = WS_SSQA + (size_t)M * 32 * 4, WS_END = WS_SSQB + (size_t)M * 32 * 4;
constexpr size_t WS_H = WS_PROJ;
static_assert((size_t)M * FF * 2 <= (size_t)M * INCP * 2, "H overlay");

constexpr int LDS_BYTES = 147456;

struct Params { const float* in[22]; float* out; unsigned char* ws; };
typedef const __attribute__((address_space(4))) Params* KP;
__device__ __forceinline__ KP fresh_params() { KP k = (KP)__builtin_amdgcn_kernarg_segment_ptr(); asm volatile("" : "+s"(k)); return k; }

__device__ __forceinline__ unsigned cvtpk(float lo, float hi) { f32x2 v = {lo, hi}; bf16x2_t b = __builtin_convertvector(v, bf16x2_t); return __builtin_bit_cast(unsigned, b); }
__device__ __forceinline__ float bf2f(unsigned short b) { return __builtin_bit_cast(float, (unsigned)b << 16); }
__device__ __forceinline__ float bflo(unsigned w) { return __builtin_bit_cast(float, w << 16); }
__device__ __forceinline__ float bfhi(unsigned w) { return __builtin_bit_cast(float, w & 0xffff0000u); }
template <int CTRL> __device__ __forceinline__ float dppm(float v) { return __builtin_bit_cast(float, __builtin_amdgcn_mov_dpp(__builtin_bit_cast(int, v), CTRL, 0xF, 0xF, true)); }
__device__ __forceinline__ float xor16_sum(float v) { const unsigned b = __builtin_bit_cast(unsigned, v); auto rr = __builtin_amdgcn_permlane16_swap(b, b, false, false); return __builtin_bit_cast(float, (unsigned)rr[0]) + __builtin_bit_cast(float, (unsigned)rr[1]); }
__device__ __forceinline__ float xor32_sum(float v) { const unsigned b = __builtin_bit_cast(unsigned, v); auto rr = __builtin_amdgcn_permlane32_swap(b, b, false, false); return __builtin_bit_cast(float, (unsigned)rr[0]) + __builtin_bit_cast(float, (unsigned)rr[1]); }
__device__ __forceinline__ float xor32_max(float v) { const unsigned b = __builtin_bit_cast(unsigned, v); auto rr = __builtin_amdgcn_permlane32_swap(b, b, false, false); return fmaxf(__builtin_bit_cast(float, (unsigned)rr[0]), __builtin_bit_cast(float, (unsigned)rr[1])); }
__device__ __forceinline__ float row16_sum(float v) { v += dppm<0xB1>(v); v += dppm<0x4E>(v); v += dppm<0x141>(v); v += dppm<0x140>(v); return v; }
__device__ __forceinline__ float wave_sum(float v) { return xor32_sum(xor16_sum(row16_sum(v))); }
__device__ __forceinline__ float dpp_xor1(float v) { return __builtin_bit_cast(float, __builtin_amdgcn_mov_dpp(__builtin_bit_cast(int, v), 0xB1, 0xF, 0xF, true)); }
__device__ __forceinline__ float dpp_xor2(float v) { return __builtin_bit_cast(float, __builtin_amdgcn_mov_dpp(__builtin_bit_cast(int, v), 0x4E, 0xF, 0xF, true)); }
__device__ __forceinline__ float quad_sum(float v) { v += dpp_xor1(v); v += dpp_xor2(v); return v; }
__device__ __forceinline__ float sigmoidf_(float x) { return __builtin_amdgcn_rcpf(1.0f + __expf(-x)); }

__device__ __forceinline__ int fresh_tid(int wave0) { unsigned z = 0u; asm volatile("" : "+v"(z)); int t = wave0 * 64 + (int)__builtin_amdgcn_mbcnt_hi(~0u, __builtin_amdgcn_mbcnt_lo(~0u, z)); asm volatile("" : "+v"(t)); return t; }

__device__ __forceinline__ float row_rstd(const float* ssq, int row, int fq) {
    const float* pp = ssq + (size_t)row * 32 + 8 * fq; const f32x4 a = *(const f32x4*)pp, b = *(const f32x4*)(pp + 4);
    float s = ((a[0] + a[1]) + (a[2] + a[3])) + ((b[0] + b[1]) + (b[2] + b[3]));
    s = xor32_sum(xor16_sum(s));
    return rsqrtf(s * (1.0f / DM) + EPS);
}

namespace pg8 {
constexpr int BM = 256, BK = 64, HALF = 128, HTB = HALF * BK * 2, STAGE_BYTES = 8 * HTB, NXCD = 8, WGM = 8;
__host__ __device__ __forceinline__ int lds_byte(int r, int c) { const int st = (r >> 4) * 2 + (c >> 5), rr = r & 15, cc = c & 31, ob = rr * 64 + cc * 2; return st * 1024 + (ob ^ (((ob >> 9) & 1) << 5)); }
__host__ __device__ __forceinline__ void stage_rc(int b, int& R, int& C) { const int st = b / 1024, sb = b % 1024, swz = sb ^ (((sb >> 9) & 1) << 5); R = (st >> 1) * 16 + swz / 64; C = (st & 1) * 32 + (swz % 64) / 2; }
__host__ __device__ __forceinline__ int perm32(int rho) { const int n = rho >> 4, i = rho & 15; return 8 * (i >> 2) + 4 * n + (i & 3); }
struct Unit { int pm, pn; };
struct Gemm { const bf16_t* A; const bf16_t* Bt; int M, N, K; };
struct StaticOrder {
    int nM, nN, nwg, G, c;
    __host__ __device__ void init(int M_, int N_, int G_, int c_) { nM = M_ / BM; nN = N_ / BM; nwg = nM * nN; G = G_; c = c_; }
    __host__ __device__ bool next(int i, Unit& u) const {
        const long L = (long)i * G + c; if (L >= nwg) return false;
        int wgid = (int)L; { const int q = nwg / NXCD, r = nwg % NXCD, xcd = wgid % NXCD, off = wgid / NXCD; wgid = (xcd < r ? xcd * (q + 1) : r * (q + 1) + (xcd - r) * q) + off; }
        const int nig = WGM * nN, gid = wgid / nig, fm = gid * WGM, gsz = (nM - fm) < WGM ? (nM - fm) : WGM;
        u.pm = fm + ((wgid % nig) % gsz); u.pn = (wgid % nig) / gsz; return true;
    }
};

template <class Epi, class Sched, bool ALIGN_EPI, bool SP2>
__device__ __forceinline__ void gemm_phase(LAS unsigned char* lds, const Gemm g, const Sched& S, const Epi& E, const int tid) {
    const int wid = __builtin_amdgcn_readfirstlane(tid >> 6), lane = tid & 63, wr = wid >> 2, wc = wid & 3, fr = lane & 15, fq = lane >> 4;
    const int K = g.K, nt = K / BK;
    unsigned voffA[2], voffB[2];
#pragma unroll
    for (int i = 0; i < 2; ++i) { int R, C; stage_rc(tid * 16 + i * 8192, R, C); const int Rb = Epi::PERM ? ((R & ~31) + perm32(R & 31)) : R;
        voffA[i] = (unsigned)(R * K + C) * 2u; voffB[i] = (unsigned)(Rb * K + C) * 2u; }
    const size_t kstep = (size_t)(BK * 2);
    const size_t hstep = (size_t)HALF * K * 2;
    const size_t tstep = 2 * hstep;
    const unsigned ldsw = (unsigned)wid * 1024u;
    const int aoff = lds_byte(wr * 64 + fr, fq * 8), boff = lds_byte(wc * 32 + fr, fq * 8);
#define PG8_SA(b, h) (((b) * 2 + (h)) * HTB)
#define PG8_SB(b, h) ((4 + (b) * 2 + (h)) * HTB)
#define PG8_STAGE(bufoff, gbase, voff) do { _Pragma("unroll") for (int _i = 0; _i < 2; ++_i) \
        __builtin_amdgcn_global_load_lds((const unsigned*)((const char*)(gbase) + (voff)[_i]), (LAS unsigned*)(lds + (bufoff) + ldsw + _i * 8192), 16, 0, 0); } while (0)
#define PG8_LDA(dst, b, h) do { _Pragma("unroll") for (int m = 0; m < 4; ++m) _Pragma("unroll") for (int k = 0; k < 2; ++k) dst[m][k] = *(const LAS bf16x8*)(lds + PG8_SA(b, h) + aoff + m * 2048 + k * 1024); } while (0)
#define PG8_LDB(dst, b, h) do { _Pragma("unroll") for (int n = 0; n < 2; ++n) _Pragma("unroll") for (int k = 0; k < 2; ++k) dst[n][k] = *(const LAS bf16x8*)(lds + PG8_SB(b, h) + boff + n * 2048 + k * 1024); } while (0)
#define PG8_MMA(ai, bj, At, Bt) do { __builtin_amdgcn_s_setprio(1); _Pragma("unroll") for (int m = 0; m < 4; ++m) _Pragma("unroll") for (int n = 0; n < 2; ++n) _Pragma("unroll") for (int k = 0; k < 2; ++k) \
        acc[ai][bj][m][n] = __builtin_amdgcn_mfma_f32_16x16x32_bf16(Bt[n][k], At[m][k], acc[ai][bj][m][n], 0, 0, 0); __builtin_amdgcn_s_setprio(0); } while (0)
#define PG8_WAIT_V(n) asm volatile("s_waitcnt vmcnt(" #n ")" ::: "memory")
#define PG8_WAIT_L(n) asm volatile("s_waitcnt lgkmcnt(" #n ")" ::: "memory")
#define PG8_BAR __builtin_amdgcn_s_barrier()
#define PG8_SCHED __builtin_amdgcn_sched_barrier(0)
    Unit cur, nxt; int ui = 0;
    if (!S.next(0, cur)) return;
    f32x4 acc[2][2][4][2];
#pragma unroll
    for (int a = 0; a < 2; ++a)
#pragma unroll
        for (int b = 0; b < 2; ++b)
#pragma unroll
            for (int m = 0; m < 4; ++m)
#pragma unroll
                for (int n = 0; n < 2; ++n) acc[a][b][m][n] = (f32x4){0.f, 0.f, 0.f, 0.f};
    bf16x8 At[4][2], B0[2][2], B1[2][2];
    const char* cA = (const char*)g.A + (size_t)cur.pm * tstep; const char* cB = (const char*)g.Bt + (size_t)cur.pn * tstep;
    if constexpr (SP2) {
        PG8_STAGE(PG8_SB(0, 0), cB, voffB); PG8_STAGE(PG8_SB(0, 1), cB + hstep, voffB); PG8_STAGE(PG8_SA(0, 0), cA, voffA); PG8_STAGE(PG8_SA(0, 1), cA + hstep, voffA);
        if (wr == 1) PG8_BAR;
        PG8_WAIT_V(2); PG8_BAR;
        PG8_STAGE(PG8_SB(1, 0), cB + kstep, voffB); PG8_STAGE(PG8_SA(1, 0), cA + kstep, voffA); PG8_STAGE(PG8_SB(1, 1), cB + hstep + kstep, voffB);
        PG8_WAIT_V(6); PG8_BAR;
    } else {
        PG8_STAGE(PG8_SB(0, 0), cB, voffB); PG8_STAGE(PG8_SA(0, 0), cA, voffA); PG8_STAGE(PG8_SB(0, 1), cB + hstep, voffB); PG8_STAGE(PG8_SA(0, 1), cA + hstep, voffA);
        if (wr == 1) PG8_BAR;
        PG8_WAIT_V(4); PG8_BAR;
        PG8_STAGE(PG8_SB(1, 0), cB + kstep, voffB); PG8_STAGE(PG8_SA(1, 0), cA + kstep, voffA); PG8_STAGE(PG8_SB(1, 1), cB + hstep + kstep, voffB);
        PG8_WAIT_V(6); PG8_BAR;
    }
    for (;;) {
        const bool has_next = S.next(ui + 1, nxt);
        const char* nA = has_next ? (const char*)g.A + (size_t)nxt.pm * tstep : cA; const char* nB = has_next ? (const char*)g.Bt + (size_t)nxt.pn * tstep : cB;
        for (int t = 0; t < nt; t += 2) {
            const bool last = (t == nt - 2);
            const char* a1 = cA + (size_t)(t + 1) * kstep;
            const char* a2 = last ? nA : cA + (size_t)(t + 2) * kstep; const char* b2 = last ? nB : cB + (size_t)(t + 2) * kstep;
            const char* a3 = a2 + kstep; const char* b3 = b2 + kstep;
            if constexpr (SP2) {
            PG8_LDB(B0, 0, 0); PG8_LDB(B1, 0, 1); PG8_SCHED; PG8_LDA(At, 0, 0); PG8_STAGE(PG8_SA(1, 1), a1 + hstep, voffA);
            PG8_WAIT_V(8); PG8_WAIT_L(0); PG8_BAR; PG8_MMA(0, 0, At, B0); PG8_MMA(0, 1, At, B1); PG8_BAR; PG8_SCHED;
            PG8_LDA(At, 0, 1); PG8_STAGE(PG8_SB(0, 0), b2, voffB); PG8_STAGE(PG8_SB(0, 1), b2 + hstep, voffB); PG8_STAGE(PG8_SA(0, 0), a2, voffA);
            PG8_WAIT_V(8); PG8_WAIT_L(0); PG8_BAR; PG8_MMA(1, 0, At, B0); PG8_MMA(1, 1, At, B1); PG8_BAR; PG8_SCHED;
            PG8_LDB(B0, 1, 0); PG8_LDB(B1, 1, 1); PG8_SCHED; PG8_LDA(At, 1, 0); PG8_STAGE(PG8_SA(0, 1), a2 + hstep, voffA);
            PG8_WAIT_V(8); PG8_WAIT_L(0); PG8_BAR; PG8_MMA(0, 0, At, B0); PG8_MMA(0, 1, At, B1); PG8_BAR; PG8_SCHED;
            PG8_LDA(At, 1, 1); PG8_STAGE(PG8_SB(1, 0), b3, voffB); PG8_STAGE(PG8_SB(1, 1), b3 + hstep, voffB); PG8_STAGE(PG8_SA(1, 0), a3, voffA);
            PG8_WAIT_V(8); PG8_WAIT_L(0); PG8_BAR; PG8_MMA(1, 0, At, B0); PG8_MMA(1, 1, At, B1); PG8_BAR; PG8_SCHED;
            } else {
            PG8_LDB(B0, 0, 0); PG8_SCHED; PG8_LDA(At, 0, 0); PG8_STAGE(PG8_SA(1, 1), a1 + hstep, voffA);
            PG8_WAIT_L(8); PG8_BAR; PG8_WAIT_L(0); PG8_MMA(0, 0, At, B0); PG8_BAR; PG8_SCHED;
            PG8_LDB(B1, 0, 1); PG8_STAGE(PG8_SB(0, 0), b2, voffB);
            PG8_BAR; PG8_WAIT_L(0); PG8_MMA(0, 1, At, B1); PG8_BAR;
            PG8_LDA(At, 0, 1); PG8_STAGE(PG8_SA(0, 0), a2, voffA);
            PG8_BAR; PG8_WAIT_L(0); PG8_MMA(1, 0, At, B0); PG8_BAR; PG8_SCHED;
            PG8_STAGE(PG8_SB(0, 1), b2 + hstep, voffB);
            PG8_WAIT_V(6); PG8_BAR; PG8_MMA(1, 1, At, B1); PG8_BAR;
            PG8_LDB(B0, 1, 0); PG8_SCHED; PG8_LDA(At, 1, 0); PG8_STAGE(PG8_SA(0, 1), a2 + hstep, voffA);
            PG8_WAIT_L(8); PG8_BAR; PG8_WAIT_L(0); PG8_MMA(0, 0, At, B0); PG8_BAR; PG8_SCHED;
            PG8_LDB(B1, 1, 1); PG8_STAGE(PG8_SB(1, 0), b3, voffB);
            PG8_BAR; PG8_WAIT_L(0); PG8_MMA(0, 1, At, B1); PG8_BAR;
            PG8_LDA(At, 1, 1); PG8_STAGE(PG8_SA(1, 0), a3, voffA);
            PG8_BAR; PG8_WAIT_L(0); PG8_MMA(1, 0, At, B0); PG8_BAR; PG8_SCHED;
            PG8_STAGE(PG8_SB(1, 1), b3 + hstep, voffB);
            PG8_WAIT_V(6); PG8_BAR; PG8_MMA(1, 1, At, B1); PG8_BAR;
            }
        }
        if constexpr (ALIGN_EPI) { if (wr == 0) PG8_BAR; }
        E(acc, cur, wr, wc, fr, fq);
        if (!has_next) break;
#pragma unroll
        for (int a = 0; a < 2; ++a)
#pragma unroll
            for (int b = 0; b < 2; ++b)
#pragma unroll
                for (int m = 0; m < 4; ++m)
#pragma unroll
                    for (int n = 0; n < 2; ++n) acc[a][b][m][n] = (f32x4){0.f, 0.f, 0.f, 0.f};
        cur = nxt; cA = nA; cB = nB; ++ui;
        if constexpr (ALIGN_EPI) { if (wr == 1) PG8_BAR; }
    }
    PG8_WAIT_V(0);
    if constexpr (!ALIGN_EPI) { if (wr == 0) PG8_BAR; }
    PG8_BAR;
#undef PG8_SA
#undef PG8_SB
#undef PG8_STAGE
#undef PG8_LDA
#undef PG8_LDB
#undef PG8_MMA
#undef PG8_WAIT_V
#undef PG8_WAIT_L
#undef PG8_BAR
#undef PG8_SCHED
}

struct EpiProj {
    static constexpr bool PERM = true;
    bf16_t* O; int ldc; const float* ssq;
    __device__ __forceinline__ void operator()(const f32x4 (&acc)[2][2][4][2], const Unit& u, int wr, int wc, int fr, int fq) const {
        const int row0 = u.pm * BM + wr * 64 + fr, col0 = u.pn * BM + wc * 32 + 8 * fq;
#pragma unroll
        for (int ai = 0; ai < 2; ++ai)
#pragma unroll
            for (int m = 0; m < 4; ++m) { const int row = row0 + ai * HALF + m * 16; const float rs = row_rstd(ssq, row, fq);
                bf16_t* rowp = O + (size_t)row * ldc + col0;
#pragma unroll
                for (int bj = 0; bj < 2; ++bj) { const f32x4 v0 = acc[ai][bj][m][0] * rs, v1 = acc[ai][bj][m][1] * rs;
                    u32x4 w; w.x = cvtpk(v0[0], v0[1]); w.y = cvtpk(v0[2], v0[3]); w.z = cvtpk(v1[0], v1[1]); w.w = cvtpk(v1[2], v1[3]);
                    *(u32x4*)(rowp + bj * HALF) = w; } }
    }
};
struct EpiSwiGLU {
    static constexpr bool PERM = true;
    bf16_t* O; const float* ssq;
    __device__ __forceinline__ void operator()(const f32x4 (&acc)[2][2][4][2], const Unit& u, int wr, int wc, int fr, int fq) const {
        const int row0 = u.pm * BM + wr * 64 + fr, col0 = u.pn * HALF + wc * 32 + 8 * fq;
#pragma unroll
        for (int ai = 0; ai < 2; ++ai)
#pragma unroll
            for (int m = 0; m < 4; ++m) { const int row = row0 + ai * HALF + m * 16; const float rs = row_rstd(ssq, row, fq);
                float h[8];
#pragma unroll
                for (int n = 0; n < 2; ++n)
#pragma unroll
                    for (int j = 0; j < 4; ++j) { const float gt = acc[ai][0][m][n][j] * rs, up = acc[ai][1][m][n][j] * rs; h[n * 4 + j] = gt * up * __builtin_amdgcn_rcpf(1.0f + __expf(-gt)); }
                u32x4 w; w.x = cvtpk(h[0], h[1]); w.y = cvtpk(h[2], h[3]); w.z = cvtpk(h[4], h[5]); w.w = cvtpk(h[6], h[7]);
                *(u32x4*)(O + (size_t)row * FF + col0) = w; }
    }
};
struct EpiResid {
    static constexpr bool PERM = false;
    float* X; bf16_t* XB; float* ssq;
    __device__ __forceinline__ void operator()(const f32x4 (&acc)[2][2][4][2], const Unit& u, int wr, int wc, int fr, int fq) const {
        const int row0 = u.pm * BM + wr * 64 + fr, col0 = u.pn * BM + wc * 32 + 4 * fq;
#pragma unroll
        for (int ai = 0; ai < 2; ++ai)
#pragma unroll
            for (int m = 0; m < 4; ++m) { const int row = row0 + ai * HALF + m * 16; const size_t off = (size_t)row * DM + col0; float ss = 0.f;
#pragma unroll
                for (int bj = 0; bj < 2; ++bj)
#pragma unroll
                    for (int n = 0; n < 2; ++n) { const size_t o = off + bj * HALF + n * 16; const f32x4 xv = *(const f32x4*)(X + o) + acc[ai][bj][m][n];
                        *(f32x4*)(X + o) = xv; u32x2 w; w.x = cvtpk(xv[0], xv[1]); w.y = cvtpk(xv[2], xv[3]); *(u32x2*)(XB + o) = w;
                        ss += (xv[0] * xv[0] + xv[1] * xv[1]) + (xv[2] * xv[2] + xv[3] * xv[3]); }
                ss = xor32_sum(xor16_sum(ss));
                if (fq == 0) ssq[(size_t)row * 32 + u.pn * 4 + wc] = ss; }
    }
};
template <int MODE> struct EpiLora {
    static constexpr bool PERM = false;
    float* O; const float* bias;
    __device__ __forceinline__ void operator()(const f32x4 (&acc)[2][2][4][2], const Unit& u, int wr, int wc, int fr, int fq) const {
        const int row0 = u.pm * BM + wr * 64 + fr, col0 = u.pn * BM + wc * 32 + 4 * fq;
#pragma unroll
        for (int bj = 0; bj < 2; ++bj)
#pragma unroll
            for (int n = 0; n < 2; ++n) { const int col = col0 + bj * HALF + n * 16;
                f32x4 bv = (f32x4){0.f, 0.f, 0.f, 0.f}; if (MODE != 2) bv = *(const f32x4*)(bias + col);
#pragma unroll
                for (int ai = 0; ai < 2; ++ai)
#pragma unroll
                    for (int m = 0; m < 4; ++m) { const int row = row0 + ai * HALF + m * 16; f32x4 v = acc[ai][bj][m][n] + bv;
                        if (MODE == 0) {
#pragma unroll
                            for (int j = 0; j < 4; ++j) v[j] = __expf(-0.60653065971f * sigmoidf_(v[j]));
                        } else if (MODE == 1) {
#pragma unroll
                            for (int j = 0; j < 4; ++j) v[j] = sigmoidf_(v[j]);
                        }
                        if (MODE == 2) { u32x2 w2; w2.x = cvtpk(v[0], v[1]); w2.y = cvtpk(v[2], v[3]); *(u32x2*)((bf16_t*)O + (size_t)row * 1024 + col) = w2; }
                        else *(f32x4*)(O + (size_t)row * 1024 + col) = v; } }
    }
};
}

template <int MAP>
__device__ __forceinline__ void transpose_item(const float* W, int K, int N, bf16_t* WT, const float* gk, LAS float* scr, int item, int lane) {
    const int nblk = N / 32, kb = item / nblk, nb = item % nblk, k0 = 64 * kb, n0 = 32 * nb;
    float v[32];
    const float* wp = W + (size_t)(k0 + (lane >> 5)) * N + n0 + (lane & 31);
#pragma unroll
    for (int i = 0; i < 32; ++i) v[i] = __builtin_nontemporal_load(wp + (size_t)(2 * i) * N);
    const int c = lane & 7;
    f32x4 g0 = (f32x4){1.f, 1.f, 1.f, 1.f}, g1 = g0;
    if (gk) { g0 = *(const f32x4*)(gk + k0 + 8 * c); g1 = *(const f32x4*)(gk + k0 + 8 * c + 4); }
#pragma unroll
    for (int i = 0; i < 32; ++i) scr[(2 * i + (lane >> 5)) * 33 + (lane & 31)] = v[i];
    asm volatile("s_waitcnt lgkmcnt(0)" ::: "memory");
#pragma unroll
    for (int j = 0; j < 4; ++j) { const int n = n0 + (lane >> 3) + 8 * j; const LAS float* s = scr + (8 * c) * 33 + (n - n0);
        float sc = 1.f; int drow = n;
        if (MAP == 0) { if (n < 512 || (n >= 1536 && n < 2048)) sc = QSC; }
        if (MAP == 1) { const int hn = n < FF ? n : n - FF; drow = (hn >> 7) * 256 + (n < FF ? 0 : 128) + (hn & 127); }
        const f32x4 h0 = g0 * sc, h1 = g1 * sc;
        u32x4 o; o.x = cvtpk(s[0 * 33] * h0[0], s[1 * 33] * h0[1]); o.y = cvtpk(s[2 * 33] * h0[2], s[3 * 33] * h0[3]); o.z = cvtpk(s[4 * 33] * h1[0], s[5 * 33] * h1[1]); o.w = cvtpk(s[6 * 33] * h1[2], s[7 * 33] * h1[3]);
        *(u32x4*)(WT + (size_t)drow * K + k0 + 8 * c) = o; }
    asm volatile("s_waitcnt lgkmcnt(0)" ::: "memory");
}

constexpr int I_IN = (DM / 64) * (INC / 32), I_OUT = (DM / 64) * (DM / 32), I_GU = (DM / 64) * (GU / 32), I_DN = (FF / 64) * (DM / 32);
constexpr int CONV_ITEMS = I_IN + I_OUT + I_GU + I_DN;
__device__ __forceinline__ void convert_item(KP p, int l, int r, LAS float* scr, int lane) {
    unsigned char* wb = p->ws + WS_W + (size_t)l * LW_STRIDE;
    if (r < I_IN) { transpose_item<0>(p->in[2] + (size_t)l * DM * INC, DM, INC, (bf16_t*)(wb + LW_WIN), p->in[1] + l * DM, scr, r, lane); return; } r -= I_IN;
    if (r < I_OUT) { transpose_item<2>(p->in[17] + (size_t)l * DM * DM, DM, DM, (bf16_t*)(wb + LW_WOUT), nullptr, scr, r, lane); return; } r -= I_OUT;
    if (r < I_GU) { transpose_item<1>(p->in[19] + (size_t)l * DM * GU, DM, GU, (bf16_t*)(wb + LW_WGU), p->in[18] + l * DM, scr, r, lane); return; } r -= I_GU;
    transpose_item<2>(p->in[20] + (size_t)l * FF * DM, FF, DM, (bf16_t*)(wb + LW_WDN), nullptr, scr, r, lane);
}

__device__ __forceinline__ void phase0(KP p, LAS unsigned char* lds, int gw, int NGW, int wave, int lane) {
    LAS float* scr = (LAS float*)(lds + wave * 16384);
    for (int it = gw; it < CONV_ITEMS; it += NGW) convert_item(p, 0, it, scr, lane);
    const int gt = gw * 64 + lane, NGT = NGW * 64;
    for (int l = 0; l < NL; ++l) {
        unsigned char* wb = p->ws + WS_W + (size_t)l * LW_STRIDE;
        bf16_t* w2t = (bf16_t*)(wb + LW_W2T); bf16_t* a2t = (bf16_t*)(wb + LW_A2T); bf16_t* g2t = (bf16_t*)(wb + LW_G2T);
        const float* w2 = p->in[8] + (size_t)l * 96 * 1024; const float* a2 = p->in[10] + (size_t)l * 96 * 1024; const float* g2 = p->in[11] + (size_t)l * 256 * 1024;
        for (int i = gt; i < 1024 * 128; i += NGT) { const int n = i >> 7, k = i & 127;
            w2t[i] = (bf16_t)(cvtpk(k < 96 ? w2[k * 1024 + n] : 0.f, 0.f) & 0xffff); a2t[i] = (bf16_t)(cvtpk(k < 96 ? a2[k * 1024 + n] : 0.f, 0.f) & 0xffff); }
        for (int i = gt; i < 1024 * 256; i += NGT) { const int n = i >> 8, k = i & 255; g2t[i] = (bf16_t)(cvtpk(g2[k * 1024 + n], 0.f) & 0xffff); }
        unsigned* padz = (unsigned*)(wb + LW_WIN + (size_t)INC * DM * 2);
        for (int i = gt; i < (INCP - INC) * DM / 2; i += NGT) padz[i] = 0u;
    }
    const float* x = p->in[0]; float* X = p->out; bf16_t* XB = (bf16_t*)(p->ws + WS_XB); float* ssqA = (float*)(p->ws + WS_SSQA);
    for (int m = gw; m < M; m += NGW) { float ss = 0.f;
#pragma unroll
        for (int j = 0; j < 8; ++j) { const size_t o = (size_t)m * DM + j * 256 + lane * 4; const f32x4 v = *(const f32x4*)(x + o); *(f32x4*)(X + o) = v;
            u32x2 w; w.x = cvtpk(v[0], v[1]); w.y = cvtpk(v[2], v[3]); *(u32x2*)(XB + o) = w; ss += (v[0] * v[0] + v[1] * v[1]) + (v[2] * v[2] + v[3] * v[3]); }
        ss = wave_sum(ss); if (lane < 32) ssqA[(size_t)m * 32 + lane] = lane == 0 ? ss : 0.f; }
}

__device__ __forceinline__ void phase_prep1(KP p, int l, LAS unsigned char* lds, int gw, int NGW, int wave, int lane) {
    const bf16_t* PROJ = (const bf16_t*)(p->ws + WS_PROJ);
    LAS unsigned short* tile = (LAS unsigned short*)(lds + wave * 8448);
    bf16_t* VAT = (bf16_t*)(p->ws + WS_VAT); bf16_t* VBT = (bf16_t*)(p->ws + WS_VBT);
    for (int it = gw; it < 128 * 10; it += NGW) {
        const int tb = it / 10, g = it % 10, t0 = tb * 64; const int cbase = g < 8 ? 1024 + 64 * g : 2176 + 64 * (g - 8);
        bf16_t* dst = g < 8 ? VAT + (size_t)(64 * g) * M : VBT + (size_t)(64 * (g - 8)) * M;
#pragma unroll
        for (int i = 0; i < 8; ++i) { const int row = i * 8 + (lane >> 3), ch = lane & 7; const u32x4 v = *(const u32x4*)(PROJ + (size_t)(t0 + row) * INCP + cbase + 8 * ch);
            LAS unsigned* d = (LAS unsigned*)(tile + row * 66 + 8 * ch); d[0] = v.x; d[1] = v.y; d[2] = v.z; d[3] = v.w; }
        asm volatile("s_waitcnt lgkmcnt(0)" ::: "memory");
#pragma unroll
        for (int i = 0; i < 8; ++i) { const int c = i * 8 + (lane >> 3), tch = lane & 7, j = tch >> 1, hi = tch & 1; unsigned short v[8];
#pragma unroll
            for (int s = 0; s < 8; ++s) v[s] = tile[(16 * j + (s & 3) + 8 * (s >> 2) + 4 * hi) * 66 + c];
            u32x4 o; o.x = v[0] | ((unsigned)v[1] << 16); o.y = v[2] | ((unsigned)v[3] << 16); o.z = v[4] | ((unsigned)v[5] << 16); o.w = v[6] | ((unsigned)v[7] << 16);
            *(u32x4*)(dst + (size_t)c * M + t0 + 16 * j + 8 * hi) = o; }
        asm volatile("s_waitcnt lgkmcnt(0)" ::: "memory");
    }
    const float* mu = p->in[6] + (size_t)l * RWC;
    bf16_t* AW = (bf16_t*)(p->ws + WS_AW); bf16_t* AA = (bf16_t*)(p->ws + WS_AA); bf16_t* AG = (bf16_t*)(p->ws + WS_AG);
    float knmax = 0.f;
    for (int t = gw; t < M; t += NGW) {
        const bf16_t* cur = PROJ + (size_t)t * INCP + RW0;
        {   const u32x4 kv = *(const u32x4*)(PROJ + (size_t)t * INCP + 512 + 8 * lane);
            float a0 = bflo(kv.x), a1 = bfhi(kv.x), a2 = bflo(kv.y), a3 = bfhi(kv.y), a4 = bflo(kv.z), a5 = bfhi(kv.z), a6 = bflo(kv.w), a7 = bfhi(kv.w);
            float ss = (a0 * a0 + a1 * a1) + (a2 * a2 + a3 * a3) + (a4 * a4 + a5 * a5) + (a6 * a6 + a7 * a7);
            ss += dppm<0xB1>(ss); ss += dppm<0x4E>(ss); ss += dppm<0x141>(ss); knmax = fmaxf(knmax, ss); }
        if (lane < 56) { const int j0 = 3072 + 8 * lane;
            const u32x4 c4 = *(const u32x4*)(cur + j0); u32x4 p4 = (u32x4){0u, 0u, 0u, 0u}; if (t > 0) p4 = *(const u32x4*)(cur - INCP + j0);
            const f32x4 m0 = *(const f32x4*)(mu + j0), m1 = *(const f32x4*)(mu + j0 + 4);
            float f[8]; const unsigned cw[4] = {c4.x, c4.y, c4.z, c4.w}, pw[4] = {p4.x, p4.y, p4.z, p4.w};
#pragma unroll
            for (int q = 0; q < 4; ++q) { const float c0 = bflo(cw[q]), c1 = bfhi(cw[q]), p0 = bflo(pw[q]), p1 = bfhi(pw[q]);
                const float mu0 = q < 2 ? m0[2 * q] : m1[2 * q - 4], mu1 = q < 2 ? m0[2 * q + 1] : m1[2 * q - 3];
                f[2 * q] = c0 + (p0 - c0) * mu0; f[2 * q + 1] = c1 + (p1 - c1) * mu1; }
            bf16_t* dstp;
            if (j0 < 3168) { dstp = AW + (size_t)t * 128 + (j0 - 3072);
#pragma unroll
                for (int q = 0; q < 8; ++q) f[q] = tanhf(f[q]); }
            else if (j0 < 3264) { dstp = AA + (size_t)t * 128 + (j0 - 3168); }
            else { dstp = AG + (size_t)t * 256 + (j0 - 3264);
#pragma unroll
                for (int q = 0; q < 8; ++q) f[q] = sigmoidf_(f[q]); }
            u32x4 o; o.x = cvtpk(f[0], f[1]); o.y = cvtpk(f[2], f[3]); o.z = cvtpk(f[4], f[5]); o.w = cvtpk(f[6], f[7]); *(u32x4*)dstp = o; }
        else { const int e = lane - 56; if (e < 4) *(u32x4*)(AW + (size_t)t * 128 + 96 + 8 * e) = (u32x4){0u, 0u, 0u, 0u}; else *(u32x4*)(AA + (size_t)t * 128 + 96 + 8 * (e - 4)) = (u32x4){0u, 0u, 0u, 0u}; }
    }
    {   LAS float* kr = (LAS float*)(lds + 8 * 8448);
        if ((lane & 7) == 0) kr[wave * 8 + (lane >> 3)] = knmax;
        __syncthreads();
        if (wave == 0 && lane < 8) { float m = kr[lane];
#pragma unroll
            for (int w2 = 1; w2 < 8; ++w2) m = fmaxf(m, kr[w2 * 8 + lane]);
            ((float*)(p->ws + WS_KNP))[(size_t)(gw >> 3) * 8 + lane] = m; }
        __syncthreads(); }
}

__device__ __forceinline__ void phase_prep2(KP p, int l, int gw, int NGW, int lane) {
    const float* KR = (const float*)(p->ws + WS_KR); const float* A = (const float*)(p->ws + WS_A);
    float* KF = (float*)(p->ws + WS_KF); float* AN = (float*)(p->ws + WS_AN); float* BB = (float*)(p->ws + WS_BB);
    const float* k_k = p->in[12] + l * 1024; const float* k_a = p->in[13] + l * 1024;
    const int c0 = 16 * lane;
    for (int t = gw; t < M; t += NGW) { const size_t o = (size_t)t * 1024 + c0; float n2 = 0.f; f32x4 kkv[4], kr[4], av[4];
#pragma unroll
        for (int q = 0; q < 4; ++q) { kr[q] = *(const f32x4*)(KR + o + 4 * q); av[q] = *(const f32x4*)(A + o + 4 * q); kkv[q] = kr[q] * *(const f32x4*)(k_k + c0 + 4 * q);
            n2 += (kkv[q][0] * kkv[q][0] + kkv[q][1] * kkv[q][1]) + (kkv[q][2] * kkv[q][2] + kkv[q][3] * kkv[q][3]); }
        n2 = quad_sum(n2); const float inv = 1.0f / fmaxf(sqrtf(n2), 1e-12f);
#pragma unroll
        for (int q = 0; q < 4; ++q) { const f32x4 kk = kkv[q] * inv; const f32x4 ka = *(const f32x4*)(k_a + c0 + 4 * q);
            *(f32x4*)(KF + o + 4 * q) = kr[q] * (1.0f + (av[q] - 1.0f) * ka); *(f32x4*)(AN + o + 4 * q) = -kk; *(f32x4*)(BB + o + 4 * q) = kk * av[q]; }
    }
}

template <int MODE>
__device__ __forceinline__ void scan_task(KP p, int l, LAS unsigned char* wl, int c, int h, int lane) {
    constexpr int NPV = MODE == 0 ? 1 : (MODE == 1 ? 2 : 3);
    constexpr int SB = 4;
    LAS float* vec = (LAS float*)wl;
    LAS float* ybuf = (LAS float*)(wl + 7 * SB * 256);
    const float* DECp = (const float*)(p->ws + WS_DEC); const float* Ap = (const float*)(p->ws + WS_A); const bf16_t* PROJ = (const bf16_t*)(p->ws + WS_PROJ);
    const int rb = lane >> 2, cb = lane & 3, t0 = c * CL;
    f32x2 s[4][8];
    if (MODE == 0) {
#pragma unroll
        for (int r = 0; r < 4; ++r)
#pragma unroll
            for (int q = 0; q < 8; ++q) { s[r][q].x = (4 * rb + r == 16 * cb + 2 * q) ? 1.f : 0.f; s[r][q].y = (4 * rb + r == 16 * cb + 2 * q + 1) ? 1.f : 0.f; }
    } else if (MODE == 1) {
#pragma unroll
        for (int r = 0; r < 4; ++r)
#pragma unroll
            for (int q = 0; q < 8; ++q) s[r][q] = (f32x2){0.f, 0.f};
    } else {
        const float* SI = (const float*)(p->ws + WS_SI) + ((size_t)(h * NCH + c)) * 4096;
#pragma unroll
        for (int x = 0; x < 16; ++x) { const f32x4 v = *(const f32x4*)(SI + (16 * cb + x) * 64 + 4 * rb);
#pragma unroll
            for (int r = 0; r < 4; ++r) { if (x & 1) s[r][x >> 1].y = v[r]; else s[r][x >> 1].x = v[r]; } }
    }
    const int lst = lane >> 4, lq = lane & 15;
    const f32x4 kk4 = *(const f32x4*)(p->in[12] + l * 1024 + 64 * h + 4 * lq), ka4 = *(const f32x4*)(p->in[13] + l * 1024 + 64 * h + 4 * lq);
    f32x4 lnw4 = (f32x4){0.f, 0.f, 0.f, 0.f}, lnb4 = lnw4, rk4 = lnw4;
    if (MODE == 2) { lnw4 = *(const f32x4*)(p->in[15] + l * 1024 + 64 * h + 4 * lq); lnb4 = *(const f32x4*)(p->in[16] + l * 1024 + 64 * h + 4 * lq); rk4 = *(const f32x4*)(p->in[14] + l * 1024 + 64 * h + 4 * lq); }
    const size_t goff = (size_t)(t0 + lst) * 1024 + 64 * h + 4 * lq;
    const int pvo[3] = {1024, 2048, 0};
    f32x4 mu4[NPV];
#pragma unroll
    for (int v = 0; v < NPV; ++v) mu4[v] = *(const f32x4*)(p->in[6] + (size_t)l * RWC + pvo[v] + 64 * h + 4 * lq);
    const bf16_t* pj = PROJ + (size_t)(t0 + lst) * INCP + RW0 + 64 * h + 4 * lq;
    const float* Gp = (const float*)(p->ws + WS_G);
    struct Pre { f32x4 dec, a; u32x2 g; u32x2 cur[NPV], prv[NPV]; };
    Pre pA, pB;
#define SCAN_LOAD(P_, SBI) do { if ((SBI) < CL / SB) { const size_t ro = (size_t)(SB * (SBI)); P_.dec = *(const f32x4*)(DECp + goff + ro * 1024); P_.a = *(const f32x4*)(Ap + goff + ro * 1024); \
        if constexpr (MODE == 2) P_.g = *(const u32x2*)((const bf16_t*)Gp + goff + ro * 1024); \
        const bool first = (t0 + (int)ro + lst) == 0; \
        _Pragma("unroll") for (int v = 0; v < NPV; ++v) { P_.cur[v] = *(const u32x2*)(pj + ro * INCP + pvo[v]); P_.prv[v] = first ? (u32x2){0u, 0u} : *(const u32x2*)(pj + ro * INCP + pvo[v] - INCP); } } } while (0)
#define SCAN_SHIFT(P_, V) ({ const f32x4 c_ = (f32x4){bflo(P_.cur[V].x), bfhi(P_.cur[V].x), bflo(P_.cur[V].y), bfhi(P_.cur[V].y)}, q_ = (f32x4){bflo(P_.prv[V].x), bfhi(P_.prv[V].x), bflo(P_.prv[V].y), bfhi(P_.prv[V].y)}; c_ + (q_ - c_) * mu4[V]; })
#define SCAN_STAGE(P_) do { const f32x4 kr = SCAN_SHIFT(P_, 0), av = P_.a; const f32x4 kkv = kr * kk4; \
        float n2 = (kkv[0] * kkv[0] + kkv[1] * kkv[1]) + (kkv[2] * kkv[2] + kkv[3] * kkv[3]); n2 = row16_sum(n2); \
        const float inv = __builtin_amdgcn_rsqf(fmaxf(n2, 1e-24f)); const f32x4 kkn = kkv * inv; \
        LAS float* vw = vec + lst * 64 + 4 * lq; \
        *(LAS f32x4*)(vw + 0 * SB * 64) = P_.dec; *(LAS f32x4*)(vw + 1 * SB * 64) = -kkn; *(LAS f32x4*)(vw + 2 * SB * 64) = kkn * av; \
        if constexpr (MODE != 0) { *(LAS f32x4*)(vw + 3 * SB * 64) = kr * (1.0f + (av - 1.0f) * ka4); *(LAS f32x4*)(vw + 4 * SB * 64) = SCAN_SHIFT(P_, 1); } \
        if constexpr (MODE == 2) { *(LAS f32x4*)(vw + 5 * SB * 64) = SCAN_SHIFT(P_, 2); *(LAS f32x4*)(vw + 6 * SB * 64) = (f32x4){bflo(P_.g.x), bfhi(P_.g.x), bflo(P_.g.y), bfhi(P_.g.y)}; } } while (0)
    SCAN_LOAD(pA, 0); SCAN_LOAD(pB, 1);
    float gam = 1.0f;
    LAS float* gbuf = ybuf + SB * 64;
    for (int sb = 0; sb < CL / SB; ++sb) {
        if (sb & 1) { SCAN_STAGE(pB); SCAN_LOAD(pB, sb + 2); } else { SCAN_STAGE(pA); SCAN_LOAD(pA, sb + 2); }
#pragma unroll
        for (int st = 0; st < SB; ++st) { const float w_ = vec[(0 * SB + st) * 64 + lane]; const float gprev = gam; gam *= w_; const float ginv = __builtin_amdgcn_rcpf(gam);
            vec[(1 * SB + st) * 64 + lane] *= gprev; vec[(2 * SB + st) * 64 + lane] *= ginv;
            if (MODE != 0) vec[(3 * SB + st) * 64 + lane] *= ginv;
            if (MODE == 2) vec[(5 * SB + st) * 64 + lane] *= gam; }
#pragma unroll 1
        for (int st = 0; st < SB; ++st) {
            const LAS float* vb = vec + st * 64 + 16 * cb;
            float sa[4];
            {   f32x2 a2[8];
#pragma unroll
                for (int q = 0; q < 4; ++q) { const f32x4 y = *(const LAS f32x4*)(vb + 1 * SB * 64 + 4 * q); a2[2 * q] = (f32x2){y[0], y[1]}; a2[2 * q + 1] = (f32x2){y[2], y[3]}; }
                f32x2 c0[4];
#pragma unroll
                for (int r = 0; r < 4; ++r) c0[r] = s[r][0] * a2[0];
#pragma unroll
                for (int q = 1; q < 8; ++q)
#pragma unroll
                    for (int r = 0; r < 4; ++r) c0[r] = s[r][q] * a2[q] + c0[r];
                float e[4];
#pragma unroll
                for (int r = 0; r < 4; ++r) e[r] = c0[r].x + c0[r].y;
#pragma unroll
                for (int r = 0; r < 4; ++r) e[r] += dpp_xor1(e[r]);
#pragma unroll
                for (int r = 0; r < 4; ++r) sa[r] = e[r] + dpp_xor2(e[r]); }
            f32x4 vv = (f32x4){0.f, 0.f, 0.f, 0.f};
            if (MODE != 0) vv = *(const LAS f32x4*)(vec + (4 * SB + st) * 64 + 4 * rb);
#pragma unroll
            for (int q = 0; q < 4; ++q) { const f32x4 b4 = *(const LAS f32x4*)(vb + 2 * SB * 64 + 4 * q);
                const f32x2 b0 = (f32x2){b4[0], b4[1]}, b1 = (f32x2){b4[2], b4[3]};
#pragma unroll
                for (int r = 0; r < 4; ++r) { s[r][2 * q] = b0 * sa[r] + s[r][2 * q]; s[r][2 * q + 1] = b1 * sa[r] + s[r][2 * q + 1]; }
                if (MODE != 0) { const f32x4 k4 = *(const LAS f32x4*)(vb + 3 * SB * 64 + 4 * q); const f32x2 k0 = (f32x2){k4[0], k4[1]}, k1 = (f32x2){k4[2], k4[3]};
#pragma unroll
                    for (int r = 0; r < 4; ++r) { s[r][2 * q] = k0 * vv[r] + s[r][2 * q]; s[r][2 * q + 1] = k1 * vv[r] + s[r][2 * q + 1]; } } }
            if (MODE == 2) {
                f32x2 r2[8];
#pragma unroll
                for (int q = 0; q < 4; ++q) { const f32x4 x = *(const LAS f32x4*)(vb + 5 * SB * 64 + 4 * q); r2[2 * q] = (f32x2){x[0], x[1]}; r2[2 * q + 1] = (f32x2){x[2], x[3]}; }
                f32x4 yv;
                f32x2 c0[4];
#pragma unroll
                for (int r = 0; r < 4; ++r) c0[r] = s[r][0] * r2[0];
#pragma unroll
                for (int q = 1; q < 8; ++q)
#pragma unroll
                    for (int r = 0; r < 4; ++r) c0[r] = s[r][q] * r2[q] + c0[r];
                float e[4];
#pragma unroll
                for (int r = 0; r < 4; ++r) e[r] = c0[r].x + c0[r].y;
#pragma unroll
                for (int r = 0; r < 4; ++r) e[r] += dpp_xor1(e[r]);
#pragma unroll
                for (int r = 0; r < 4; ++r) yv[r] = e[r] + dpp_xor2(e[r]);
                if (cb == 0) *(LAS f32x4*)(ybuf + st * 64 + 4 * rb) = yv;
            }
        }
        if ((sb & 15) == 15) {
            gbuf[lane] = gam; gam = 1.0f;
#pragma unroll
            for (int q = 0; q < 4; ++q) { const f32x4 g4 = *(const LAS f32x4*)(gbuf + 16 * cb + 4 * q); const f32x2 g0 = (f32x2){g4[0], g4[1]}, g1 = (f32x2){g4[2], g4[3]};
#pragma unroll
                for (int r = 0; r < 4; ++r) { s[r][2 * q] = s[r][2 * q] * g0; s[r][2 * q + 1] = s[r][2 * q + 1] * g1; } } }
        if (MODE == 2) {
            bf16_t* MIX = (bf16_t*)(p->ws + WS_MIX);
            const int t = t0 + SB * sb + lst; const LAS float* vr = vec + lst * 64 + 4 * lq;
            const f32x4 y = *(const LAS f32x4*)(ybuf + lst * 64 + 4 * lq), rr = *(const LAS f32x4*)(vr + 5 * SB * 64), kk = *(const LAS f32x4*)(vr + 3 * SB * 64),
                        vv = *(const LAS f32x4*)(vr + 4 * SB * 64), g = *(const LAS f32x4*)(vr + 6 * SB * 64);
            const float mean = row16_sum((y[0] + y[1]) + (y[2] + y[3])) * (1.0f / 64.0f);
            const f32x4 d = y - mean;
            const float var = row16_sum((d[0] * d[0] + d[1] * d[1]) + (d[2] * d[2] + d[3] * d[3])) * (1.0f / 64.0f);
            const f32x4 rkk = rr * kk * rk4;
            const float bon = row16_sum((rkk[0] + rkk[1]) + (rkk[2] + rkk[3]));
            const f32x4 o = (d * __builtin_amdgcn_rsqf(var + 64e-5f) * lnw4 + lnb4 + vv * bon) * g;
            u32x2 wv; wv.x = cvtpk(o[0], o[1]); wv.y = cvtpk(o[2], o[3]);
            *(u32x2*)(MIX + (size_t)t * DM + 1024 + 64 * h + 4 * lq) = wv;
        }
    }
    if (MODE == 0) { float* dst = (float*)(p->ws + WS_PB) + ((size_t)(h * NCH + c)) * 4096;
#pragma unroll
        for (int r = 0; r < 4; ++r)
#pragma unroll
            for (int q = 0; q < 4; ++q) *(f32x4*)(dst + (4 * rb + r) * 64 + 16 * cb + 4 * q) = (f32x4){s[r][2 * q].x, s[r][2 * q].y, s[r][2 * q + 1].x, s[r][2 * q + 1].y}; }
    if (MODE == 1) { float* dst = (float*)(p->ws + WS_UB) + ((size_t)(h * NCH + c)) * 4096;
#pragma unroll
        for (int x = 0; x < 16; ++x) { f32x4 v;
#pragma unroll
            for (int r = 0; r < 4; ++r) v[r] = (x & 1) ? s[r][x >> 1].y : s[r][x >> 1].x;
            *(f32x4*)(dst + (16 * cb + x) * 64 + 4 * rb) = v; } }
}

#undef SCAN_LOAD
#undef SCAN_SHIFT
#undef SCAN_STAGE
__device__ __forceinline__ void s2_head(KP p, LAS unsigned char* lds, int h, int ti, const int tid) {
    const float* PB = (const float*)(p->ws + WS_PB) + (size_t)h * NCH * 4096; const float* UT = (const float*)(p->ws + WS_UB) + (size_t)h * NCH * 4096;
    float* SI = (float*)(p->ws + WS_SI) + (size_t)h * NCH * 4096;
    const int lane = tid & 63, w = __builtin_amdgcn_readfirstlane(tid >> 6), n = lane & 31, lh = lane >> 5, to = (w >> 1) & 1, tj = w & 1;
    static_assert((NCH - 1) % 3 == 0, "three rotating prefetch buffers");
    if (w >= 4) {
        for (int c = 0; c < NCH - 1; ++c) __syncthreads();
    } else {
        f32x16 breg, ua, ub, uc2; float pa[16], pb[16], pc2[16];
#pragma unroll
        for (int r = 0; r < 16; ++r) breg[r] = 0.f;
        const int offu = (32 * to + 4 * lh) * 64 + 32 * ti + n, offp = (32 * tj + 4 * lh) * 64 + 32 * to + n, offs = (32 * tj + 4 * lh) * 64 + 32 * ti + n;
#define S2_LOAD(CH, U_, P_) do { const int ch_ = (CH) < NCH - 1 ? (CH) : NCH - 2; const float* pb_ = PB + (size_t)ch_ * 4096 + offp; const float* ub_ = UT + (size_t)ch_ * 4096 + offu; \
        _Pragma("unroll") for (int r = 0; r < 16; ++r) { const int cr = ((r & 3) + 8 * (r >> 2)) * 64; U_[r] = tj == 0 ? ub_[cr] : 0.f; P_[r] = pb_[cr]; } } while (0)
#define S2_STEP(C, UC_, PC_, UN_, PN_) do { \
        if (to == 0) { float* si = SI + (size_t)(C) * 4096 + offs; \
            _Pragma("unroll") for (int r = 0; r < 16; ++r) si[((r & 3) + 8 * (r >> 2)) * 64] = breg[r]; } \
        f32x16 acc = UC_; \
        _Pragma("unroll") for (int r = 0; r < 16; ++r) acc = __builtin_amdgcn_mfma_f32_32x32x2f32(PC_[r], breg[r], acc, 0, 0, 0); \
        LAS f32x4* ex = (LAS f32x4*)(lds + ((C) & 1) * 16384); \
        _Pragma("unroll") for (int q = 0; q < 4; ++q) ex[(w * 4 + q) * 64 + lane] = (f32x4){acc[4 * q], acc[4 * q + 1], acc[4 * q + 2], acc[4 * q + 3]}; \
        __syncthreads(); \
        S2_LOAD((C) + 2, UN_, PN_); \
        _Pragma("unroll") for (int q = 0; q < 4; ++q) { const f32x4 v0 = ex[((tj * 2) * 4 + q) * 64 + lane], v1 = ex[((tj * 2 + 1) * 4 + q) * 64 + lane]; \
            breg[4 * q] = v0[0] + v1[0]; breg[4 * q + 1] = v0[1] + v1[1]; breg[4 * q + 2] = v0[2] + v1[2]; breg[4 * q + 3] = v0[3] + v1[3]; } } while (0)
        S2_LOAD(0, ua, pa); S2_LOAD(1, ub, pb);
#pragma unroll 1
        for (int c = 0; c < NCH - 1; c += 3) {
            S2_STEP(c, ua, pa, uc2, pc2);
            S2_STEP(c + 1, ub, pb, ua, pa);
            S2_STEP(c + 2, uc2, pc2, ub, pb);
        }
        if (to == 0) { float* si = SI + (size_t)(NCH - 1) * 4096 + offs;
#pragma unroll
            for (int r = 0; r < 16; ++r) si[((r & 3) + 8 * (r >> 2)) * 64] = breg[r]; }
#undef S2_LOAD
#undef S2_STEP
    }
    __syncthreads();
}

template <int DV, bool SWA>
__device__ __forceinline__ void attn_unit(LAS unsigned char* lds, const bf16_t* Q, const bf16_t* Kp, const bf16_t* VT, float slope2, int q0, float sink2,
                                          float* Of32, float* MLp, bf16_t* Obf, const int tid, int kt_lo, int kt_hi, float kn) {
    constexpr int KROW = 144, KTILE = 64 * KROW, VTILE = DV * KROW, BUF = KTILE + VTILE, NVL = DV / 64;
    const int lane = tid & 63, w = __builtin_amdgcn_readfirstlane(tid >> 6), r32 = lane & 31, hi = lane >> 5;
    const int qpos = q0 + 32 * w + r32;
    bf16x8 qf[4];
#pragma unroll
    for (int j = 0; j < 4; ++j) qf[j] = *(const bf16x8*)(Q + (size_t)qpos * INCP + 16 * j + 8 * hi);
    int kt0 = kt_lo, kt1 = kt_hi;
    if (!SWA) {
        float qq = 0.f, qk = 0.f;
#pragma unroll
        for (int j = 0; j < 4; ++j) { const bf16x8 kf = *(const bf16x8*)(Kp + (size_t)qpos * INCP + 16 * j + 8 * hi);
#pragma unroll
            for (int e = 0; e < 8; ++e) { const float qv = bf2f((unsigned short)qf[j][e]), kv = bf2f((unsigned short)kf[e]); qq += qv * qv; qk += qv * kv; } }
        qq = xor32_sum(qq); qk = xor32_sum(qk);
        const float dneed = (sqrtf(qq) * kn - qk + 45.0f) / slope2;
        float kneed = (float)qpos - dneed;
        kneed = fminf(kneed, dppm<0xB1>(kneed)); kneed = fminf(kneed, dppm<0x4E>(kneed)); kneed = fminf(kneed, dppm<0x141>(kneed)); kneed = fminf(kneed, dppm<0x140>(kneed));
        LAS float* red = (LAS float*)(lds + 2 * BUF);
        if ((lane & 15) == 0) red[w * 4 + (lane >> 4)] = kneed;
        __syncthreads();
        float km = red[0];
#pragma unroll
        for (int i = 1; i < 32; ++i) km = fminf(km, red[i]);
        const int ktw = km <= 0.f ? 0 : ((int)km >> 6);
        kt0 = ktw > kt_lo ? ktw : kt_lo;
    }
    const int qlo = q0 + 32 * w, qhi = qlo + 31;
    f32x16 o[DV / 32];
#pragma unroll
    for (int d = 0; d < DV / 32; ++d)
#pragma unroll
        for (int r = 0; r < 16; ++r) o[d][r] = 0.f;
    float mrun = 0.f, lsum = 0.f;
    const int krow = tid >> 3, kch = tid & 7;
    u32x4 kreg, vreg[NVL];
    if (kt0 <= kt1) {   const int k0 = 64 * kt0; kreg = *(const u32x4*)(Kp + (size_t)(k0 + krow) * INCP + 8 * kch);
#pragma unroll
        for (int i = 0; i < NVL; ++i) { const int idx = tid + 512 * i; vreg[i] = *(const u32x4*)(VT + (size_t)(idx >> 3) * M + k0 + 8 * (idx & 7)); } }
    for (int kt = kt0; kt <= kt1; ++kt) {
        LAS unsigned char* buf = lds + ((kt - kt0) & 1) * BUF;
        *(LAS u32x4*)(buf + krow * KROW + 16 * kch) = kreg;
#pragma unroll
        for (int i = 0; i < NVL; ++i) { const int idx = tid + 512 * i; *(LAS u32x4*)(buf + KTILE + (idx >> 3) * KROW + 16 * (idx & 7)) = vreg[i]; }
        __syncthreads();
        if (kt < kt1) { const int k0 = 64 * (kt + 1); kreg = *(const u32x4*)(Kp + (size_t)(k0 + krow) * INCP + 8 * kch);
#pragma unroll
            for (int i = 0; i < NVL; ++i) { const int idx = tid + 512 * i; vreg[i] = *(const u32x4*)(VT + (size_t)(idx >> 3) * M + k0 + 8 * (idx & 7)); } }
        const int k0 = 64 * kt;
        bool act = k0 <= qhi; if (SWA) act = act && (k0 + 63 >= qlo - 127);
        if (act) {
            f32x16 p0, p1;
            {   const float c0 = slope2 * (float)(k0 + 4 * hi - qpos) - mrun, c1 = c0 + 32.0f * slope2;
#pragma unroll
                for (int r = 0; r < 16; ++r) { const float cr = (float)((r & 3) + 8 * (r >> 2)); p0[r] = __builtin_fmaf(slope2, cr, c0); p1[r] = __builtin_fmaf(slope2, cr, c1); } }
#pragma unroll
            for (int j = 0; j < 4; ++j) { const bf16x8 a0 = *(const LAS bf16x8*)(buf + r32 * KROW + 32 * j + 16 * hi), a1 = *(const LAS bf16x8*)(buf + (r32 + 32) * KROW + 32 * j + 16 * hi);
                p0 = __builtin_amdgcn_mfma_f32_32x32x16_bf16(a0, qf[j], p0, 0, 0, 0); p1 = __builtin_amdgcn_mfma_f32_32x32x16_bf16(a1, qf[j], p1, 0, 0, 0); }
            bool need_mask = k0 + 63 > qlo; if (SWA) need_mask = need_mask || (qhi - k0 >= 128);
            if (need_mask) {
#pragma unroll
                for (int r = 0; r < 16; ++r) { const int kv = k0 + (r & 3) + 8 * (r >> 2) + 4 * hi; const int d0 = qpos - kv, d1 = d0 - 32;
                    bool ok0 = d0 >= 0, ok1 = d1 >= 0; if (SWA) { ok0 = ok0 && d0 < 128; ok1 = ok1 && d1 < 128; }
                    p0[r] = ok0 ? p0[r] : -1e30f; p1[r] = ok1 ? p1[r] : -1e30f; } }
            float mx = fmaxf(p0[0], p1[0]);
#pragma unroll
            for (int r = 1; r < 16; ++r) mx = fmaxf(mx, fmaxf(p0[r], p1[r]));
            mx = xor32_max(mx);
            if (__builtin_amdgcn_ballot_w64(mx > 8.0f) != 0ull) {
                const float d = fmaxf(mx, 0.f), f = __builtin_amdgcn_exp2f(-d); mrun += d; lsum *= f;
#pragma unroll
                for (int r = 0; r < 16; ++r) { p0[r] -= d; p1[r] -= d; }
#pragma unroll
                for (int dd = 0; dd < DV / 32; ++dd)
#pragma unroll
                    for (int r = 0; r < 16; ++r) o[dd][r] *= f; }
            float rs = 0.f;
#pragma unroll
            for (int r = 0; r < 16; ++r) { p0[r] = __builtin_amdgcn_exp2f(p0[r]); p1[r] = __builtin_amdgcn_exp2f(p1[r]); rs += p0[r] + p1[r]; }
            lsum += rs;
            u32x4 pw[4];
            pw[0] = (u32x4){cvtpk(p0[0], p0[1]), cvtpk(p0[2], p0[3]), cvtpk(p0[4], p0[5]), cvtpk(p0[6], p0[7])};
            pw[1] = (u32x4){cvtpk(p0[8], p0[9]), cvtpk(p0[10], p0[11]), cvtpk(p0[12], p0[13]), cvtpk(p0[14], p0[15])};
            pw[2] = (u32x4){cvtpk(p1[0], p1[1]), cvtpk(p1[2], p1[3]), cvtpk(p1[4], p1[5]), cvtpk(p1[6], p1[7])};
            pw[3] = (u32x4){cvtpk(p1[8], p1[9]), cvtpk(p1[10], p1[11]), cvtpk(p1[12], p1[13]), cvtpk(p1[14], p1[15])};
#pragma unroll
            for (int d = 0; d < DV / 32; ++d)
#pragma unroll
                for (int j = 0; j < 4; ++j) { const bf16x8 vf = *(const LAS bf16x8*)(buf + KTILE + (32 * d + r32) * KROW + 32 * j + 16 * hi);
                    o[d] = __builtin_amdgcn_mfma_f32_32x32x16_bf16(vf, __builtin_bit_cast(bf16x8, pw[j]), o[d], 0, 0, 0); }
        }
    }
    lsum = xor32_sum(lsum);
    if (SWA) { lsum += __builtin_amdgcn_exp2f(sink2 - mrun);
        const float inv = 1.0f / lsum; bf16_t* op = Obf + (size_t)qpos * DM;
#pragma unroll
        for (int d = 0; d < DV / 32; ++d)
#pragma unroll
            for (int g = 0; g < 4; ++g) { u32x2 wv; wv.x = cvtpk(o[d][4 * g] * inv, o[d][4 * g + 1] * inv); wv.y = cvtpk(o[d][4 * g + 2] * inv, o[d][4 * g + 3] * inv);
                *(u32x2*)(op + 32 * d + 8 * g + 4 * hi) = wv; }
    } else { float* op = Of32 + (size_t)qpos * 1024;
#pragma unroll
        for (int d = 0; d < DV / 32; ++d)
#pragma unroll
            for (int g = 0; g < 4; ++g) *(f32x4*)(op + 32 * d + 8 * g + 4 * hi) = (f32x4){o[d][4 * g], o[d][4 * g + 1], o[d][4 * g + 2], o[d][4 * g + 3]};
        if (hi == 0) *(f32x2*)(MLp + (size_t)qpos * 16) = (f32x2){mrun, lsum};
    }
    __syncthreads();
}

__device__ __forceinline__ void phase_diffcombine(KP p, int l, int gw, int NGW, int lane) {
    const float* lamv = p->in[3] + l * 256;
    const float lambda_init = 0.8f - 0.6f * expf(-0.3f * (float)l);
    const float s1 = wave_sum(lamv[lane] * lamv[64 + lane]), s2 = wave_sum(lamv[128 + lane] * lamv[192 + lane]);
    const float lam = expf(s1) - expf(s2) + lambda_init;
    const float* OD = (const float*)(p->ws + WS_OD); const float* ML = (const float*)(p->ws + WS_ML); bf16_t* MIX = (bf16_t*)(p->ws + WS_MIX);
    const int h = lane >> 4, d0 = (lane & 15) * 8;
    const f32x4 g0 = *(const f32x4*)(p->in[4] + l * 128 + d0), g1 = *(const f32x4*)(p->in[4] + l * 128 + d0 + 4);
    for (int t = gw; t < M; t += NGW) { const int nseg = ((t >> 8) + 8) >> 3;
        f32x4 oc[2][2];
#pragma unroll
        for (int c = 0; c < 2; ++c) {
            f32x2 ml[4]; float mm = -1e30f;
#pragma unroll
            for (int s = 0; s < 4; ++s) if (s < nseg) { ml[s] = *(const f32x2*)(ML + ((size_t)s * M + t) * 16 + h * 4 + c * 2); mm = fmaxf(mm, ml[s].x); }
            f32x4 a0 = (f32x4){0.f, 0.f, 0.f, 0.f}, a1 = a0; float L = 0.f;
#pragma unroll
            for (int s = 0; s < 4; ++s) if (s < nseg) { const float f = exp2f(ml[s].x - mm); L += ml[s].y * f;
                const float* b = OD + ((size_t)s * M + t) * 1024 + h * 256 + c * 128 + d0; a0 += *(const f32x4*)b * f; a1 += *(const f32x4*)(b + 4) * f; }
            const float inv = 1.0f / L; oc[c][0] = a0 * inv; oc[c][1] = a1 * inv; }
        const f32x4 o0 = oc[0][0] - oc[1][0] * lam, o1 = oc[0][1] - oc[1][1] * lam;
        float ss = (o0[0] * o0[0] + o0[1] * o0[1]) + (o0[2] * o0[2] + o0[3] * o0[3]) + (o1[0] * o1[0] + o1[1] * o1[1]) + (o1[2] * o1[2] + o1[3] * o1[3]);
        ss = row16_sum(ss);
        const float r = rsqrtf(ss * (1.0f / 128.0f) + EPS) * (1.0f - lambda_init);
        const f32x4 y0 = o0 * g0 * r, y1 = o1 * g1 * r;
        u32x4 wv; wv.x = cvtpk(y0[0], y0[1]); wv.y = cvtpk(y0[2], y0[3]); wv.z = cvtpk(y1[0], y1[1]); wv.w = cvtpk(y1[2], y1[3]);
        *(u32x4*)(MIX + (size_t)t * DM + h * 128 + d0) = wv; }
}

#define XB_TMO      128
#define XB_XCNT(j)  (256  + 64 * (j))
#define XB_XSUB(j)  (1280 + 64 * (j))
#define XB_XGEN(j)  (2304 + 64 * (j))
#define XB_TOP      3328
#define XB_TOPGEN   3392
#define XCD_BAR_WORDS 3456
#define XB_SPIN_CAP (1u << 22)
__device__ __forceinline__ unsigned xb_ld(unsigned* p)              { return __hip_atomic_load(p, __ATOMIC_RELAXED, __HIP_MEMORY_SCOPE_AGENT); }
__device__ __forceinline__ unsigned xb_add(unsigned* p, unsigned v) { return __hip_atomic_fetch_add(p, v, __ATOMIC_RELAXED, __HIP_MEMORY_SCOPE_AGENT); }
__device__ __forceinline__ unsigned xb_xcc_id() { return (unsigned)__builtin_amdgcn_s_getreg((3 << 11) | 20) & 0xFu; }
#define XB_SPIN(cond, bar) do { unsigned _sp = 0; while (cond) { __builtin_amdgcn_s_sleep(1); \
    if ((++_sp & 255u) == 0u) { if (xb_ld(&(bar)[XB_TMO])) break; if (_sp > XB_SPIN_CAP) { atomicAdd(&(bar)[XB_TMO], 1u); break; } } } } while (0)
__device__ __forceinline__ void xcd_barrier_complete(unsigned* bar, unsigned x, unsigned& nloc, unsigned& nx) {
    const unsigned G = gridDim.x;
    unsigned sum, cnt, mine, sp = 0u;
    for (;;) {
        sum = 0u; cnt = 0u; mine = 0u;
#pragma unroll
        for (unsigned j = 0; j < 16; ++j) { const unsigned c = xb_ld(&bar[XB_XCNT(j)]); sum += c; cnt += (c > 0u) ? 1u : 0u; mine = (j == x) ? c : mine; }
        if (sum == G) break;
        __builtin_amdgcn_s_sleep(1);
        if ((++sp & 255u) == 0u) { if (xb_ld(&bar[XB_TMO])) break; if (sp > XB_SPIN_CAP) { atomicAdd(&bar[XB_TMO], 1u); break; } }
    }
    nloc = mine > 0u ? mine : 1u; nx = cnt > 0u ? cnt : 1u;
}
__device__ __forceinline__ void xcd_barrier(unsigned* bar, volatile LAS unsigned* st, const int tid) {
    asm volatile("s_waitcnt vmcnt(0)" ::: "memory");
    __syncthreads();
    if (tid == 0) {
        const unsigned x = xb_xcc_id();
        __builtin_amdgcn_s_waitcnt(0);
        unsigned nloc = st[0], nx = st[1];
        if (nloc == 0u) { xcd_barrier_complete(bar, x, nloc, nx); st[0] = nloc; st[1] = nx; }
        const unsigned old = xb_add(&bar[XB_XSUB(x)], 1u);
        const unsigned gen = old / nloc;
        if (old + 1u == (gen + 1u) * nloc) {
            __builtin_amdgcn_fence(__ATOMIC_RELEASE, "agent");
            asm volatile("s_waitcnt vmcnt(0)" ::: "memory");
            const unsigned og = xb_add(&bar[XB_TOP], 1u);
            const unsigned tg = og / nx;
            if (og + 1u == (tg + 1u) * nx) xb_add(&bar[XB_TOPGEN], 1u);
            else XB_SPIN(xb_ld(&bar[XB_TOPGEN]) == tg, bar);
            __builtin_amdgcn_fence(__ATOMIC_ACQUIRE, "agent");
            xb_add(&bar[XB_XGEN(x)], 1u);
            asm volatile("s_waitcnt vmcnt(0)" ::: "memory");
        } else {
            XB_SPIN(xb_ld(&bar[XB_XGEN(x)]) == gen, bar);
            __builtin_amdgcn_fence(__ATOMIC_ACQUIRE, "agent");
            asm volatile("s_waitcnt vmcnt(0)" ::: "memory");
        }
    }
    __syncthreads();
}

#ifndef DUPBAR
#define DUPBAR 1
#endif
#define GSYNC() do { FRESH(); for (int rb_ = 0; rb_ < DUPBAR; ++rb_) xcd_barrier((unsigned*)(p->ws + WS_CTL) + 4096, (volatile LAS unsigned*)(lds + LDS_BYTES - 32), tid); } while (0)
#define PTRS() unsigned* ctl = (unsigned*)(p->ws + WS_CTL); bf16_t* XB = (bf16_t*)(p->ws + WS_XB); bf16_t* PROJ = (bf16_t*)(p->ws + WS_PROJ); bf16_t* MIX = (bf16_t*)(p->ws + WS_MIX); bf16_t* H = (bf16_t*)(p->ws + WS_H); \
    float* ssqA = (float*)(p->ws + WS_SSQA); float* ssqB = (float*)(p->ws + WS_SSQB); unsigned char* wb = p->ws + WS_W + (size_t)l * LW_STRIDE; (void)ctl; (void)XB; (void)PROJ; (void)MIX; (void)H; (void)ssqA; (void)ssqB; (void)wb
#define FRESH() KP p = fresh_params(); int G = gridDim.x, bx = blockIdx.x; asm volatile("" : "+s"(G), "+s"(bx)); const int NGW = G * 8; (void)NGW; const int tid = fresh_tid(wave0), lane = tid & 63, wave = __builtin_amdgcn_readfirstlane(tid >> 6), gw = bx * 8 + wave; (void)lane; (void)gw
template <int L> __device__ __forceinline__ void layer_body(LAS unsigned char* lds, const int wave0) {
    constexpr int l = L;

#ifndef DUP1
#define DUP1 1
#endif
        for (int rep = 0; rep < DUP1; ++rep) {   if (rep) GSYNC(); FRESH(); PTRS(); pg8::Gemm g{XB, (const bf16_t*)(wb + LW_WIN), M, INCP, DM}; pg8::StaticOrder S; S.init(M, INCP, G, bx);
            pg8::EpiProj E{PROJ, INCP, ssqA};
            pg8::gemm_phase<pg8::EpiProj, pg8::StaticOrder, true, true>(lds, g, S, E, tid); }
        GSYNC();
#ifndef DUP234
#define DUP234 1
#endif
        for (int rep = 0; rep < DUP234; ++rep) { if (rep) GSYNC(); FRESH(); phase_prep1(p, l, lds, gw, NGW, wave, lane); }
        GSYNC();
        {   FRESH(); PTRS(); pg8::Gemm g{(const bf16_t*)(p->ws + WS_AW), (const bf16_t*)(wb + LW_W2T), M, 1024, 128}; pg8::StaticOrder S; S.init(M, 1024, G, bx);
            pg8::EpiLora<0> E{(float*)(p->ws + WS_DEC), p->in[7] + l * 1024};
            pg8::gemm_phase<pg8::EpiLora<0>, pg8::StaticOrder, true, true>(lds, g, S, E, tid); }
        {   FRESH(); PTRS(); pg8::Gemm g{(const bf16_t*)(p->ws + WS_AA), (const bf16_t*)(wb + LW_A2T), M, 1024, 128}; pg8::StaticOrder S; S.init(M, 1024, G, (bx + 128) % G);
            pg8::EpiLora<1> E{(float*)(p->ws + WS_A), p->in[9] + l * 1024};
            pg8::gemm_phase<pg8::EpiLora<1>, pg8::StaticOrder, true, true>(lds, g, S, E, tid); }
        {   FRESH(); PTRS(); pg8::Gemm g{(const bf16_t*)(p->ws + WS_AG), (const bf16_t*)(wb + LW_G2T), M, 1024, 256}; pg8::StaticOrder S; S.init(M, 1024, G, (bx + 128) % G);
            pg8::EpiLora<2> E{(float*)(p->ws + WS_G), nullptr};
            pg8::gemm_phase<pg8::EpiLora<2>, pg8::StaticOrder, true, true>(lds, g, S, E, tid); }
        GSYNC();
        {   FRESH(); LAS unsigned char* wl = lds + wave * 14336;
#ifndef DUP57
#define DUP57 1
#endif
#ifndef DUP5
#define DUP5 1
#endif
            for (int rep = 0; rep < DUP57 * DUP5; ++rep) for (int it = gw; it < 2 * NCH * 16; it += NGW) { const int mode = it & 1, ch = it >> 1, c = ch % NCH, h = ch / NCH;
                if (mode == 0) scan_task<0>(p, l, wl, c, h, lane); else scan_task<1>(p, l, wl, c, h, lane); } }
        GSYNC();
#ifndef DUP6
#define DUP6 1
#endif
        for (int rep = 0; rep < DUP6; ++rep) {   if (rep) GSYNC(); FRESH(); PTRS(); LAS int* slot = (LAS int*)(lds + LDS_BYTES - 64);
            LAS float* knl = (LAS float*)(lds + LDS_BYTES - 128);
            {   LAS float* kr = (LAS float*)lds; const float* knp = (const float*)(p->ws + WS_KNP); const int g = tid & 7, part = tid >> 3; float m = 0.f;
                for (int b2 = part; b2 < G; b2 += 64) m = fmaxf(m, knp[(size_t)b2 * 8 + g]);
                kr[part * 8 + g] = m; __syncthreads();
                if (tid < 8) { float mm = kr[tid]; for (int q2 = 1; q2 < 64; ++q2) mm = fmaxf(mm, kr[q2 * 8 + tid]); knl[tid] = mm; }
                __syncthreads(); }
            const float* sinks = p->in[5] + l * 8;
            for (;;) {
                if (tid == 0) *slot = (int)atomicAdd(ctl + 64 * (l + 1) + 16 * rep, 1u);
                __syncthreads();
                const int it = *slot;
                __syncthreads();
                if (it >= 928) break;
                if (it < 32) {
#ifndef NO_S2
                    s2_head(p, lds, it >> 1, it & 1, tid);
#endif
                }
                else if (it < 672) { const int d = it - 32, h = 3 - d / 160, u = d % 160, c = u & 1, v = u >> 1; int qb, seg;
                    if (v < 32) { qb = 31 - (v >> 2); seg = v & 3; } else if (v < 56) { const int w2 = v - 32; qb = 23 - w2 / 3; seg = w2 % 3; }
                    else if (v < 72) { const int w2 = v - 56; qb = 15 - (w2 >> 1); seg = w2 & 1; } else { qb = 79 - v; seg = 0; }
                    const float slope2 = exp2f(-2.0f * (float)(h + 1)) * LOG2E;
                    const float kn = sqrtf(knl[h * 2 + c]);
                    const int kt1 = 4 * qb + 3, klo = 32 * seg, khi = (klo + 31 < kt1) ? klo + 31 : kt1;
                    attn_unit<128, false>(lds, PROJ + h * 128 + c * 64, PROJ + 512 + h * 128 + c * 64, (const bf16_t*)(p->ws + WS_VAT) + (size_t)(h * 128) * M, slope2, qb * 256, 0.f,
                                          (float*)(p->ws + WS_OD) + (size_t)seg * M * 1024 + h * 256 + c * 128, (float*)(p->ws + WS_ML) + (size_t)seg * M * 16 + h * 4 + c * 2, nullptr, tid, klo, khi, kn); }
                else { const int s = it - 672, hq = s & 7, qb = s >> 3;
                    const int aidx = (hq >> 1) * 3 + (hq & 1);
                    const float slope2 = exp2f(-8.0f * (float)(aidx + 1) / 12.0f) * LOG2E;
                    const int q0 = qb * 256;
                    attn_unit<64, true>(lds, PROJ + 1536 + hq * 64, PROJ + 2048 + (hq >> 2) * 64, (const bf16_t*)(p->ws + WS_VBT) + (size_t)((hq >> 2) * 64) * M, slope2, q0, sinks[hq] * LOG2E,
                                        nullptr, nullptr, MIX + 512 + hq * 64, tid, q0 >= 128 ? (q0 - 128) / 64 : 0, (q0 + 255) / 64, 0.f); }
            } }
        GSYNC();
        {   FRESH();
            if (wave < 4) {
                LAS unsigned char* wl = lds + wave * 14336;
                for (int rep = 0; rep < DUP57; ++rep) for (int it = bx * 4 + wave; it < NCH * 16; it += G * 4) { const int c = it % NCH, h = it / NCH; scan_task<2>(p, l, wl, c, h, lane); }
            } else {
                phase_diffcombine(p, l, bx * 4 + (wave - 4), G * 4, lane);
                if (l + 1 < NL) { LAS float* scr = (LAS float*)(lds + 4 * 14336 + (wave - 4) * 8448);
                    for (int r = bx * 4 + (wave - 4); r < CONV_ITEMS; r += G * 4) convert_item(p, l + 1 < NL ? l + 1 : l, r, scr, lane); }
            } }
        GSYNC();
        {   FRESH(); PTRS(); pg8::Gemm g{MIX, (const bf16_t*)(wb + LW_WOUT), M, DM, DM}; pg8::StaticOrder S; S.init(M, DM, G, bx);
            pg8::EpiResid E{p->out, XB, ssqB};
            pg8::gemm_phase<pg8::EpiResid, pg8::StaticOrder, true, true>(lds, g, S, E, tid); }
        GSYNC();
        for (int rep = 0; rep < DUP1; ++rep) {   if (rep) GSYNC(); FRESH(); PTRS(); pg8::Gemm g{XB, (const bf16_t*)(wb + LW_WGU), M, GU, DM}; pg8::StaticOrder S; S.init(M, GU, G, bx);
            pg8::EpiSwiGLU E{H, ssqB};
            pg8::gemm_phase<pg8::EpiSwiGLU, pg8::StaticOrder, true, true>(lds, g, S, E, tid); }
        GSYNC();
        {   FRESH(); PTRS(); pg8::Gemm g{H, (const bf16_t*)(wb + LW_WDN), M, DM, FF}; pg8::StaticOrder S; S.init(M, DM, G, bx);
            pg8::EpiResid E{p->out, XB, ssqA};
            pg8::gemm_phase<pg8::EpiResid, pg8::StaticOrder, true, true>(lds, g, S, E, tid); }
        GSYNC();
    }

__global__ void __launch_bounds__(512, 2) fwd_megakernel(Params p_unused) {
    extern __shared__ __attribute__((aligned(16))) unsigned char lds_raw[];
    LAS unsigned char* lds = (LAS unsigned char*)lds_raw;
    cg::grid_group grid = cg::this_grid();
    const int wave0 = __builtin_amdgcn_readfirstlane((int)threadIdx.x >> 6);
    if (threadIdx.x < 16) ((LAS unsigned*)(lds + LDS_BYTES - 64))[threadIdx.x] = 0u;
    if (threadIdx.x == 0) xb_add((unsigned*)(p_unused.ws + WS_CTL) + 4096 + XB_XCNT(xb_xcc_id()), 1u);
    __syncthreads();

#ifndef DUP0
#define DUP0 1
#endif
    for (int rep = 0; rep < DUP0; ++rep) { FRESH(); phase0(p, lds, gw, NGW, wave, lane); __syncthreads(); }
    grid.sync();

    layer_body<0>(lds, wave0); layer_body<1>(lds, wave0); layer_body<2>(lds, wave0); layer_body<3>(lds, wave0);
    {   FRESH(); const int l = 0; PTRS(); const float* gf = p->in[21];
        for (int m = gw; m < M; m += NGW) { const float rs = rsqrtf(wave_sum(lane < 32 ? ssqA[(size_t)m * 32 + lane] : 0.f) * (1.0f / DM) + EPS);
#pragma unroll
            for (int j = 0; j < 8; ++j) { const size_t o = (size_t)m * DM + j * 256 + lane * 4; const f32x4 v = *(const f32x4*)(p->out + o); const f32x4 gv = *(const f32x4*)(gf + j * 256 + lane * 4);
                *(f32x4*)(p->out + o) = v * rs * gv; } } }
}

extern "C" void kernel_launch(void* const* d_in, const int* in_sizes, int n_in, void* d_out, int out_size, void* d_ws, size_t ws_size, hipStream_t stream) {
    static int grid = 0;
    if (grid == 0) {
        if (n_in != 22 || out_size != M * DM || ws_size < WS_END) { fprintf(stderr, "kernel_launch: unexpected shapes (n_in %d out %d ws %zu need %zu)\n", n_in, out_size, ws_size, (size_t)WS_END); grid = -1; return; }
        int dev = 0, cus = 0, per_cu = 0;
        hipGetDevice(&dev); hipDeviceGetAttribute(&cus, hipDeviceAttributeMultiprocessorCount, dev);
        hipFuncSetAttribute((const void*)fwd_megakernel, hipFuncAttributeMaxDynamicSharedMemorySize, LDS_BYTES);
        hipOccupancyMaxActiveBlocksPerMultiprocessor(&per_cu, (const void*)fwd_megakernel, 512, LDS_BYTES);
        if (per_cu < 1) { fprintf(stderr, "kernel_launch: occupancy query says %d blocks per CU\n", per_cu); per_cu = 1; }
        (void)hipGetLastError();
        grid = cus;
    }
    if (grid < 0) return;
    hipMemsetAsync((char*)d_ws + WS_CTL, 0, 65536, stream);
    Params p{};
    for (int i = 0; i < 22; ++i) p.in[i] = (const float*)d_in[i];
    p.out = (float*)d_out; p.ws = (unsigned char*)d_ws;
    void* args[] = {&p};
    hipError_t e = hipLaunchCooperativeKernel((const void*)fwd_megakernel, dim3(grid), dim3(512), args, LDS_BYTES, stream);
    if (e != hipSuccess) fprintf(stderr, "cooperative launch failed: %s (grid %d)\n", hipGetErrorString(e), grid);
}
```

```cpp
#include <hip/hip_runtime.h>
#include <hip/hip_cooperative_groups.h>
#include <cstdio>
#include <cstdint>
namespace cg = cooperative_groups;

#define LAS __attribute__((address_space(3)))
typedef unsigned short bf16_t;
typedef short bf16x8 __attribute__((ext_vector_type(8)));
typedef float f32x4 __attribute__((ext_vector_type(4)));
typedef float f32x2 __attribute__((ext_vector_type(2)));
typedef float f32x16 __attribute__((ext_vector_type(16)));
typedef unsigned u32x4 __attribute__((ext_vector_type(4)));
typedef unsigned u32x2 __attribute__((ext_vector_type(2)));
typedef __bf16 bf16x2_t __attribute__((ext_vector_type(2)));

constexpr int M = 8192, DM = 2048, INC = 5824, INCP = 5888, FF = 5632, GU = 11264, RW0 = 2304, RWC = 3520;
constexpr int NL = 4, NCH = 64, CL = 128;
constexpr float EPS = 1e-5f, LOG2E = 1.4426950408889634f;
constexpr float QSC = 0.125f * LOG2E;

constexpr size_t MiB = 1u << 20;
constexpr size_t SZ_WIN = (size_t)INCP * DM * 2, SZ_WOUT = (size_t)DM * DM * 2, SZ_WGU = (size_t)GU * DM * 2, SZ_WDN = (size_t)DM * FF * 2;
constexpr size_t SZ_W2T = 1024 * 128 * 2, SZ_G2T = 1024 * 256 * 2;
constexpr size_t LW_WIN = 0, LW_WOUT = LW_WIN + SZ_WIN, LW_WGU = LW_WOUT + SZ_WOUT, LW_WDN = LW_WGU + SZ_WGU, LW_W2T = LW_WDN + SZ_WDN,
                 LW_A2T = LW_W2T + SZ_W2T, LW_G2T = LW_A2T + SZ_W2T, LW_STRIDE = LW_G2T + SZ_G2T;
constexpr size_t SZ_F = (size_t)M * 1024 * 4;
constexpr size_t WS_CTL = 0, WS_W = 1 * MiB, WS_XB = WS_W + NL * LW_STRIDE, WS_PROJ = WS_XB + (size_t)M * DM * 2,
                 WS_VAT = WS_PROJ + (size_t)M * INCP * 2, WS_VBT = WS_VAT + (size_t)512 * M * 2, WS_AW = WS_VBT + (size_t)128 * M * 2,
                 WS_AA = WS_AW + (size_t)M * 128 * 2, WS_AG = WS_AA + (size_t)M * 128 * 2, WS_R = WS_AG + (size_t)M * 256 * 2,
                 WS_KR = WS_R + SZ_F, WS_V = WS_KR + SZ_F, WS_DEC = WS_V + SZ_F, WS_A = WS_DEC + SZ_F, WS_G = WS_A + SZ_F,
                 WS_KF = WS_G + SZ_F, WS_AN = WS_KF + SZ_F, WS_BB = WS_AN + SZ_F, WS_PB = WS_BB + SZ_F, WS_UB = WS_PB + SZ_F,
                 WS_SI = WS_UB + SZ_F, WS_OD = WS_SI + SZ_F, WS_ML = WS_OD + 4 * SZ_F, WS_KNP = WS_ML + (size_t)4 * M * 16 * 4, WS_MIX = WS_KNP + 65536, WS_SSQA = WS_MIX + (size_t)M * DM * 2,
                 WS_SSQB = WS_SSQA + (size_t)M * 32 * 4, WS_END = WS_SSQB + (size_t)M * 32 * 4;
constexpr size_t WS_H = WS_PROJ;
static_assert((size_t)M * FF * 2 <= (size_t)M * INCP * 2, "H overlay");

constexpr int LDS_BYTES = 147456;

struct Params { const float* in[22]; float* out; unsigned char* ws; };
typedef const __attribute__((address_space(4))) Params* KP;
__device__ __forceinline__ KP fresh_params() { KP k = (KP)__builtin_amdgcn_kernarg_segment_ptr(); asm volatile("" : "+s"(k)); return k; }

__device__ __forceinline__ unsigned cvtpk(float lo, float hi) { f32x2 v = {lo, hi}; bf16x2_t b = __builtin_convertvector(v, bf16x2_t); return __builtin_bit_cast(unsigned, b); }
__device__ __forceinline__ float bf2f(unsigned short b) { return __builtin_bit_cast(float, (unsigned)b << 16); }
__device__ __forceinline__ float bflo(unsigned w) { return __builtin_bit_cast(float, w << 16); }
__device__ __forceinline__ float bfhi(unsigned w) { return __builtin_bit_cast(float, w & 0xffff0000u); }
template <int CTRL> __device__ __forceinline__ float dppm(float v) { return __builtin_bit_cast(float, __builtin_amdgcn_mov_dpp(__builtin_bit_cast(int, v), CTRL, 0xF, 0xF, true)); }
__device__ __forceinline__ float xor16_sum(float v) { const unsigned b = __builtin_bit_cast(unsigned, v); auto rr = __builtin_amdgcn_permlane16_swap(b, b, false, false); return __builtin_bit_cast(float, (unsigned)rr[0]) + __builtin_bit_cast(float, (unsigned)rr[1]); }
__device__ __forceinline__ float xor32_sum(float v) { const unsigned b = __builtin_bit_cast(unsigned, v); auto rr = __builtin_amdgcn_permlane32_swap(b, b, false, false); return __builtin_bit_cast(float, (unsigned)rr[0]) + __builtin_bit_cast(float, (unsigned)rr[1]); }
__device__ __forceinline__ float xor32_max(float v) { const unsigned b = __builtin_bit_cast(unsigned, v); auto rr = __builtin_amdgcn_permlane32_swap(b, b, false, false); return fmaxf(__builtin_bit_cast(float, (unsigned)rr[0]), __builtin_bit_cast(float, (unsigned)rr[1])); }
__device__ __forceinline__ float row16_sum(float v) { v += dppm<0xB1>(v); v += dppm<0x4E>(v); v += dppm<0x141>(v); v += dppm<0x140>(v); return v; }
__device__ __forceinline__ float wave_sum(float v) { return xor32_sum(xor16_sum(row16_sum(v))); }
__device__ __forceinline__ float dpp_xor1(float v) { return __builtin_bit_cast(float, __builtin_amdgcn_mov_dpp(__builtin_bit_cast(int, v), 0xB1, 0xF, 0xF, true)); }
__device__ __forceinline__ float dpp_xor2(float v) { return __builtin_bit_cast(float, __builtin_amdgcn_mov_dpp(__builtin_bit_cast(int, v), 0x4E, 0xF, 0xF, true)); }
__device__ __forceinline__ float quad_sum(float v) { v += dpp_xor1(v); v += dpp_xor2(v); return v; }
__device__ __forceinline__ float sigmoidf_(float x) { return __builtin_amdgcn_rcpf(1.0f + __expf(-x)); }

__device__ __forceinline__ int fresh_tid(int wave0) { unsigned z = 0u; asm volatile("" : "+v"(z)); int t = wave0 * 64 + (int)__builtin_amdgcn_mbcnt_hi(~0u, __builtin_amdgcn_mbcnt_lo(~0u, z)); asm volatile("" : "+v"(t)); return t; }

__device__ __forceinline__ float row_rstd(const float* ssq, int row, int fq) {
    const float* pp = ssq + (size_t)row * 32 + 8 * fq; const f32x4 a = *(const f32x4*)pp, b = *(const f32x4*)(pp + 4);
    float s = ((a[0] + a[1]) + (a[2] + a[3])) + ((b[0] + b[1]) + (b[2] + b[3]));
    s = xor32_sum(xor16_sum(s));
    return rsqrtf(s * (1.0f / DM) + EPS);
}

namespace pg8 {
constexpr int BM = 256, BK = 64, HALF = 128, HTB = HALF * BK * 2, STAGE_BYTES = 8 * HTB, NXCD = 8, WGM = 8;
__host__ __device__ __forceinline__ int lds_byte(int r, int c) { const int st = (r >> 4) * 2 + (c >> 5), rr = r & 15, cc = c & 31, ob = rr * 64 + cc * 2; return st * 1024 + (ob ^ (((ob >> 9) & 1) << 5)); }
__host__ __device__ __forceinline__ void stage_rc(int b, int& R, int& C) { const int st = b / 1024, sb = b % 1024, swz = sb ^ (((sb >> 9) & 1) << 5); R = (st >> 1) * 16 + swz / 64; C = (st & 1) * 32 + (swz % 64) / 2; }
__host__ __device__ __forceinline__ int perm32(int rho) { const int n = rho >> 4, i = rho & 15; return 8 * (i >> 2) + 4 * n + (i & 3); }
struct Unit { int pm, pn; };
struct Gemm { const bf16_t* A; const bf16_t* Bt; int M, N, K; };
struct StaticOrder {
    int nM, nN, nwg, G, c;
    __host__ __device__ void init(int M_, int N_, int G_, int c_) { nM = M_ / BM; nN = N_ / BM; nwg = nM * nN; G = G_; c = c_; }
    __host__ __device__ bool next(int i, Unit& u) const {
        const long L = (long)i * G + c; if (L >= nwg) return false;
        int wgid = (int)L; { const int q = nwg / NXCD, r = nwg % NXCD, xcd = wgid % NXCD, off = wgid / NXCD; wgid = (xcd < r ? xcd * (q + 1) : r * (q + 1) + (xcd - r) * q) + off; }
        const int nig = WGM * nN, gid = wgid / nig, fm = gid * WGM, gsz = (nM - fm) < WGM ? (nM - fm) : WGM;
        u.pm = fm + ((wgid % nig) % gsz); u.pn = (wgid % nig) / gsz; return true;
    }
};

template <class Epi, class Sched, bool ALIGN_EPI, bool SP2>
__device__ __forceinline__ void gemm_phase(LAS unsigned char* lds, const Gemm g, const Sched& S, const Epi& E, const int tid) {
    const int wid = __builtin_amdgcn_readfirstlane(tid >> 6), lane = tid & 63, wr = wid >> 2, wc = wid & 3, fr = lane & 15, fq = lane >> 4;
    const int K = g.K, nt = K / BK;
    unsigned voffA[2], voffB[2];
#pragma unroll
    for (int i = 0; i < 2; ++i) { int R, C; stage_rc(tid * 16 + i * 8192, R, C); const int Rb = Epi::PERM ? ((R & ~31) + perm32(R & 31)) : R;
        voffA[i] = (unsigned)(R * K + C) * 2u; voffB[i] = (unsigned)(Rb * K + C) * 2u; }
    const size_t kstep = (size_t)(BK * 2);
    const size_t hstep = (size_t)HALF * K * 2;
    const size_t tstep = 2 * hstep;
    const unsigned ldsw = (unsigned)wid * 1024u;
    const int aoff = lds_byte(wr * 64 + fr, fq * 8), boff = lds_byte(wc * 32 + fr, fq * 8);
#define PG8_SA(b, h) (((b) * 2 + (h)) * HTB)
#define PG8_SB(b, h) ((4 + (b) * 2 + (h)) * HTB)
#define PG8_STAGE(bufoff, gbase, voff) do { _Pragma("unroll") for (int _i = 0; _i < 2; ++_i) \
        __builtin_amdgcn_global_load_lds((const unsigned*)((const char*)(gbase) + (voff)[_i]), (LAS unsigned*)(lds + (bufoff) + ldsw + _i * 8192), 16, 0, 0); } while (0)
#define PG8_LDA(dst, b, h) do { _Pragma("unroll") for (int m = 0; m < 4; ++m) _Pragma("unroll") for (int k = 0; k < 2; ++k) dst[m][k] = *(const LAS bf16x8*)(lds + PG8_SA(b, h) + aoff + m * 2048 + k * 1024); } while (0)
#define PG8_LDB(dst, b, h) do { _Pragma("unroll") for (int n = 0; n < 2; ++n) _Pragma("unroll") for (int k = 0; k < 2; ++k) dst[n][k] = *(const LAS bf16x8*)(lds + PG8_SB(b, h) + boff + n * 2048 + k * 1024); } while (0)
#define PG8_MMA(ai, bj, At, Bt) do { __builtin_amdgcn_s_setprio(1); _Pragma("unroll") for (int m = 0; m < 4; ++m) _Pragma("unroll") for (int n = 0; n < 2; ++n) _Pragma("unroll") for (int k = 0; k < 2; ++k) \
        acc[ai][bj][m][n] = __builtin_amdgcn_mfma_f32_16x16x32_bf16(Bt[n][k], At[m][k], acc[ai][bj][m][n], 0, 0, 0); __builtin_amdgcn_s_setprio(0); } while (0)
#define PG8_WAIT_V(n) asm volatile("s_waitcnt vmcnt(" #n ")" ::: "memory")
#define PG8_WAIT_L(n) asm volatile("s_waitcnt lgkmcnt(" #n ")" ::: "memory")
#define PG8_BAR __builtin_amdgcn_s_barrier()
#define PG8_SCHED __builtin_amdgcn_sched_barrier(0)
    Unit cur, nxt; int ui = 0;
    if (!S.next(0, cur)) return;
    f32x4 acc[2][2][4][2];
#pragma unroll
    for (int a = 0; a < 2; ++a)
#pragma unroll
        for (int b = 0; b < 2; ++b)
#pragma unroll
            for (int m = 0; m < 4; ++m)
#pragma unroll
                for (int n = 0; n < 2; ++n) acc[a][b][m][n] = (f32x4){0.f, 0.f, 0.f, 0.f};
    bf16x8 At[4][2], B0[2][2], B1[2][2];
    const char* cA = (const char*)g.A + (size_t)cur.pm * tstep; const char* cB = (const char*)g.Bt + (size_t)cur.pn * tstep;
    if constexpr (SP2) {
        PG8_STAGE(PG8_SB(0, 0), cB, voffB); PG8_STAGE(PG8_SB(0, 1), cB + hstep, voffB); PG8_STAGE(PG8_SA(0, 0), cA, voffA); PG8_STAGE(PG8_SA(0, 1), cA + hstep, voffA);
        if (wr == 1) PG8_BAR;
        PG8_WAIT_V(2); PG8_BAR;
        PG8_STAGE(PG8_SB(1, 0), cB + kstep, voffB); PG8_STAGE(PG8_SA(1, 0), cA + kstep, voffA); PG8_STAGE(PG8_SB(1, 1), cB + hstep + kstep, voffB);
        PG8_WAIT_V(6); PG8_BAR;
    } else {
        PG8_STAGE(PG8_SB(0, 0), cB, voffB); PG8_STAGE(PG8_SA(0, 0), cA, voffA); PG8_STAGE(PG8_SB(0, 1), cB + hstep, voffB); PG8_STAGE(PG8_SA(0, 1), cA + hstep, voffA);
        if (wr == 1) PG8_BAR;
        PG8_WAIT_V(4); PG8_BAR;
        PG8_STAGE(PG8_SB(1, 0), cB + kstep, voffB); PG8_STAGE(PG8_SA(1, 0), cA + kstep, voffA); PG8_STAGE(PG8_SB(1, 1), cB + hstep + kstep, voffB);
        PG8_WAIT_V(6); PG8_BAR;
    }
    for (;;) {
        const bool has_next = S.next(ui + 1, nxt);
        const char* nA = has_next ? (const char*)g.A + (size_t)nxt.pm * tstep : cA; const char* nB = has_next ? (const char*)g.Bt + (size_t)nxt.pn * tstep : cB;
        for (int t = 0; t < nt; t += 2) {
            const bool last = (t == nt - 2);
            const char* a1 = cA + (size_t)(t + 1) * kstep;
            const char* a2 = last ? nA : cA + (size_t)(t + 2) * kstep; const char* b2 = last ? nB : cB + (size_t)(t + 2) * kstep;
            const char* a3 = a2 + kstep; const char* b3 = b2 + kstep;
            if constexpr (SP2) {
            PG8_LDB(B0, 0, 0); PG8_LDB(B1, 0, 1); PG8_SCHED; PG8_LDA(At, 0, 0); PG8_STAGE(PG8_SA(1, 1), a1 + hstep, voffA);
            PG8_WAIT_V(8); PG8_WAIT_L(0); PG8_BAR; PG8_MMA(0, 0, At, B0); PG8_MMA(0, 1, At, B1); PG8_BAR; PG8_SCHED;
            PG8_LDA(At, 0, 1); PG8_STAGE(PG8_SB(0, 0), b2, voffB); PG8_STAGE(PG8_SB(0, 1), b2 + hstep, voffB); PG8_STAGE(PG8_SA(0, 0), a2, voffA);
            PG8_WAIT_V(8); PG8_WAIT_L(0); PG8_BAR; PG8_MMA(1, 0, At, B0); PG8_MMA(1, 1, At, B1); PG8_BAR; PG8_SCHED;
            PG8_LDB(B0, 1, 0); PG8_LDB(B1, 1, 1); PG8_SCHED; PG8_LDA(At, 1, 0); PG8_STAGE(PG8_SA(0, 1), a2 + hstep, voffA);
            PG8_WAIT_V(8); PG8_WAIT_L(0); PG8_BAR; PG8_MMA(0, 0, At, B0); PG8_MMA(0, 1, At, B1); PG8_BAR; PG8_SCHED;
            PG8_LDA(At, 1, 1); PG8_STAGE(PG8_SB(1, 0), b3, voffB); PG8_STAGE(PG8_SB(1, 1), b3 + hstep, voffB); PG8_STAGE(PG8_SA(1, 0), a3, voffA);
            PG8_WAIT_V(8); PG8_WAIT_L(0); PG8_BAR; PG8_MMA(1, 0, At, B0); PG8_MMA(1, 1, At, B1); PG8_BAR; PG8_SCHED;
            } else {
            PG8_LDB(B0, 0, 0); PG8_SCHED; PG8_LDA(At, 0, 0); PG8_STAGE(PG8_SA(1, 1), a1 + hstep, voffA);
            PG8_WAIT_L(8); PG8_BAR; PG8_WAIT_L(0); PG8_MMA(0, 0, At, B0); PG8_BAR; PG8_SCHED;
            PG8_LDB(B1, 0, 1); PG8_STAGE(PG8_SB(0, 0), b2, voffB);
            PG8_BAR; PG8_WAIT_L(0); PG8_MMA(0, 1, At, B1); PG8_BAR;
            PG8_LDA(At, 0, 1); PG8_STAGE(PG8_SA(0, 0), a2, voffA);
            PG8_BAR; PG8_WAIT_L(0); PG8_MMA(1, 0, At, B0); PG8_BAR; PG8_SCHED;
            PG8_STAGE(PG8_SB(0, 1), b2 + hstep, voffB);
            PG8_WAIT_V(6); PG8_BAR; PG8_MMA(1, 1, At, B1); PG8_BAR;
            PG8_LDB(B0, 1, 0); PG8_SCHED; PG8_LDA(At, 1, 0); PG8_STAGE(PG8_SA(0, 1), a2 + hstep, voffA);
            PG8_WAIT_L(8); PG8_BAR; PG8_WAIT_L(0); PG8_MMA(0, 0, At, B0); PG8_BAR; PG8_SCHED;
            PG8_LDB(B1, 1, 1); PG8_STAGE(PG8_SB(1, 0), b3, voffB);
            PG8_BAR; PG8_WAIT_L(0); PG8_MMA(0, 1, At, B1); PG8_BAR;
            PG8_LDA(At, 1, 1); PG8_STAGE(PG8_SA(1, 0), a3, voffA);
            PG8_BAR; PG8_WAIT_L(0); PG8_MMA(1, 0, At, B0); PG8_BAR; PG8_SCHED;
            PG8_STAGE(PG8_SB(1, 1), b3 + hstep, voffB);
            PG8_WAIT_V(6); PG8_BAR; PG8_MMA(1, 1, At, B1); PG8_BAR;
            }
        }
        if constexpr (ALIGN_EPI) { if (wr == 0) PG8_BAR; }
        E(acc, cur, wr, wc, fr, fq);
        if (!has_next) break;
#pragma unroll
        for (int a = 0; a < 2; ++a)
#pragma unroll
            for (int b = 0; b < 2; ++b)
#pragma unroll
                for (int m = 0; m < 4; ++m)
#pragma unroll
                    for (int n = 0; n < 2; ++n) acc[a][b][m][n] = (f32x4){0.f, 0.f, 0.f, 0.f};
        cur = nxt; cA = nA; cB = nB; ++ui;
        if constexpr (ALIGN_EPI) { if (wr == 1) PG8_BAR; }
    }
    PG8_WAIT_V(0);
    if constexpr (!ALIGN_EPI) { if (wr == 0) PG8_BAR; }
    PG8_BAR;
#undef PG8_SA
#undef PG8_SB
#undef PG8_STAGE
#undef PG8_LDA
#undef PG8_LDB
#undef PG8_MMA
#undef PG8_WAIT_V
#undef PG8_WAIT_L
#undef PG8_BAR
#undef PG8_SCHED
}

struct EpiProj {
    static constexpr bool PERM = true;
    bf16_t* O; int ldc; const float* ssq;
    __device__ __forceinline__ void operator()(const f32x4 (&acc)[2][2][4][2], const Unit& u, int wr, int wc, int fr, int fq) const {
        const int row0 = u.pm * BM + wr * 64 + fr, col0 = u.pn * BM + wc * 32 + 8 * fq;
#pragma unroll
        for (int ai = 0; ai < 2; ++ai)
#pragma unroll
            for (int m = 0; m < 4; ++m) { const int row = row0 + ai * HALF + m * 16; const float rs = row_rstd(ssq, row, fq);
                bf16_t* rowp = O + (size_t)row * ldc + col0;
#pragma unroll
                for (int bj = 0; bj < 2; ++bj) { const f32x4 v0 = acc[ai][bj][m][0] * rs, v1 = acc[ai][bj][m][1] * rs;
                    u32x4 w; w.x = cvtpk(v0[0], v0[1]); w.y = cvtpk(v0[2], v0[3]); w.z = cvtpk(v1[0], v1[1]); w.w = cvtpk(v1[2], v1[3]);
                    *(u32x4*)(rowp + bj * HALF) = w; } }
    }
};
struct EpiSwiGLU {
    static constexpr bool PERM = true;
    bf16_t* O; const float* ssq;
    __device__ __forceinline__ void operator()(const f32x4 (&acc)[2][2][4][2], const Unit& u, int wr, int wc, int fr, int fq) const {
        const int row0 = u.pm * BM + wr * 64 + fr, col0 = u.pn * HALF + wc * 32 + 8 * fq;
#pragma unroll
        for (int ai = 0; ai < 2; ++ai)
#pragma unroll
            for (int m = 0; m < 4; ++m) { const int row = row0 + ai * HALF + m * 16; const float rs = row_rstd(ssq, row, fq);
                float h[8];
#pragma unroll
                for (int n = 0; n < 2; ++n)
#pragma unroll
                    for (int j = 0; j < 4; ++j) { const float gt = acc[ai][0][m][n][j] * rs, up = acc[ai][1][m][n][j] * rs; h[n * 4 + j] = gt * up * __builtin_amdgcn_rcpf(1.0f + __expf(-gt)); }
                u32x4 w; w.x = cvtpk(h[0], h[1]); w.y = cvtpk(h[2], h[3]); w.z = cvtpk(h[4], h[5]); w.w = cvtpk(h[6], h[7]);
                *(u32x4*)(O + (size_t)row * FF + col0) = w; }
    }
};
struct EpiResid {
    static constexpr bool PERM = false;
    float* X; bf16_t* XB; float* ssq;
    __device__ __forceinline__ void operator()(const f32x4 (&acc)[2][2][4][2], const Unit& u, int wr, int wc, int fr, int fq) const {
        const int row0 = u.pm * BM + wr * 64 + fr, col0 = u.pn * BM + wc * 32 + 4 * fq;
#pragma unroll
        for (int ai = 0; ai < 2; ++ai)
#pragma unroll
            for (int m = 0; m < 4; ++m) { const int row = row0 + ai * HALF + m * 16; const size_t off = (size_t)row * DM + col0; float ss = 0.f;
#pragma unroll
                for (int bj = 0; bj < 2; ++bj)
#pragma unroll
                    for (int n = 0; n < 2; ++n) { const size_t o = off + bj * HALF + n * 16; const f32x4 xv = *(const f32x4*)(X + o) + acc[ai][bj][m][n];
                        *(f32x4*)(X + o) = xv; u32x2 w; w.x = cvtpk(xv[0], xv[1]); w.y = cvtpk(xv[2], xv[3]); *(u32x2*)(XB + o) = w;
                        ss += (xv[0] * xv[0] + xv[1] * xv[1]) + (xv[2] * xv[2] + xv[3] * xv[3]); }
                ss = xor32_sum(xor16_sum(ss));
                if (fq == 0) ssq[(size_t)row * 32 + u.pn * 4 + wc] = ss; }
    }
};
template <int MODE> struct EpiLora {
    static constexpr bool PERM = false;
    float* O; const float* bias;
    __device__ __forceinline__ void operator()(const f32x4 (&acc)[2][2][4][2], const Unit& u, int wr, int wc, int fr, int fq) const {
        const int row0 = u.pm * BM + wr * 64 + fr, col0 = u.pn * BM + wc * 32 + 4 * fq;
#pragma unroll
        for (int bj = 0; bj < 2; ++bj)
#pragma unroll
            for (int n = 0; n < 2; ++n) { const int col = col0 + bj * HALF + n * 16;
                f32x4 bv = (f32x4){0.f, 0.f, 0.f, 0.f}; if (MODE != 2) bv = *(const f32x4*)(bias + col);
#pragma unroll
                for (int ai = 0; ai < 2; ++ai)
#pragma unroll
                    for (int m = 0; m < 4; ++m) { const int row = row0 + ai * HALF + m * 16; f32x4 v = acc[ai][bj][m][n] + bv;
                        if (MODE == 0) {
#pragma unroll
                            for (int j = 0; j < 4; ++j) v[j] = __expf(-0.60653065971f * sigmoidf_(v[j]));
                        } else if (MODE == 1) {
#pragma unroll
                            for (int j = 0; j < 4; ++j) v[j] = sigmoidf_(v[j]);
                        }
                        if (MODE != 0) { u32x2 w2; w2.x = cvtpk(v[0], v[1]); w2.y = cvtpk(v[2], v[3]); *(u32x2*)((bf16_t*)O + (size_t)row * 1024 + col) = w2; }
                        else *(f32x4*)(O + (size_t)row * 1024 + col) = v; } }
    }
};
}

template <int MAP>
__device__ __forceinline__ void transpose_item(const float* W, int K, int N, bf16_t* WT, const float* gk, LAS float* scr, int item, int lane) {
    const int nblk = N / 32, kb = item / nblk, nb = item % nblk, k0 = 64 * kb, n0 = 32 * nb;
    float v[32];
    const float* wp = W + (size_t)(k0 + (lane >> 5)) * N + n0 + (lane & 31);
#pragma unroll
    for (int i = 0; i < 32; ++i) v[i] = __builtin_nontemporal_load(wp + (size_t)(2 * i) * N);
    const int c = lane & 7;
    f32x4 g0 = (f32x4){1.f, 1.f, 1.f, 1.f}, g1 = g0;
    if (gk) { g0 = *(const f32x4*)(gk + k0 + 8 * c); g1 = *(const f32x4*)(gk + k0 + 8 * c + 4); }
#pragma unroll
    for (int i = 0; i < 32; ++i) scr[(2 * i + (lane >> 5)) * 33 + (lane & 31)] = v[i];
    asm volatile("s_waitcnt lgkmcnt(0)" ::: "memory");
#pragma unroll
    for (int j = 0; j < 4; ++j) { const int n = n0 + (lane >> 3) + 8 * j; const LAS float* s = scr + (8 * c) * 33 + (n - n0);
        float sc = 1.f; int drow = n;
        if (MAP == 0) { if (n < 512 || (n >= 1536 && n < 2048)) sc = QSC; }
        if (MAP == 1) { const int hn = n < FF ? n : n - FF; drow = (hn >> 7) * 256 + (n < FF ? 0 : 128) + (hn & 127); }
        const f32x4 h0 = g0 * sc, h1 = g1 * sc;
        u32x4 o; o.x = cvtpk(s[0 * 33] * h0[0], s[1 * 33] * h0[1]); o.y = cvtpk(s[2 * 33] * h0[2], s[3 * 33] * h0[3]); o.z = cvtpk(s[4 * 33] * h1[0], s[5 * 33] * h1[1]); o.w = cvtpk(s[6 * 33] * h1[2], s[7 * 33] * h1[3]);
        *(u32x4*)(WT + (size_t)drow * K + k0 + 8 * c) = o; }
    asm volatile("s_waitcnt lgkmcnt(0)" ::: "memory");
}

constexpr int I_IN = (DM / 64) * (INC / 32), I_OUT = (DM / 64) * (DM / 32), I_GU = (DM / 64) * (GU / 32), I_DN = (FF / 64) * (DM / 32);
constexpr int CONV_ITEMS = I_IN + I_OUT + I_GU + I_DN;
__device__ __forceinline__ void convert_item(KP p, int l, int r, LAS float* scr, int lane) {
    unsigned char* wb = p->ws + WS_W + (size_t)l * LW_STRIDE;
    if (r < I_IN) { transpose_item<0>(p->in[2] + (size_t)l * DM * INC, DM, INC, (bf16_t*)(wb + LW_WIN), p->in[1] + l * DM, scr, r, lane); return; } r -= I_IN;
    if (r < I_OUT) { transpose_item<2>(p->in[17] + (size_t)l * DM * DM, DM, DM, (bf16_t*)(wb + LW_WOUT), nullptr, scr, r, lane); return; } r -= I_OUT;
    if (r < I_GU) { transpose_item<1>(p->in[19] + (size_t)l * DM * GU, DM, GU, (bf16_t*)(wb + LW_WGU), p->in[18] + l * DM, scr, r, lane); return; } r -= I_GU;
    transpose_item<2>(p->in[20] + (size_t)l * FF * DM, FF, DM, (bf16_t*)(wb + LW_WDN), nullptr, scr, r, lane);
}

__device__ __forceinline__ void phase0(KP p, LAS unsigned char* lds, int gw, int NGW, int wave, int lane) {
    LAS float* scr = (LAS float*)(lds + wave * 16384);
    for (int it = gw; it < CONV_ITEMS; it += NGW) convert_item(p, 0, it, scr, lane);
    const int gt = gw * 64 + lane, NGT = NGW * 64;
    for (int l = 0; l < NL; ++l) {
        unsigned char* wb = p->ws + WS_W + (size_t)l * LW_STRIDE;
        bf16_t* w2t = (bf16_t*)(wb + LW_W2T); bf16_t* a2t = (bf16_t*)(wb + LW_A2T); bf16_t* g2t = (bf16_t*)(wb + LW_G2T);
        const float* w2 = p->in[8] + (size_t)l * 96 * 1024; const float* a2 = p->in[10] + (size_t)l * 96 * 1024; const float* g2 = p->in[11] + (size_t)l * 256 * 1024;
        for (int i = gt; i < 1024 * 128; i += NGT) { const int n = i >> 7, k = i & 127;
            w2t[i] = (bf16_t)(cvtpk(k < 96 ? w2[k * 1024 + n] : 0.f, 0.f) & 0xffff); a2t[i] = (bf16_t)(cvtpk(k < 96 ? a2[k * 1024 + n] : 0.f, 0.f) & 0xffff); }
        for (int i = gt; i < 1024 * 256; i += NGT) { const int n = i >> 8, k = i & 255; g2t[i] = (bf16_t)(cvtpk(g2[k * 1024 + n], 0.f) & 0xffff); }
        unsigned* padz = (unsigned*)(wb + LW_WIN + (size_t)INC * DM * 2);
        for (int i = gt; i < (INCP - INC) * DM / 2; i += NGT) padz[i] = 0u;
    }
    const float* x = p->in[0]; float* X = p->out; bf16_t* XB = (bf16_t*)(p->ws + WS_XB); float* ssqA = (float*)(p->ws + WS_SSQA);
    for (int m = gw; m < M; m += NGW) { float ss = 0.f;
#pragma unroll
        for (int j = 0; j < 8; ++j) { const size_t o = (size_t)m * DM + j * 256 + lane * 4; const f32x4 v = *(const f32x4*)(x + o); *(f32x4*)(X + o) = v;
            u32x2 w; w.x = cvtpk(v[0], v[1]); w.y = cvtpk(v[2], v[3]); *(u32x2*)(XB + o) = w; ss += (v[0] * v[0] + v[1] * v[1]) + (v[2] * v[2] + v[3] * v[3]); }
        ss = wave_sum(ss); if (lane < 32) ssqA[(size_t)m * 32 + lane] = lane == 0 ? ss : 0.f; }
}

__device__ __forceinline__ void phase_prep1(KP p, int l, LAS unsigned char* lds, int gw, int NGW, int wave, int lane) {
    const bf16_t* PROJ = (const bf16_t*)(p->ws + WS_PROJ);
    LAS unsigned short* tile = (LAS unsigned short*)(lds + wave * 8448);
    bf16_t* VAT = (bf16_t*)(p->ws + WS_VAT); bf16_t* VBT = (bf16_t*)(p->ws + WS_VBT);
    for (int it = gw; it < 128 * 10; it += NGW) {
        const int tb = it / 10, g = it % 10, t0 = tb * 64; const int cbase = g < 8 ? 1024 + 64 * g : 2176 + 64 * (g - 8);
        bf16_t* dst = g < 8 ? VAT + (size_t)(64 * g) * M : VBT + (size_t)(64 * (g - 8)) * M;
#pragma unroll
        for (int i = 0; i < 8; ++i) { const int row = i * 8 + (lane >> 3), ch = lane & 7; const u32x4 v = *(const u32x4*)(PROJ + (size_t)(t0 + row) * INCP + cbase + 8 * ch);
            LAS unsigned* d = (LAS unsigned*)(tile + row * 66 + 8 * ch); d[0] = v.x; d[1] = v.y; d[2] = v.z; d[3] = v.w; }
        asm volatile("s_waitcnt lgkmcnt(0)" ::: "memory");
#pragma unroll
        for (int i = 0; i < 8; ++i) { const int c = i * 8 + (lane >> 3), tch = lane & 7, j = tch >> 1, hi = tch & 1; unsigned short v[8];
#pragma unroll
            for (int s = 0; s < 8; ++s) v[s] = tile[(16 * j + (s & 3) + 8 * (s >> 2) + 4 * hi) * 66 + c];
            u32x4 o; o.x = v[0] | ((unsigned)v[1] << 16); o.y = v[2] | ((unsigned)v[3] << 16); o.z = v[4] | ((unsigned)v[5] << 16); o.w = v[6] | ((unsigned)v[7] << 16);
            *(u32x4*)(dst + (size_t)c * M + t0 + 16 * j + 8 * hi) = o; }
        asm volatile("s_waitcnt lgkmcnt(0)" ::: "memory");
    }
    const float* mu = p->in[6] + (size_t)l * RWC;
    bf16_t* AW = (bf16_t*)(p->ws + WS_AW); bf16_t* AA = (bf16_t*)(p->ws + WS_AA); bf16_t* AG = (bf16_t*)(p->ws + WS_AG);
    float knmax = 0.f;
    for (int t = gw; t < M; t += NGW) {
        const bf16_t* cur = PROJ + (size_t)t * INCP + RW0;
        {   const u32x4 kv = *(const u32x4*)(PROJ + (size_t)t * INCP + 512 + 8 * lane);
            float a0 = bflo(kv.x), a1 = bfhi(kv.x), a2 = bflo(kv.y), a3 = bfhi(kv.y), a4 = bflo(kv.z), a5 = bfhi(kv.z), a6 = bflo(kv.w), a7 = bfhi(kv.w);
            float ss = (a0 * a0 + a1 * a1) + (a2 * a2 + a3 * a3) + (a4 * a4 + a5 * a5) + (a6 * a6 + a7 * a7);
            ss += dppm<0xB1>(ss); ss += dppm<0x4E>(ss); ss += dppm<0x141>(ss); knmax = fmaxf(knmax, ss); }
        if (lane < 56) { const int j0 = 3072 + 8 * lane;
            const u32x4 c4 = *(const u32x4*)(cur + j0); u32x4 p4 = (u32x4){0u, 0u, 0u, 0u}; if (t > 0) p4 = *(const u32x4*)(cur - INCP + j0);
            const f32x4 m0 = *(const f32x4*)(mu + j0), m1 = *(const f32x4*)(mu + j0 + 4);
            float f[8]; const unsigned cw[4] = {c4.x, c4.y, c4.z, c4.w}, pw[4] = {p4.x, p4.y, p4.z, p4.w};
#pragma unroll
            for (int q = 0; q < 4; ++q) { const float c0 = bflo(cw[q]), c1 = bfhi(cw[q]), p0 = bflo(pw[q]), p1 = bfhi(pw[q]);
                const float mu0 = q < 2 ? m0[2 * q] : m1[2 * q - 4], mu1 = q < 2 ? m0[2 * q + 1] : m1[2 * q - 3];
                f[2 * q] = c0 + (p0 - c0) * mu0; f[2 * q + 1] = c1 + (p1 - c1) * mu1; }
            bf16_t* dstp;
            if (j0 < 3168) { dstp = AW + (size_t)t * 128 + (j0 - 3072);
#pragma unroll
                for (int q = 0; q < 8; ++q) f[q] = tanhf(f[q]); }
            else if (j0 < 3264) { dstp = AA + (size_t)t * 128 + (j0 - 3168); }
            else { dstp = AG + (size_t)t * 256 + (j0 - 3264);
#pragma unroll
                for (int q = 0; q < 8; ++q) f[q] = sigmoidf_(f[q]); }
            u32x4 o; o.x = cvtpk(f[0], f[1]); o.y = cvtpk(f[2], f[3]); o.z = cvtpk(f[4], f[5]); o.w = cvtpk(f[6], f[7]); *(u32x4*)dstp = o; }
        else { const int e = lane - 56; if (e < 4) *(u32x4*)(AW + (size_t)t * 128 + 96 + 8 * e) = (u32x4){0u, 0u, 0u, 0u}; else *(u32x4*)(AA + (size_t)t * 128 + 96 + 8 * (e - 4)) = (u32x4){0u, 0u, 0u, 0u}; }
    }
    {   LAS float* kr = (LAS float*)(lds + 8 * 8448);
        if ((lane & 7) == 0) kr[wave * 8 + (lane >> 3)] = knmax;
        __syncthreads();
        if (wave == 0 && lane < 8) { float m = kr[lane];
#pragma unroll
            for (int w2 = 1; w2 < 8; ++w2) m = fmaxf(m, kr[w2 * 8 + lane]);
            ((float*)(p->ws + WS_KNP))[(size_t)(gw >> 3) * 8 + lane] = m; }
        __syncthreads(); }
}

__device__ __forceinline__ void phase_prep2(KP p, int l, int gw, int NGW, int lane) {
    const float* KR = (const float*)(p->ws + WS_KR); const float* A = (const float*)(p->ws + WS_A);
    float* KF = (float*)(p->ws + WS_KF); float* AN = (float*)(p->ws + WS_AN); float* BB = (float*)(p->ws + WS_BB);
    const float* k_k = p->in[12] + l * 1024; const float* k_a = p->in[13] + l * 1024;
    const int c0 = 16 * lane;
    for (int t = gw; t < M; t += NGW) { const size_t o = (size_t)t * 1024 + c0; float n2 = 0.f; f32x4 kkv[4], kr[4], av[4];
#pragma unroll
        for (int q = 0; q < 4; ++q) { kr[q] = *(const f32x4*)(KR + o + 4 * q); av[q] = *(const f32x4*)(A + o + 4 * q); kkv[q] = kr[q] * *(const f32x4*)(k_k + c0 + 4 * q);
            n2 += (kkv[q][0] * kkv[q][0] + kkv[q][1] * kkv[q][1]) + (kkv[q][2] * kkv[q][2] + kkv[q][3] * kkv[q][3]); }
        n2 = quad_sum(n2); const float inv = 1.0f / fmaxf(sqrtf(n2), 1e-12f);
#pragma unroll
        for (int q = 0; q < 4; ++q) { const f32x4 kk = kkv[q] * inv; const f32x4 ka = *(const f32x4*)(k_a + c0 + 4 * q);
            *(f32x4*)(KF + o + 4 * q) = kr[q] * (1.0f + (av[q] - 1.0f) * ka); *(f32x4*)(AN + o + 4 * q) = -kk; *(f32x4*)(BB + o + 4 * q) = kk * av[q]; }
    }
}

template <int MODE>
__device__ __forceinline__ void scan_task(KP p, int l, LAS unsigned char* wl, int c, int h, int lane) {
    constexpr int NPV = MODE == 0 ? 1 : (MODE == 1 ? 2 : 3);
    constexpr int SB = 4;
    LAS float* vec = (LAS float*)wl;
    LAS float* ybuf = (LAS float*)(wl + 7 * SB * 256);
    const float* DECp = (const float*)(p->ws + WS_DEC); const float* Ap = (const float*)(p->ws + WS_A); const bf16_t* PROJ = (const bf16_t*)(p->ws + WS_PROJ);
    const int rb = lane >> 2, cb = lane & 3, t0 = c * CL;
    f32x2 s[4][8];
    if (MODE == 0) {
#pragma unroll
        for (int r = 0; r < 4; ++r)
#pragma unroll
            for (int q = 0; q < 8; ++q) { s[r][q].x = (4 * rb + r == 16 * cb + 2 * q) ? 1.f : 0.f; s[r][q].y = (4 * rb + r == 16 * cb + 2 * q + 1) ? 1.f : 0.f; }
    } else if (MODE == 1) {
#pragma unroll
        for (int r = 0; r < 4; ++r)
#pragma unroll
            for (int q = 0; q < 8; ++q) s[r][q] = (f32x2){0.f, 0.f};
    } else {
        const float* SI = (const float*)(p->ws + WS_SI) + ((size_t)(h * NCH + c)) * 4096;
#pragma unroll
        for (int x = 0; x < 16; ++x) { const f32x4 v = *(const f32x4*)(SI + (16 * cb + x) * 64 + 4 * rb);
#pragma unroll
            for (int r = 0; r < 4; ++r) { if (x & 1) s[r][x >> 1].y = v[r]; else s[r][x >> 1].x = v[r]; } }
    }
    const int lst = lane >> 4, lq = lane & 15;
    const f32x4 kk4 = *(const f32x4*)(p->in[12] + l * 1024 + 64 * h + 4 * lq), ka4 = *(const f32x4*)(p->in[13] + l * 1024 + 64 * h + 4 * lq);
    f32x4 lnw4 = (f32x4){0.f, 0.f, 0.f, 0.f}, lnb4 = lnw4, rk4 = lnw4;
    if (MODE == 2) { lnw4 = *(const f32x4*)(p->in[15] + l * 1024 + 64 * h + 4 * lq); lnb4 = *(const f32x4*)(p->in[16] + l * 1024 + 64 * h + 4 * lq); rk4 = *(const f32x4*)(p->in[14] + l * 1024 + 64 * h + 4 * lq); }
    const size_t goff = (size_t)(t0 + lst) * 1024 + 64 * h + 4 * lq;
    const int pvo[3] = {1024, 2048, 0};
    f32x4 mu4[NPV];
#pragma unroll
    for (int v = 0; v < NPV; ++v) mu4[v] = *(const f32x4*)(p->in[6] + (size_t)l * RWC + pvo[v] + 64 * h + 4 * lq);
    const bf16_t* pj = PROJ + (size_t)(t0 + lst) * INCP + RW0 + 64 * h + 4 * lq;
    const float* Gp = (const float*)(p->ws + WS_G);
    struct Pre { f32x4 dec; u32x2 a, g; u32x2 cur[NPV], prv[NPV]; };
    Pre pA, pB;
#define SCAN_LOAD(P_, SBI) do { if ((SBI) < CL / SB) { const size_t ro = (size_t)(SB * (SBI)); P_.dec = *(const f32x4*)(DECp + goff + ro * 1024); P_.a = *(const u32x2*)((const bf16_t*)Ap + goff + ro * 1024); \
        if constexpr (MODE == 2) P_.g = *(const u32x2*)((const bf16_t*)Gp + goff + ro * 1024); \
        const bool first = (t0 + (int)ro + lst) == 0; \
        _Pragma("unroll") for (int v = 0; v < NPV; ++v) { P_.cur[v] = *(const u32x2*)(pj + ro * INCP + pvo[v]); P_.prv[v] = first ? (u32x2){0u, 0u} : *(const u32x2*)(pj + ro * INCP + pvo[v] - INCP); } } } while (0)
#define SCAN_SHIFT(P_, V) ({ const f32x4 c_ = (f32x4){bflo(P_.cur[V].x), bfhi(P_.cur[V].x), bflo(P_.cur[V].y), bfhi(P_.cur[V].y)}, q_ = (f32x4){bflo(P_.prv[V].x), bfhi(P_.prv[V].x), bflo(P_.prv[V].y), bfhi(P_.prv[V].y)}; c_ + (q_ - c_) * mu4[V]; })
#define SCAN_STAGE(P_) do { const f32x4 kr = SCAN_SHIFT(P_, 0), av = (f32x4){bflo(P_.a.x), bfhi(P_.a.x), bflo(P_.a.y), bfhi(P_.a.y)}; const f32x4 kkv = kr * kk4; \
        float n2 = (kkv[0] * kkv[0] + kkv[1] * kkv[1]) + (kkv[2] * kkv[2] + kkv[3] * kkv[3]); n2 = row16_sum(n2); \
        const float inv = __builtin_amdgcn_rsqf(fmaxf(n2, 1e-24f)); const f32x4 kkn = kkv * inv; \
        LAS float* vw = vec + lst * 64 + 4 * lq; \
        *(LAS f32x4*)(vw + 0 * SB * 64) = P_.dec; *(LAS f32x4*)(vw + 1 * SB * 64) = -kkn; *(LAS f32x4*)(vw + 2 * SB * 64) = kkn * av; \
        if constexpr (MODE != 0) { *(LAS f32x4*)(vw + 3 * SB * 64) = kr * (1.0f + (av - 1.0f) * ka4); *(LAS f32x4*)(vw + 4 * SB * 64) = SCAN_SHIFT(P_, 1); } \
        if constexpr (MODE == 2) { *(LAS f32x4*)(vw + 5 * SB * 64) = SCAN_SHIFT(P_, 2); *(LAS f32x4*)(vw + 6 * SB * 64) = (f32x4){bflo(P_.g.x), bfhi(P_.g.x), bflo(P_.g.y), bfhi(P_.g.y)}; } } while (0)
    SCAN_LOAD(pA, 0); SCAN_LOAD(pB, 1);
    float gam = 1.0f;
    LAS float* gbuf = ybuf + SB * 64;
    for (int sb = 0; sb < CL / SB; ++sb) {
        if (sb & 1) { SCAN_STAGE(pB); SCAN_LOAD(pB, sb + 2); } else { SCAN_STAGE(pA); SCAN_LOAD(pA, sb + 2); }
#pragma unroll
        for (int st = 0; st < SB; ++st) { const float w_ = vec[(0 * SB + st) * 64 + lane]; const float gprev = gam; gam *= w_; const float ginv = __builtin_amdgcn_rcpf(gam);
            vec[(1 * SB + st) * 64 + lane] *= gprev; vec[(2 * SB + st) * 64 + lane] *= ginv;
            if (MODE != 0) vec[(3 * SB + st) * 64 + lane] *= ginv;
            if (MODE == 2) vec[(5 * SB + st) * 64 + lane] *= gam; }
#pragma unroll 1
        for (int st = 0; st < SB; ++st) {
            const LAS float* vb = vec + st * 64 + 16 * cb;
            float sa[4];
            {   f32x2 a2[8];
#pragma unroll
                for (int q = 0; q < 4; ++q) { const f32x4 y = *(const LAS f32x4*)(vb + 1 * SB * 64 + 4 * q); a2[2 * q] = (f32x2){y[0], y[1]}; a2[2 * q + 1] = (f32x2){y[2], y[3]}; }
                f32x2 c0[4];
#pragma unroll
                for (int r = 0; r < 4; ++r) c0[r] = s[r][0] * a2[0];
#pragma unroll
                for (int q = 1; q < 8; ++q)
#pragma unroll
                    for (int r = 0; r < 4; ++r) c0[r] = s[r][q] * a2[q] + c0[r];
                float e[4];
#pragma unroll
                for (int r = 0; r < 4; ++r) e[r] = c0[r].x + c0[r].y;
#pragma unroll
                for (int r = 0; r < 4; ++r) e[r] += dpp_xor1(e[r]);
#pragma unroll
                for (int r = 0; r < 4; ++r) sa[r] = e[r] + dpp_xor2(e[r]); }
            f32x4 vv = (f32x4){0.f, 0.f, 0.f, 0.f};
            if (MODE != 0) vv = *(const LAS f32x4*)(vec + (4 * SB + st) * 64 + 4 * rb);
#pragma unroll
            for (int q = 0; q < 4; ++q) { const f32x4 b4 = *(const LAS f32x4*)(vb + 2 * SB * 64 + 4 * q);
                const f32x2 b0 = (f32x2){b4[0], b4[1]}, b1 = (f32x2){b4[2], b4[3]};
#pragma unroll
                for (int r = 0; r < 4; ++r) { s[r][2 * q] = b0 * sa[r] + s[r][2 * q]; s[r][2 * q + 1] = b1 * sa[r] + s[r][2 * q + 1]; }
                if (MODE != 0) { const f32x4 k4 = *(const LAS f32x4*)(vb + 3 * SB * 64 + 4 * q); const f32x2 k0 = (f32x2){k4[0], k4[1]}, k1 = (f32x2){k4[2], k4[3]};
#pragma unroll
                    for (int r = 0; r < 4; ++r) { s[r][2 * q] = k0 * vv[r] + s[r][2 * q]; s[r][2 * q + 1] = k1 * vv[r] + s[r][2 * q + 1]; } } }
            if (MODE == 2) {
                f32x2 r2[8];
#pragma unroll
                for (int q = 0; q < 4; ++q) { const f32x4 x = *(const LAS f32x4*)(vb + 5 * SB * 64 + 4 * q); r2[2 * q] = (f32x2){x[0], x[1]}; r2[2 * q + 1] = (f32x2){x[2], x[3]}; }
                f32x4 yv;
                f32x2 c0[4];
#pragma unroll
                for (int r = 0; r < 4; ++r) c0[r] = s[r][0] * r2[0];
#pragma unroll
                for (int q = 1; q < 8; ++q)
#pragma unroll
                    for (int r = 0; r < 4; ++r) c0[r] = s[r][q] * r2[q] + c0[r];
                float e[4];
#pragma unroll
                for (int r = 0; r < 4; ++r) e[r] = c0[r].x + c0[r].y;
#pragma unroll
                for (int r = 0; r < 4; ++r) e[r] += dpp_xor1(e[r]);
#pragma unroll
                for (int r = 0; r < 4; ++r) yv[r] = e[r] + dpp_xor2(e[r]);
                if (cb == 0) *(LAS f32x4*)(ybuf + st * 64 + 4 * rb) = yv;
            }
        }
        if ((sb & 15) == 15) {
            gbuf[lane] = gam; gam = 1.0f;
#pragma unroll
            for (int q = 0; q < 4; ++q) { const f32x4 g4 = *(const LAS f32x4*)(gbuf + 16 * cb + 4 * q); const f32x2 g0 = (f32x2){g4[0], g4[1]}, g1 = (f32x2){g4[2], g4[3]};
#pragma unroll
                for (int r = 0; r < 4; ++r) { s[r][2 * q] = s[r][2 * q] * g0; s[r][2 * q + 1] = s[r][2 * q + 1] * g1; } } }
        if (MODE == 2) {
            bf16_t* MIX = (bf16_t*)(p->ws + WS_MIX);
            const int t = t0 + SB * sb + lst; const LAS float* vr = vec + lst * 64 + 4 * lq;
            const f32x4 y = *(const LAS f32x4*)(ybuf + lst * 64 + 4 * lq), rr = *(const LAS f32x4*)(vr + 5 * SB * 64), kk = *(const LAS f32x4*)(vr + 3 * SB * 64),
                        vv = *(const LAS f32x4*)(vr + 4 * SB * 64), g = *(const LAS f32x4*)(vr + 6 * SB * 64);
            const float mean = row16_sum((y[0] + y[1]) + (y[2] + y[3])) * (1.0f / 64.0f);
            const f32x4 d = y - mean;
            const float var = row16_sum((d[0] * d[0] + d[1] * d[1]) + (d[2] * d[2] + d[3] * d[3])) * (1.0f / 64.0f);
            const f32x4 rkk = rr * kk * rk4;
            const float bon = row16_sum((rkk[0] + rkk[1]) + (rkk[2] + rkk[3]));
            const f32x4 o = (d * __builtin_amdgcn_rsqf(var + 64e-5f) * lnw4 + lnb4 + vv * bon) * g;
            u32x2 wv; wv.x = cvtpk(o[0], o[1]); wv.y = cvtpk(o[2], o[3]);
            *(u32x2*)(MIX + (size_t)t * DM + 1024 + 64 * h + 4 * lq) = wv;
        }
    }
    if (MODE == 0) { float* dst = (float*)(p->ws + WS_PB) + ((size_t)(h * NCH + c)) * 4096;
#pragma unroll
        for (int r = 0; r < 4; ++r)
#pragma unroll
            for (int q = 0; q < 4; ++q) *(f32x4*)(dst + (4 * rb + r) * 64 + 16 * cb + 4 * q) = (f32x4){s[r][2 * q].x, s[r][2 * q].y, s[r][2 * q + 1].x, s[r][2 * q + 1].y}; }
    if (MODE == 1) { float* dst = (float*)(p->ws + WS_UB) + ((size_t)(h * NCH + c)) * 4096;
#pragma unroll
        for (int x = 0; x < 16; ++x) { f32x4 v;
#pragma unroll
            for (int r = 0; r < 4; ++r) v[r] = (x & 1) ? s[r][x >> 1].y : s[r][x >> 1].x;
            *(f32x4*)(dst + (16 * cb + x) * 64 + 4 * rb) = v; } }
}

#undef SCAN_LOAD
#undef SCAN_SHIFT
#undef SCAN_STAGE
__device__ __forceinline__ void s2_head(KP p, LAS unsigned char* lds, int h, int ti, const int tid) {
    const float* PB = (const float*)(p->ws + WS_PB) + (size_t)h * NCH * 4096; const float* UT = (const float*)(p->ws + WS_UB) + (size_t)h * NCH * 4096;
    float* SI = (float*)(p->ws + WS_SI) + (size_t)h * NCH * 4096;
    const int lane = tid & 63, w = __builtin_amdgcn_readfirstlane(tid >> 6), n = lane & 31, lh = lane >> 5, to = (w >> 1) & 1, tj = w & 1;
    static_assert((NCH - 1) % 3 == 0, "three rotating prefetch buffers");
    if (w >= 4) {
        for (int c = 0; c < NCH - 1; ++c) __syncthreads();
    } else {
        f32x16 breg, ua, ub, uc2; float pa[16], pb[16], pc2[16];
#pragma unroll
        for (int r = 0; r < 16; ++r) breg[r] = 0.f;
        const int offu = (32 * to + 4 * lh) * 64 + 32 * ti + n, offp = (32 * tj + 4 * lh) * 64 + 32 * to + n, offs = (32 * tj + 4 * lh) * 64 + 32 * ti + n;
#define S2_LOAD(CH, U_, P_) do { const int ch_ = (CH) < NCH - 1 ? (CH) : NCH - 2; const float* pb_ = PB + (size_t)ch_ * 4096 + offp; const float* ub_ = UT + (size_t)ch_ * 4096 + offu; \
        _Pragma("unroll") for (int r = 0; r < 16; ++r) { const int cr = ((r & 3) + 8 * (r >> 2)) * 64; U_[r] = tj == 0 ? ub_[cr] : 0.f; P_[r] = pb_[cr]; } } while (0)
#define S2_STEP(C, UC_, PC_, UN_, PN_) do { \
        if (to == 0) { float* si = SI + (size_t)(C) * 4096 + offs; \
            _Pragma("unroll") for (int r = 0; r < 16; ++r) si[((r & 3) + 8 * (r >> 2)) * 64] = breg[r]; } \
        f32x16 acc = UC_; \
        _Pragma("unroll") for (int r = 0; r < 16; ++r) acc = __builtin_amdgcn_mfma_f32_32x32x2f32(PC_[r], breg[r], acc, 0, 0, 0); \
        LAS f32x4* ex = (LAS f32x4*)(lds + ((C) & 1) * 16384); \
        _Pragma("unroll") for (int q = 0; q < 4; ++q) ex[(w * 4 + q) * 64 + lane] = (f32x4){acc[4 * q], acc[4 * q + 1], acc[4 * q + 2], acc[4 * q + 3]}; \
        __syncthreads(); \
        S2_LOAD((C) + 2, UN_, PN_); \
        _Pragma("unroll") for (int q = 0; q < 4; ++q) { const f32x4 v0 = ex[((tj * 2) * 4 + q) * 64 + lane], v1 = ex[((tj * 2 + 1) * 4 + q) * 64 + lane]; \
            breg[4 * q] = v0[0] + v1[0]; breg[4 * q + 1] = v0[1] + v1[1]; breg[4 * q + 2] = v0[2] + v1[2]; breg[4 * q + 3] = v0[3] + v1[3]; } } while (0)
        S2_LOAD(0, ua, pa); S2_LOAD(1, ub, pb);
#pragma unroll 1
        for (int c = 0; c < NCH - 1; c += 3) {
            S2_STEP(c, ua, pa, uc2, pc2);
            S2_STEP(c + 1, ub, pb, ua, pa);
            S2_STEP(c + 2, uc2, pc2, ub, pb);
        }
        if (to == 0) { float* si = SI + (size_t)(NCH - 1) * 4096 + offs;
#pragma unroll
            for (int r = 0; r < 16; ++r) si[((r & 3) + 8 * (r >> 2)) * 64] = breg[r]; }
#undef S2_LOAD
#undef S2_STEP
    }
    __syncthreads();
}

template <int DV, bool SWA>
__device__ __forceinline__ void attn_unit(LAS unsigned char* lds, const bf16_t* Q, const bf16_t* Kp, const bf16_t* VT, float slope2, int q0, float sink2,
                                          float* Of32, float* MLp, bf16_t* Obf, const int tid, int kt_lo, int kt_hi, float kn) {
    constexpr int KROW = 144, KTILE = 64 * KROW, VTILE = DV * KROW, BUF = KTILE + VTILE, NVL = DV / 64;
    const int lane = tid & 63, w = __builtin_amdgcn_readfirstlane(tid >> 6), r32 = lane & 31, hi = lane >> 5;
    const int qpos = q0 + 32 * w + r32;
    bf16x8 qf[4];
#pragma unroll
    for (int j = 0; j < 4; ++j) qf[j] = *(const bf16x8*)(Q + (size_t)qpos * INCP + 16 * j + 8 * hi);
    int kt0 = kt_lo, kt1 = kt_hi;
    if (!SWA) {
        float qq = 0.f, qk = 0.f;
#pragma unroll
        for (int j = 0; j < 4; ++j) { const bf16x8 kf = *(const bf16x8*)(Kp + (size_t)qpos * INCP + 16 * j + 8 * hi);
#pragma unroll
            for (int e = 0; e < 8; ++e) { const float qv = bf2f((unsigned short)qf[j][e]), kv = bf2f((unsigned short)kf[e]); qq += qv * qv; qk += qv * kv; } }
        qq = xor32_sum(qq); qk = xor32_sum(qk);
        const float dneed = (sqrtf(qq) * kn - qk + 45.0f) / slope2;
        float kneed = (float)qpos - dneed;
        kneed = fminf(kneed, dppm<0xB1>(kneed)); kneed = fminf(kneed, dppm<0x4E>(kneed)); kneed = fminf(kneed, dppm<0x141>(kneed)); kneed = fminf(kneed, dppm<0x140>(kneed));
        LAS float* red = (LAS float*)(lds + 2 * BUF);
        if ((lane & 15) == 0) red[w * 4 + (lane >> 4)] = kneed;
        __syncthreads();
        float km = red[0];
#pragma unroll
        for (int i = 1; i < 32; ++i) km = fminf(km, red[i]);
        const int ktw = km <= 0.f ? 0 : ((int)km >> 6);
        kt0 = ktw > kt_lo ? ktw : kt_lo;
    }
    const int qlo = q0 + 32 * w, qhi = qlo + 31;
    f32x16 o[DV / 32];
#pragma unroll
    for (int d = 0; d < DV / 32; ++d)
#pragma unroll
        for (int r = 0; r < 16; ++r) o[d][r] = 0.f;
    float mrun = 0.f, lsum = 0.f;
    const int krow = tid >> 3, kch = tid & 7;
    u32x4 kreg, vreg[NVL];
    if (kt0 <= kt1) {   const int k0 = 64 * kt0; kreg = *(const u32x4*)(Kp + (size_t)(k0 + krow) * INCP + 8 * kch);
#pragma unroll
        for (int i = 0; i < NVL; ++i) { const int idx = tid + 512 * i; vreg[i] = *(const u32x4*)(VT + (size_t)(idx >> 3) * M + k0 + 8 * (idx & 7)); } }
    for (int kt = kt0; kt <= kt1; ++kt) {
        LAS unsigned char* buf = lds + ((kt - kt0) & 1) * BUF;
        *(LAS u32x4*)(buf + krow * KROW + 16 * kch) = kreg;
#pragma unroll
        for (int i = 0; i < NVL; ++i) { const int idx = tid + 512 * i; *(LAS u32x4*)(buf + KTILE + (idx >> 3) * KROW + 16 * (idx & 7)) = vreg[i]; }
        __syncthreads();
        if (kt < kt1) { const int k0 = 64 * (kt + 1); kreg = *(const u32x4*)(Kp + (size_t)(k0 + krow) * INCP + 8 * kch);
#pragma unroll
            for (int i = 0; i < NVL; ++i) { const int idx = tid + 512 * i; vreg[i] = *(const u32x4*)(VT + (size_t)(idx >> 3) * M + k0 + 8 * (idx & 7)); } }
        const int k0 = 64 * kt;
        bool act = k0 <= qhi; if (SWA) act = act && (k0 + 63 >= qlo - 127);
        if (act) {
            f32x16 p0, p1;
            {   const float c0 = slope2 * (float)(k0 + 4 * hi - qpos) - mrun, c1 = c0 + 32.0f * slope2;
#pragma unroll
                for (int r = 0; r < 16; ++r) { const float cr = (float)((r & 3) + 8 * (r >> 2)); p0[r] = __builtin_fmaf(slope2, cr, c0); p1[r] = __builtin_fmaf(slope2, cr, c1); } }
#pragma unroll
            for (int j = 0; j < 4; ++j) { const bf16x8 a0 = *(const LAS bf16x8*)(buf + r32 * KROW + 32 * j + 16 * hi), a1 = *(const LAS bf16x8*)(buf + (r32 + 32) * KROW + 32 * j + 16 * hi);
                p0 = __builtin_amdgcn_mfma_f32_32x32x16_bf16(a0, qf[j], p0, 0, 0, 0); p1 = __builtin_amdgcn_mfma_f32_32x32x16_bf16(a1, qf[j], p1, 0, 0, 0); }
            bool need_mask = k0 + 63 > qlo; if (SWA) need_mask = need_mask || (qhi - k0 >= 128);
            if (need_mask) {
#pragma unroll
                for (int r = 0; r < 16; ++r) { const int kv = k0 + (r & 3) + 8 * (r >> 2) + 4 * hi; const int d0 = qpos - kv, d1 = d0 - 32;
                    bool ok0 = d0 >= 0, ok1 = d1 >= 0; if (SWA) { ok0 = ok0 && d0 < 128; ok1 = ok1 && d1 < 128; }
                    p0[r] = ok0 ? p0[r] : -1e30f; p1[r] = ok1 ? p1[r] : -1e30f; } }
            float mx = fmaxf(p0[0], p1[0]);
#pragma unroll
            for (int r = 1; r < 16; ++r) mx = fmaxf(mx, fmaxf(p0[r], p1[r]));
            mx = xor32_max(mx);
            if (__builtin_amdgcn_ballot_w64(mx > 8.0f) != 0ull) {
                const float d = fmaxf(mx, 0.f), f = __builtin_amdgcn_exp2f(-d); mrun += d; lsum *= f;
#pragma unroll
                for (int r = 0; r < 16; ++r) { p0[r] -= d; p1[r] -= d; }
#pragma unroll
                for (int dd = 0; dd < DV / 32; ++dd)
#pragma unroll
                    for (int r = 0; r < 16; ++r) o[dd][r] *= f; }
            float rs = 0.f;
#pragma unroll
            for (int r = 0; r < 16; ++r) { p0[r] = __builtin_amdgcn_exp2f(p0[r]); p1[r] = __builtin_amdgcn_exp2f(p1[r]); rs += p0[r] + p1[r]; }
            lsum += rs;
            u32x4 pw[4];
            pw[0] = (u32x4){cvtpk(p0[0], p0[1]), cvtpk(p0[2], p0[3]), cvtpk(p0[4], p0[5]), cvtpk(p0[6], p0[7])};
            pw[1] = (u32x4){cvtpk(p0[8], p0[9]), cvtpk(p0[10], p0[11]), cvtpk(p0[12], p0[13]), cvtpk(p0[14], p0[15])};
            pw[2] = (u32x4){cvtpk(p1[0], p1[1]), cvtpk(p1[2], p1[3]), cvtpk(p1[4], p1[5]), cvtpk(p1[6], p1[7])};
            pw[3] = (u32x4){cvtpk(p1[8], p1[9]), cvtpk(p1[10], p1[11]), cvtpk(p1[12], p1[13]), cvtpk(p1[14], p1[15])};
#pragma unroll
            for (int d = 0; d < DV / 32; ++d)
#pragma unroll
                for (int j = 0; j < 4; ++j) { const bf16x8 vf = *(const LAS bf16x8*)(buf + KTILE + (32 * d + r32) * KROW + 32 * j + 16 * hi);
                    o[d] = __builtin_amdgcn_mfma_f32_32x32x16_bf16(vf, __builtin_bit_cast(bf16x8, pw[j]), o[d], 0, 0, 0); }
        }
    }
    lsum = xor32_sum(lsum);
    if (SWA) { lsum += __builtin_amdgcn_exp2f(sink2 - mrun);
        const float inv = 1.0f / lsum; bf16_t* op = Obf + (size_t)qpos * DM;
#pragma unroll
        for (int d = 0; d < DV / 32; ++d)
#pragma unroll
            for (int g = 0; g < 4; ++g) { u32x2 wv; wv.x = cvtpk(o[d][4 * g] * inv, o[d][4 * g + 1] * inv); wv.y = cvtpk(o[d][4 * g + 2] * inv, o[d][4 * g + 3] * inv);
                *(u32x2*)(op + 32 * d + 8 * g + 4 * hi) = wv; }
    } else { float* op = Of32 + (size_t)qpos * 1024;
#pragma unroll
        for (int d = 0; d < DV / 32; ++d)
#pragma unroll
            for (int g = 0; g < 4; ++g) *(f32x4*)(op + 32 * d + 8 * g + 4 * hi) = (f32x4){o[d][4 * g], o[d][4 * g + 1], o[d][4 * g + 2], o[d][4 * g + 3]};
        if (hi == 0) *(f32x2*)(MLp + (size_t)qpos * 16) = (f32x2){mrun, lsum};
    }
    __syncthreads();
}

__device__ __forceinline__ void phase_diffcombine(KP p, int l, int gw, int NGW, int lane) {
    const float* lamv = p->in[3] + l * 256;
    const float lambda_init = 0.8f - 0.6f * expf(-0.3f * (float)l);
    const float s1 = wave_sum(lamv[lane] * lamv[64 + lane]), s2 = wave_sum(lamv[128 + lane] * lamv[192 + lane]);
    const float lam = expf(s1) - expf(s2) + lambda_init;
    const float* OD = (const float*)(p->ws + WS_OD); const float* ML = (const float*)(p->ws + WS_ML); bf16_t* MIX = (bf16_t*)(p->ws + WS_MIX);
    const int h = lane >> 4, d0 = (lane & 15) * 8;
    const f32x4 g0 = *(const f32x4*)(p->in[4] + l * 128 + d0), g1 = *(const f32x4*)(p->in[4] + l * 128 + d0 + 4);
    for (int t = gw; t < M; t += NGW) { const int nseg = ((t >> 8) + 8) >> 3;
        f32x4 oc[2][2];
#pragma unroll
        for (int c = 0; c < 2; ++c) {
            f32x2 ml[4]; float mm = -1e30f;
#pragma unroll
            for (int s = 0; s < 4; ++s) if (s < nseg) { ml[s] = *(const f32x2*)(ML + ((size_t)s * M + t) * 16 + h * 4 + c * 2); mm = fmaxf(mm, ml[s].x); }
            f32x4 a0 = (f32x4){0.f, 0.f, 0.f, 0.f}, a1 = a0; float L = 0.f;
#pragma unroll
            for (int s = 0; s < 4; ++s) if (s < nseg) { const float f = exp2f(ml[s].x - mm); L += ml[s].y * f;
                const float* b = OD + ((size_t)s * M + t) * 1024 + h * 256 + c * 128 + d0; a0 += *(const f32x4*)b * f; a1 += *(const f32x4*)(b + 4) * f; }
            const float inv = 1.0f / L; oc[c][0] = a0 * inv; oc[c][1] = a1 * inv; }
        const f32x4 o0 = oc[0][0] - oc[1][0] * lam, o1 = oc[0][1] - oc[1][1] * lam;
        float ss = (o0[0] * o0[0] + o0[1] * o0[1]) + (o0[2] * o0[2] + o0[3] * o0[3]) + (o1[0] * o1[0] + o1[1] * o1[1]) + (o1[2] * o1[2] + o1[3] * o1[3]);
        ss = row16_sum(ss);
        const float r = rsqrtf(ss * (1.0f / 128.0f) + EPS) * (1.0f - lambda_init);
        const f32x4 y0 = o0 * g0 * r, y1 = o1 * g1 * r;
        u32x4 wv; wv.x = cvtpk(y0[0], y0[1]); wv.y = cvtpk(y0[2], y0[3]); wv.z = cvtpk(y1[0], y1[1]); wv.w = cvtpk(y1[2], y1[3]);
        *(u32x4*)(MIX + (size_t)t * DM + h * 128 + d0) = wv; }
}

#define XB_TMO      128
#define XB_XCNT(j)  (256  + 64 * (j))
#define XB_XSUB(j)  (1280 + 64 * (j))
#define XB_XGEN(j)  (2304 + 64 * (j))
#define XB_TOP      3328
#define XB_TOPGEN   3392
#define XCD_BAR_WORDS 3456
#define XB_SPIN_CAP (1u << 22)
__device__ __forceinline__ unsigned xb_ld(unsigned* p)              { return __hip_atomic_load(p, __ATOMIC_RELAXED, __HIP_MEMORY_SCOPE_AGENT); }
__device__ __forceinline__ unsigned xb_add(unsigned* p, unsigned v) { return __hip_atomic_fetch_add(p, v, __ATOMIC_RELAXED, __HIP_MEMORY_SCOPE_AGENT); }
__device__ __forceinline__ unsigned xb_xcc_id() { return (unsigned)__builtin_amdgcn_s_getreg((3 << 11) | 20) & 0xFu; }
#define XB_SPIN(cond, bar) do { unsigned _sp = 0; while (cond) { __builtin_amdgcn_s_sleep(1); \
    if ((++_sp & 255u) == 0u) { if (xb_ld(&(bar)[XB_TMO])) break; if (_sp > XB_SPIN_CAP) { atomicAdd(&(bar)[XB_TMO], 1u); break; } } } } while (0)
__device__ __forceinline__ void xcd_barrier_complete(unsigned* bar, unsigned x, unsigned& nloc, unsigned& nx) {
    const unsigned G = gridDim.x;
    unsigned sum, cnt, mine, sp = 0u;
    for (;;) {
        sum = 0u; cnt = 0u; mine = 0u;
#pragma unroll
        for (unsigned j = 0; j < 16; ++j) { const unsigned c = xb_ld(&bar[XB_XCNT(j)]); sum += c; cnt += (c > 0u) ? 1u : 0u; mine = (j == x) ? c : mine; }
        if (sum == G) break;
        __builtin_amdgcn_s_sleep(1);
        if ((++sp & 255u) == 0u) { if (xb_ld(&bar[XB_TMO])) break; if (sp > XB_SPIN_CAP) { atomicAdd(&bar[XB_TMO], 1u); break; } }
    }
    nloc = mine > 0u ? mine : 1u; nx = cnt > 0u ? cnt : 1u;
}
__device__ __forceinline__ void xcd_barrier(unsigned* bar, volatile LAS unsigned* st, const int tid) {
    asm volatile("s_waitcnt vmcnt(0)" ::: "memory");
    __syncthreads();
    if (tid == 0) {
        const unsigned x = xb_xcc_id();
        __builtin_amdgcn_s_waitcnt(0);
        unsigned nloc = st[0], nx = st[1];
        if (nloc == 0u) { xcd_barrier_complete(bar, x, nloc, nx); st[0] = nloc; st[1] = nx; }
        const unsigned old = xb_add(&bar[XB_XSUB(x)], 1u);
        const unsigned gen = old / nloc;
        if (old + 1u == (gen + 1u) * nloc) {
            __builtin_amdgcn_fence(__ATOMIC_RELEASE, "agent");
            asm volatile("s_waitcnt vmcnt(0)" ::: "memory");
            const unsigned og = xb_add(&bar[XB_TOP], 1u);
            const unsigned tg = og / nx;
            if (og + 1u == (tg + 1u) * nx) xb_add(&bar[XB_TOPGEN], 1u);
            else XB_SPIN(xb_ld(&bar[XB_TOPGEN]) == tg, bar);
            __builtin_amdgcn_fence(__ATOMIC_ACQUIRE, "agent");
            xb_add(&bar[XB_XGEN(x)], 1u);
            asm volatile("s_waitcnt vmcnt(0)" ::: "memory");
        } else {
            XB_SPIN(xb_ld(&bar[XB_XGEN(x)]) == gen, bar);
            __builtin_amdgcn_fence(__ATOMIC_ACQUIRE, "agent");
            asm volatile("s_waitcnt vmcnt(0)" ::: "memory");
        }
    }
    __syncthreads();
}

#ifndef DUPBAR
#define DUPBAR 1
#endif
#define GSYNC() do { FRESH(); for (int rb_ = 0; rb_ < DUPBAR; ++rb_) xcd_barrier((unsigned*)(p->ws + WS_CTL) + 4096, (volatile LAS unsigned*)(lds + LDS_BYTES - 32), tid); } while (0)
#define PTRS() unsigned* ctl = (unsigned*)(p->ws + WS_CTL); bf16_t* XB = (bf16_t*)(p->ws + WS_XB); bf16_t* PROJ = (bf16_t*)(p->ws + WS_PROJ); bf16_t* MIX = (bf16_t*)(p->ws + WS_MIX); bf16_t* H = (bf16_t*)(p->ws + WS_H); \
    float* ssqA = (float*)(p->ws + WS_SSQA); float* ssqB = (float*)(p->ws + WS_SSQB); unsigned char* wb = p->ws + WS_W + (size_t)l * LW_STRIDE; (void)ctl; (void)XB; (void)PROJ; (void)MIX; (void)H; (void)ssqA; (void)ssqB; (void)wb
#define FRESH() KP p = fresh_params(); int G = gridDim.x, bx = blockIdx.x; asm volatile("" : "+s"(G), "+s"(bx)); const int NGW = G * 8; (void)NGW; const int tid = fresh_tid(wave0), lane = tid & 63, wave = __builtin_amdgcn_readfirstlane(tid >> 6), gw = bx * 8 + wave; (void)lane; (void)gw
template <int L> __device__ __forceinline__ void layer_body(LAS unsigned char* lds, const int wave0) {
    constexpr int l = L;

#ifndef DUP1
#define DUP1 1
#endif
        for (int rep = 0; rep < DUP1; ++rep) {   if (rep) GSYNC(); FRESH(); PTRS(); pg8::Gemm g{XB, (const bf16_t*)(wb + LW_WIN), M, INCP, DM}; pg8::StaticOrder S; S.init(M, INCP, G, bx);
            pg8::EpiProj E{PROJ, INCP, ssqA};
            pg8::gemm_phase<pg8::EpiProj, pg8::StaticOrder, true, true>(lds, g, S, E, tid); }
        GSYNC();
#ifndef DUP234
#define DUP234 1
#endif
        for (int rep = 0; rep < DUP234; ++rep) { if (rep) GSYNC(); FRESH(); phase_prep1(p, l, lds, gw, NGW, wave, lane); }
        GSYNC();
        {   FRESH(); PTRS(); pg8::Gemm g{(const bf16_t*)(p->ws + WS_AW), (const bf16_t*)(wb + LW_W2T), M, 1024, 128}; pg8::StaticOrder S; S.init(M, 1024, G, bx);
            pg8::EpiLora<0> E{(float*)(p->ws + WS_DEC), p->in[7] + l * 1024};
            pg8::gemm_phase<pg8::EpiLora<0>, pg8::StaticOrder, true, true>(lds, g, S, E, tid); }
        {   FRESH(); PTRS(); pg8::Gemm g{(const bf16_t*)(p->ws + WS_AA), (const bf16_t*)(wb + LW_A2T), M, 1024, 128}; pg8::StaticOrder S; S.init(M, 1024, G, (bx + 128) % G);
            pg8::EpiLora<1> E{(float*)(p->ws + WS_A), p->in[9] + l * 1024};
            pg8::gemm_phase<pg8::EpiLora<1>, pg8::StaticOrder, true, true>(lds, g, S, E, tid); }
        {   FRESH(); PTRS(); pg8::Gemm g{(const bf16_t*)(p->ws + WS_AG), (const bf16_t*)(wb + LW_G2T), M, 1024, 256}; pg8::StaticOrder S; S.init(M, 1024, G, (bx + 128) % G);
            pg8::EpiLora<2> E{(float*)(p->ws + WS_G), nullptr};
            pg8::gemm_phase<pg8::EpiLora<2>, pg8::StaticOrder, true, true>(lds, g, S, E, tid); }
        GSYNC();
        {   FRESH(); LAS unsigned char* wl = lds + wave * 14336;
#ifndef DUP57
#define DUP57 1
#endif
#ifndef DUP5
#define DUP5 1
#endif
            for (int rep = 0; rep < DUP57 * DUP5; ++rep) for (int it = gw; it < 2 * NCH * 16; it += NGW) { const int mode = it & 1, ch = it >> 1, c = ch % NCH, h = ch / NCH;
                if (mode == 0) scan_task<0>(p, l, wl, c, h, lane); else scan_task<1>(p, l, wl, c, h, lane); } }
        GSYNC();
#ifndef DUP6
#define DUP6 1
#endif
        for (int rep = 0; rep < DUP6; ++rep) {   if (rep) GSYNC(); FRESH(); PTRS(); LAS int* slot = (LAS int*)(lds + LDS_BYTES - 64);
            LAS float* knl = (LAS float*)(lds + LDS_BYTES - 128);
            {   LAS float* kr = (LAS float*)lds; const float* knp = (const float*)(p->ws + WS_KNP); const int g = tid & 7, part = tid >> 3; float m = 0.f;
                for (int b2 = part; b2 < G; b2 += 64) m = fmaxf(m, knp[(size_t)b2 * 8 + g]);
                kr[part * 8 + g] = m; __syncthreads();
                if (tid < 8) { float mm = kr[tid]; for (int q2 = 1; q2 < 64; ++q2) mm = fmaxf(mm, kr[q2 * 8 + tid]); knl[tid] = mm; }
                __syncthreads(); }
            const float* sinks = p->in[5] + l * 8;
            for (;;) {
                if (tid == 0) *slot = (int)atomicAdd(ctl + 64 * (l + 1) + 16 * rep, 1u);
                __syncthreads();
                const int it = *slot;
                __syncthreads();
                if (it >= 928) break;
                if (it < 32) {
#ifndef NO_S2
                    s2_head(p, lds, it >> 1, it & 1, tid);
#endif
                }
                else if (it < 672) { const int d = it - 32, h = 3 - d / 160, u = d % 160, c = u & 1, v = u >> 1; int qb, seg;
                    if (v < 32) { qb = 31 - (v >> 2); seg = v & 3; } else if (v < 56) { const int w2 = v - 32; qb = 23 - w2 / 3; seg = w2 % 3; }
                    else if (v < 72) { const int w2 = v - 56; qb = 15 - (w2 >> 1); seg = w2 & 1; } else { qb = 79 - v; seg = 0; }
                    const float slope2 = exp2f(-2.0f * (float)(h + 1)) * LOG2E;
                    const float kn = sqrtf(knl[h * 2 + c]);
                    const int kt1 = 4 * qb + 3, klo = 32 * seg, khi = (klo + 31 < kt1) ? klo + 31 : kt1;
                    attn_unit<128, false>(lds, PROJ + h * 128 + c * 64, PROJ + 512 + h * 128 + c * 64, (const bf16_t*)(p->ws + WS_VAT) + (size_t)(h * 128) * M, slope2, qb * 256, 0.f,
                                          (float*)(p->ws + WS_OD) + (size_t)seg * M * 1024 + h * 256 + c * 128, (float*)(p->ws + WS_ML) + (size_t)seg * M * 16 + h * 4 + c * 2, nullptr, tid, klo, khi, kn); }
                else { const int s = it - 672, hq = s & 7, qb = s >> 3;
                    const int aidx = (hq >> 1) * 3 + (hq & 1);
                    const float slope2 = exp2f(-8.0f * (float)(aidx + 1) / 12.0f) * LOG2E;
                    const int q0 = qb * 256;
                    attn_unit<64, true>(lds, PROJ + 1536 + hq * 64, PROJ + 2048 + (hq >> 2) * 64, (const bf16_t*)(p->ws + WS_VBT) + (size_t)((hq >> 2) * 64) * M, slope2, q0, sinks[hq] * LOG2E,
                                        nullptr, nullptr, MIX + 512 + hq * 64, tid, q0 >= 128 ? (q0 - 128) / 64 : 0, (q0 + 255) / 64, 0.f); }
            } }
        GSYNC();
        {   FRESH();
            if (wave < 4) {
                LAS unsigned char* wl = lds + wave * 14336;
                for (int rep = 0; rep < DUP57; ++rep) for (int it = bx * 4 + wave; it < NCH * 16; it += G * 4) { const int c = it % NCH, h = it / NCH; scan_task<2>(p, l, wl, c, h, lane); }
            } else {
                phase_diffcombine(p, l, bx * 4 + (wave - 4), G * 4, lane);
                if (l + 1 < NL) { LAS float* scr = (LAS float*)(lds + 4 * 14336 + (wave - 4) * 8448);
                    for (int r = bx * 4 + (wave - 4); r < CONV_ITEMS; r += G * 4) convert_item(p, l + 1 < NL ? l + 1 : l, r, scr, lane); }
            } }
        GSYNC();
        {   FRESH(); PTRS(); pg8::Gemm g{MIX, (const bf16_t*)(wb + LW_WOUT), M, DM, DM}; pg8::StaticOrder S; S.init(M, DM, G, bx);
            pg8::EpiResid E{p->out, XB, ssqB};
            pg8::gemm_phase<pg8::EpiResid, pg8::StaticOrder, true, true>(lds, g, S, E, tid); }
        GSYNC();
        for (int rep = 0; rep < DUP1; ++rep) {   if (rep) GSYNC(); FRESH(); PTRS(); pg8::Gemm g{XB, (const bf16_t*)(wb + LW_WGU), M, GU, DM}; pg8::StaticOrder S; S.init(M, GU, G, bx);
            pg8::EpiSwiGLU E{H, ssqB};
            pg8::gemm_phase<pg8::EpiSwiGLU, pg8::StaticOrder, true, true>(lds, g, S, E, tid); }
        GSYNC();
        {   FRESH(); PTRS(); pg8::Gemm g{H, (const bf16_t*)(wb + LW_WDN), M, DM, FF}; pg8::StaticOrder S; S.init(M, DM, G, bx);
            pg8::EpiResid E{p->out, XB, ssqA};
            pg8::gemm_phase<pg8::EpiResid, pg8::StaticOrder, true, true>(lds, g, S, E, tid); }
        GSYNC();
    }

__global__ void __launch_bounds__(512, 2) fwd_megakernel(Params p_unused) {
    extern __shared__ __attribute__((aligned(16))) unsigned char lds_raw[];
    LAS unsigned char* lds = (LAS unsigned char*)lds_raw;
    cg::grid_group grid = cg::this_grid();
    const int wave0 = __builtin_amdgcn_readfirstlane((int)threadIdx.x >> 6);
    if (threadIdx.x < 16) ((LAS unsigned*)(lds + LDS_BYTES - 64))[threadIdx.x] = 0u;
    if (threadIdx.x == 0) xb_add((unsigned*)(p_unused.ws + WS_CTL) + 4096 + XB_XCNT(xb_xcc_id()), 1u);
    __syncthreads();

#ifndef DUP0
#define DUP0 1
#endif
    for (int rep = 0; rep < DUP0; ++rep) { FRESH(); phase0(p, lds, gw, NGW, wave, lane); __syncthreads(); }
    grid.sync();

    layer_body<0>(lds, wave0); layer_body<1>(lds, wave0); layer_body<2>(lds, wave0); layer_body<3>(lds, wave0);
    {   FRESH(); const int l = 0; PTRS(); const float* gf = p->in[21];
        for (int m = gw; m < M; m += NGW) { const float rs = rsqrtf(wave_sum(lane < 32 ? ssqA[(size_t)m * 32 + lane] : 0.f) * (1.0f / DM) + EPS);
#pragma unroll
            for (int j = 0; j < 8; ++j) { const size_t o = (size_t)m * DM + j * 256 + lane * 4; const f32x4 v = *(const f32x4*)(p->out + o); const f32x4 gv = *(const f32x4*)(gf + j * 256 + lane * 4);
                *(f32x4*)(p->out + o) = v * rs * gv; } } }
}

extern "C" void kernel_launch(void* const* d_in, const int* in_sizes, int n_in, void* d_out, int out_size, void* d_ws, size_t ws_size, hipStream_t stream) {
    static int grid = 0;
    if (grid == 0) {
        if (n_in != 22 || out_size != M * DM || ws_size < WS_END) { fprintf(stderr, "kernel_launch: unexpected shapes (n_in %d out %d ws %zu need %zu)\n", n_in, out_size, ws_size, (size_t)WS_END); grid = -1; return; }
        int dev = 0, cus = 0, per_cu = 0;
        hipGetDevice(&dev); hipDeviceGetAttribute(&cus, hipDeviceAttributeMultiprocessorCount, dev);
        hipFuncSetAttribute((const void*)fwd_megakernel, hipFuncAttributeMaxDynamicSharedMemorySize, LDS_BYTES);
        hipOccupancyMaxActiveBlocksPerMultiprocessor(&per_cu, (const void*)fwd_megakernel, 512, LDS_BYTES);
        if (per_cu < 1) { fprintf(stderr, "kernel_launch: occupancy query says %d blocks per CU\n", per_cu); per_cu = 1; }
        (void)hipGetLastError();
        grid = cus;
    }
    if (grid < 0) return;
    hipMemsetAsync((char*)d_ws + WS_CTL, 0, 65536, stream);
    Params p{};
    for (int i = 0; i < 22; ++i) p.in[i] = (const float*)d_in[i];
    p.out = (float*)d_out; p.ws = (unsigned char*)d_ws;
    void* args[] = {&p};
    hipError_t e = hipLaunchCooperativeKernel((const void*)fwd_megakernel, dim3(grid), dim3(512), args, LDS_BYTES, stream);
    if (e != hipSuccess) fprintf(stderr, "cooperative launch failed: %s (grid %d)\n", hipGetErrorString(e), grid);
}
```

```cpp
#include <hip/hip_runtime.h>
#include <hip/hip_cooperative_groups.h>
#include <cstdio>
#include <cstdint>
namespace cg = cooperative_groups;

#define LAS __attribute__((address_space(3)))
typedef unsigned short bf16_t;
typedef short bf16x8 __attribute__((ext_vector_type(8)));
typedef float f32x4 __attribute__((ext_vector_type(4)));
typedef float f32x2 __attribute__((ext_vector_type(2)));
typedef float f32x16 __attribute__((ext_vector_type(16)));
typedef unsigned u32x4 __attribute__((ext_vector_type(4)));
typedef unsigned u32x2 __attribute__((ext_vector_type(2)));
typedef __bf16 bf16x2_t __attribute__((ext_vector_type(2)));

constexpr int M = 8192, DM = 2048, INC = 5824, INCP = 5888, FF = 5632, GU = 11264, RW0 = 2304, RWC = 3520;
constexpr int NL = 4, NCH = 64, CL = 128;
constexpr float EPS = 1e-5f, LOG2E = 1.4426950408889634f;
constexpr float QSC = 0.125f * LOG2E;

constexpr size_t MiB = 1u << 20;
constexpr size_t SZ_WIN = (size_t)INCP * DM * 2, SZ_WOUT = (size_t)DM * DM * 2, SZ_WGU = (size_t)GU * DM * 2, SZ_WDN = (size_t)DM * FF * 2;
constexpr size_t SZ_W2T = 1024 * 128 * 2, SZ_G2T = 1024 * 256 * 2;
constexpr size_t LW_WIN = 0, LW_WOUT = LW_WIN + SZ_WIN, LW_WGU = LW_WOUT + SZ_WOUT, LW_WDN = LW_WGU + SZ_WGU, LW_W2T = LW_WDN + SZ_WDN,
                 LW_A2T = LW_W2T + SZ_W2T, LW_G2T = LW_A2T + SZ_W2T, LW_STRIDE = LW_G2T + SZ_G2T;
constexpr size_t SZ_F = (size_t)M * 1024 * 4;
constexpr size_t WS_CTL = 0, WS_W = 1 * MiB, WS_XB = WS_W + NL * LW_STRIDE, WS_PROJ = WS_XB + (size_t)M * DM * 2,
                 WS_VAT = WS_PROJ + (size_t)M * INCP * 2, WS_VBT = WS_VAT + (size_t)512 * M * 2, WS_AW = WS_VBT + (size_t)128 * M * 2,
                 WS_AA = WS_AW + (size_t)M * 128 * 2, WS_AG = WS_AA + (size_t)M * 128 * 2, WS_R = WS_AG + (size_t)M * 256 * 2,
                 WS_KR = WS_R + SZ_F, WS_V = WS_KR + SZ_F, WS_DEC = WS_V + SZ_F, WS_A = WS_DEC + SZ_F, WS_G = WS_A + SZ_F,
                 WS_KF = WS_G + SZ_F, WS_AN = WS_KF + SZ_F, WS_BB = WS_AN + SZ_F, WS_PB = WS_BB + SZ_F, WS_UB = WS_PB + SZ_F,
                 WS_SI = WS_UB + SZ_F, WS_OD = WS_SI + SZ_F, WS_ML = WS_OD + 4 * SZ_F, WS_KNP = WS_ML + (size_t)4 * M * 16 * 4, WS_MIX = WS_KNP + 65536, WS_SSQA = WS_MIX + (size_t)M * DM * 2,
                 WS_SSQB = WS_SSQA + (size_t)M * 32 * 4, WS_END = WS_SSQB + (size_t)M * 32 * 4;
constexpr size_t WS_H = WS_PROJ;
static_assert((size_t)M * FF * 2 <= (size_t)M * INCP * 2, "H overlay");

constexpr int LDS_BYTES = 147456;

struct Params { const float* in[22]; float* out; unsigned char* ws; };
typedef const __attribute__((address_space(4))) Params* KP;
__device__ __forceinline__ KP fresh_params() { KP k = (KP)__builtin_amdgcn_kernarg_segment_ptr(); asm volatile("" : "+s"(k)); return k; }

__device__ __forceinline__ unsigned cvtpk(float lo, float hi) { f32x2 v = {lo, hi}; bf16x2_t b = __builtin_convertvector(v, bf16x2_t); return __builtin_bit_cast(unsigned, b); }
__device__ __forceinline__ float bf2f(unsigned short b) { return __builtin_bit_cast(float, (unsigned)b << 16); }
__device__ __forceinline__ float bflo(unsigned w) { return __builtin_bit_cast(float, w << 16); }
__device__ __forceinline__ float bfhi(unsigned w) { return __builtin_bit_cast(float, w & 0xffff0000u); }
template <int CTRL> __device__ __forceinline__ float dppm(float v) { return __builtin_bit_cast(float, __builtin_amdgcn_mov_dpp(__builtin_bit_cast(int, v), CTRL, 0xF, 0xF, true)); }
__device__ __forceinline__ float xor16_sum(float v) { const unsigned b = __builtin_bit_cast(unsigned, v); auto rr = __builtin_amdgcn_permlane16_swap(b, b, false, false); return __builtin_bit_cast(float, (unsigned)rr[0]) + __builtin_bit_cast(float, (unsigned)rr[1]); }
__device__ __forceinline__ float xor32_sum(float v) { const unsigned b = __builtin_bit_cast(unsigned, v); auto rr = __builtin_amdgcn_permlane32_swap(b, b, false, false); return __builtin_bit_cast(float, (unsigned)rr[0]) + __builtin_bit_cast(float, (unsigned)rr[1]); }
__device__ __forceinline__ float xor32_max(float v) { const unsigned b = __builtin_bit_cast(unsigned, v); auto rr = __builtin_amdgcn_permlane32_swap(b, b, false, false); return fmaxf(__builtin_bit_cast(float, (unsigned)rr[0]), __builtin_bit_cast(float, (unsigned)rr[1])); }
__device__ __forceinline__ float row16_sum(float v) { v += dppm<0xB1>(v); v += dppm<0x4E>(v); v += dppm<0x141>(v); v += dppm<0x140>(v); return v; }
__device__ __forceinline__ float wave_sum(float v) { return xor32_sum(xor16_sum(row16_sum(v))); }
__device__ __forceinline__ float dpp_xor1(float v) { return __builtin_bit_cast(float, __builtin_amdgcn_mov_dpp(__builtin_bit_cast(int, v), 0xB1, 0xF, 0xF, true)); }
__device__ __forceinline__ float dpp_xor2(float v) { return __builtin_bit_cast(float, __builtin_amdgcn_mov_dpp(__builtin_bit_cast(int, v), 0x4E, 0xF, 0xF, true)); }
__device__ __forceinline__ float quad_sum(float v) { v += dpp_xor1(v); v += dpp_xor2(v); return v; }
__device__ __forceinline__ float sigmoidf_(float x) { return __builtin_amdgcn_rcpf(1.0f + __expf(-x)); }

__device__ __forceinline__ int fresh_tid(int wave0) { unsigned z = 0u; asm volatile("" : "+v"(z)); int t = wave0 * 64 + (int)__builtin_amdgcn_mbcnt_hi(~0u, __builtin_amdgcn_mbcnt_lo(~0u, z)); asm volatile("" : "+v"(t)); return t; }

__device__ __forceinline__ float row_rstd(const float* ssq, int row, int fq) {
    const float* pp = ssq + (size_t)row * 32 + 8 * fq; const f32x4 a = *(const f32x4*)pp, b = *(const f32x4*)(pp + 4);
    float s = ((a[0] + a[1]) + (a[2] + a[3])) + ((b[0] + b[1]) + (b[2] + b[3]));
    s = xor32_sum(xor16_sum(s));
    return rsqrtf(s * (1.0f / DM) + EPS);
}

namespace pg8 {
constexpr int BM = 256, BK = 64, HALF = 128, HTB = HALF * BK * 2, STAGE_BYTES = 8 * HTB, NXCD = 8, WGM = 8;
__host__ __device__ __forceinline__ int lds_byte(int r, int c) { const int st = (r >> 4) * 2 + (c >> 5), rr = r & 15, cc = c & 31, ob = rr * 64 + cc * 2; return st * 1024 + (ob ^ (((ob >> 9) & 1) << 5)); }
__host__ __device__ __forceinline__ void stage_rc(int b, int& R, int& C) { const int st = b / 1024, sb = b % 1024, swz = sb ^ (((sb >> 9) & 1) << 5); R = (st >> 1) * 16 + swz / 64; C = (st & 1) * 32 + (swz % 64) / 2; }
__host__ __device__ __forceinline__ int perm32(int rho) { const int n = rho >> 4, i = rho & 15; return 8 * (i >> 2) + 4 * n + (i & 3); }
struct Unit { int pm, pn; };
struct Gemm { const bf16_t* A; const bf16_t* Bt; int M, N, K; };
struct StaticOrder {
    int nM, nN, nwg, G, c;
    __host__ __device__ void init(int M_, int N_, int G_, int c_) { nM = M_ / BM; nN = N_ / BM; nwg = nM * nN; G = G_; c = c_; }
    __host__ __device__ bool next(int i, Unit& u) const {
        const long L = (long)i * G + c; if (L >= nwg) return false;
        int wgid = (int)L; { const int q = nwg / NXCD, r = nwg % NXCD, xcd = wgid % NXCD, off = wgid / NXCD; wgid = (xcd < r ? xcd * (q + 1) : r * (q + 1) + (xcd - r) * q) + off; }
        const int nig = WGM * nN, gid = wgid / nig, fm = gid * WGM, gsz = (nM - fm) < WGM ? (nM - fm) : WGM;
        u.pm = fm + ((wgid % nig) % gsz); u.pn = (wgid % nig) / gsz; return true;
    }
};

template <class Epi, class Sched, bool ALIGN_EPI, bool SP2>
__device__ __forceinline__ void gemm_phase(LAS unsigned char* lds, const Gemm g, const Sched& S, const Epi& E, const int tid) {
    const int wid = __builtin_amdgcn_readfirstlane(tid >> 6), lane = tid & 63, wr = wid >> 2, wc = wid & 3, fr = lane & 15, fq = lane >> 4;
    const int K = g.K, nt = K / BK;
    unsigned voffA[2], voffB[2];
#pragma unroll
    for (int i = 0; i < 2; ++i) { int R, C; stage_rc(tid * 16 + i * 8192, R, C); const int Rb = Epi::PERM ? ((R & ~31) + perm32(R & 31)) : R;
        voffA[i] = (unsigned)(R * K + C) * 2u; voffB[i] = (unsigned)(Rb * K + C) * 2u; }
    const size_t kstep = (size_t)(BK * 2);
    const size_t hstep = (size_t)HALF * K * 2;
    const size_t tstep = 2 * hstep;
    const unsigned ldsw = (unsigned)wid * 1024u;
    const int aoff = lds_byte(wr * 64 + fr, fq * 8), boff = lds_byte(wc * 32 + fr, fq * 8);
#define PG8_SA(b, h) (((b) * 2 + (h)) * HTB)
#define PG8_SB(b, h) ((4 + (b) * 2 + (h)) * HTB)
#define PG8_STAGE(bufoff, gbase, voff) do { _Pragma("unroll") for (int _i = 0; _i < 2; ++_i) \
        __builtin_amdgcn_global_load_lds((const unsigned*)((const char*)(gbase) + (voff)[_i]), (LAS unsigned*)(lds + (bufoff) + ldsw + _i * 8192), 16, 0, 0); } while (0)
#define PG8_LDA(dst, b, h) do { _Pragma("unroll") for (int m = 0; m < 4; ++m) _Pragma("unroll") for (int k = 0; k < 2; ++k) dst[m][k] = *(const LAS bf16x8*)(lds + PG8_SA(b, h) + aoff + m * 2048 + k * 1024); } while (0)
#define PG8_LDB(dst, b, h) do { _Pragma("unroll") for (int n = 0; n < 2; ++n) _Pragma("unroll") for (int k = 0; k < 2; ++k) dst[n][k] = *(const LAS bf16x8*)(lds + PG8_SB(b, h) + boff + n * 2048 + k * 1024); } while (0)
#define PG8_MMA(ai, bj, At, Bt) do { __builtin_amdgcn_s_setprio(1); _Pragma("unroll") for (int m = 0; m < 4; ++m) _Pragma("unroll") for (int n = 0; n < 2; ++n) _Pragma("unroll") for (int k = 0; k < 2; ++k) \
        acc[ai][bj][m][n] = __builtin_amdgcn_mfma_f32_16x16x32_bf16(Bt[n][k], At[m][k], acc[ai][bj][m][n], 0, 0, 0); __builtin_amdgcn_s_setprio(0); } while (0)
#define PG8_WAIT_V(n) asm volatile("s_waitcnt vmcnt(" #n ")" ::: "memory")
#define PG8_WAIT_L(n) asm volatile("s_waitcnt lgkmcnt(" #n ")" ::: "memory")
#define PG8_BAR __builtin_amdgcn_s_barrier()
#define PG8_SCHED __builtin_amdgcn_sched_barrier(0)
    Unit cur, nxt; int ui = 0;
    if (!S.next(0, cur)) return;
    f32x4 acc[2][2][4][2];
#pragma unroll
    for (int a = 0; a < 2; ++a)
#pragma unroll
        for (int b = 0; b < 2; ++b)
#pragma unroll
            for (int m = 0; m < 4; ++m)
#pragma unroll
                for (int n = 0; n < 2; ++n) acc[a][b][m][n] = (f32x4){0.f, 0.f, 0.f, 0.f};
    bf16x8 At[4][2], B0[2][2], B1[2][2];
    const char* cA = (const char*)g.A + (size_t)cur.pm * tstep; const char* cB = (const char*)g.Bt + (size_t)cur.pn * tstep;
    if constexpr (SP2) {
        PG8_STAGE(PG8_SB(0, 0), cB, voffB); PG8_STAGE(PG8_SB(0, 1), cB + hstep, voffB); PG8_STAGE(PG8_SA(0, 0), cA, voffA); PG8_STAGE(PG8_SA(0, 1), cA + hstep, voffA);
        if (wr == 1) PG8_BAR;
        PG8_WAIT_V(2); PG8_BAR;
        PG8_STAGE(PG8_SB(1, 0), cB + kstep, voffB); PG8_STAGE(PG8_SA(1, 0), cA + kstep, voffA); PG8_STAGE(PG8_SB(1, 1), cB + hstep + kstep, voffB);
        PG8_WAIT_V(6); PG8_BAR;
    } else {
        PG8_STAGE(PG8_SB(0, 0), cB, voffB); PG8_STAGE(PG8_SA(0, 0), cA, voffA); PG8_STAGE(PG8_SB(0, 1), cB + hstep, voffB); PG8_STAGE(PG8_SA(0, 1), cA + hstep, voffA);
        if (wr == 1) PG8_BAR;
        PG8_WAIT_V(4); PG8_BAR;
        PG8_STAGE(PG8_SB(1, 0), cB + kstep, voffB); PG8_STAGE(PG8_SA(1, 0), cA + kstep, voffA); PG8_STAGE(PG8_SB(1, 1), cB + hstep + kstep, voffB);
        PG8_WAIT_V(6); PG8_BAR;
    }
    for (;;) {
        const bool has_next = S.next(ui + 1, nxt);
        const char* nA = has_next ? (const char*)g.A + (size_t)nxt.pm * tstep : cA; const char* nB = has_next ? (const char*)g.Bt + (size_t)nxt.pn * tstep : cB;
        for (int t = 0; t < nt; t += 2) {
            const bool last = (t == nt - 2);
            const char* a1 = cA + (size_t)(t + 1) * kstep;
            const char* a2 = last ? nA : cA + (size_t)(t + 2) * kstep; const char* b2 = last ? nB : cB + (size_t)(t + 2) * kstep;
            const char* a3 = a2 + kstep; const char* b3 = b2 + kstep;
            if constexpr (SP2) {
            PG8_LDB(B0, 0, 0); PG8_LDB(B1, 0, 1); PG8_SCHED; PG8_LDA(At, 0, 0); PG8_STAGE(PG8_SA(1, 1), a1 + hstep, voffA);
            PG8_WAIT_V(8); PG8_WAIT_L(0); PG8_BAR; PG8_MMA(0, 0, At, B0); PG8_MMA(0, 1, At, B1); PG8_BAR; PG8_SCHED;
            PG8_LDA(At, 0, 1); PG8_STAGE(PG8_SB(0, 0), b2, voffB); PG8_STAGE(PG8_SB(0, 1), b2 + hstep, voffB); PG8_STAGE(PG8_SA(0, 0), a2, voffA);
            PG8_WAIT_V(8); PG8_WAIT_L(0); PG8_BAR; PG8_MMA(1, 0, At, B0); PG8_MMA(1, 1, At, B1); PG8_BAR; PG8_SCHED;
            PG8_LDB(B0, 1, 0); PG8_LDB(B1, 1, 1); PG8_SCHED; PG8_LDA(At, 1, 0); PG8_STAGE(PG8_SA(0, 1), a2 + hstep, voffA);
            PG8_WAIT_V(8); PG8_WAIT_L(0); PG8_BAR; PG8_MMA(0, 0, At, B0); PG8_MMA(0, 1, At, B1); PG8_BAR; PG8_SCHED;
            PG8_LDA(At, 1, 1); PG8_STAGE(PG8_SB(1, 0), b3, voffB); PG8_STAGE(PG8_SB(1, 1), b3 + hstep, voffB); PG8_STAGE(PG8_SA(1, 0), a3, voffA);
            PG8_WAIT_V(8); PG8_WAIT_L(0); PG8_BAR; PG8_MMA(1, 0, At, B0); PG8_MMA(1, 1, At, B1); PG8_BAR; PG8_SCHED;
            } else {
            PG8_LDB(B0, 0, 0); PG8_SCHED; PG8_LDA(At, 0, 0); PG8_STAGE(PG8_SA(1, 1), a1 + hstep, voffA);
            PG8_WAIT_L(8); PG8_BAR; PG8_WAIT_L(0); PG8_MMA(0, 0, At, B0); PG8_BAR; PG8_SCHED;
            PG8_LDB(B1, 0, 1); PG8_STAGE(PG8_SB(0, 0), b2, voffB);
            PG8_BAR; PG8_WAIT_L(0); PG8_MMA(0, 1, At, B1); PG8_BAR;
            PG8_LDA(At, 0, 1); PG8_STAGE(PG8_SA(0, 0), a2, voffA);
            PG8_BAR; PG8_WAIT_L(0); PG8_MMA(1, 0, At, B0); PG8_BAR; PG8_SCHED;
            PG8_STAGE(PG8_SB(0, 1), b2 + hstep, voffB);
            PG8_WAIT_V(6); PG8_BAR; PG8_MMA(1, 1, At, B1); PG8_BAR;
            PG8_LDB(B0, 1, 0); PG8_SCHED; PG8_LDA(At, 1, 0); PG8_STAGE(PG8_SA(0, 1), a2 + hstep, voffA);
            PG8_WAIT_L(8); PG8_BAR; PG8_WAIT_L(0); PG8_MMA(0, 0, At, B0); PG8_BAR; PG8_SCHED;
            PG8_LDB(B1, 1, 1); PG8_STAGE(PG8_SB(1, 0), b3, voffB);
            PG8_BAR; PG8_WAIT_L(0); PG8_MMA(0, 1, At, B1); PG8_BAR;
            PG8_LDA(At, 1, 1); PG8_STAGE(PG8_SA(1, 0), a3, voffA);
            PG8_BAR; PG8_WAIT_L(0); PG8_MMA(1, 0, At, B0); PG8_BAR; PG8_SCHED;
            PG8_STAGE(PG8_SB(1, 1), b3 + hstep, voffB);
            PG8_WAIT_V(6); PG8_BAR; PG8_MMA(1, 1, At, B1); PG8_BAR;
            }
        }
        if constexpr (ALIGN_EPI) { if (wr == 0) PG8_BAR; }
        E(acc, cur, wr, wc, fr, fq);
        if (!has_next) break;
#pragma unroll
        for (int a = 0; a < 2; ++a)
#pragma unroll
            for (int b = 0; b < 2; ++b)
#pragma unroll
                for (int m = 0; m < 4; ++m)
#pragma unroll
                    for (int n = 0; n < 2; ++n) acc[a][b][m][n] = (f32x4){0.f, 0.f, 0.f, 0.f};
        cur = nxt; cA = nA; cB = nB; ++ui;
        if constexpr (ALIGN_EPI) { if (wr == 1) PG8_BAR; }
    }
    PG8_WAIT_V(0);
    if constexpr (!ALIGN_EPI) { if (wr == 0) PG8_BAR; }
    PG8_BAR;
#undef PG8_SA
#undef PG8_SB
#undef PG8_STAGE
#undef PG8_LDA
#undef PG8_LDB
#undef PG8_MMA
#undef PG8_WAIT_V
#undef PG8_WAIT_L
#undef PG8_BAR
#undef PG8_SCHED
}

struct EpiProj {
    static constexpr bool PERM = true;
    bf16_t* O; int ldc; const float* ssq;
    __device__ __forceinline__ void operator()(const f32x4 (&acc)[2][2][4][2], const Unit& u, int wr, int wc, int fr, int fq) const {
        const int row0 = u.pm * BM + wr * 64 + fr, col0 = u.pn * BM + wc * 32 + 8 * fq;
#pragma unroll
        for (int ai = 0; ai < 2; ++ai)
#pragma unroll
            for (int m = 0; m < 4; ++m) { const int row = row0 + ai * HALF + m * 16; const float rs = row_rstd(ssq, row, fq);
                bf16_t* rowp = O + (size_t)row * ldc + col0;
#pragma unroll
                for (int bj = 0; bj < 2; ++bj) { const f32x4 v0 = acc[ai][bj][m][0] * rs, v1 = acc[ai][bj][m][1] * rs;
                    u32x4 w; w.x = cvtpk(v0[0], v0[1]); w.y = cvtpk(v0[2], v0[3]); w.z = cvtpk(v1[0], v1[1]); w.w = cvtpk(v1[2], v1[3]);
                    *(u32x4*)(rowp + bj * HALF) = w; } }
    }
};
struct EpiSwiGLU {
    static constexpr bool PERM = true;
    bf16_t* O; const float* ssq;
    __device__ __forceinline__ void operator()(const f32x4 (&acc)[2][2][4][2], const Unit& u, int wr, int wc, int fr, int fq) const {
        const int row0 = u.pm * BM + wr * 64 + fr, col0 = u.pn * HALF + wc * 32 + 8 * fq;
#pragma unroll
        for (int ai = 0; ai < 2; ++ai)
#pragma unroll
            for (int m = 0; m < 4; ++m) { const int row = row0 + ai * HALF + m * 16; const float rs = row_rstd(ssq, row, fq);
                float h[8];
#pragma unroll
                for (int n = 0; n < 2; ++n)
#pragma unroll
                    for (int j = 0; j < 4; ++j) { const float gt = acc[ai][0][m][n][j] * rs, up = acc[ai][1][m][n][j] * rs; h[n * 4 + j] = gt * up * __builtin_amdgcn_rcpf(1.0f + __expf(-gt)); }
                u32x4 w; w.x = cvtpk(h[0], h[1]); w.y = cvtpk(h[2], h[3]); w.z = cvtpk(h[4], h[5]); w.w = cvtpk(h[6], h[7]);
                *(u32x4*)(O + (size_t)row * FF + col0) = w; }
    }
};
struct EpiResid {
    static constexpr bool PERM = false;
    float* X; bf16_t* XB; float* ssq;
    __device__ __forceinline__ void operator()(const f32x4 (&acc)[2][2][4][2], const Unit& u, int wr, int wc, int fr, int fq) const {
        const int row0 = u.pm * BM + wr * 64 + fr, col0 = u.pn * BM + wc * 32 + 4 * fq;
#pragma unroll
        for (int ai = 0; ai < 2; ++ai)
#pragma unroll
            for (int m = 0; m < 4; ++m) { const int row = row0 + ai * HALF + m * 16; const size_t off = (size_t)row * DM + col0; float ss = 0.f;
#pragma unroll
                for (int bj = 0; bj < 2; ++bj)
#pragma unroll
                    for (int n = 0; n < 2; ++n) { const size_t o = off + bj * HALF + n * 16; const f32x4 xv = *(const f32x4*)(X + o) + acc[ai][bj][m][n];
                        *(f32x4*)(X + o) = xv; u32x2 w; w.x = cvtpk(xv[0], xv[1]); w.y = cvtpk(xv[2], xv[3]); *(u32x2*)(XB + o) = w;
                        ss += (xv[0] * xv[0] + xv[1] * xv[1]) + (xv[2] * xv[2] + xv[3] * xv[3]); }
                ss = xor32_sum(xor16_sum(ss));
                if (fq == 0) ssq[(size_t)row * 32 + u.pn * 4 + wc] = ss; }
    }
};
template <int MODE> struct EpiLora {
    static constexpr bool PERM = false;
    float* O; const float* bias;
    __device__ __forceinline__ void operator()(const f32x4 (&acc)[2][2][4][2], const Unit& u, int wr, int wc, int fr, int fq) const {
        const int row0 = u.pm * BM + wr * 64 + fr, col0 = u.pn * BM + wc * 32 + 4 * fq;
#pragma unroll
        for (int bj = 0; bj < 2; ++bj)
#pragma unroll
            for (int n = 0; n < 2; ++n) { const int col = col0 + bj * HALF + n * 16;
                f32x4 bv = (f32x4){0.f, 0.f, 0.f, 0.f}; if (MODE != 2) bv = *(const f32x4*)(bias + col);
#pragma unroll
                for (int ai = 0; ai < 2; ++ai)
#pragma unroll
                    for (int m = 0; m < 4; ++m) { const int row = row0 + ai * HALF + m * 16; f32x4 v = acc[ai][bj][m][n] + bv;
                        if (MODE == 0) {
#pragma unroll
                            for (int j = 0; j < 4; ++j) v[j] = __expf(-0.60653065971f * sigmoidf_(v[j]));
                        } else if (MODE == 1) {
#pragma unroll
                            for (int j = 0; j < 4; ++j) v[j] = sigmoidf_(v[j]);
                        }
                        if (MODE != 0) { u32x2 w2; w2.x = cvtpk(v[0], v[1]); w2.y = cvtpk(v[2], v[3]); *(u32x2*)((bf16_t*)O + (size_t)row * 1024 + col) = w2; }
                        else *(f32x4*)(O + (size_t)row * 1024 + col) = v; } }
    }
};
}

template <int MAP>
__device__ __forceinline__ void transpose_item(const float* W, int K, int N, bf16_t* WT, const float* gk, LAS float* scr, int item, int lane) {
    const int nblk = N / 32, kb = item / nblk, nb = item % nblk, k0 = 64 * kb, n0 = 32 * nb;
    float v[32];
    const float* wp = W + (size_t)(k0 + (lane >> 5)) * N + n0 + (lane & 31);
#pragma unroll
    for (int i = 0; i < 32; ++i) v[i] = __builtin_nontemporal_load(wp + (size_t)(2 * i) * N);
    const int c = lane & 7;
    f32x4 g0 = (f32x4){1.f, 1.f, 1.f, 1.f}, g1 = g0;
    if (gk) { g0 = *(const f32x4*)(gk + k0 + 8 * c); g1 = *(const f32x4*)(gk + k0 + 8 * c + 4); }
#pragma unroll
    for (int i = 0; i < 32; ++i) scr[(2 * i + (lane >> 5)) * 33 + (lane & 31)] = v[i];
    asm volatile("s_waitcnt lgkmcnt(0)" ::: "memory");
#pragma unroll
    for (int j = 0; j < 4; ++j) { const int n = n0 + (lane >> 3) + 8 * j; const LAS float* s = scr + (8 * c) * 33 + (n - n0);
        float sc = 1.f; int drow = n;
        if (MAP == 0) { if (n < 512 || (n >= 1536 && n < 2048)) sc = QSC; }
        if (MAP == 1) { const int hn = n < FF ? n : n - FF; drow = (hn >> 7) * 256 + (n < FF ? 0 : 128) + (hn & 127); }
        const f32x4 h0 = g0 * sc, h1 = g1 * sc;
        u32x4 o; o.x = cvtpk(s[0 * 33] * h0[0], s[1 * 33] * h0[1]); o.y = cvtpk(s[2 * 33] * h0[2], s[3 * 33] * h0[3]); o.z = cvtpk(s[4 * 33] * h1[0], s[5 * 33] * h1[1]); o.w = cvtpk(s[6 * 33] * h1[2], s[7 * 33] * h1[3]);
        *(u32x4*)(WT + (size_t)drow * K + k0 + 8 * c) = o; }
    asm volatile("s_waitcnt lgkmcnt(0)" ::: "memory");
}

constexpr int I_IN = (DM / 64) * (INC / 32), I_OUT = (DM / 64) * (DM / 32), I_GU = (DM / 64) * (GU / 32), I_DN = (FF / 64) * (DM / 32);
constexpr int CONV_ITEMS = I_IN + I_OUT + I_GU + I_DN;
__device__ __forceinline__ void convert_item(KP p, int l, int r, LAS float* scr, int lane) {
    unsigned char* wb = p->ws + WS_W + (size_t)l * LW_STRIDE;
    if (r < I_IN) { transpose_item<0>(p->in[2] + (size_t)l * DM * INC, DM, INC, (bf16_t*)(wb + LW_WIN), p->in[1] + l * DM, scr, r, lane); return; } r -= I_IN;
    if (r < I_OUT) { transpose_item<2>(p->in[17] + (size_t)l * DM * DM, DM, DM, (bf16_t*)(wb + LW_WOUT), nullptr, scr, r, lane); return; } r -= I_OUT;
    if (r < I_GU) { transpose_item<1>(p->in[19] + (size_t)l * DM * GU, DM, GU, (bf16_t*)(wb + LW_WGU), p->in[18] + l * DM, scr, r, lane); return; } r -= I_GU;
    transpose_item<2>(p->in[20] + (size_t)l * FF * DM, FF, DM, (bf16_t*)(wb + LW_WDN), nullptr, scr, r, lane);
}

__device__ __forceinline__ void phase0(KP p, LAS unsigned char* lds, int gw, int NGW, int wave, int lane) {
    LAS float* scr = (LAS float*)(lds + wave * 16384);
    for (int it = gw; it < CONV_ITEMS; it += NGW) convert_item(p, 0, it, scr, lane);
    const int gt = gw * 64 + lane, NGT = NGW * 64;
    for (int l = 0; l < NL; ++l) {
        unsigned char* wb = p->ws + WS_W + (size_t)l * LW_STRIDE;
        bf16_t* w2t = (bf16_t*)(wb + LW_W2T); bf16_t* a2t = (bf16_t*)(wb + LW_A2T); bf16_t* g2t = (bf16_t*)(wb + LW_G2T);
        const float* w2 = p->in[8] + (size_t)l * 96 * 1024; const float* a2 = p->in[10] + (size_t)l * 96 * 1024; const float* g2 = p->in[11] + (size_t)l * 256 * 1024;
        for (int i = gt; i < 1024 * 128; i += NGT) { const int n = i >> 7, k = i & 127;
            w2t[i] = (bf16_t)(cvtpk(k < 96 ? w2[k * 1024 + n] : 0.f, 0.f) & 0xffff); a2t[i] = (bf16_t)(cvtpk(k < 96 ? a2[k * 1024 + n] : 0.f, 0.f) & 0xffff); }
        for (int i = gt; i < 1024 * 256; i += NGT) { const int n = i >> 8, k = i & 255; g2t[i] = (bf16_t)(cvtpk(g2[k * 1024 + n], 0.f) & 0xffff); }
        unsigned* padz = (unsigned*)(wb + LW_WIN + (size_t)INC * DM * 2);
        for (int i = gt; i < (INCP - INC) * DM / 2; i += NGT) padz[i] = 0u;
    }
    const float* x = p->in[0]; float* X = p->out; bf16_t* XB = (bf16_t*)(p->ws + WS_XB); float* ssqA = (float*)(p->ws + WS_SSQA);
    for (int m = gw; m < M; m += NGW) { float ss = 0.f;
#pragma unroll
        for (int j = 0; j < 8; ++j) { const size_t o = (size_t)m * DM + j * 256 + lane * 4; const f32x4 v = *(const f32x4*)(x + o); *(f32x4*)(X + o) = v;
            u32x2 w; w.x = cvtpk(v[0], v[1]); w.y = cvtpk(v[2], v[3]); *(u32x2*)(XB + o) = w; ss += (v[0] * v[0] + v[1] * v[1]) + (v[2] * v[2] + v[3] * v[3]); }
        ss = wave_sum(ss); if (lane < 32) ssqA[(size_t)m * 32 + lane] = lane == 0 ? ss : 0.f; }
}

__device__ __forceinline__ void phase_prep1(KP p, int l, LAS unsigned char* lds, int gw, int NGW, int wave, int lane) {
    const bf16_t* PROJ = (const bf16_t*)(p->ws + WS_PROJ);
    LAS unsigned short* tile = (LAS unsigned short*)(lds + wave * 8448);
    bf16_t* VAT = (bf16_t*)(p->ws + WS_VAT); bf16_t* VBT = (bf16_t*)(p->ws + WS_VBT);
    for (int it = gw; it < 128 * 10; it += NGW) {
        const int tb = it / 10, g = it % 10, t0 = tb * 64; const int cbase = g < 8 ? 1024 + 64 * g : 2176 + 64 * (g - 8);
        bf16_t* dst = g < 8 ? VAT + (size_t)(64 * g) * M : VBT + (size_t)(64 * (g - 8)) * M;
#pragma unroll
        for (int i = 0; i < 8; ++i) { const int row = i * 8 + (lane >> 3), ch = lane & 7; const u32x4 v = *(const u32x4*)(PROJ + (size_t)(t0 + row) * INCP + cbase + 8 * ch);
            LAS unsigned* d = (LAS unsigned*)(tile + row * 66 + 8 * ch); d[0] = v.x; d[1] = v.y; d[2] = v.z; d[3] = v.w; }
        asm volatile("s_waitcnt lgkmcnt(0)" ::: "memory");
#pragma unroll
        for (int i = 0; i < 8; ++i) { const int c = i * 8 + (lane >> 3), tch = lane & 7, j = tch >> 1, hi = tch & 1; unsigned short v[8];
#pragma unroll
            for (int s = 0; s < 8; ++s) v[s] = tile[(16 * j + (s & 3) + 8 * (s >> 2) + 4 * hi) * 66 + c];
            u32x4 o; o.x = v[0] | ((unsigned)v[1] << 16); o.y = v[2] | ((unsigned)v[3] << 16); o.z = v[4] | ((unsigned)v[5] << 16); o.w = v[6] | ((unsigned)v[7] << 16);
            *(u32x4*)(dst + (size_t)c * M + t0 + 16 * j + 8 * hi) = o; }
        asm volatile("s_waitcnt lgkmcnt(0)" ::: "memory");
    }
    const float* mu = p->in[6] + (size_t)l * RWC;
    bf16_t* AW = (bf16_t*)(p->ws + WS_AW); bf16_t* AA = (bf16_t*)(p->ws + WS_AA); bf16_t* AG = (bf16_t*)(p->ws + WS_AG);
    float knmax = 0.f;
    for (int t = gw; t < M; t += NGW) {
        const bf16_t* cur = PROJ + (size_t)t * INCP + RW0;
        {   const u32x4 kv = *(const u32x4*)(PROJ + (size_t)t * INCP + 512 + 8 * lane);
            float a0 = bflo(kv.x), a1 = bfhi(kv.x), a2 = bflo(kv.y), a3 = bfhi(kv.y), a4 = bflo(kv.z), a5 = bfhi(kv.z), a6 = bflo(kv.w), a7 = bfhi(kv.w);
            float ss = (a0 * a0 + a1 * a1) + (a2 * a2 + a3 * a3) + (a4 * a4 + a5 * a5) + (a6 * a6 + a7 * a7);
            ss += dppm<0xB1>(ss); ss += dppm<0x4E>(ss); ss += dppm<0x141>(ss); knmax = fmaxf(knmax, ss); }
        if (lane < 56) { const int j0 = 3072 + 8 * lane;
            const u32x4 c4 = *(const u32x4*)(cur + j0); u32x4 p4 = (u32x4){0u, 0u, 0u, 0u}; if (t > 0) p4 = *(const u32x4*)(cur - INCP + j0);
            const f32x4 m0 = *(const f32x4*)(mu + j0), m1 = *(const f32x4*)(mu + j0 + 4);
            float f[8]; const unsigned cw[4] = {c4.x, c4.y, c4.z, c4.w}, pw[4] = {p4.x, p4.y, p4.z, p4.w};
#pragma unroll
            for (int q = 0; q < 4; ++q) { const float c0 = bflo(cw[q]), c1 = bfhi(cw[q]), p0 = bflo(pw[q]), p1 = bfhi(pw[q]);
                const float mu0 = q < 2 ? m0[2 * q] : m1[2 * q - 4], mu1 = q < 2 ? m0[2 * q + 1] : m1[2 * q - 3];
                f[2 * q] = c0 + (p0 - c0) * mu0; f[2 * q + 1] = c1 + (p1 - c1) * mu1; }
            bf16_t* dstp;
            if (j0 < 3168) { dstp = AW + (size_t)t * 128 + (j0 - 3072);
#pragma unroll
                for (int q = 0; q < 8; ++q) f[q] = tanhf(f[q]); }
            else if (j0 < 3264) { dstp = AA + (size_t)t * 128 + (j0 - 3168); }
            else { dstp = AG + (size_t)t * 256 + (j0 - 3264);
#pragma unroll
                for (int q = 0; q < 8; ++q) f[q] = sigmoidf_(f[q]); }
            u32x4 o; o.x = cvtpk(f[0], f[1]); o.y = cvtpk(f[2], f[3]); o.z = cvtpk(f[4], f[5]); o.w = cvtpk(f[6], f[7]); *(u32x4*)dstp = o; }
        else { const int e = lane - 56; if (e < 4) *(u32x4*)(AW + (size_t)t * 128 + 96 + 8 * e) = (u32x4){0u, 0u, 0u, 0u}; else *(u32x4*)(AA + (size_t)t * 128 + 96 + 8 * (e - 4)) = (u32x4){0u, 0u, 0u, 0u}; }
    }
    {   LAS float* kr = (LAS float*)(lds + 8 * 8448);
        if ((lane & 7) == 0) kr[wave * 8 + (lane >> 3)] = knmax;
        __syncthreads();
        if (wave == 0 && lane < 8) { float m = kr[lane];
#pragma unroll
            for (int w2 = 1; w2 < 8; ++w2) m = fmaxf(m, kr[w2 * 8 + lane]);
            ((float*)(p->ws + WS_KNP))[(size_t)(gw >> 3) * 8 + lane] = m; }
        __syncthreads(); }
}

__device__ __forceinline__ void phase_prep2(KP p, int l, int gw, int NGW, int lane) {
    const float* KR = (const float*)(p->ws + WS_KR); const float* A = (const float*)(p->ws + WS_A);
    float* KF = (float*)(p->ws + WS_KF); float* AN = (float*)(p->ws + WS_AN); float* BB = (float*)(p->ws + WS_BB);
    const float* k_k = p->in[12] + l * 1024; const float* k_a = p->in[13] + l * 1024;
    const int c0 = 16 * lane;
    for (int t = gw; t < M; t += NGW) { const size_t o = (size_t)t * 1024 + c0; float n2 = 0.f; f32x4 kkv[4], kr[4], av[4];
#pragma unroll
        for (int q = 0; q < 4; ++q) { kr[q] = *(const f32x4*)(KR + o + 4 * q); av[q] = *(const f32x4*)(A + o + 4 * q); kkv[q] = kr[q] * *(const f32x4*)(k_k + c0 + 4 * q);
            n2 += (kkv[q][0] * kkv[q][0] + kkv[q][1] * kkv[q][1]) + (kkv[q][2] * kkv[q][2] + kkv[q][3] * kkv[q][3]); }
        n2 = quad_sum(n2); const float inv = 1.0f / fmaxf(sqrtf(n2), 1e-12f);
#pragma unroll
        for (int q = 0; q < 4; ++q) { const f32x4 kk = kkv[q] * inv; const f32x4 ka = *(const f32x4*)(k_a + c0 + 4 * q);
            *(f32x4*)(KF + o + 4 * q) = kr[q] * (1.0f + (av[q] - 1.0f) * ka); *(f32x4*)(AN + o + 4 * q) = -kk; *(f32x4*)(BB + o + 4 * q) = kk * av[q]; }
    }
}

template <int MODE>
__device__ __forceinline__ void scan_task(KP p, int l, LAS unsigned char* wl, int c, int h, int lane) {
    constexpr int NPV = MODE == 0 ? 1 : (MODE == 1 ? 2 : 3);
    constexpr int SB = 4;
    LAS float* vec = (LAS float*)wl;
    LAS float* ybuf = (LAS float*)(wl + 7 * SB * 256);
    const float* DECp = (const float*)(p->ws + WS_DEC); const float* Ap = (const float*)(p->ws + WS_A); const bf16_t* PROJ = (const bf16_t*)(p->ws + WS_PROJ);
    const int rb = lane >> 2, cb = lane & 3, t0 = c * CL;
    f32x2 s[4][8];
    if (MODE == 0) {
#pragma unroll
        for (int r = 0; r < 4; ++r)
#pragma unroll
            for (int q = 0; q < 8; ++q) { s[r][q].x = (4 * rb + r == 16 * cb + 2 * q) ? 1.f : 0.f; s[r][q].y = (4 * rb + r == 16 * cb + 2 * q + 1) ? 1.f : 0.f; }
    } else if (MODE == 1) {
#pragma unroll
        for (int r = 0; r < 4; ++r)
#pragma unroll
            for (int q = 0; q < 8; ++q) s[r][q] = (f32x2){0.f, 0.f};
    } else {
        const float* SI = (const float*)(p->ws + WS_SI) + ((size_t)(h * NCH + c)) * 4096;
#pragma unroll
        for (int x = 0; x < 16; ++x) { const f32x4 v = *(const f32x4*)(SI + (16 * cb + x) * 64 + 4 * rb);
#pragma unroll
            for (int r = 0; r < 4; ++r) { if (x & 1) s[r][x >> 1].y = v[r]; else s[r][x >> 1].x = v[r]; } }
    }
    const int lst = lane >> 4, lq = lane & 15;
    const f32x4 kk4 = *(const f32x4*)(p->in[12] + l * 1024 + 64 * h + 4 * lq), ka4 = *(const f32x4*)(p->in[13] + l * 1024 + 64 * h + 4 * lq);
    f32x4 lnw4 = (f32x4){0.f, 0.f, 0.f, 0.f}, lnb4 = lnw4, rk4 = lnw4;
    if (MODE == 2) { lnw4 = *(const f32x4*)(p->in[15] + l * 1024 + 64 * h + 4 * lq); lnb4 = *(const f32x4*)(p->in[16] + l * 1024 + 64 * h + 4 * lq); rk4 = *(const f32x4*)(p->in[14] + l * 1024 + 64 * h + 4 * lq); }
    const size_t goff = (size_t)(t0 + lst) * 1024 + 64 * h + 4 * lq;
    const int pvo[3] = {1024, 2048, 0};
    f32x4 mu4[NPV];
#pragma unroll
    for (int v = 0; v < NPV; ++v) mu4[v] = *(const f32x4*)(p->in[6] + (size_t)l * RWC + pvo[v] + 64 * h + 4 * lq);
    const bf16_t* pj = PROJ + (size_t)(t0 + lst) * INCP + RW0 + 64 * h + 4 * lq;
    const float* Gp = (const float*)(p->ws + WS_G);
    struct Pre { f32x4 dec; u32x2 a, g; u32x2 cur[NPV], prv[NPV]; };
    Pre pA, pB;
#define SCAN_LOAD(P_, SBI) do { if ((SBI) < CL / SB) { const size_t ro = (size_t)(SB * (SBI)); P_.dec = *(const f32x4*)(DECp + goff + ro * 1024); P_.a = *(const u32x2*)((const bf16_t*)Ap + goff + ro * 1024); \
        if constexpr (MODE == 2) P_.g = *(const u32x2*)((const bf16_t*)Gp + goff + ro * 1024); \
        const bool first = (t0 + (int)ro + lst) == 0; \
        _Pragma("unroll") for (int v = 0; v < NPV; ++v) { P_.cur[v] = *(const u32x2*)(pj + ro * INCP + pvo[v]); P_.prv[v] = first ? (u32x2){0u, 0u} : *(const u32x2*)(pj + ro * INCP + pvo[v] - INCP); } } } while (0)
#define SCAN_SHIFT(P_, V) ({ const f32x4 c_ = (f32x4){bflo(P_.cur[V].x), bfhi(P_.cur[V].x), bflo(P_.cur[V].y), bfhi(P_.cur[V].y)}, q_ = (f32x4){bflo(P_.prv[V].x), bfhi(P_.prv[V].x), bflo(P_.prv[V].y), bfhi(P_.prv[V].y)}; c_ + (q_ - c_) * mu4[V]; })
#define SCAN_STAGE(P_) do { const f32x4 kr = SCAN_SHIFT(P_, 0), av = (f32x4){bflo(P_.a.x), bfhi(P_.a.x), bflo(P_.a.y), bfhi(P_.a.y)}; const f32x4 kkv = kr * kk4; \
        float n2 = (kkv[0] * kkv[0] + kkv[1] * kkv[1]) + (kkv[2] * kkv[2] + kkv[3] * kkv[3]); n2 = row16_sum(n2); \
        const float inv = __builtin_amdgcn_rsqf(fmaxf(n2, 1e-24f)); const f32x4 kkn = kkv * inv; \
        LAS float* vw = vec + lst * 64 + 4 * lq; \
        *(LAS f32x4*)(vw + 0 * SB * 64) = P_.dec; *(LAS f32x4*)(vw + 1 * SB * 64) = -kkn; *(LAS f32x4*)(vw + 2 * SB * 64) = kkn * av; \
        if constexpr (MODE != 0) { *(LAS f32x4*)(vw + 3 * SB * 64) = kr * (1.0f + (av - 1.0f) * ka4); *(LAS f32x4*)(vw + 4 * SB * 64) = SCAN_SHIFT(P_, 1); } \
        if constexpr (MODE == 2) { *(LAS f32x4*)(vw + 5 * SB * 64) = SCAN_SHIFT(P_, 2); *(LAS f32x4*)(vw + 6 * SB * 64) = (f32x4){bflo(P_.g.x), bfhi(P_.g.x), bflo(P_.g.y), bfhi(P_.g.y)}; } } while (0)
    SCAN_LOAD(pA, 0); SCAN_LOAD(pB, 1);
    float gam = 1.0f;
    LAS float* gbuf = ybuf + SB * 64;
    for (int sb = 0; sb < CL / SB; ++sb) {
        if (sb & 1) { SCAN_STAGE(pB); SCAN_LOAD(pB, sb + 2); } else { SCAN_STAGE(pA); SCAN_LOAD(pA, sb + 2); }
#pragma unroll
        for (int st = 0; st < SB; ++st) { const float w_ = vec[(0 * SB + st) * 64 + lane]; const float gprev = gam; gam *= w_; const float ginv = __builtin_amdgcn_rcpf(gam);
            vec[(1 * SB + st) * 64 + lane] *= gprev; vec[(2 * SB + st) * 64 + lane] *= ginv;
            if (MODE != 0) vec[(3 * SB + st) * 64 + lane] *= ginv;
            if (MODE == 2) vec[(5 * SB + st) * 64 + lane] *= gam; }
#pragma unroll 1
        for (int st = 0; st < SB; ++st) {
            const LAS float* vb = vec + st * 64 + 16 * cb;
            float sa[4];
            {   f32x2 a2[8];
#pragma unroll
                for (int q = 0; q < 4; ++q) { const f32x4 y = *(const LAS f32x4*)(vb + 1 * SB * 64 + 4 * q); a2[2 * q] = (f32x2){y[0], y[1]}; a2[2 * q + 1] = (f32x2){y[2], y[3]}; }
                f32x2 c0[4];
#pragma unroll
                for (int r = 0; r < 4; ++r) c0[r] = s[r][0] * a2[0];
#pragma unroll
                for (int q = 1; q < 8; ++q)
#pragma unroll
                    for (int r = 0; r < 4; ++r) c0[r] = s[r][q] * a2[q] + c0[r];
                float e[4];
#pragma unroll
                for (int r = 0; r < 4; ++r) e[r] = c0[r].x + c0[r].y;
#pragma unroll
                for (int r = 0; r < 4; ++r) e[r] += dpp_xor1(e[r]);
#pragma unroll
                for (int r = 0; r < 4; ++r) sa[r] = e[r] + dpp_xor2(e[r]); }
            f32x4 vv = (f32x4){0.f, 0.f, 0.f, 0.f};
            if (MODE != 0) vv = *(const LAS f32x4*)(vec + (4 * SB + st) * 64 + 4 * rb);
#pragma unroll
            for (int q = 0; q < 4; ++q) { const f32x4 b4 = *(const LAS f32x4*)(vb + 2 * SB * 64 + 4 * q);
                const f32x2 b0 = (f32x2){b4[0], b4[1]}, b1 = (f32x2){b4[2], b4[3]};
#pragma unroll
                for (int r = 0; r < 4; ++r) { s[r][2 * q] = b0 * sa[r] + s[r][2 * q]; s[r][2 * q + 1] = b1 * sa[r] + s[r][2 * q + 1]; }
                if (MODE != 0) { const f32x4 k4 = *(const LAS f32x4*)(vb + 3 * SB * 64 + 4 * q); const f32x2 k0 = (f32x2){k4[0], k4[1]}, k1 = (f32x2){k4[2], k4[3]};
#pragma unroll
                    for (int r = 0; r < 4; ++r) { s[r][2 * q] = k0 * vv[r] + s[r][2 * q]; s[r][2 * q + 1] = k1 * vv[r] + s[r][2 * q + 1]; } } }
            if (MODE == 2) {
                f32x2 r2[8];
#pragma unroll
                for (int q = 0; q < 4; ++q) { const f32x4 x = *(const LAS f32x4*)(vb + 5 * SB * 64 + 4 * q); r2[2 * q] = (f32x2){x[0], x[1]}; r2[2 * q + 1] = (f32x2){x[2], x[3]}; }
                f32x4 yv;
                f32x2 c0[4];
#pragma unroll
                for (int r = 0; r < 4; ++r) c0[r] = s[r][0] * r2[0];
#pragma unroll
                for (int q = 1; q < 8; ++q)
#pragma unroll
                    for (int r = 0; r < 4; ++r) c0[r] = s[r][q] * r2[q] + c0[r];
                float e[4];
#pragma unroll
                for (int r = 0; r < 4; ++r) e[r] = c0[r].x + c0[r].y;
#pragma unroll
                for (int r = 0; r < 4; ++r) e[r] += dpp_xor1(e[r]);
#pragma unroll
                for (int r = 0; r < 4; ++r) yv[r] = e[r] + dpp_xor2(e[r]);
                if (cb == 0) *(LAS f32x4*)(ybuf + st * 64 + 4 * rb) = yv;
            }
        }
        if ((sb & 15) == 15) {
            gbuf[lane] = gam; gam = 1.0f;
#pragma unroll
            for (int q = 0; q < 4; ++q) { const f32x4 g4 = *(const LAS f32x4*)(gbuf + 16 * cb + 4 * q); const f32x2 g0 = (f32x2){g4[0], g4[1]}, g1 = (f32x2){g4[2], g4[3]};
#pragma unroll
                for (int r = 0; r < 4; ++r) { s[r][2 * q] = s[r][2 * q] * g0; s[r][2 * q + 1] = s[r][2 * q + 1] * g1; } } }
        if (MODE == 2) {
            bf16_t* MIX = (bf16_t*)(p->ws + WS_MIX);
            const int t = t0 + SB * sb + lst; const LAS float* vr = vec + lst * 64 + 4 * lq;
            const f32x4 y = *(const LAS f32x4*)(ybuf + lst * 64 + 4 * lq), rr = *(const LAS f32x4*)(vr + 5 * SB * 64), kk = *(const LAS f32x4*)(vr + 3 * SB * 64),
                        vv = *(const LAS f32x4*)(vr + 4 * SB * 64), g = *(const LAS f32x4*)(vr + 6 * SB * 64);
            const float mean = row16_sum((y[0] + y[1]) + (y[2] + y[3])) * (1.0f / 64.0f);
            const f32x4 d = y - mean;
            const float var = row16_sum((d[0] * d[0] + d[1] * d[1]) + (d[2] * d[2] + d[3] * d[3])) * (1.0f / 64.0f);
            const f32x4 rkk = rr * kk * rk4;
            const float bon = row16_sum((rkk[0] + rkk[1]) + (rkk[2] + rkk[3]));
            const f32x4 o = (d * __builtin_amdgcn_rsqf(var + 64e-5f) * lnw4 + lnb4 + vv * bon) * g;
            u32x2 wv; wv.x = cvtpk(o[0], o[1]); wv.y = cvtpk(o[2], o[3]);
            *(u32x2*)(MIX + (size_t)t * DM + 1024 + 64 * h + 4 * lq) = wv;
        }
    }
    if (MODE == 0) { float* dst = (float*)(p->ws + WS_PB) + ((size_t)(h * NCH + c)) * 4096;
#pragma unroll
        for (int r = 0; r < 4; ++r)
#pragma unroll
            for (int q = 0; q < 4; ++q) *(f32x4*)(dst + (4 * rb + r) * 64 + 16 * cb + 4 * q) = (f32x4){s[r][2 * q].x, s[r][2 * q].y, s[r][2 * q + 1].x, s[r][2 * q + 1].y}; }
    if (MODE == 1) { float* dst = (float*)(p->ws + WS_UB) + ((size_t)(h * NCH + c)) * 4096;
#pragma unroll
        for (int x = 0; x < 16; ++x) { f32x4 v;
#pragma unroll
            for (int r = 0; r < 4; ++r) v[r] = (x & 1) ? s[r][x >> 1].y : s[r][x >> 1].x;
            *(f32x4*)(dst + (16 * cb + x) * 64 + 4 * rb) = v; } }
}

#undef SCAN_LOAD
#undef SCAN_SHIFT
#undef SCAN_STAGE
__device__ __forceinline__ void s2_head(KP p, LAS unsigned char* lds, int h, int ti, const int tid) {
    const float* PB = (const float*)(p->ws + WS_PB) + (size_t)h * NCH * 4096; const float* UT = (const float*)(p->ws + WS_UB) + (size_t)h * NCH * 4096;
    float* SI = (float*)(p->ws + WS_SI) + (size_t)h * NCH * 4096;
    const int lane = tid & 63, w = __builtin_amdgcn_readfirstlane(tid >> 6), n = lane & 31, lh = lane >> 5, to = (w >> 1) & 1, tj = w & 1;
    static_assert((NCH - 1) % 3 == 0, "three rotating prefetch buffers");
    if (w >= 4) {
        for (int c = 0; c < NCH - 1; ++c) __syncthreads();
    } else {
        f32x16 breg, ua, ub, uc2; float pa[16], pb[16], pc2[16];
#pragma unroll
        for (int r = 0; r < 16; ++r) breg[r] = 0.f;
        const int offu = (32 * to + 4 * lh) * 64 + 32 * ti + n, offp = (32 * tj + 4 * lh) * 64 + 32 * to + n, offs = (32 * tj + 4 * lh) * 64 + 32 * ti + n;
#define S2_LOAD(CH, U_, P_) do { const int ch_ = (CH) < NCH - 1 ? (CH) : NCH - 2; const float* pb_ = PB + (size_t)ch_ * 4096 + offp; const float* ub_ = UT + (size_t)ch_ * 4096 + offu; \
        _Pragma("unroll") for (int r = 0; r < 16; ++r) { const int cr = ((r & 3) + 8 * (r >> 2)) * 64; U_[r] = tj == 0 ? ub_[cr] : 0.f; P_[r] = pb_[cr]; } } while (0)
#define S2_STEP(C, UC_, PC_, UN_, PN_) do { \
        if (to == 0) { float* si = SI + (size_t)(C) * 4096 + offs; \
            _Pragma("unroll") for (int r = 0; r < 16; ++r) si[((r & 3) + 8 * (r >> 2)) * 64] = breg[r]; } \
        f32x16 acc = UC_; \
        _Pragma("unroll") for (int r = 0; r < 16; ++r) acc = __builtin_amdgcn_mfma_f32_32x32x2f32(PC_[r], breg[r], acc, 0, 0, 0); \
        LAS f32x4* ex = (LAS f32x4*)(lds + ((C) & 1) * 16384); \
        _Pragma("unroll") for (int q = 0; q < 4; ++q) ex[(w * 4 + q) * 64 + lane] = (f32x4){acc[4 * q], acc[4 * q + 1], acc[4 * q + 2], acc[4 * q + 3]}; \
        __syncthreads(); \
        S2_LOAD((C) + 2, UN_, PN_); \
        _Pragma("unroll") for (int q = 0; q < 4; ++q) { const f32x4 v0 = ex[((tj * 2) * 4 + q) * 64 + lane], v1 = ex[((tj * 2 + 1) * 4 + q) * 64 + lane]; \
            breg[4 * q] = v0[0] + v1[0]; breg[4 * q + 1] = v0[1] + v1[1]; breg[4 * q + 2] = v0[2] + v1[2]; breg[4 * q + 3] = v0[3] + v1[3]; } } while (0)
        S2_LOAD(0, ua, pa); S2_LOAD(1, ub, pb);
#pragma unroll 1
        for (int c = 0; c < NCH - 1; c += 3) {
            S2_STEP(c, ua, pa, uc2, pc2);
            S2_STEP(c + 1, ub, pb, ua, pa);
            S2_STEP(c + 2, uc2, pc2, ub, pb);
        }
        if (to == 0) { float* si = SI + (size_t)(NCH - 1) * 4096 + offs;
#pragma unroll
            for (int r = 0; r < 16; ++r) si[((r & 3) + 8 * (r >> 2)) * 64] = breg[r]; }
#undef S2_LOAD
#undef S2_STEP
    }
    __syncthreads();
}

template <int DV, bool SWA>
__device__ __forceinline__ void attn_unit(LAS unsigned char* lds, const bf16_t* Q, const bf16_t* Kp, const bf16_t* VT, float slope2, int q0, float sink2,
                                          float* Of32, float* MLp, bf16_t* Obf, const int tid, int kt_lo, int kt_hi, float kn) {
    constexpr int KROW = 144, KTILE = 64 * KROW, VTILE = DV * KROW, BUF = KTILE + VTILE, NVL = DV / 64;
    const int lane = tid & 63, w = __builtin_amdgcn_readfirstlane(tid >> 6), r32 = lane & 31, hi = lane >> 5;
    const int qpos = q0 + 32 * w + r32;
    bf16x8 qf[4];
#pragma unroll
    for (int j = 0; j < 4; ++j) qf[j] = *(const bf16x8*)(Q + (size_t)qpos * INCP + 16 * j + 8 * hi);
    int kt0 = kt_lo, kt1 = kt_hi;
    if (!SWA) {
        float qq = 0.f, qk = 0.f;
#pragma unroll
        for (int j = 0; j < 4; ++j) { const bf16x8 kf = *(const bf16x8*)(Kp + (size_t)qpos * INCP + 16 * j + 8 * hi);
#pragma unroll
            for (int e = 0; e < 8; ++e) { const float qv = bf2f((unsigned short)qf[j][e]), kv = bf2f((unsigned short)kf[e]); qq += qv * qv; qk += qv * kv; } }
        qq = xor32_sum(qq); qk = xor32_sum(qk);
        const float dneed = (sqrtf(qq) * kn - qk + 45.0f) / slope2;
        float kneed = (float)qpos - dneed;
        kneed = fminf(kneed, dppm<0xB1>(kneed)); kneed = fminf(kneed, dppm<0x4E>(kneed)); kneed = fminf(kneed, dppm<0x141>(kneed)); kneed = fminf(kneed, dppm<0x140>(kneed));
        LAS float* red = (LAS float*)(lds + 2 * BUF);
        if ((lane & 15) == 0) red[w * 4 + (lane >> 4)] = kneed;
        __syncthreads();
        float km = red[0];
#pragma unroll
        for (int i = 1; i < 32; ++i) km = fminf(km, red[i]);
        const int ktw = km <= 0.f ? 0 : ((int)km >> 6);
        kt0 = ktw > kt_lo ? ktw : kt_lo;
    }
    const int qlo = q0 + 32 * w, qhi = qlo + 31;
    f32x16 o[DV / 32];
#pragma unroll
    for (int d = 0; d < DV / 32; ++d)
#pragma unroll
        for (int r = 0; r < 16; ++r) o[d][r] = 0.f;
    float mrun = 0.f, lsum = 0.f;
    const int krow = tid >> 3, kch = tid & 7;
    u32x4 kreg, vreg[NVL];
    if (kt0 <= kt1) {   const int k0 = 64 * kt0; kreg = *(const u32x4*)(Kp + (size_t)(k0 + krow) * INCP + 8 * kch);
#pragma unroll
        for (int i = 0; i < NVL; ++i) { const int idx = tid + 512 * i; vreg[i] = *(const u32x4*)(VT + (size_t)(idx >> 3) * M + k0 + 8 * (idx & 7)); } }
    for (int kt = kt0; kt <= kt1; ++kt) {
        LAS unsigned char* buf = lds + ((kt - kt0) & 1) * BUF;
        *(LAS u32x4*)(buf + krow * KROW + 16 * kch) = kreg;
#pragma unroll
        for (int i = 0; i < NVL; ++i) { const int idx = tid + 512 * i; *(LAS u32x4*)(buf + KTILE + (idx >> 3) * KROW + 16 * (idx & 7)) = vreg[i]; }
        __syncthreads();
        if (kt < kt1) { const int k0 = 64 * (kt + 1); kreg = *(const u32x4*)(Kp + (size_t)(k0 + krow) * INCP + 8 * kch);
#pragma unroll
            for (int i = 0; i < NVL; ++i) { const int idx = tid + 512 * i; vreg[i] = *(const u32x4*)(VT + (size_t)(idx >> 3) * M + k0 + 8 * (idx & 7)); } }
        const int k0 = 64 * kt;
        bool act = k0 <= qhi; if (SWA) act = act && (k0 + 63 >= qlo - 127);
        if (act) {
            f32x16 p0, p1;
            {   const float c0 = slope2 * (float)(k0 + 4 * hi - qpos) - mrun, c1 = c0 + 32.0f * slope2;
#pragma unroll
                for (int r = 0; r < 16; ++r) { const float cr = (float)((r & 3) + 8 * (r >> 2)); p0[r] = __builtin_fmaf(slope2, cr, c0); p1[r] = __builtin_fmaf(slope2, cr, c1); } }
#pragma unroll
            for (int j = 0; j < 4; ++j) { const bf16x8 a0 = *(const LAS bf16x8*)(buf + r32 * KROW + 32 * j + 16 * hi), a1 = *(const LAS bf16x8*)(buf + (r32 + 32) * KROW + 32 * j + 16 * hi);
                p0 = __builtin_amdgcn_mfma_f32_32x32x16_bf16(a0, qf[j], p0, 0, 0, 0); p1 = __builtin_amdgcn_mfma_f32_32x32x16_bf16(a1, qf[j], p1, 0, 0, 0); }
            bool need_mask = k0 + 63 > qlo; if (SWA) need_mask = need_mask || (qhi - k0 >= 128);
            if (need_mask) {
#pragma unroll
                for (int r = 0; r < 16; ++r) { const int kv = k0 + (r & 3) + 8 * (r >> 2) + 4 * hi; const int d0 = qpos - kv, d1 = d0 - 32;
                    bool ok0 = d0 >= 0, ok1 = d1 >= 0; if (SWA) { ok0 = ok0 && d0 < 128; ok1 = ok1 && d1 < 128; }
                    p0[r] = ok0 ? p0[r] : -1e30f; p1[r] = ok1 ? p1[r] : -1e30f; } }
            float mx = fmaxf(p0[0], p1[0]);
#pragma unroll
            for (int r = 1; r < 16; ++r) mx = fmaxf(mx, fmaxf(p0[r], p1[r]));
            mx = xor32_max(mx);
            if (__builtin_amdgcn_ballot_w64(mx > 8.0f) != 0ull) {
                const float d = fmaxf(mx, 0.f), f = __builtin_amdgcn_exp2f(-d); mrun += d; lsum *= f;
#pragma unroll
                for (int r = 0; r < 16; ++r) { p0[r] -= d; p1[r] -= d; }
#pragma unroll
                for (int dd = 0; dd < DV / 32; ++dd)
#pragma unroll
                    for (int r = 0; r < 16; ++r) o[dd][r] *= f; }
            float rs = 0.f;
#pragma unroll
            for (int r = 0; r < 16; ++r) { p0[r] = __builtin_amdgcn_exp2f(p0[r]); p1[r] = __builtin_amdgcn_exp2f(p1[r]); rs += p0[r] + p1[r]; }
            lsum += rs;
            u32x4 pw[4];
            pw[0] = (u32x4){cvtpk(p0[0], p0[1]), cvtpk(p0[2], p0[3]), cvtpk(p0[4], p0[5]), cvtpk(p0[6], p0[7])};
            pw[1] = (u32x4){cvtpk(p0[8], p0[9]), cvtpk(p0[10], p0[11]), cvtpk(p0[12], p0[13]), cvtpk(p0[14], p0[15])};
            pw[2] = (u32x4){cvtpk(p1[0], p1[1]), cvtpk(p1[2], p1[3]), cvtpk(p1[4], p1[5]), cvtpk(p1[6], p1[7])};
            pw[3] = (u32x4){cvtpk(p1[8], p1[9]), cvtpk(p1[10], p1[11]), cvtpk(p1[12], p1[13]), cvtpk(p1[14], p1[15])};
#pragma unroll
            for (int d = 0; d < DV / 32; ++d)
#pragma unroll
                for (int j = 0; j < 4; ++j) { const bf16x8 vf = *(const LAS bf16x8*)(buf + KTILE + (32 * d + r32) * KROW + 32 * j + 16 * hi);
                    o[d] = __builtin_amdgcn_mfma_f32_32x32x16_bf16(vf, __builtin_bit_cast(bf16x8, pw[j]), o[d], 0, 0, 0); }
        }
    }
    lsum = xor32_sum(lsum);
    if (SWA) { lsum += __builtin_amdgcn_exp2f(sink2 - mrun);
        const float inv = 1.0f / lsum; bf16_t* op = Obf + (size_t)qpos * DM;
#pragma unroll
        for (int d = 0; d < DV / 32; ++d)
#pragma unroll
            for (int g = 0; g < 4; ++g) { u32x2 wv; wv.x = cvtpk(o[d][4 * g] * inv, o[d][4 * g + 1] * inv); wv.y = cvtpk(o[d][4 * g + 2] * inv, o[d][4 * g + 3] * inv);
                *(u32x2*)(op + 32 * d + 8 * g + 4 * hi) = wv; }
    } else if (kt0 > kt1) {
        if (hi == 0) *(f32x2*)(MLp + (size_t)qpos * 16) = (f32x2){-1e30f, 0.f};
    } else { float* op = Of32 + (size_t)qpos * 1024;
#pragma unroll
        for (int d = 0; d < DV / 32; ++d)
#pragma unroll
            for (int g = 0; g < 4; ++g) *(f32x4*)(op + 32 * d + 8 * g + 4 * hi) = (f32x4){o[d][4 * g], o[d][4 * g + 1], o[d][4 * g + 2], o[d][4 * g + 3]};
        if (hi == 0) *(f32x2*)(MLp + (size_t)qpos * 16) = (f32x2){mrun, lsum};
    }
    __syncthreads();
}

__device__ __forceinline__ void phase_diffcombine(KP p, int l, int gw, int NGW, int lane) {
    const float* lamv = p->in[3] + l * 256;
    const float lambda_init = 0.8f - 0.6f * expf(-0.3f * (float)l);
    const float s1 = wave_sum(lamv[lane] * lamv[64 + lane]), s2 = wave_sum(lamv[128 + lane] * lamv[192 + lane]);
    const float lam = expf(s1) - expf(s2) + lambda_init;
    const float* OD = (const float*)(p->ws + WS_OD); const float* ML = (const float*)(p->ws + WS_ML); bf16_t* MIX = (bf16_t*)(p->ws + WS_MIX);
    const int h = lane >> 4, d0 = (lane & 15) * 8;
    const f32x4 g0 = *(const f32x4*)(p->in[4] + l * 128 + d0), g1 = *(const f32x4*)(p->in[4] + l * 128 + d0 + 4);
    for (int t = gw; t < M; t += NGW) { const int nseg = ((t >> 8) + 8) >> 3;
        f32x4 oc[2][2];
#pragma unroll
        for (int c = 0; c < 2; ++c) {
            f32x2 ml[4]; float mm = -1e30f;
#pragma unroll
            for (int s = 0; s < 4; ++s) if (s < nseg) { ml[s] = *(const f32x2*)(ML + ((size_t)s * M + t) * 16 + h * 4 + c * 2); mm = fmaxf(mm, ml[s].x); }
            f32x4 a0 = (f32x4){0.f, 0.f, 0.f, 0.f}, a1 = a0; float L = 0.f;
#pragma unroll
            for (int s = 0; s < 4; ++s) if (s < nseg && ml[s].x > -1e29f) { const float f = exp2f(ml[s].x - mm); L += ml[s].y * f;
                const float* b = OD + ((size_t)s * M + t) * 1024 + h * 256 + c * 128 + d0; a0 += *(const f32x4*)b * f; a1 += *(const f32x4*)(b + 4) * f; }
            const float inv = 1.0f / L; oc[c][0] = a0 * inv; oc[c][1] = a1 * inv; }
        const f32x4 o0 = oc[0][0] - oc[1][0] * lam, o1 = oc[0][1] - oc[1][1] * lam;
        float ss = (o0[0] * o0[0] + o0[1] * o0[1]) + (o0[2] * o0[2] + o0[3] * o0[3]) + (o1[0] * o1[0] + o1[1] * o1[1]) + (o1[2] * o1[2] + o1[3] * o1[3]);
        ss = row16_sum(ss);
        const float r = rsqrtf(ss * (1.0f / 128.0f) + EPS) * (1.0f - lambda_init);
        const f32x4 y0 = o0 * g0 * r, y1 = o1 * g1 * r;
        u32x4 wv; wv.x = cvtpk(y0[0], y0[1]); wv.y = cvtpk(y0[2], y0[3]); wv.z = cvtpk(y1[0], y1[1]); wv.w = cvtpk(y1[2], y1[3]);
        *(u32x4*)(MIX + (size_t)t * DM + h * 128 + d0) = wv; }
}

#define XB_TMO      128
#define XB_XCNT(j)  (256  + 64 * (j))
#define XB_XSUB(j)  (1280 + 64 * (j))
#define XB_XGEN(j)  (2304 + 64 * (j))
#define XB_TOP      3328
#define XB_TOPGEN   3392
#define XCD_BAR_WORDS 3456
#define XB_SPIN_CAP (1u << 22)
__device__ __forceinline__ unsigned xb_ld(unsigned* p)              { return __hip_atomic_load(p, __ATOMIC_RELAXED, __HIP_MEMORY_SCOPE_AGENT); }
__device__ __forceinline__ unsigned xb_add(unsigned* p, unsigned v) { return __hip_atomic_fetch_add(p, v, __ATOMIC_RELAXED, __HIP_MEMORY_SCOPE_AGENT); }
__device__ __forceinline__ unsigned xb_xcc_id() { return (unsigned)__builtin_amdgcn_s_getreg((3 << 11) | 20) & 0xFu; }
#define XB_SPIN(cond, bar) do { unsigned _sp = 0; while (cond) { __builtin_amdgcn_s_sleep(1); \
    if ((++_sp & 255u) == 0u) { if (xb_ld(&(bar)[XB_TMO])) break; if (_sp > XB_SPIN_CAP) { atomicAdd(&(bar)[XB_TMO], 1u); break; } } } } while (0)
__device__ __forceinline__ void xcd_barrier_complete(unsigned* bar, unsigned x, unsigned& nloc, unsigned& nx) {
    const unsigned G = gridDim.x;
    unsigned sum, cnt, mine, sp = 0u;
    for (;;) {
        sum = 0u; cnt = 0u; mine = 0u;
#pragma unroll
        for (unsigned j = 0; j < 16; ++j) { const unsigned c = xb_ld(&bar[XB_XCNT(j)]); sum += c; cnt += (c > 0u) ? 1u : 0u; mine = (j == x) ? c : mine; }
        if (sum == G) break;
        __builtin_amdgcn_s_sleep(1);
        if ((++sp & 255u) == 0u) { if (xb_ld(&bar[XB_TMO])) break; if (sp > XB_SPIN_CAP) { atomicAdd(&bar[XB_TMO], 1u); break; } }
    }
    nloc = mine > 0u ? mine : 1u; nx = cnt > 0u ? cnt : 1u;
}
__device__ __forceinline__ void xcd_barrier(unsigned* bar, volatile LAS unsigned* st, const int tid) {
    asm volatile("s_waitcnt vmcnt(0)" ::: "memory");
    __syncthreads();
    if (tid == 0) {
        const unsigned x = xb_xcc_id();
        __builtin_amdgcn_s_waitcnt(0);
        unsigned nloc = st[0], nx = st[1];
        if (nloc == 0u) { xcd_barrier_complete(bar, x, nloc, nx); st[0] = nloc; st[1] = nx; }
        const unsigned old = xb_add(&bar[XB_XSUB(x)], 1u);
        const unsigned gen = old / nloc;
        if (old + 1u == (gen + 1u) * nloc) {
            __builtin_amdgcn_fence(__ATOMIC_RELEASE, "agent");
            asm volatile("s_waitcnt vmcnt(0)" ::: "memory");
            const unsigned og = xb_add(&bar[XB_TOP], 1u);
            const unsigned tg = og / nx;
            if (og + 1u == (tg + 1u) * nx) xb_add(&bar[XB_TOPGEN], 1u);
            else XB_SPIN(xb_ld(&bar[XB_TOPGEN]) == tg, bar);
            __builtin_amdgcn_fence(__ATOMIC_ACQUIRE, "agent");
            xb_add(&bar[XB_XGEN(x)], 1u);
            asm volatile("s_waitcnt vmcnt(0)" ::: "memory");
        } else {
            XB_SPIN(xb_ld(&bar[XB_XGEN(x)]) == gen, bar);
            __builtin_amdgcn_fence(__ATOMIC_ACQUIRE, "agent");
            asm volatile("s_waitcnt vmcnt(0)" ::: "memory");
        }
    }
    __syncthreads();
}

#ifndef DUPBAR
#define DUPBAR 1
#endif
#define GSYNC() do { FRESH(); for (int rb_ = 0; rb_ < DUPBAR; ++rb_) xcd_barrier((unsigned*)(p->ws + WS_CTL) + 4096, (volatile LAS unsigned*)(lds + LDS_BYTES - 32), tid); } while (0)
#define PTRS() unsigned* ctl = (unsigned*)(p->ws + WS_CTL); bf16_t* XB = (bf16_t*)(p->ws + WS_XB); bf16_t* PROJ = (bf16_t*)(p->ws + WS_PROJ); bf16_t* MIX = (bf16_t*)(p->ws + WS_MIX); bf16_t* H = (bf16_t*)(p->ws + WS_H); \
    float* ssqA = (float*)(p->ws + WS_SSQA); float* ssqB = (float*)(p->ws + WS_SSQB); unsigned char* wb = p->ws + WS_W + (size_t)l * LW_STRIDE; (void)ctl; (void)XB; (void)PROJ; (void)MIX; (void)H; (void)ssqA; (void)ssqB; (void)wb
#define FRESH() KP p = fresh_params(); int G = gridDim.x, bx = blockIdx.x; asm volatile("" : "+s"(G), "+s"(bx)); const int NGW = G * 8; (void)NGW; const int tid = fresh_tid(wave0), lane = tid & 63, wave = __builtin_amdgcn_readfirstlane(tid >> 6), gw = bx * 8 + wave; (void)lane; (void)gw
template <int L> __device__ __forceinline__ void layer_body(LAS unsigned char* lds, const int wave0) {
    constexpr int l = L;

#ifndef DUP1
#define DUP1 1
#endif
        for (int rep = 0; rep < DUP1; ++rep) {   if (rep) GSYNC(); FRESH(); PTRS(); pg8::Gemm g{XB, (const bf16_t*)(wb + LW_WIN), M, INCP, DM}; pg8::StaticOrder S; S.init(M, INCP, G, bx);
            pg8::EpiProj E{PROJ, INCP, ssqA};
            pg8::gemm_phase<pg8::EpiProj, pg8::StaticOrder, true, true>(lds, g, S, E, tid); }
        GSYNC();
#ifndef DUP234
#define DUP234 1
#endif
        for (int rep = 0; rep < DUP234; ++rep) { if (rep) GSYNC(); FRESH(); phase_prep1(p, l, lds, gw, NGW, wave, lane); }
        GSYNC();
        {   FRESH(); PTRS(); pg8::Gemm g{(const bf16_t*)(p->ws + WS_AW), (const bf16_t*)(wb + LW_W2T), M, 1024, 128}; pg8::StaticOrder S; S.init(M, 1024, G, bx);
            pg8::EpiLora<0> E{(float*)(p->ws + WS_DEC), p->in[7] + l * 1024};
            pg8::gemm_phase<pg8::EpiLora<0>, pg8::StaticOrder, true, true>(lds, g, S, E, tid); }
        {   FRESH(); PTRS(); pg8::Gemm g{(const bf16_t*)(p->ws + WS_AA), (const bf16_t*)(wb + LW_A2T), M, 1024, 128}; pg8::StaticOrder S; S.init(M, 1024, G, (bx + 128) % G);
            pg8::EpiLora<1> E{(float*)(p->ws + WS_A), p->in[9] + l * 1024};
            pg8::gemm_phase<pg8::EpiLora<1>, pg8::StaticOrder, true, true>(lds, g, S, E, tid); }
        {   FRESH(); PTRS(); pg8::Gemm g{(const bf16_t*)(p->ws + WS_AG), (const bf16_t*)(wb + LW_G2T), M, 1024, 256}; pg8::StaticOrder S; S.init(M, 1024, G, (bx + 128) % G);
            pg8::EpiLora<2> E{(float*)(p->ws + WS_G), nullptr};
            pg8::gemm_phase<pg8::EpiLora<2>, pg8::StaticOrder, true, true>(lds, g, S, E, tid); }
        GSYNC();
        {   FRESH(); LAS unsigned char* wl = lds + wave * 14336;
#ifndef DUP57
#define DUP57 1
#endif
#ifndef DUP5
#define DUP5 1
#endif
            for (int rep = 0; rep < DUP57 * DUP5; ++rep) for (int it = gw; it < 2 * NCH * 16; it += NGW) { const int mode = it & 1, ch = it >> 1, c = ch % NCH, h = ch / NCH;
                if (mode == 0) scan_task<0>(p, l, wl, c, h, lane); else scan_task<1>(p, l, wl, c, h, lane); } }
        GSYNC();
#ifndef DUP6
#define DUP6 1
#endif
        for (int rep = 0; rep < DUP6; ++rep) {   if (rep) GSYNC(); FRESH(); PTRS(); LAS int* slot = (LAS int*)(lds + LDS_BYTES - 64);
            LAS float* knl = (LAS float*)(lds + LDS_BYTES - 128);
            {   LAS float* kr = (LAS float*)lds; const float* knp = (const float*)(p->ws + WS_KNP); const int g = tid & 7, part = tid >> 3; float m = 0.f;
                for (int b2 = part; b2 < G; b2 += 64) m = fmaxf(m, knp[(size_t)b2 * 8 + g]);
                kr[part * 8 + g] = m; __syncthreads();
                if (tid < 8) { float mm = kr[tid]; for (int q2 = 1; q2 < 64; ++q2) mm = fmaxf(mm, kr[q2 * 8 + tid]); knl[tid] = mm; }
                __syncthreads(); }
            const float* sinks = p->in[5] + l * 8;
            for (;;) {
                if (tid == 0) *slot = (int)atomicAdd(ctl + 64 * (l + 1) + 16 * rep, 1u);
                __syncthreads();
                const int it = *slot;
                __syncthreads();
                if (it >= 928) break;
                if (it < 32) {
#ifndef NO_S2
                    s2_head(p, lds, it >> 1, it & 1, tid);
#endif
                }
                else if (it < 672) { const int d = it - 32, h = 3 - d / 160, u = d % 160, c = u & 1, v = u >> 1; int qb, seg;
                    if (v < 32) { qb = 31 - (v >> 2); seg = v & 3; } else if (v < 56) { const int w2 = v - 32; qb = 23 - w2 / 3; seg = w2 % 3; }
                    else if (v < 72) { const int w2 = v - 56; qb = 15 - (w2 >> 1); seg = w2 & 1; } else { qb = 79 - v; seg = 0; }
                    const float slope2 = exp2f(-2.0f * (float)(h + 1)) * LOG2E;
                    const float kn = sqrtf(knl[h * 2 + c]);
                    const int kt1 = 4 * qb + 3, klo = 32 * seg, khi = (klo + 31 < kt1) ? klo + 31 : kt1;
                    attn_unit<128, false>(lds, PROJ + h * 128 + c * 64, PROJ + 512 + h * 128 + c * 64, (const bf16_t*)(p->ws + WS_VAT) + (size_t)(h * 128) * M, slope2, qb * 256, 0.f,
                                          (float*)(p->ws + WS_OD) + (size_t)seg * M * 1024 + h * 256 + c * 128, (float*)(p->ws + WS_ML) + (size_t)seg * M * 16 + h * 4 + c * 2, nullptr, tid, klo, khi, kn); }
                else { const int s = it - 672, hq = s & 7, qb = s >> 3;
                    const int aidx = (hq >> 1) * 3 + (hq & 1);
                    const float slope2 = exp2f(-8.0f * (float)(aidx + 1) / 12.0f) * LOG2E;
                    const int q0 = qb * 256;
                    attn_unit<64, true>(lds, PROJ + 1536 + hq * 64, PROJ + 2048 + (hq >> 2) * 64, (const bf16_t*)(p->ws + WS_VBT) + (size_t)((hq >> 2) * 64) * M, slope2, q0, sinks[hq] * LOG2E,
                                        nullptr, nullptr, MIX + 512 + hq * 64, tid, q0 >= 128 ? (q0 - 128) / 64 : 0, (q0 + 255) / 64, 0.f); }
            } }
        GSYNC();
        {   FRESH();
            if (wave < 4) {
                LAS unsigned char* wl = lds + wave * 14336;
                for (int rep = 0; rep < DUP57; ++rep) for (int it = bx * 4 + wave; it < NCH * 16; it += G * 4) { const int c = it % NCH, h = it / NCH; scan_task<2>(p, l, wl, c, h, lane); }
            } else {
                phase_diffcombine(p, l, bx * 4 + (wave - 4), G * 4, lane);
                if (l + 1 < NL) { LAS float* scr = (LAS float*)(lds + 4 * 14336 + (wave - 4) * 8448);
                    for (int r = bx * 4 + (wave - 4); r < CONV_ITEMS; r += G * 4) convert_item(p, l + 1 < NL ? l + 1 : l, r, scr, lane); }
            } }
        GSYNC();
        {   FRESH(); PTRS(); pg8::Gemm g{MIX, (const bf16_t*)(wb + LW_WOUT), M, DM, DM}; pg8::StaticOrder S; S.init(M, DM, G, bx);
            pg8::EpiResid E{p->out, XB, ssqB};
            pg8::gemm_phase<pg8::EpiResid, pg8::StaticOrder, true, true>(lds, g, S, E, tid); }
        GSYNC();
        for (int rep = 0; rep < DUP1; ++rep) {   if (rep) GSYNC(); FRESH(); PTRS(); pg8::Gemm g{XB, (const bf16_t*)(wb + LW_WGU), M, GU, DM}; pg8::StaticOrder S; S.init(M, GU, G, bx);
            pg8::EpiSwiGLU E{H, ssqB};
            pg8::gemm_phase<pg8::EpiSwiGLU, pg8::StaticOrder, true, true>(lds, g, S, E, tid); }
        GSYNC();
        {   FRESH(); PTRS(); pg8::Gemm g{H, (const bf16_t*)(wb + LW_WDN), M, DM, FF}; pg8::StaticOrder S; S.init(M, DM, G, bx);
            pg8::EpiResid E{p->out, XB, ssqA};
            pg8::gemm_phase<pg8::EpiResid, pg8::StaticOrder, true, true>(lds, g, S, E, tid); }
        GSYNC();
    }

__global__ void __launch_bounds__(512, 2) fwd_megakernel(Params p_unused) {
    extern __shared__ __attribute__((aligned(16))) unsigned char lds_raw[];
    LAS unsigned char* lds = (LAS unsigned char*)lds_raw;
    cg::grid_group grid = cg::this_grid();
    const int wave0 = __builtin_amdgcn_readfirstlane((int)threadIdx.x >> 6);
    if (threadIdx.x < 16) ((LAS unsigned*)(lds + LDS_BYTES - 64))[threadIdx.x] = 0u;
    if (threadIdx.x == 0) xb_add((unsigned*)(p_unused.ws + WS_CTL) + 4096 + XB_XCNT(xb_xcc_id()), 1u);
    __syncthreads();

#ifndef DUP0
#define DUP0 1
#endif
    for (int rep = 0; rep < DUP0; ++rep) { FRESH(); phase0(p, lds, gw, NGW, wave, lane); __syncthreads(); }
    grid.sync();

    layer_body<0>(lds, wave0); layer_body<1>(lds, wave0); layer_body<2>(lds, wave0); layer_body<3>(lds, wave0);
    {   FRESH(); const int l = 0; PTRS(); const float* gf = p->in[21];
        for (int m = gw; m < M; m += NGW) { const float rs = rsqrtf(wave_sum(lane < 32 ? ssqA[(size_t)m * 32 + lane] : 0.f) * (1.0f / DM) + EPS);
#pragma unroll
            for (int j = 0; j < 8; ++j) { const size_t o = (size_t)m * DM + j * 256 + lane * 4; const f32x4 v = *(const f32x4*)(p->out + o); const f32x4 gv = *(const f32x4*)(gf + j * 256 + lane * 4);
                *(f32x4*)(p->out + o) = v * rs * gv; } } }
}

extern "C" void kernel_launch(void* const* d_in, const int* in_sizes, int n_in, void* d_out, int out_size, void* d_ws, size_t ws_size, hipStream_t stream) {
    static int grid = 0;
    if (grid == 0) {
        if (n_in != 22 || out_size != M * DM || ws_size < WS_END) { fprintf(stderr, "kernel_launch: unexpected shapes (n_in %d out %d ws %zu need %zu)\n", n_in, out_size, ws_size, (size_t)WS_END); grid = -1; return; }
        int dev = 0, cus = 0, per_cu = 0;
        hipGetDevice(&dev); hipDeviceGetAttribute(&cus, hipDeviceAttributeMultiprocessorCount, dev);
        hipFuncSetAttribute((const void*)fwd_megakernel, hipFuncAttributeMaxDynamicSharedMemorySize, LDS_BYTES);
        hipOccupancyMaxActiveBlocksPerMultiprocessor(&per_cu, (const void*)fwd_megakernel, 512, LDS_BYTES);
        if (per_cu < 1) { fprintf(stderr, "kernel_launch: occupancy query says %d blocks per CU\n", per_cu); per_cu = 1; }
        (void)hipGetLastError();
        grid = cus;
    }
    if (grid < 0) return;
    hipMemsetAsync((char*)d_ws + WS_CTL, 0, 65536, stream);
    Params p{};
    for (int i = 0; i < 22; ++i) p.in[i] = (const float*)d_in[i];
    p.out = (float*)d_out; p.ws = (unsigned char*)d_ws;
    void* args[] = {&p};
    hipError_t e = hipLaunchCooperativeKernel((const void*)fwd_megakernel, dim3(grid), dim3(512), args, LDS_BYTES, stream);
    if (e != hipSuccess) fprintf(stderr, "cooperative launch failed: %s (grid %d)\n", hipGetErrorString(e), grid);
}
```

```cpp
#include <hip/hip_runtime.h>
#include <hip/hip_cooperative_groups.h>
#include <cstdio>
#include <cstdint>
namespace cg = cooperative_groups;

#define LAS __attribute__((address_space(3)))
typedef unsigned short bf16_t;
typedef short bf16x8 __attribute__((ext_vector_type(8)));
typedef float f32x4 __attribute__((ext_vector_type(4)));
typedef float f32x2 __attribute__((ext_vector_type(2)));
typedef float f32x16 __attribute__((ext_vector_type(16)));
typedef unsigned u32x4 __attribute__((ext_vector_type(4)));
typedef unsigned u32x2 __attribute__((ext_vector_type(2)));
typedef __bf16 bf16x2_t __attribute__((ext_vector_type(2)));

constexpr int M = 8192, DM = 2048, INC = 5824, INCP = 5888, FF = 5632, GU = 11264, RW0 = 2304, RWC = 3520;
constexpr int NL = 4, NCH = 64, CL = 128;
constexpr float EPS = 1e-5f, LOG2E = 1.4426950408889634f;
constexpr float QSC = 0.125f * LOG2E;

constexpr size_t MiB = 1u << 20;
constexpr size_t SZ_WIN = (size_t)INCP * DM * 2, SZ_WOUT = (size_t)DM * DM * 2, SZ_WGU = (size_t)GU * DM * 2, SZ_WDN = (size_t)DM * FF * 2;
constexpr size_t SZ_W2T = 1024 * 128 * 2, SZ_G2T = 1024 * 256 * 2;
constexpr size_t LW_WIN = 0, LW_WOUT = LW_WIN + SZ_WIN, LW_WGU = LW_WOUT + SZ_WOUT, LW_WDN = LW_WGU + SZ_WGU, LW_W2T = LW_WDN + SZ_WDN,
                 LW_A2T = LW_W2T + SZ_W2T, LW_G2T = LW_A2T + SZ_W2T, LW_STRIDE = LW_G2T + SZ_G2T;
constexpr size_t SZ_F = (size_t)M * 1024 * 4;
constexpr size_t WS_CTL = 0, WS_W = 1 * MiB, WS_XB = WS_W + NL * LW_STRIDE, WS_PROJ = WS_XB + (size_t)M * DM * 2,
                 WS_VAT = WS_PROJ + (size_t)M * INCP * 2, WS_VBT = WS_VAT + (size_t)512 * M * 2, WS_AW = WS_VBT + (size_t)128 * M * 2,
                 WS_AA = WS_AW + (size_t)M * 128 * 2, WS_AG = WS_AA + (size_t)M * 128 * 2, WS_R = WS_AG + (size_t)M * 256 * 2,
                 WS_KR = WS_R + SZ_F, WS_V = WS_KR + SZ_F, WS_DEC = WS_V + SZ_F, WS_A = WS_DEC + SZ_F, WS_G = WS_A + SZ_F,
                 WS_KF = WS_G + SZ_F, WS_AN = WS_KF + SZ_F, WS_BB = WS_AN + SZ_F, WS_PB = WS_BB + SZ_F, WS_UB = WS_PB + SZ_F,
                 WS_SI = WS_UB + SZ_F, WS_OD = WS_SI + SZ_F, WS_ML = WS_OD + 4 * SZ_F, WS_KNP = WS_ML + (size_t)4 * M * 16 * 4, WS_MIX = WS_KNP + 65536, WS_SSQA = WS_MIX + (size_t)M * DM * 2,
                 WS_SSQB = WS_SSQA + (size_t)M * 32 * 4, WS_END = WS_SSQB + (size_t)M * 32 * 4;
constexpr size_t WS_H = WS_PROJ;
static_assert((size_t)M * FF * 2 <= (size_t)M * INCP * 2, "H overlay");

constexpr int LDS_BYTES = 147456;

struct Params { const float* in[22]; float* out; unsigned char* ws; };
typedef const __attribute__((address_space(4))) Params* KP;
__device__ __forceinline__ KP fresh_params() { KP k = (KP)__builtin_amdgcn_kernarg_segment_ptr(); asm volatile("" : "+s"(k)); return k; }

__device__ __forceinline__ unsigned cvtpk(float lo, float hi) { f32x2 v = {lo, hi}; bf16x2_t b = __builtin_convertvector(v, bf16x2_t); return __builtin_bit_cast(unsigned, b); }
__device__ __forceinline__ float bf2f(unsigned short b) { return __builtin_bit_cast(float, (unsigned)b << 16); }
__device__ __forceinline__ float bflo(unsigned w) { return __builtin_bit_cast(float, w << 16); }
__device__ __forceinline__ float bfhi(unsigned w) { return __builtin_bit_cast(float, w & 0xffff0000u); }
template <int CTRL> __device__ __forceinline__ float dppm(float v) { return __builtin_bit_cast(float, __builtin_amdgcn_mov_dpp(__builtin_bit_cast(int, v), CTRL, 0xF, 0xF, true)); }
__device__ __forceinline__ float xor16_sum(float v) { const unsigned b = __builtin_bit_cast(unsigned, v); auto rr = __builtin_amdgcn_permlane16_swap(b, b, false, false); return __builtin_bit_cast(float, (unsigned)rr[0]) + __builtin_bit_cast(float, (unsigned)rr[1]); }
__device__ __forceinline__ float xor32_sum(float v) { const unsigned b = __builtin_bit_cast(unsigned, v); auto rr = __builtin_amdgcn_permlane32_swap(b, b, false, false); return __builtin_bit_cast(float, (unsigned)rr[0]) + __builtin_bit_cast(float, (unsigned)rr[1]); }
__device__ __forceinline__ float xor32_max(float v) { const unsigned b = __builtin_bit_cast(unsigned, v); auto rr = __builtin_amdgcn_permlane32_swap(b, b, false, false); return fmaxf(__builtin_bit_cast(float, (unsigned)rr[0]), __builtin_bit_cast(float, (unsigned)rr[1])); }
__device__ __forceinline__ float row16_sum(float v) { v += dppm<0xB1>(v); v += dppm<0x4E>(v); v += dppm<0x141>(v); v += dppm<0x140>(v); return v; }
__device__ __forceinline__ float wave_sum(float v) { return xor32_sum(xor16_sum(row16_sum(v))); }
__device__ __forceinline__ float dpp_xor1(float v) { return __builtin_bit_cast(float, __builtin_amdgcn_mov_dpp(__builtin_bit_cast(int, v), 0xB1, 0xF, 0xF, true)); }
__device__ __forceinline__ float dpp_xor2(float v) { return __builtin_bit_cast(float, __builtin_amdgcn_mov_dpp(__builtin_bit_cast(int, v), 0x4E, 0xF, 0xF, true)); }
__device__ __forceinline__ float quad_sum(float v) { v += dpp_xor1(v); v += dpp_xor2(v); return v; }
__device__ __forceinline__ float sigmoidf_(float x) { return __builtin_amdgcn_rcpf(1.0f + __expf(-x)); }

__device__ __forceinline__ int fresh_tid(int wave0) { unsigned z = 0u; asm volatile("" : "+v"(z)); int t = wave0 * 64 + (int)__builtin_amdgcn_mbcnt_hi(~0u, __builtin_amdgcn_mbcnt_lo(~0u, z)); asm volatile("" : "+v"(t)); return t; }

__device__ __forceinline__ float row_rstd(const float* ssq, int row, int fq) {
    const float* pp = ssq + (size_t)row * 32 + 8 * fq; const f32x4 a = *(const f32x4*)pp, b = *(const f32x4*)(pp + 4);
    float s = ((a[0] + a[1]) + (a[2] + a[3])) + ((b[0] + b[1]) + (b[2] + b[3]));
    s = xor32_sum(xor16_sum(s));
    return rsqrtf(s * (1.0f / DM) + EPS);
}

namespace pg8 {
constexpr int BM = 256, BK = 64, HALF = 128, HTB = HALF * BK * 2, STAGE_BYTES = 8 * HTB, NXCD = 8, WGM = 8;
__host__ __device__ __forceinline__ int lds_byte(int r, int c) { const int st = (r >> 4) * 2 + (c >> 5), rr = r & 15, cc = c & 31, ob = rr * 64 + cc * 2; return st * 1024 + (ob ^ (((ob >> 9) & 1) << 5)); }
__host__ __device__ __forceinline__ void stage_rc(int b, int& R, int& C) { const int st = b / 1024, sb = b % 1024, swz = sb ^ (((sb >> 9) & 1) << 5); R = (st >> 1) * 16 + swz / 64; C = (st & 1) * 32 + (swz % 64) / 2; }
__host__ __device__ __forceinline__ int perm32(int rho) { const int n = rho >> 4, i = rho & 15; return 8 * (i >> 2) + 4 * n + (i & 3); }
struct Unit { int pm, pn; };
struct Gemm { const bf16_t* A; const bf16_t* Bt; int M, N, K; };
struct StaticOrder {
    int nM, nN, nwg, G, c;
    __host__ __device__ void init(int M_, int N_, int G_, int c_) { nM = M_ / BM; nN = N_ / BM; nwg = nM * nN; G = G_; c = c_; }
    __host__ __device__ bool next(int i, Unit& u) const {
        const long L = (long)i * G + c; if (L >= nwg) return false;
        int wgid = (int)L; { const int q = nwg / NXCD, r = nwg % NXCD, xcd = wgid % NXCD, off = wgid / NXCD; wgid = (xcd < r ? xcd * (q + 1) : r * (q + 1) + (xcd - r) * q) + off; }
        const int nig = WGM * nN, gid = wgid / nig, fm = gid * WGM, gsz = (nM - fm) < WGM ? (nM - fm) : WGM;
        u.pm = fm + ((wgid % nig) % gsz); u.pn = (wgid % nig) / gsz; return true;
    }
};

template <class Epi, class Sched, bool ALIGN_EPI, bool SP2>
__device__ __forceinline__ void gemm_phase(LAS unsigned char* lds, const Gemm g, const Sched& S, const Epi& E, const int tid) {
    const int wid = __builtin_amdgcn_readfirstlane(tid >> 6), lane = tid & 63, wr = wid >> 2, wc = wid & 3, fr = lane & 15, fq = lane >> 4;
    const int K = g.K, nt = K / BK;
    unsigned voffA[2], voffB[2];
#pragma unroll
    for (int i = 0; i < 2; ++i) { int R, C; stage_rc(tid * 16 + i * 8192, R, C); const int Rb = Epi::PERM ? ((R & ~31) + perm32(R & 31)) : R;
        voffA[i] = (unsigned)(R * K + C) * 2u; voffB[i] = (unsigned)(Rb * K + C) * 2u; }
    const size_t kstep = (size_t)(BK * 2);
    const size_t hstep = (size_t)HALF * K * 2;
    const size_t tstep = 2 * hstep;
    const unsigned ldsw = (unsigned)wid * 1024u;
    const int aoff = lds_byte(wr * 64 + fr, fq * 8), boff = lds_byte(wc * 32 + fr, fq * 8);
#define PG8_SA(b, h) (((b) * 2 + (h)) * HTB)
#define PG8_SB(b, h) ((4 + (b) * 2 + (h)) * HTB)
#define PG8_STAGE(bufoff, gbase, voff) do { _Pragma("unroll") for (int _i = 0; _i < 2; ++_i) \
        __builtin_amdgcn_global_load_lds((const unsigned*)((const char*)(gbase) + (voff)[_i]), (LAS unsigned*)(lds + (bufoff) + ldsw + _i * 8192), 16, 0, 0); } while (0)
#define PG8_LDA(dst, b, h) do { _Pragma("unroll") for (int m = 0; m < 4; ++m) _Pragma("unroll") for (int k = 0; k < 2; ++k) dst[m][k] = *(const LAS bf16x8*)(lds + PG8_SA(b, h) + aoff + m * 2048 + k * 1024); } while (0)
#define PG8_LDB(dst, b, h) do { _Pragma("unroll") for (int n = 0; n < 2; ++n) _Pragma("unroll") for (int k = 0; k < 2; ++k) dst[n][k] = *(const LAS bf16x8*)(lds + PG8_SB(b, h) + boff + n * 2048 + k * 1024); } while (0)
#define PG8_MMA(ai, bj, At, Bt) do { __builtin_amdgcn_s_setprio(1); _Pragma("unroll") for (int m = 0; m < 4; ++m) _Pragma("unroll") for (int n = 0; n < 2; ++n) _Pragma("unroll") for (int k = 0; k < 2; ++k) \
        acc[ai][bj][m][n] = __builtin_amdgcn_mfma_f32_16x16x32_bf16(Bt[n][k], At[m][k], acc[ai][bj][m][n], 0, 0, 0); __builtin_amdgcn_s_setprio(0); } while (0)
#define PG8_WAIT_V(n) asm volatile("s_waitcnt vmcnt(" #n ")" ::: "memory")
#define PG8_WAIT_L(n) asm volatile("s_waitcnt lgkmcnt(" #n ")" ::: "memory")
#define PG8_BAR __builtin_amdgcn_s_barrier()
#define PG8_SCHED __builtin_amdgcn_sched_barrier(0)
    Unit cur, nxt; int ui = 0;
    if (!S.next(0, cur)) return;
    f32x4 acc[2][2][4][2];
#pragma unroll
    for (int a = 0; a < 2; ++a)
#pragma unroll
        for (int b = 0; b < 2; ++b)
#pragma unroll
            for (int m = 0; m < 4; ++m)
#pragma unroll
                for (int n = 0; n < 2; ++n) acc[a][b][m][n] = (f32x4){0.f, 0.f, 0.f, 0.f};
    bf16x8 At[4][2], B0[2][2], B1[2][2];
    const char* cA = (const char*)g.A + (size_t)cur.pm * tstep; const char* cB = (const char*)g.Bt + (size_t)cur.pn * tstep;
    if constexpr (SP2) {
        PG8_STAGE(PG8_SB(0, 0), cB, voffB); PG8_STAGE(PG8_SB(0, 1), cB + hstep, voffB); PG8_STAGE(PG8_SA(0, 0), cA, voffA); PG8_STAGE(PG8_SA(0, 1), cA + hstep, voffA);
        if (wr == 1) PG8_BAR;
        PG8_WAIT_V(2); PG8_BAR;
        PG8_STAGE(PG8_SB(1, 0), cB + kstep, voffB); PG8_STAGE(PG8_SA(1, 0), cA + kstep, voffA); PG8_STAGE(PG8_SB(1, 1), cB + hstep + kstep, voffB);
        PG8_WAIT_V(6); PG8_BAR;
    } else {
        PG8_STAGE(PG8_SB(0, 0), cB, voffB); PG8_STAGE(PG8_SA(0, 0), cA, voffA); PG8_STAGE(PG8_SB(0, 1), cB + hstep, voffB); PG8_STAGE(PG8_SA(0, 1), cA + hstep, voffA);
        if (wr == 1) PG8_BAR;
        PG8_WAIT_V(4); PG8_BAR;
        PG8_STAGE(PG8_SB(1, 0), cB + kstep, voffB); PG8_STAGE(PG8_SA(1, 0), cA + kstep, voffA); PG8_STAGE(PG8_SB(1, 1), cB + hstep + kstep, voffB);
        PG8_WAIT_V(6); PG8_BAR;
    }
    for (;;) {
        const bool has_next = S.next(ui + 1, nxt);
        const char* nA = has_next ? (const char*)g.A + (size_t)nxt.pm * tstep : cA; const char* nB = has_next ? (const char*)g.Bt + (size_t)nxt.pn * tstep : cB;
        for (int t = 0; t < nt; t += 2) {
            const bool last = (t == nt - 2);
            const char* a1 = cA + (size_t)(t + 1) * kstep;
            const char* a2 = last ? nA : cA + (size_t)(t + 2) * kstep; const char* b2 = last ? nB : cB + (size_t)(t + 2) * kstep;
            const char* a3 = a2 + kstep; const char* b3 = b2 + kstep;
            if constexpr (SP2) {
            PG8_LDB(B0, 0, 0); PG8_LDB(B1, 0, 1); PG8_SCHED; PG8_LDA(At, 0, 0); PG8_STAGE(PG8_SA(1, 1), a1 + hstep, voffA);
            PG8_WAIT_V(8); PG8_WAIT_L(0); PG8_BAR; PG8_MMA(0, 0, At, B0); PG8_MMA(0, 1, At, B1); PG8_BAR; PG8_SCHED;
            PG8_LDA(At, 0, 1); PG8_STAGE(PG8_SB(0, 0), b2, voffB); PG8_STAGE(PG8_SB(0, 1), b2 + hstep, voffB); PG8_STAGE(PG8_SA(0, 0), a2, voffA);
            PG8_WAIT_V(8); PG8_WAIT_L(0); PG8_BAR; PG8_MMA(1, 0, At, B0); PG8_MMA(1, 1, At, B1); PG8_BAR; PG8_SCHED;
            PG8_LDB(B0, 1, 0); PG8_LDB(B1, 1, 1); PG8_SCHED; PG8_LDA(At, 1, 0); PG8_STAGE(PG8_SA(0, 1), a2 + hstep, voffA);
            PG8_WAIT_V(8); PG8_WAIT_L(0); PG8_BAR; PG8_MMA(0, 0, At, B0); PG8_MMA(0, 1, At, B1); PG8_BAR; PG8_SCHED;
            PG8_LDA(At, 1, 1); PG8_STAGE(PG8_SB(1, 0), b3, voffB); PG8_STAGE(PG8_SB(1, 1), b3 + hstep, voffB); PG8_STAGE(PG8_SA(1, 0), a3, voffA);
            PG8_WAIT_V(8); PG8_WAIT_L(0); PG8_BAR; PG8_MMA(1, 0, At, B0); PG8_MMA(1, 1, At, B1); PG8_BAR; PG8_SCHED;
            } else {
            PG8_LDB(B0, 0, 0); PG8_SCHED; PG8_LDA(At, 0, 0); PG8_STAGE(PG8_SA(1, 1), a1 + hstep, voffA);
            PG8_WAIT_L(8); PG8_BAR; PG8_WAIT_L(0); PG8_MMA(0, 0, At, B0); PG8_BAR; PG8_SCHED;
            PG8_LDB(B1, 0, 1); PG8_STAGE(PG8_SB(0, 0), b2, voffB);
            PG8_BAR; PG8_WAIT_L(0); PG8_MMA(0, 1, At, B1); PG8_BAR;
            PG8_LDA(At, 0, 1); PG8_STAGE(PG8_SA(0, 0), a2, voffA);
            PG8_BAR; PG8_WAIT_L(0); PG8_MMA(1, 0, At, B0); PG8_BAR; PG8_SCHED;
            PG8_STAGE(PG8_SB(0, 1), b2 + hstep, voffB);
            PG8_WAIT_V(6); PG8_BAR; PG8_MMA(1, 1, At, B1); PG8_BAR;
            PG8_LDB(B0, 1, 0); PG8_SCHED; PG8_LDA(At, 1, 0); PG8_STAGE(PG8_SA(0, 1), a2 + hstep, voffA);
            PG8_WAIT_L(8); PG8_BAR; PG8_WAIT_L(0); PG8_MMA(0, 0, At, B0); PG8_BAR; PG8_SCHED;
            PG8_LDB(B1, 1, 1); PG8_STAGE(PG8_SB(1, 0), b3, voffB);
            PG8_BAR; PG8_WAIT_L(0); PG8_MMA(0, 1, At, B1); PG8_BAR;
            PG8_LDA(At, 1, 1); PG8_STAGE(PG8_SA(1, 0), a3, voffA);
            PG8_BAR; PG8_WAIT_L(0); PG8_MMA(1, 0, At, B0); PG8_BAR; PG8_SCHED;
            PG8_STAGE(PG8_SB(1, 1), b3 + hstep, voffB);
            PG8_WAIT_V(6); PG8_BAR; PG8_MMA(1, 1, At, B1); PG8_BAR;
            }
        }
        if constexpr (ALIGN_EPI) { if (wr == 0) PG8_BAR; }
        E(acc, cur, wr, wc, fr, fq);
        if (!has_next) break;
#pragma unroll
        for (int a = 0; a < 2; ++a)
#pragma unroll
            for (int b = 0; b < 2; ++b)
#pragma unroll
                for (int m = 0; m < 4; ++m)
#pragma unroll
                    for (int n = 0; n < 2; ++n) acc[a][b][m][n] = (f32x4){0.f, 0.f, 0.f, 0.f};
        cur = nxt; cA = nA; cB = nB; ++ui;
        if constexpr (ALIGN_EPI) { if (wr == 1) PG8_BAR; }
    }
    PG8_WAIT_V(0);
    if constexpr (!ALIGN_EPI) { if (wr == 0) PG8_BAR; }
    PG8_BAR;
#undef PG8_SA
#undef PG8_SB
#undef PG8_STAGE
#undef PG8_LDA
#undef PG8_LDB
#undef PG8_MMA
#undef PG8_WAIT_V
#undef PG8_WAIT_L
#undef PG8_BAR
#undef PG8_SCHED
}

struct EpiProj {
    static constexpr bool PERM = true;
    bf16_t* O; int ldc; const float* ssq;
    __device__ __forceinline__ void operator()(const f32x4 (&acc)[2][2][4][2], const Unit& u, int wr, int wc, int fr, int fq) const {
        const int row0 = u.pm * BM + wr * 64 + fr, col0 = u.pn * BM + wc * 32 + 8 * fq;
#pragma unroll
        for (int ai = 0; ai < 2; ++ai)
#pragma unroll
            for (int m = 0; m < 4; ++m) { const int row = row0 + ai * HALF + m * 16; const float rs = row_rstd(ssq, row, fq);
                bf16_t* rowp = O + (size_t)row * ldc + col0;
#pragma unroll
                for (int bj = 0; bj < 2; ++bj) { const f32x4 v0 = acc[ai][bj][m][0] * rs, v1 = acc[ai][bj][m][1] * rs;
                    u32x4 w; w.x = cvtpk(v0[0], v0[1]); w.y = cvtpk(v0[2], v0[3]); w.z = cvtpk(v1[0], v1[1]); w.w = cvtpk(v1[2], v1[3]);
                    *(u32x4*)(rowp + bj * HALF) = w; } }
    }
};
struct EpiSwiGLU {
    static constexpr bool PERM = true;
    bf16_t* O; const float* ssq;
    __device__ __forceinline__ void operator()(const f32x4 (&acc)[2][2][4][2], const Unit& u, int wr, int wc, int fr, int fq) const {
        const int row0 = u.pm * BM + wr * 64 + fr, col0 = u.pn * HALF + wc * 32 + 8 * fq;
#pragma unroll
        for (int ai = 0; ai < 2; ++ai)
#pragma unroll
            for (int m = 0; m < 4; ++m) { const int row = row0 + ai * HALF + m * 16; const float rs = row_rstd(ssq, row, fq);
                float h[8];
#pragma unroll
                for (int n = 0; n < 2; ++n)
#pragma unroll
                    for (int j = 0; j < 4; ++j) { const float gt = acc[ai][0][m][n][j] * rs, up = acc[ai][1][m][n][j] * rs; h[n * 4 + j] = gt * up * __builtin_amdgcn_rcpf(1.0f + __expf(-gt)); }
                u32x4 w; w.x = cvtpk(h[0], h[1]); w.y = cvtpk(h[2], h[3]); w.z = cvtpk(h[4], h[5]); w.w = cvtpk(h[6], h[7]);
                *(u32x4*)(O + (size_t)row * FF + col0) = w; }
    }
};
struct EpiResid {
    static constexpr bool PERM = false;
    float* X; bf16_t* XB; float* ssq;
    __device__ __forceinline__ void operator()(const f32x4 (&acc)[2][2][4][2], const Unit& u, int wr, int wc, int fr, int fq) const {
        const int row0 = u.pm * BM + wr * 64 + fr, col0 = u.pn * BM + wc * 32 + 4 * fq;
#pragma unroll
        for (int ai = 0; ai < 2; ++ai)
#pragma unroll
            for (int m = 0; m < 4; ++m) { const int row = row0 + ai * HALF + m * 16; const size_t off = (size_t)row * DM + col0; float ss = 0.f;
#pragma unroll
                for (int bj = 0; bj < 2; ++bj)
#pragma unroll
                    for (int n = 0; n < 2; ++n) { const size_t o = off + bj * HALF + n * 16; const f32x4 xv = *(const f32x4*)(X + o) + acc[ai][bj][m][n];
                        *(f32x4*)(X + o) = xv; u32x2 w; w.x = cvtpk(xv[0], xv[1]); w.y = cvtpk(xv[2], xv[3]); *(u32x2*)(XB + o) = w;
                        ss += (xv[0] * xv[0] + xv[1] * xv[1]) + (xv[2] * xv[2] + xv[3] * xv[3]); }
                ss = xor32_sum(xor16_sum(ss));
                if (fq == 0) ssq[(size_t)row * 32 + u.pn * 4 + wc] = ss; }
    }
};
template <int MODE> struct EpiLora {
    static constexpr bool PERM = false;
    float* O; const float* bias;
    __device__ __forceinline__ void operator()(const f32x4 (&acc)[2][2][4][2], const Unit& u, int wr, int wc, int fr, int fq) const {
        const int row0 = u.pm * BM + wr * 64 + fr, col0 = u.pn * BM + wc * 32 + 4 * fq;
#pragma unroll
        for (int bj = 0; bj < 2; ++bj)
#pragma unroll
            for (int n = 0; n < 2; ++n) { const int col = col0 + bj * HALF + n * 16;
                f32x4 bv = (f32x4){0.f, 0.f, 0.f, 0.f}; if (MODE != 2) bv = *(const f32x4*)(bias + col);
#pragma unroll
                for (int ai = 0; ai < 2; ++ai)
#pragma unroll
                    for (int m = 0; m < 4; ++m) { const int row = row0 + ai * HALF + m * 16; f32x4 v = acc[ai][bj][m][n] + bv;
                        if (MODE == 0) {
#pragma unroll
                            for (int j = 0; j < 4; ++j) v[j] = __expf(-0.60653065971f * sigmoidf_(v[j]));
                        } else if (MODE == 1) {
#pragma unroll
                            for (int j = 0; j < 4; ++j) v[j] = sigmoidf_(v[j]);
                        }
                        if (MODE != 0) { u32x2 w2; w2.x = cvtpk(v[0], v[1]); w2.y = cvtpk(v[2], v[3]); *(u32x2*)((bf16_t*)O + (size_t)row * 1024 + col) = w2; }
                        else *(f32x4*)(O + (size_t)row * 1024 + col) = v; } }
    }
};
}

template <int MAP>
__device__ __forceinline__ void transpose_item(const float* W, int K, int N, bf16_t* WT, const float* gk, LAS float* scr, int item, int lane) {
    const int nblk = N / 32, kb = item / nblk, nb = item % nblk, k0 = 64 * kb, n0 = 32 * nb;
    float v[32];
    const float* wp = W + (size_t)(k0 + (lane >> 5)) * N + n0 + (lane & 31);
#pragma unroll
    for (int i = 0; i < 32; ++i) v[i] = __builtin_nontemporal_load(wp + (size_t)(2 * i) * N);
    const int c = lane & 7;
    f32x4 g0 = (f32x4){1.f, 1.f, 1.f, 1.f}, g1 = g0;
    if (gk) { g0 = *(const f32x4*)(gk + k0 + 8 * c); g1 = *(const f32x4*)(gk + k0 + 8 * c + 4); }
#pragma unroll
    for (int i = 0; i < 32; ++i) scr[(2 * i + (lane >> 5)) * 33 + (lane & 31)] = v[i];
    asm volatile("s_waitcnt lgkmcnt(0)" ::: "memory");
#pragma unroll
    for (int j = 0; j < 4; ++j) { const int n = n0 + (lane >> 3) + 8 * j; const LAS float* s = scr + (8 * c) * 33 + (n - n0);
        float sc = 1.f; int drow = n;
        if (MAP == 0) { if (n < 512 || (n >= 1536 && n < 2048)) sc = QSC; }
        if (MAP == 1) { const int hn = n < FF ? n : n - FF; drow = (hn >> 7) * 256 + (n < FF ? 0 : 128) + (hn & 127); }
        const f32x4 h0 = g0 * sc, h1 = g1 * sc;
        u32x4 o; o.x = cvtpk(s[0 * 33] * h0[0], s[1 * 33] * h0[1]); o.y = cvtpk(s[2 * 33] * h0[2], s[3 * 33] * h0[3]); o.z = cvtpk(s[4 * 33] * h1[0], s[5 * 33] * h1[1]); o.w = cvtpk(s[6 * 33] * h1[2], s[7 * 33] * h1[3]);
        *(u32x4*)(WT + (size_t)drow * K + k0 + 8 * c) = o; }
    asm volatile("s_waitcnt lgkmcnt(0)" ::: "memory");
}

constexpr int I_IN = (DM / 64) * (INC / 32), I_OUT = (DM / 64) * (DM / 32), I_GU = (DM / 64) * (GU / 32), I_DN = (FF / 64) * (DM / 32);
constexpr int CONV_ITEMS = I_IN + I_OUT + I_GU + I_DN;
__device__ __forceinline__ void convert_item(KP p, int l, int r, LAS float* scr, int lane) {
    unsigned char* wb = p->ws + WS_W + (size_t)l * LW_STRIDE;
    if (r < I_IN) { transpose_item<0>(p->in[2] + (size_t)l * DM * INC, DM, INC, (bf16_t*)(wb + LW_WIN), p->in[1] + l * DM, scr, r, lane); return; } r -= I_IN;
    if (r < I_OUT) { transpose_item<2>(p->in[17] + (size_t)l * DM * DM, DM, DM, (bf16_t*)(wb + LW_WOUT), nullptr, scr, r, lane); return; } r -= I_OUT;
    if (r < I_GU) { transpose_item<1>(p->in[19] + (size_t)l * DM * GU, DM, GU, (bf16_t*)(wb + LW_WGU), p->in[18] + l * DM, scr, r, lane); return; } r -= I_GU;
    transpose_item<2>(p->in[20] + (size_t)l * FF * DM, FF, DM, (bf16_t*)(wb + LW_WDN), nullptr, scr, r, lane);
}

__device__ __forceinline__ void phase0(KP p, LAS unsigned char* lds, int gw, int NGW, int wave, int lane) {
    LAS float* scr = (LAS float*)(lds + wave * 16384);
    for (int it = gw; it < CONV_ITEMS; it += NGW) convert_item(p, 0, it, scr, lane);
    const int gt = gw * 64 + lane, NGT = NGW * 64;
    for (int l = 0; l < NL; ++l) {
        unsigned char* wb = p->ws + WS_W + (size_t)l * LW_STRIDE;
        bf16_t* w2t = (bf16_t*)(wb + LW_W2T); bf16_t* a2t = (bf16_t*)(wb + LW_A2T); bf16_t* g2t = (bf16_t*)(wb + LW_G2T);
        const float* w2 = p->in[8] + (size_t)l * 96 * 1024; const float* a2 = p->in[10] + (size_t)l * 96 * 1024; const float* g2 = p->in[11] + (size_t)l * 256 * 1024;
        for (int id = gt; id < 65536; id += NGT) {
            const float* sm; bf16_t* dm; int ld, klim, q = id;
            if (q < 16384) { sm = w2; dm = w2t; ld = 128; klim = 96; } else if (q < 32768) { q -= 16384; sm = a2; dm = a2t; ld = 128; klim = 96; } else { q -= 32768; sm = g2; dm = g2t; ld = 256; klim = 256; }
            const int n = q & 1023, k0 = (q >> 10) * 8; float v[8];
#pragma unroll
            for (int j = 0; j < 8; ++j) v[j] = (k0 + j < klim) ? sm[(size_t)(k0 + j) * 1024 + n] : 0.f;
            u32x4 o; o.x = cvtpk(v[0], v[1]); o.y = cvtpk(v[2], v[3]); o.z = cvtpk(v[4], v[5]); o.w = cvtpk(v[6], v[7]);
            *(u32x4*)(dm + (size_t)n * ld + k0) = o; }
        unsigned* padz = (unsigned*)(wb + LW_WIN + (size_t)INC * DM * 2);
        for (int i = gt; i < (INCP - INC) * DM / 2; i += NGT) padz[i] = 0u;
    }
    const float* x = p->in[0]; float* X = p->out; bf16_t* XB = (bf16_t*)(p->ws + WS_XB); float* ssqA = (float*)(p->ws + WS_SSQA);
    for (int m = gw; m < M; m += NGW) { float ss = 0.f;
#pragma unroll
        for (int j = 0; j < 8; ++j) { const size_t o = (size_t)m * DM + j * 256 + lane * 4; const f32x4 v = *(const f32x4*)(x + o); *(f32x4*)(X + o) = v;
            u32x2 w; w.x = cvtpk(v[0], v[1]); w.y = cvtpk(v[2], v[3]); *(u32x2*)(XB + o) = w; ss += (v[0] * v[0] + v[1] * v[1]) + (v[2] * v[2] + v[3] * v[3]); }
        ss = wave_sum(ss); if (lane < 32) ssqA[(size_t)m * 32 + lane] = lane == 0 ? ss : 0.f; }
}

__device__ __forceinline__ void phase_prep1(KP p, int l, LAS unsigned char* lds, int gw, int NGW, int wave, int lane) {
    const bf16_t* PROJ = (const bf16_t*)(p->ws + WS_PROJ);
    LAS unsigned short* tile = (LAS unsigned short*)(lds + wave * 8448);
    bf16_t* VAT = (bf16_t*)(p->ws + WS_VAT); bf16_t* VBT = (bf16_t*)(p->ws + WS_VBT);
    for (int it = gw; it < 128 * 10; it += NGW) {
        const int tb = it / 10, g = it % 10, t0 = tb * 64; const int cbase = g < 8 ? 1024 + 64 * g : 2176 + 64 * (g - 8);
        bf16_t* dst = g < 8 ? VAT + (size_t)(64 * g) * M : VBT + (size_t)(64 * (g - 8)) * M;
#pragma unroll
        for (int i = 0; i < 8; ++i) { const int row = i * 8 + (lane >> 3), ch = lane & 7; const u32x4 v = *(const u32x4*)(PROJ + (size_t)(t0 + row) * INCP + cbase + 8 * ch);
            LAS unsigned* d = (LAS unsigned*)(tile + row * 66 + 8 * ch); d[0] = v.x; d[1] = v.y; d[2] = v.z; d[3] = v.w; }
        asm volatile("s_waitcnt lgkmcnt(0)" ::: "memory");
#pragma unroll
        for (int i = 0; i < 8; ++i) { const int c = i * 8 + (lane >> 3), tch = lane & 7, j = tch >> 1, hi = tch & 1; unsigned short v[8];
#pragma unroll
            for (int s = 0; s < 8; ++s) v[s] = tile[(16 * j + (s & 3) + 8 * (s >> 2) + 4 * hi) * 66 + c];
            u32x4 o; o.x = v[0] | ((unsigned)v[1] << 16); o.y = v[2] | ((unsigned)v[3] << 16); o.z = v[4] | ((unsigned)v[5] << 16); o.w = v[6] | ((unsigned)v[7] << 16);
            *(u32x4*)(dst + (size_t)c * M + t0 + 16 * j + 8 * hi) = o; }
        asm volatile("s_waitcnt lgkmcnt(0)" ::: "memory");
    }
    const float* mu = p->in[6] + (size_t)l * RWC;
    bf16_t* AW = (bf16_t*)(p->ws + WS_AW); bf16_t* AA = (bf16_t*)(p->ws + WS_AA); bf16_t* AG = (bf16_t*)(p->ws + WS_AG);
    float knmax = 0.f;
    for (int t = gw; t < M; t += NGW) {
        const bf16_t* cur = PROJ + (size_t)t * INCP + RW0;
        {   const u32x4 kv = *(const u32x4*)(PROJ + (size_t)t * INCP + 512 + 8 * lane);
            float a0 = bflo(kv.x), a1 = bfhi(kv.x), a2 = bflo(kv.y), a3 = bfhi(kv.y), a4 = bflo(kv.z), a5 = bfhi(kv.z), a6 = bflo(kv.w), a7 = bfhi(kv.w);
            float ss = (a0 * a0 + a1 * a1) + (a2 * a2 + a3 * a3) + (a4 * a4 + a5 * a5) + (a6 * a6 + a7 * a7);
            ss += dppm<0xB1>(ss); ss += dppm<0x4E>(ss); ss += dppm<0x141>(ss); knmax = fmaxf(knmax, ss); }
        if (lane < 56) { const int j0 = 3072 + 8 * lane;
            const u32x4 c4 = *(const u32x4*)(cur + j0); u32x4 p4 = (u32x4){0u, 0u, 0u, 0u}; if (t > 0) p4 = *(const u32x4*)(cur - INCP + j0);
            const f32x4 m0 = *(const f32x4*)(mu + j0), m1 = *(const f32x4*)(mu + j0 + 4);
            float f[8]; const unsigned cw[4] = {c4.x, c4.y, c4.z, c4.w}, pw[4] = {p4.x, p4.y, p4.z, p4.w};
#pragma unroll
            for (int q = 0; q < 4; ++q) { const float c0 = bflo(cw[q]), c1 = bfhi(cw[q]), p0 = bflo(pw[q]), p1 = bfhi(pw[q]);
                const float mu0 = q < 2 ? m0[2 * q] : m1[2 * q - 4], mu1 = q < 2 ? m0[2 * q + 1] : m1[2 * q - 3];
                f[2 * q] = c0 + (p0 - c0) * mu0; f[2 * q + 1] = c1 + (p1 - c1) * mu1; }
            bf16_t* dstp;
            if (j0 < 3168) { dstp = AW + (size_t)t * 128 + (j0 - 3072);
#pragma unroll
                for (int q = 0; q < 8; ++q) f[q] = tanhf(f[q]); }
            else if (j0 < 3264) { dstp = AA + (size_t)t * 128 + (j0 - 3168); }
            else { dstp = AG + (size_t)t * 256 + (j0 - 3264);
#pragma unroll
                for (int q = 0; q < 8; ++q) f[q] = sigmoidf_(f[q]); }
            u32x4 o; o.x = cvtpk(f[0], f[1]); o.y = cvtpk(f[2], f[3]); o.z = cvtpk(f[4], f[5]); o.w = cvtpk(f[6], f[7]); *(u32x4*)dstp = o; }
        else { const int e = lane - 56; if (e < 4) *(u32x4*)(AW + (size_t)t * 128 + 96 + 8 * e) = (u32x4){0u, 0u, 0u, 0u}; else *(u32x4*)(AA + (size_t)t * 128 + 96 + 8 * (e - 4)) = (u32x4){0u, 0u, 0u, 0u}; }
    }
    {   LAS float* kr = (LAS float*)(lds + 8 * 8448);
        if ((lane & 7) == 0) kr[wave * 8 + (lane >> 3)] = knmax;
        __syncthreads();
        if (wave == 0 && lane < 8) { float m = kr[lane];
#pragma unroll
            for (int w2 = 1; w2 < 8; ++w2) m = fmaxf(m, kr[w2 * 8 + lane]);
            ((float*)(p->ws + WS_KNP))[(size_t)(gw >> 3) * 8 + lane] = m; }
        __syncthreads(); }
}

__device__ __forceinline__ void phase_prep2(KP p, int l, int gw, int NGW, int lane) {
    const float* KR = (const float*)(p->ws + WS_KR); const float* A = (const float*)(p->ws + WS_A);
    float* KF = (float*)(p->ws + WS_KF); float* AN = (float*)(p->ws + WS_AN); float* BB = (float*)(p->ws + WS_BB);
    const float* k_k = p->in[12] + l * 1024; const float* k_a = p->in[13] + l * 1024;
    const int c0 = 16 * lane;
    for (int t = gw; t < M; t += NGW) { const size_t o = (size_t)t * 1024 + c0; float n2 = 0.f; f32x4 kkv[4], kr[4], av[4];
#pragma unroll
        for (int q = 0; q < 4; ++q) { kr[q] = *(const f32x4*)(KR + o + 4 * q); av[q] = *(const f32x4*)(A + o + 4 * q); kkv[q] = kr[q] * *(const f32x4*)(k_k + c0 + 4 * q);
            n2 += (kkv[q][0] * kkv[q][0] + kkv[q][1] * kkv[q][1]) + (kkv[q][2] * kkv[q][2] + kkv[q][3] * kkv[q][3]); }
        n2 = quad_sum(n2); const float inv = 1.0f / fmaxf(sqrtf(n2), 1e-12f);
#pragma unroll
        for (int q = 0; q < 4; ++q) { const f32x4 kk = kkv[q] * inv; const f32x4 ka = *(const f32x4*)(k_a + c0 + 4 * q);
            *(f32x4*)(KF + o + 4 * q) = kr[q] * (1.0f + (av[q] - 1.0f) * ka); *(f32x4*)(AN + o + 4 * q) = -kk; *(f32x4*)(BB + o + 4 * q) = kk * av[q]; }
    }
}

template <int MODE>
__device__ __forceinline__ void scan_task(KP p, int l, LAS unsigned char* wl, int c, int h, int lane) {
    constexpr int NPV = MODE == 0 ? 1 : (MODE == 1 ? 2 : 3);
    constexpr int SB = 4;
    LAS float* vec = (LAS float*)wl;
    LAS float* ybuf = (LAS float*)(wl + 7 * SB * 256);
    const float* DECp = (const float*)(p->ws + WS_DEC); const float* Ap = (const float*)(p->ws + WS_A); const bf16_t* PROJ = (const bf16_t*)(p->ws + WS_PROJ);
    const int rb = lane >> 2, cb = lane & 3, t0 = c * CL;
    f32x2 s[4][8];
    if (MODE == 0) {
#pragma unroll
        for (int r = 0; r < 4; ++r)
#pragma unroll
            for (int q = 0; q < 8; ++q) { s[r][q].x = (4 * rb + r == 16 * cb + 2 * q) ? 1.f : 0.f; s[r][q].y = (4 * rb + r == 16 * cb + 2 * q + 1) ? 1.f : 0.f; }
    } else if (MODE == 1) {
#pragma unroll
        for (int r = 0; r < 4; ++r)
#pragma unroll
            for (int q = 0; q < 8; ++q) s[r][q] = (f32x2){0.f, 0.f};
    } else {
        const float* SI = (const float*)(p->ws + WS_SI) + ((size_t)(h * NCH + c)) * 4096;
#pragma unroll
        for (int x = 0; x < 16; ++x) { const f32x4 v = *(const f32x4*)(SI + (16 * cb + x) * 64 + 4 * rb);
#pragma unroll
            for (int r = 0; r < 4; ++r) { if (x & 1) s[r][x >> 1].y = v[r]; else s[r][x >> 1].x = v[r]; } }
    }
    const int lst = lane >> 4, lq = lane & 15;
    const f32x4 kk4 = *(const f32x4*)(p->in[12] + l * 1024 + 64 * h + 4 * lq), ka4 = *(const f32x4*)(p->in[13] + l * 1024 + 64 * h + 4 * lq);
    f32x4 lnw4 = (f32x4){0.f, 0.f, 0.f, 0.f}, lnb4 = lnw4, rk4 = lnw4;
    if (MODE == 2) { lnw4 = *(const f32x4*)(p->in[15] + l * 1024 + 64 * h + 4 * lq); lnb4 = *(const f32x4*)(p->in[16] + l * 1024 + 64 * h + 4 * lq); rk4 = *(const f32x4*)(p->in[14] + l * 1024 + 64 * h + 4 * lq); }
    const size_t goff = (size_t)(t0 + lst) * 1024 + 64 * h + 4 * lq;
    const int pvo[3] = {1024, 2048, 0};
    f32x4 mu4[NPV];
#pragma unroll
    for (int v = 0; v < NPV; ++v) mu4[v] = *(const f32x4*)(p->in[6] + (size_t)l * RWC + pvo[v] + 64 * h + 4 * lq);
    const bf16_t* pj = PROJ + (size_t)(t0 + lst) * INCP + RW0 + 64 * h + 4 * lq;
    const float* Gp = (const float*)(p->ws + WS_G);
    struct Pre { f32x4 dec; u32x2 a, g; u32x2 cur[NPV], prv[NPV]; };
    Pre pA, pB;
#define SCAN_LOAD(P_, SBI) do { if ((SBI) < CL / SB) { const size_t ro = (size_t)(SB * (SBI)); P_.dec = *(const f32x4*)(DECp + goff + ro * 1024); P_.a = *(const u32x2*)((const bf16_t*)Ap + goff + ro * 1024); \
        if constexpr (MODE == 2) P_.g = *(const u32x2*)((const bf16_t*)Gp + goff + ro * 1024); \
        const bool first = (t0 + (int)ro + lst) == 0; \
        _Pragma("unroll") for (int v = 0; v < NPV; ++v) { P_.cur[v] = *(const u32x2*)(pj + ro * INCP + pvo[v]); P_.prv[v] = first ? (u32x2){0u, 0u} : *(const u32x2*)(pj + ro * INCP + pvo[v] - INCP); } } } while (0)
#define SCAN_SHIFT(P_, V) ({ const f32x4 c_ = (f32x4){bflo(P_.cur[V].x), bfhi(P_.cur[V].x), bflo(P_.cur[V].y), bfhi(P_.cur[V].y)}, q_ = (f32x4){bflo(P_.prv[V].x), bfhi(P_.prv[V].x), bflo(P_.prv[V].y), bfhi(P_.prv[V].y)}; c_ + (q_ - c_) * mu4[V]; })
#define SCAN_STAGE(P_) do { const f32x4 kr = SCAN_SHIFT(P_, 0), av = (f32x4){bflo(P_.a.x), bfhi(P_.a.x), bflo(P_.a.y), bfhi(P_.a.y)}; const f32x4 kkv = kr * kk4; \
        float n2 = (kkv[0] * kkv[0] + kkv[1] * kkv[1]) + (kkv[2] * kkv[2] + kkv[3] * kkv[3]); n2 = row16_sum(n2); \
        const float inv = __builtin_amdgcn_rsqf(fmaxf(n2, 1e-24f)); const f32x4 kkn = kkv * inv; \
        LAS float* vw = vec + lst * 64 + 4 * lq; \
        *(LAS f32x4*)(vw + 0 * SB * 64) = P_.dec; *(LAS f32x4*)(vw + 1 * SB * 64) = -kkn; *(LAS f32x4*)(vw + 2 * SB * 64) = kkn * av; \
        if constexpr (MODE != 0) { *(LAS f32x4*)(vw + 3 * SB * 64) = kr * (1.0f + (av - 1.0f) * ka4); *(LAS f32x4*)(vw + 4 * SB * 64) = SCAN_SHIFT(P_, 1); } \
        if constexpr (MODE == 2) { *(LAS f32x4*)(vw + 5 * SB * 64) = SCAN_SHIFT(P_, 2); *(LAS f32x4*)(vw + 6 * SB * 64) = (f32x4){bflo(P_.g.x), bfhi(P_.g.x), bflo(P_.g.y), bfhi(P_.g.y)}; } } while (0)
    SCAN_LOAD(pA, 0); SCAN_LOAD(pB, 1);
    float gam = 1.0f;
    LAS float* gbuf = ybuf + SB * 64;
    for (int sb = 0; sb < CL / SB; ++sb) {
        if (sb & 1) { SCAN_STAGE(pB); SCAN_LOAD(pB, sb + 2); } else { SCAN_STAGE(pA); SCAN_LOAD(pA, sb + 2); }
#pragma unroll
        for (int st = 0; st < SB; ++st) { const float w_ = vec[(0 * SB + st) * 64 + lane]; const float gprev = gam; gam *= w_; const float ginv = __builtin_amdgcn_rcpf(gam);
            vec[(1 * SB + st) * 64 + lane] *= gprev; vec[(2 * SB + st) * 64 + lane] *= ginv;
            if (MODE != 0) vec[(3 * SB + st) * 64 + lane] *= ginv;
            if (MODE == 2) vec[(5 * SB + st) * 64 + lane] *= gam; }
#pragma unroll 1
        for (int st = 0; st < SB; ++st) {
            const LAS float* vb = vec + st * 64 + 16 * cb;
            float sa[4];
            {   f32x2 a2[8];
#pragma unroll
                for (int q = 0; q < 4; ++q) { const f32x4 y = *(const LAS f32x4*)(vb + 1 * SB * 64 + 4 * q); a2[2 * q] = (f32x2){y[0], y[1]}; a2[2 * q + 1] = (f32x2){y[2], y[3]}; }
                f32x2 c0[4];
#pragma unroll
                for (int r = 0; r < 4; ++r) c0[r] = s[r][0] * a2[0];
#pragma unroll
                for (int q = 1; q < 8; ++q)
#pragma unroll
                    for (int r = 0; r < 4; ++r) c0[r] = s[r][q] * a2[q] + c0[r];
                float e[4];
#pragma unroll
                for (int r = 0; r < 4; ++r) e[r] = c0[r].x + c0[r].y;
#pragma unroll
                for (int r = 0; r < 4; ++r) e[r] += dpp_xor1(e[r]);
#pragma unroll
                for (int r = 0; r < 4; ++r) sa[r] = e[r] + dpp_xor2(e[r]); }
            f32x4 vv = (f32x4){0.f, 0.f, 0.f, 0.f};
            if (MODE != 0) vv = *(const LAS f32x4*)(vec + (4 * SB + st) * 64 + 4 * rb);
#pragma unroll
            for (int q = 0; q < 4; ++q) { const f32x4 b4 = *(const LAS f32x4*)(vb + 2 * SB * 64 + 4 * q);
                const f32x2 b0 = (f32x2){b4[0], b4[1]}, b1 = (f32x2){b4[2], b4[3]};
#pragma unroll
                for (int r = 0; r < 4; ++r) { s[r][2 * q] = b0 * sa[r] + s[r][2 * q]; s[r][2 * q + 1] = b1 * sa[r] + s[r][2 * q + 1]; }
                if (MODE != 0) { const f32x4 k4 = *(const LAS f32x4*)(vb + 3 * SB * 64 + 4 * q); const f32x2 k0 = (f32x2){k4[0], k4[1]}, k1 = (f32x2){k4[2], k4[3]};
#pragma unroll
                    for (int r = 0; r < 4; ++r) { s[r][2 * q] = k0 * vv[r] + s[r][2 * q]; s[r][2 * q + 1] = k1 * vv[r] + s[r][2 * q + 1]; } } }
            if (MODE == 2) {
                f32x2 r2[8];
#pragma unroll
                for (int q = 0; q < 4; ++q) { const f32x4 x = *(const LAS f32x4*)(vb + 5 * SB * 64 + 4 * q); r2[2 * q] = (f32x2){x[0], x[1]}; r2[2 * q + 1] = (f32x2){x[2], x[3]}; }
                f32x4 yv;
                f32x2 c0[4];
#pragma unroll
                for (int r = 0; r < 4; ++r) c0[r] = s[r][0] * r2[0];
#pragma unroll
                for (int q = 1; q < 8; ++q)
#pragma unroll
                    for (int r = 0; r < 4; ++r) c0[r] = s[r][q] * r2[q] + c0[r];
                float e[4];
#pragma unroll
                for (int r = 0; r < 4; ++r) e[r] = c0[r].x + c0[r].y;
#pragma unroll
                for (int r = 0; r < 4; ++r) e[r] += dpp_xor1(e[r]);
#pragma unroll
                for (int r = 0; r < 4; ++r) yv[r] = e[r] + dpp_xor2(e[r]);
                if (cb == 0) *(LAS f32x4*)(ybuf + st * 64 + 4 * rb) = yv;
            }
        }
        if ((sb & 15) == 15) {
            gbuf[lane] = gam; gam = 1.0f;
#pragma unroll
            for (int q = 0; q < 4; ++q) { const f32x4 g4 = *(const LAS f32x4*)(gbuf + 16 * cb + 4 * q); const f32x2 g0 = (f32x2){g4[0], g4[1]}, g1 = (f32x2){g4[2], g4[3]};
#pragma unroll
                for (int r = 0; r < 4; ++r) { s[r][2 * q] = s[r][2 * q] * g0; s[r][2 * q + 1] = s[r][2 * q + 1] * g1; } } }
        if (MODE == 2) {
            bf16_t* MIX = (bf16_t*)(p->ws + WS_MIX);
            const int t = t0 + SB * sb + lst; const LAS float* vr = vec + lst * 64 + 4 * lq;
            const f32x4 y = *(const LAS f32x4*)(ybuf + lst * 64 + 4 * lq), rr = *(const LAS f32x4*)(vr + 5 * SB * 64), kk = *(const LAS f32x4*)(vr + 3 * SB * 64),
                        vv = *(const LAS f32x4*)(vr + 4 * SB * 64), g = *(const LAS f32x4*)(vr + 6 * SB * 64);
            const float mean = row16_sum((y[0] + y[1]) + (y[2] + y[3])) * (1.0f / 64.0f);
            const f32x4 d = y - mean;
            const float var = row16_sum((d[0] * d[0] + d[1] * d[1]) + (d[2] * d[2] + d[3] * d[3])) * (1.0f / 64.0f);
            const f32x4 rkk = rr * kk * rk4;
            const float bon = row16_sum((rkk[0] + rkk[1]) + (rkk[2] + rkk[3]));
            const f32x4 o = (d * __builtin_amdgcn_rsqf(var + 64e-5f) * lnw4 + lnb4 + vv * bon) * g;
            u32x2 wv; wv.x = cvtpk(o[0], o[1]); wv.y = cvtpk(o[2], o[3]);
            *(u32x2*)(MIX + (size_t)t * DM + 1024 + 64 * h + 4 * lq) = wv;
        }
    }
    if (MODE == 0) { float* dst = (float*)(p->ws + WS_PB) + ((size_t)(h * NCH + c)) * 4096;
#pragma unroll
        for (int r = 0; r < 4; ++r)
#pragma unroll
            for (int q = 0; q < 4; ++q) *(f32x4*)(dst + (4 * rb + r) * 64 + 16 * cb + 4 * q) = (f32x4){s[r][2 * q].x, s[r][2 * q].y, s[r][2 * q + 1].x, s[r][2 * q + 1].y}; }
    if (MODE == 1) { float* dst = (float*)(p->ws + WS_UB) + ((size_t)(h * NCH + c)) * 4096;
#pragma unroll
        for (int x = 0; x < 16; ++x) { f32x4 v;
#pragma unroll
            for (int r = 0; r < 4; ++r) v[r] = (x & 1) ? s[r][x >> 1].y : s[r][x >> 1].x;
            *(f32x4*)(dst + (16 * cb + x) * 64 + 4 * rb) = v; } }
}

#undef SCAN_LOAD
#undef SCAN_SHIFT
#undef SCAN_STAGE
__device__ __forceinline__ void s2_head(KP p, LAS unsigned char* lds, int h, int ti, const int tid) {
    const float* PB = (const float*)(p->ws + WS_PB) + (size_t)h * NCH * 4096; const float* UT = (const float*)(p->ws + WS_UB) + (size_t)h * NCH * 4096;
    float* SI = (float*)(p->ws + WS_SI) + (size_t)h * NCH * 4096;
    const int lane = tid & 63, w = __builtin_amdgcn_readfirstlane(tid >> 6), n = lane & 31, lh = lane >> 5, to = (w >> 1) & 1, tj = w & 1;
    static_assert((NCH - 1) % 3 == 0, "three rotating prefetch buffers");
    if (w >= 4) {
        for (int c = 0; c < NCH - 1; ++c) __syncthreads();
    } else {
        f32x16 breg, ua, ub, uc2; float pa[16], pb[16], pc2[16];
#pragma unroll
        for (int r = 0; r < 16; ++r) breg[r] = 0.f;
        const int offu = (32 * to + 4 * lh) * 64 + 32 * ti + n, offp = (32 * tj + 4 * lh) * 64 + 32 * to + n, offs = (32 * tj + 4 * lh) * 64 + 32 * ti + n;
#define S2_LOAD(CH, U_, P_) do { const int ch_ = (CH) < NCH - 1 ? (CH) : NCH - 2; const float* pb_ = PB + (size_t)ch_ * 4096 + offp; const float* ub_ = UT + (size_t)ch_ * 4096 + offu; \
        _Pragma("unroll") for (int r = 0; r < 16; ++r) { const int cr = ((r & 3) + 8 * (r >> 2)) * 64; U_[r] = tj == 0 ? ub_[cr] : 0.f; P_[r] = pb_[cr]; } } while (0)
#define S2_STEP(C, UC_, PC_, UN_, PN_) do { \
        if (to == 0) { float* si = SI + (size_t)(C) * 4096 + offs; \
            _Pragma("unroll") for (int r = 0; r < 16; ++r) si[((r & 3) + 8 * (r >> 2)) * 64] = breg[r]; } \
        f32x16 acc = UC_; \
        _Pragma("unroll") for (int r = 0; r < 16; ++r) acc = __builtin_amdgcn_mfma_f32_32x32x2f32(PC_[r], breg[r], acc, 0, 0, 0); \
        LAS f32x4* ex = (LAS f32x4*)(lds + ((C) & 1) * 16384); \
        _Pragma("unroll") for (int q = 0; q < 4; ++q) ex[(w * 4 + q) * 64 + lane] = (f32x4){acc[4 * q], acc[4 * q + 1], acc[4 * q + 2], acc[4 * q + 3]}; \
        __syncthreads(); \
        S2_LOAD((C) + 2, UN_, PN_); \
        _Pragma("unroll") for (int q = 0; q < 4; ++q) { const f32x4 v0 = ex[((tj * 2) * 4 + q) * 64 + lane], v1 = ex[((tj * 2 + 1) * 4 + q) * 64 + lane]; \
            breg[4 * q] = v0[0] + v1[0]; breg[4 * q + 1] = v0[1] + v1[1]; breg[4 * q + 2] = v0[2] + v1[2]; breg[4 * q + 3] = v0[3] + v1[3]; } } while (0)
        S2_LOAD(0, ua, pa); S2_LOAD(1, ub, pb);
#pragma unroll 1
        for (int c = 0; c < NCH - 1; c += 3) {
            S2_STEP(c, ua, pa, uc2, pc2);
            S2_STEP(c + 1, ub, pb, ua, pa);
            S2_STEP(c + 2, uc2, pc2, ub, pb);
        }
        if (to == 0) { float* si = SI + (size_t)(NCH - 1) * 4096 + offs;
#pragma unroll
            for (int r = 0; r < 16; ++r) si[((r & 3) + 8 * (r >> 2)) * 64] = breg[r]; }
#undef S2_LOAD
#undef S2_STEP
    }
    __syncthreads();
}

template <int DV, bool SWA>
__device__ __forceinline__ void attn_unit(LAS unsigned char* lds, const bf16_t* Q, const bf16_t* Kp, const bf16_t* VT, float slope2, int q0, float sink2,
                                          float* Of32, float* MLp, bf16_t* Obf, const int tid, int kt_lo, int kt_hi, float kn) {
    constexpr int KROW = 144, KTILE = 64 * KROW, VTILE = DV * KROW, BUF = KTILE + VTILE, NVL = DV / 64;
    const int lane = tid & 63, w = __builtin_amdgcn_readfirstlane(tid >> 6), r32 = lane & 31, hi = lane >> 5;
    const int qpos = q0 + 32 * w + r32;
    bf16x8 qf[4];
#pragma unroll
    for (int j = 0; j < 4; ++j) qf[j] = *(const bf16x8*)(Q + (size_t)qpos * INCP + 16 * j + 8 * hi);
    int kt0 = kt_lo, kt1 = kt_hi;
    if (!SWA) {
        float qq = 0.f, qk = 0.f;
#pragma unroll
        for (int j = 0; j < 4; ++j) { const bf16x8 kf = *(const bf16x8*)(Kp + (size_t)qpos * INCP + 16 * j + 8 * hi);
#pragma unroll
            for (int e = 0; e < 8; ++e) { const float qv = bf2f((unsigned short)qf[j][e]), kv = bf2f((unsigned short)kf[e]); qq += qv * qv; qk += qv * kv; } }
        qq = xor32_sum(qq); qk = xor32_sum(qk);
        const float dneed = (sqrtf(qq) * kn - qk + 45.0f) / slope2;
        float kneed = (float)qpos - dneed;
        kneed = fminf(kneed, dppm<0xB1>(kneed)); kneed = fminf(kneed, dppm<0x4E>(kneed)); kneed = fminf(kneed, dppm<0x141>(kneed)); kneed = fminf(kneed, dppm<0x140>(kneed));
        LAS float* red = (LAS float*)(lds + 2 * BUF);
        if ((lane & 15) == 0) red[w * 4 + (lane >> 4)] = kneed;
        __syncthreads();
        float km = red[0];
#pragma unroll
        for (int i = 1; i < 32; ++i) km = fminf(km, red[i]);
        const int ktw = km <= 0.f ? 0 : ((int)km >> 6);
        kt0 = ktw > kt_lo ? ktw : kt_lo;
    }
    const int qlo = q0 + 32 * w, qhi = qlo + 31;
    f32x16 o[DV / 32];
#pragma unroll
    for (int d = 0; d < DV / 32; ++d)
#pragma unroll
        for (int r = 0; r < 16; ++r) o[d][r] = 0.f;
    float mrun = 0.f, lsum = 0.f;
    const int krow = tid >> 3, kch = tid & 7;
    u32x4 kreg, vreg[NVL];
    if (kt0 <= kt1) {   const int k0 = 64 * kt0; kreg = *(const u32x4*)(Kp + (size_t)(k0 + krow) * INCP + 8 * kch);
#pragma unroll
        for (int i = 0; i < NVL; ++i) { const int idx = tid + 512 * i; vreg[i] = *(const u32x4*)(VT + (size_t)(idx >> 3) * M + k0 + 8 * (idx & 7)); } }
    for (int kt = kt0; kt <= kt1; ++kt) {
        LAS unsigned char* buf = lds + ((kt - kt0) & 1) * BUF;
        *(LAS u32x4*)(buf + krow * KROW + 16 * kch) = kreg;
#pragma unroll
        for (int i = 0; i < NVL; ++i) { const int idx = tid + 512 * i; *(LAS u32x4*)(buf + KTILE + (idx >> 3) * KROW + 16 * (idx & 7)) = vreg[i]; }
        __syncthreads();
        if (kt < kt1) { const int k0 = 64 * (kt + 1); kreg = *(const u32x4*)(Kp + (size_t)(k0 + krow) * INCP + 8 * kch);
#pragma unroll
            for (int i = 0; i < NVL; ++i) { const int idx = tid + 512 * i; vreg[i] = *(const u32x4*)(VT + (size_t)(idx >> 3) * M + k0 + 8 * (idx & 7)); } }
        const int k0 = 64 * kt;
        bool act = k0 <= qhi; if (SWA) act = act && (k0 + 63 >= qlo - 127);
        if (act) {
            f32x16 p0, p1;
            {   const float c0 = slope2 * (float)(k0 + 4 * hi - qpos) - mrun, c1 = c0 + 32.0f * slope2;
#pragma unroll
                for (int r = 0; r < 16; ++r) { const float cr = (float)((r & 3) + 8 * (r >> 2)); p0[r] = __builtin_fmaf(slope2, cr, c0); p1[r] = __builtin_fmaf(slope2, cr, c1); } }
#pragma unroll
            for (int j = 0; j < 4; ++j) { const bf16x8 a0 = *(const LAS bf16x8*)(buf + r32 * KROW + 32 * j + 16 * hi), a1 = *(const LAS bf16x8*)(buf + (r32 + 32) * KROW + 32 * j + 16 * hi);
                p0 = __builtin_amdgcn_mfma_f32_32x32x16_bf16(a0, qf[j], p0, 0, 0, 0); p1 = __builtin_amdgcn_mfma_f32_32x32x16_bf16(a1, qf[j], p1, 0, 0, 0); }
            bool need_mask = k0 + 63 > qlo; if (SWA) need_mask = need_mask || (qhi - k0 >= 128);
            if (need_mask) {
#pragma unroll
                for (int r = 0; r < 16; ++r) { const int kv = k0 + (r & 3) + 8 * (r >> 2) + 4 * hi; const int d0 = qpos - kv, d1 = d0 - 32;
                    bool ok0 = d0 >= 0, ok1 = d1 >= 0; if (SWA) { ok0 = ok0 && d0 < 128; ok1 = ok1 && d1 < 128; }
                    p0[r] = ok0 ? p0[r] : -1e30f; p1[r] = ok1 ? p1[r] : -1e30f; } }
            float mx = fmaxf(p0[0], p1[0]);
#pragma unroll
            for (int r = 1; r < 16; ++r) mx = fmaxf(mx, fmaxf(p0[r], p1[r]));
            mx = xor32_max(mx);
            if (__builtin_amdgcn_ballot_w64(mx > 8.0f) != 0ull) {
                const float d = fmaxf(mx, 0.f), f = __builtin_amdgcn_exp2f(-d); mrun += d; lsum *= f;
#pragma unroll
                for (int r = 0; r < 16; ++r) { p0[r] -= d; p1[r] -= d; }
#pragma unroll
                for (int dd = 0; dd < DV / 32; ++dd)
#pragma unroll
                    for (int r = 0; r < 16; ++r) o[dd][r] *= f; }
            float rs = 0.f;
#pragma unroll
            for (int r = 0; r < 16; ++r) { p0[r] = __builtin_amdgcn_exp2f(p0[r]); p1[r] = __builtin_amdgcn_exp2f(p1[r]); rs += p0[r] + p1[r]; }
            lsum += rs;
            u32x4 pw[4];
            pw[0] = (u32x4){cvtpk(p0[0], p0[1]), cvtpk(p0[2], p0[3]), cvtpk(p0[4], p0[5]), cvtpk(p0[6], p0[7])};
            pw[1] = (u32x4){cvtpk(p0[8], p0[9]), cvtpk(p0[10], p0[11]), cvtpk(p0[12], p0[13]), cvtpk(p0[14], p0[15])};
            pw[2] = (u32x4){cvtpk(p1[0], p1[1]), cvtpk(p1[2], p1[3]), cvtpk(p1[4], p1[5]), cvtpk(p1[6], p1[7])};
            pw[3] = (u32x4){cvtpk(p1[8], p1[9]), cvtpk(p1[10], p1[11]), cvtpk(p1[12], p1[13]), cvtpk(p1[14], p1[15])};
#pragma unroll
            for (int d = 0; d < DV / 32; ++d)
#pragma unroll
                for (int j = 0; j < 4; ++j) { const bf16x8 vf = *(const LAS bf16x8*)(buf + KTILE + (32 * d + r32) * KROW + 32 * j + 16 * hi);
                    o[d] = __builtin_amdgcn_mfma_f32_32x32x16_bf16(vf, __builtin_bit_cast(bf16x8, pw[j]), o[d], 0, 0, 0); }
        }
    }
    lsum = xor32_sum(lsum);
    if (SWA) { lsum += __builtin_amdgcn_exp2f(sink2 - mrun);
        const float inv = 1.0f / lsum; bf16_t* op = Obf + (size_t)qpos * DM;
#pragma unroll
        for (int d = 0; d < DV / 32; ++d)
#pragma unroll
            for (int g = 0; g < 4; ++g) { u32x2 wv; wv.x = cvtpk(o[d][4 * g] * inv, o[d][4 * g + 1] * inv); wv.y = cvtpk(o[d][4 * g + 2] * inv, o[d][4 * g + 3] * inv);
                *(u32x2*)(op + 32 * d + 8 * g + 4 * hi) = wv; }
    } else if (kt0 > kt1) {
        if (hi == 0) *(f32x2*)(MLp + (size_t)qpos * 16) = (f32x2){-1e30f, 0.f};
    } else { float* op = Of32 + (size_t)qpos * 1024;
#pragma unroll
        for (int d = 0; d < DV / 32; ++d)
#pragma unroll
            for (int g = 0; g < 4; ++g) *(f32x4*)(op + 32 * d + 8 * g + 4 * hi) = (f32x4){o[d][4 * g], o[d][4 * g + 1], o[d][4 * g + 2], o[d][4 * g + 3]};
        if (hi == 0) *(f32x2*)(MLp + (size_t)qpos * 16) = (f32x2){mrun, lsum};
    }
    __syncthreads();
}

__device__ __forceinline__ void phase_diffcombine(KP p, int l, int gw, int NGW, int lane) {
    const float* lamv = p->in[3] + l * 256;
    const float lambda_init = 0.8f - 0.6f * expf(-0.3f * (float)l);
    const float s1 = wave_sum(lamv[lane] * lamv[64 + lane]), s2 = wave_sum(lamv[128 + lane] * lamv[192 + lane]);
    const float lam = expf(s1) - expf(s2) + lambda_init;
    const float* OD = (const float*)(p->ws + WS_OD); const float* ML = (const float*)(p->ws + WS_ML); bf16_t* MIX = (bf16_t*)(p->ws + WS_MIX);
    const int h = lane >> 4, d0 = (lane & 15) * 8;
    const f32x4 g0 = *(const f32x4*)(p->in[4] + l * 128 + d0), g1 = *(const f32x4*)(p->in[4] + l * 128 + d0 + 4);
    for (int t = gw; t < M; t += NGW) { const int nseg = ((t >> 8) + 8) >> 3;
        f32x4 oc[2][2];
#pragma unroll
        for (int c = 0; c < 2; ++c) {
            f32x2 ml[4]; float mm = -1e30f;
#pragma unroll
            for (int s = 0; s < 4; ++s) if (s < nseg) { ml[s] = *(const f32x2*)(ML + ((size_t)s * M + t) * 16 + h * 4 + c * 2); mm = fmaxf(mm, ml[s].x); }
            f32x4 a0 = (f32x4){0.f, 0.f, 0.f, 0.f}, a1 = a0; float L = 0.f;
#pragma unroll
            for (int s = 0; s < 4; ++s) if (s < nseg && ml[s].x > -1e29f) { const float f = exp2f(ml[s].x - mm); L += ml[s].y * f;
                const float* b = OD + ((size_t)s * M + t) * 1024 + h * 256 + c * 128 + d0; a0 += *(const f32x4*)b * f; a1 += *(const f32x4*)(b + 4) * f; }
            const float inv = 1.0f / L; oc[c][0] = a0 * inv; oc[c][1] = a1 * inv; }
        const f32x4 o0 = oc[0][0] - oc[1][0] * lam, o1 = oc[0][1] - oc[1][1] * lam;
        float ss = (o0[0] * o0[0] + o0[1] * o0[1]) + (o0[2] * o0[2] + o0[3] * o0[3]) + (o1[0] * o1[0] + o1[1] * o1[1]) + (o1[2] * o1[2] + o1[3] * o1[3]);
        ss = row16_sum(ss);
        const float r = rsqrtf(ss * (1.0f / 128.0f) + EPS) * (1.0f - lambda_init);
        const f32x4 y0 = o0 * g0 * r, y1 = o1 * g1 * r;
        u32x4 wv; wv.x = cvtpk(y0[0], y0[1]); wv.y = cvtpk(y0[2], y0[3]); wv.z = cvtpk(y1[0], y1[1]); wv.w = cvtpk(y1[2], y1[3]);
        *(u32x4*)(MIX + (size_t)t * DM + h * 128 + d0) = wv; }
}

#define XB_TMO      128
#define XB_XCNT(j)  (256  + 64 * (j))
#define XB_XSUB(j)  (1280 + 64 * (j))
#define XB_XGEN(j)  (2304 + 64 * (j))
#define XB_TOP      3328
#define XB_TOPGEN   3392
#define XCD_BAR_WORDS 3456
#define XB_SPIN_CAP (1u << 22)
__device__ __forceinline__ unsigned xb_ld(unsigned* p)              { return __hip_atomic_load(p, __ATOMIC_RELAXED, __HIP_MEMORY_SCOPE_AGENT); }
__device__ __forceinline__ unsigned xb_add(unsigned* p, unsigned v) { return __hip_atomic_fetch_add(p, v, __ATOMIC_RELAXED, __HIP_MEMORY_SCOPE_AGENT); }
__device__ __forceinline__ unsigned xb_xcc_id() { return (unsigned)__builtin_amdgcn_s_getreg((3 << 11) | 20) & 0xFu; }
#define XB_SPIN(cond, bar) do { unsigned _sp = 0; while (cond) { __builtin_amdgcn_s_sleep(1); \
    if ((++_sp & 255u) == 0u) { if (xb_ld(&(bar)[XB_TMO])) break; if (_sp > XB_SPIN_CAP) { atomicAdd(&(bar)[XB_TMO], 1u); break; } } } } while (0)
__device__ __forceinline__ void xcd_barrier_complete(unsigned* bar, unsigned x, unsigned& nloc, unsigned& nx) {
    const unsigned G = gridDim.x;
    unsigned sum, cnt, mine, sp = 0u;
    for (;;) {
        sum = 0u; cnt = 0u; mine = 0u;
#pragma unroll
        for (unsigned j = 0; j < 16; ++j) { const unsigned c = xb_ld(&bar[XB_XCNT(j)]); sum += c; cnt += (c > 0u) ? 1u : 0u; mine = (j == x) ? c : mine; }
        if (sum == G) break;
        __builtin_amdgcn_s_sleep(1);
        if ((++sp & 255u) == 0u) { if (xb_ld(&bar[XB_TMO])) break; if (sp > XB_SPIN_CAP) { atomicAdd(&bar[XB_TMO], 1u); break; } }
    }
    nloc = mine > 0u ? mine : 1u; nx = cnt > 0u ? cnt : 1u;
}
__device__ __forceinline__ void xcd_barrier(unsigned* bar, volatile LAS unsigned* st, const int tid) {
    asm volatile("s_waitcnt vmcnt(0)" ::: "memory");
    __syncthreads();
    if (tid == 0) {
        const unsigned x = xb_xcc_id();
        __builtin_amdgcn_s_waitcnt(0);
        unsigned nloc = st[0], nx = st[1];
        if (nloc == 0u) { xcd_barrier_complete(bar, x, nloc, nx); st[0] = nloc; st[1] = nx; }
        const unsigned old = xb_add(&bar[XB_XSUB(x)], 1u);
        const unsigned gen = old / nloc;
        if (old + 1u == (gen + 1u) * nloc) {
            __builtin_amdgcn_fence(__ATOMIC_RELEASE, "agent");
            asm volatile("s_waitcnt vmcnt(0)" ::: "memory");
            const unsigned og = xb_add(&bar[XB_TOP], 1u);
            const unsigned tg = og / nx;
            if (og + 1u == (tg + 1u) * nx) xb_add(&bar[XB_TOPGEN], 1u);
            else XB_SPIN(xb_ld(&bar[XB_TOPGEN]) == tg, bar);
            __builtin_amdgcn_fence(__ATOMIC_ACQUIRE, "agent");
            xb_add(&bar[XB_XGEN(x)], 1u);
            asm volatile("s_waitcnt vmcnt(0)" ::: "memory");
        } else {
            XB_SPIN(xb_ld(&bar[XB_XGEN(x)]) == gen, bar);
            __builtin_amdgcn_fence(__ATOMIC_ACQUIRE, "agent");
            asm volatile("s_waitcnt vmcnt(0)" ::: "memory");
        }
    }
    __syncthreads();
}

#ifndef DUPBAR
#define DUPBAR 1
#endif
#define GSYNC() do { FRESH(); for (int rb_ = 0; rb_ < DUPBAR; ++rb_) xcd_barrier((unsigned*)(p->ws + WS_CTL) + 4096, (volatile LAS unsigned*)(lds + LDS_BYTES - 32), tid); } while (0)
#define PTRS() unsigned* ctl = (unsigned*)(p->ws + WS_CTL); bf16_t* XB = (bf16_t*)(p->ws + WS_XB); bf16_t* PROJ = (bf16_t*)(p->ws + WS_PROJ); bf16_t* MIX = (bf16_t*)(p->ws + WS_MIX); bf16_t* H = (bf16_t*)(p->ws + WS_H); \
    float* ssqA = (float*)(p->ws + WS_SSQA); float* ssqB = (float*)(p->ws + WS_SSQB); unsigned char* wb = p->ws + WS_W + (size_t)l * LW_STRIDE; (void)ctl; (void)XB; (void)PROJ; (void)MIX; (void)H; (void)ssqA; (void)ssqB; (void)wb
#define FRESH() KP p = fresh_params(); int G = gridDim.x, bx = blockIdx.x; asm volatile("" : "+s"(G), "+s"(bx)); const int NGW = G * 8; (void)NGW; const int tid = fresh_tid(wave0), lane = tid & 63, wave = __builtin_amdgcn_readfirstlane(tid >> 6), gw = bx * 8 + wave; (void)lane; (void)gw
template <int L> __device__ __forceinline__ void layer_body(LAS unsigned char* lds, const int wave0) {
    constexpr int l = L;

#ifndef DUP1
#define DUP1 1
#endif
        for (int rep = 0; rep < DUP1; ++rep) {   if (rep) GSYNC(); FRESH(); PTRS(); pg8::Gemm g{XB, (const bf16_t*)(wb + LW_WIN), M, INCP, DM}; pg8::StaticOrder S; S.init(M, INCP, G, bx);
            pg8::EpiProj E{PROJ, INCP, ssqA};
            pg8::gemm_phase<pg8::EpiProj, pg8::StaticOrder, true, true>(lds, g, S, E, tid); }
        GSYNC();
#ifndef DUP234
#define DUP234 1
#endif
        for (int rep = 0; rep < DUP234; ++rep) { if (rep) GSYNC(); FRESH(); phase_prep1(p, l, lds, gw, NGW, wave, lane); }
        GSYNC();
        {   FRESH(); PTRS(); pg8::Gemm g{(const bf16_t*)(p->ws + WS_AW), (const bf16_t*)(wb + LW_W2T), M, 1024, 128}; pg8::StaticOrder S; S.init(M, 1024, G, bx);
            pg8::EpiLora<0> E{(float*)(p->ws + WS_DEC), p->in[7] + l * 1024};
            pg8::gemm_phase<pg8::EpiLora<0>, pg8::StaticOrder, true, true>(lds, g, S, E, tid); }
        {   FRESH(); PTRS(); pg8::Gemm g{(const bf16_t*)(p->ws + WS_AA), (const bf16_t*)(wb + LW_A2T), M, 1024, 128}; pg8::StaticOrder S; S.init(M, 1024, G, (bx + 128) % G);
            pg8::EpiLora<1> E{(float*)(p->ws + WS_A), p->in[9] + l * 1024};
            pg8::gemm_phase<pg8::EpiLora<1>, pg8::StaticOrder, true, true>(lds, g, S, E, tid); }
        {   FRESH(); PTRS(); pg8::Gemm g{(const bf16_t*)(p->ws + WS_AG), (const bf16_t*)(wb + LW_G2T), M, 1024, 256}; pg8::StaticOrder S; S.init(M, 1024, G, (bx + 128) % G);
            pg8::EpiLora<2> E{(float*)(p->ws + WS_G), nullptr};
            pg8::gemm_phase<pg8::EpiLora<2>, pg8::StaticOrder, true, true>(lds, g, S, E, tid); }
        GSYNC();
        {   FRESH(); LAS unsigned char* wl = lds + wave * 14336;
#ifndef DUP57
#define DUP57 1
#endif
#ifndef DUP5
#define DUP5 1
#endif
            for (int rep = 0; rep < DUP57 * DUP5; ++rep) for (int it = gw; it < 2 * NCH * 16; it += NGW) { const int mode = it & 1, ch = it >> 1, c = ch % NCH, h = ch / NCH;
                if (mode == 0) scan_task<0>(p, l, wl, c, h, lane); else scan_task<1>(p, l, wl, c, h, lane); } }
        GSYNC();
#ifndef DUP6
#define DUP6 1
#endif
        for (int rep = 0; rep < DUP6; ++rep) {   if (rep) GSYNC(); FRESH(); PTRS(); LAS int* slot = (LAS int*)(lds + LDS_BYTES - 64);
            LAS float* knl = (LAS float*)(lds + LDS_BYTES - 128);
            {   LAS float* kr = (LAS float*)lds; const float* knp = (const float*)(p->ws + WS_KNP); const int g = tid & 7, part = tid >> 3; float m = 0.f;
                for (int b2 = part; b2 < G; b2 += 64) m = fmaxf(m, knp[(size_t)b2 * 8 + g]);
                kr[part * 8 + g] = m; __syncthreads();
                if (tid < 8) { float mm = kr[tid]; for (int q2 = 1; q2 < 64; ++q2) mm = fmaxf(mm, kr[q2 * 8 + tid]); knl[tid] = mm; }
                __syncthreads(); }
            const float* sinks = p->in[5] + l * 8;
            for (;;) {
                if (tid == 0) *slot = (int)atomicAdd(ctl + 64 * (l + 1) + 16 * rep, 1u);
                __syncthreads();
                const int it = *slot;
                __syncthreads();
                if (it >= 928) break;
                if (it < 32) {
#ifndef NO_S2
                    s2_head(p, lds, it >> 1, it & 1, tid);
#endif
                }
                else if (it < 672) { const int d = it - 32, h = 3 - d / 160, u = d % 160, c = u & 1, v = u >> 1; int qb, seg;
                    if (v < 32) { qb = 31 - (v >> 2); seg = v & 3; } else if (v < 56) { const int w2 = v - 32; qb = 23 - w2 / 3; seg = w2 % 3; }
                    else if (v < 72) { const int w2 = v - 56; qb = 15 - (w2 >> 1); seg = w2 & 1; } else { qb = 79 - v; seg = 0; }
                    const float slope2 = exp2f(-2.0f * (float)(h + 1)) * LOG2E;
                    const float kn = sqrtf(knl[h * 2 + c]);
                    const int kt1 = 4 * qb + 3, klo = 32 * seg, khi = (klo + 31 < kt1) ? klo + 31 : kt1;
                    attn_unit<128, false>(lds, PROJ + h * 128 + c * 64, PROJ + 512 + h * 128 + c * 64, (const bf16_t*)(p->ws + WS_VAT) + (size_t)(h * 128) * M, slope2, qb * 256, 0.f,
                                          (float*)(p->ws + WS_OD) + (size_t)seg * M * 1024 + h * 256 + c * 128, (float*)(p->ws + WS_ML) + (size_t)seg * M * 16 + h * 4 + c * 2, nullptr, tid, klo, khi, kn); }
                else { const int s = it - 672, hq = s & 7, qb = s >> 3;
                    const int aidx = (hq >> 1) * 3 + (hq & 1);
                    const float slope2 = exp2f(-8.0f * (float)(aidx + 1) / 12.0f) * LOG2E;
                    const int q0 = qb * 256;
                    attn_unit<64, true>(lds, PROJ + 1536 + hq * 64, PROJ + 2048 + (hq >> 2) * 64, (const bf16_t*)(p->ws + WS_VBT) + (size_t)((hq >> 2) * 64) * M, slope2, q0, sinks[hq] * LOG2E,
                                        nullptr, nullptr, MIX + 512 + hq * 64, tid, q0 >= 128 ? (q0 - 128) / 64 : 0, (q0 + 255) / 64, 0.f); }
            } }
        GSYNC();
        {   FRESH();
            if (wave < 4) {
                LAS unsigned char* wl = lds + wave * 14336;
                for (int rep = 0; rep < DUP57; ++rep) for (int it = bx * 4 + wave; it < NCH * 16; it += G * 4) { const int c = it % NCH, h = it / NCH; scan_task<2>(p, l, wl, c, h, lane); }
            } else {
                phase_diffcombine(p, l, bx * 4 + (wave - 4), G * 4, lane);
                if (l + 1 < NL) { LAS float* scr = (LAS float*)(lds + 4 * 14336 + (wave - 4) * 8448);
                    for (int r = bx * 4 + (wave - 4); r < CONV_ITEMS; r += G * 4) convert_item(p, l + 1 < NL ? l + 1 : l, r, scr, lane); }
            } }
        GSYNC();
        {   FRESH(); PTRS(); pg8::Gemm g{MIX, (const bf16_t*)(wb + LW_WOUT), M, DM, DM}; pg8::StaticOrder S; S.init(M, DM, G, bx);
            pg8::EpiResid E{p->out, XB, ssqB};
            pg8::gemm_phase<pg8::EpiResid, pg8::StaticOrder, true, true>(lds, g, S, E, tid); }
        GSYNC();
        for (int rep = 0; rep < DUP1; ++rep) {   if (rep) GSYNC(); FRESH(); PTRS(); pg8::Gemm g{XB, (const bf16_t*)(wb + LW_WGU), M, GU, DM}; pg8::StaticOrder S; S.init(M, GU, G, bx);
            pg8::EpiSwiGLU E{H, ssqB};
            pg8::gemm_phase<pg8::EpiSwiGLU, pg8::StaticOrder, true, true>(lds, g, S, E, tid); }
        GSYNC();
        {   FRESH(); PTRS(); pg8::Gemm g{H, (const bf16_t*)(wb + LW_WDN), M, DM, FF}; pg8::StaticOrder S; S.init(M, DM, G, bx);
            pg8::EpiResid E{p->out, XB, ssqA};
            pg8::gemm_phase<pg8::EpiResid, pg8::StaticOrder, true, true>(lds, g, S, E, tid); }
        GSYNC();
    }

__global__ void __launch_bounds__(512, 2) fwd_megakernel(Params p_unused) {
    extern __shared__ __attribute__((aligned(16))) unsigned char lds_raw[];
    LAS unsigned char* lds = (LAS unsigned char*)lds_raw;
    cg::grid_group grid = cg::this_grid();
    const int wave0 = __builtin_amdgcn_readfirstlane((int)threadIdx.x >> 6);
    if (threadIdx.x < 16) ((LAS unsigned*)(lds + LDS_BYTES - 64))[threadIdx.x] = 0u;
    if (threadIdx.x == 0) xb_add((unsigned*)(p_unused.ws + WS_CTL) + 4096 + XB_XCNT(xb_xcc_id()), 1u);
    __syncthreads();

#ifndef DUP0
#define DUP0 1
#endif
    for (int rep = 0; rep < DUP0; ++rep) { FRESH(); phase0(p, lds, gw, NGW, wave, lane); __syncthreads(); }
    grid.sync();

    layer_body<0>(lds, wave0); layer_body<1>(lds, wave0); layer_body<2>(lds, wave0); layer_body<3>(lds, wave0);
    {   FRESH(); const int l = 0; PTRS(); const float* gf = p->in[21];
        for (int m = gw; m < M; m += NGW) { const float rs = rsqrtf(wave_sum(lane < 32 ? ssqA[(size_t)m * 32 + lane] : 0.f) * (1.0f / DM) + EPS);
#pragma unroll
            for (int j = 0; j < 8; ++j) { const size_t o = (size_t)m * DM + j * 256 + lane * 4; const f32x4 v = *(const f32x4*)(p->out + o); const f32x4 gv = *(const f32x4*)(gf + j * 256 + lane * 4);
                *(f32x4*)(p->out + o) = v * rs * gv; } } }
}

extern "C" void kernel_launch(void* const* d_in, const int* in_sizes, int n_in, void* d_out, int out_size, void* d_ws, size_t ws_size, hipStream_t stream) {
    static int grid = 0;
    if (grid == 0) {
        if (n_in != 22 || out_size != M * DM || ws_size < WS_END) { fprintf(stderr, "kernel_launch: unexpected shapes (n_in %d out %d ws %zu need %zu)\n", n_in, out_size, ws_size, (size_t)WS_END); grid = -1; return; }
        int dev = 0, cus = 0, per_cu = 0;
        hipGetDevice(&dev); hipDeviceGetAttribute(&cus, hipDeviceAttributeMultiprocessorCount, dev);
        hipFuncSetAttribute((const void*)fwd_megakernel, hipFuncAttributeMaxDynamicSharedMemorySize, LDS_BYTES);
        hipOccupancyMaxActiveBlocksPerMultiprocessor(&per_cu, (const void*)fwd_megakernel, 512, LDS_BYTES);
        if (per_cu < 1) { fprintf(stderr, "kernel_launch: occupancy query says %d blocks per CU\n", per_cu); per_cu = 1; }
        (void)hipGetLastError();
        grid = cus;
    }
    if (grid < 0) return;
    hipMemsetAsync((char*)d_ws + WS_CTL, 0, 65536, stream);
    Params p{};
    for (int i = 0; i < 22; ++i) p.in[i] = (const float*)d_in[i];
    p.out = (float*)d_out; p.ws = (unsigned char*)d_ws;
    void* args[] = {&p};
    hipError_t e = hipLaunchCooperativeKernel((const void*)fwd_megakernel, dim3(grid), dim3(512), args, LDS_BYTES, stream);
    if (e != hipSuccess) fprintf(stderr, "cooperative launch failed: %s (grid %d)\n", hipGetErrorString(e), grid);
}
```
